# Optimizing an MI355X kernel written in HIP

```python
import math
import jax, jax.numpy as jnp
from jax import lax
import numpy as np

D_MODEL = 2048
BATCH = 1
SEQ = 8192
DEPTH = 2

D_MIX = D_MODEL
GROUP = D_MIX // 4
EPS = 1e-6

A_HEADS = 4
A_CH = GROUP // A_HEADS
A_CHUNK = 128
A_IN = 2 * GROUP

B_HEADS = 8
B_HD = GROUP // B_HEADS
B_W_RANK = 32
B_A_RANK = 32
B_G_RANK = 96
B_LNX_EPS = 64e-5
B_IN = 3 * GROUP + B_W_RANK + B_A_RANK + B_G_RANK
B_SPLITS = [GROUP, 2 * GROUP, 3 * GROUP, 3 * GROUP + B_W_RANK, 3 * GROUP + B_W_RANK + B_A_RANK]

C_HEADS = 8
C_HD = GROUP // C_HEADS
C_BLOCK = 256
C_TOPK = 3
C_QBLOCK = 128
ROPE_THETA = 10000.0
C_IN = 3 * GROUP

D_HEADS = 4
D_DK = 64
D_DV = GROUP // D_HEADS
D_GATE_RANK = 16
D_GATE_TEMP = 16.0
D_CHUNK = 64
D_IN = 2 * D_HEADS * D_DK + GROUP + D_GATE_RANK + GROUP
D_SPLITS = [D_HEADS * D_DK, 2 * D_HEADS * D_DK, 2 * D_HEADS * D_DK + GROUP, 2 * D_HEADS * D_DK + GROUP + D_GATE_RANK]

N_IN = A_IN + B_IN + C_IN + D_IN
IN_SPLITS = [A_IN, A_IN + B_IN, A_IN + B_IN + C_IN]

D_FF = 5632
CONV_W = 3

kernel_name = "hymba_style_gmlp_rwkv7_moba_gla_convffn"

F32 = jnp.float32


def _rmsnorm(x, g):
    xf = x.astype(F32)
    y = xf * lax.rsqrt(jnp.mean(xf * xf, axis=-1, keepdims=True) + EPS)
    return (y * g.astype(F32)).astype(x.dtype)


def _rope(x, pos):
    half = x.shape[-1] // 2
    inv = ROPE_THETA ** (-jnp.arange(half, dtype=F32) / half)
    ang = pos.astype(F32)[:, None] * inv[None, :]
    cos = jnp.cos(ang)[None, :, None, :]
    sin = jnp.sin(ang)[None, :, None, :]
    x1, x2 = x[..., :half], x[..., half:]
    return jnp.concatenate([x1 * cos - x2 * sin, x1 * sin + x2 * cos], axis=-1)


def _gmlp_mixer(p, ln_g, ln_b, ws, bs):
    b, s, _ = p.shape
    z = jax.nn.gelu(p.astype(F32))
    u, v = jnp.split(z, 2, axis=-1)
    mu = jnp.mean(v, axis=-1, keepdims=True)
    var = jnp.mean(jnp.square(v - mu), axis=-1, keepdims=True)
    v = (v - mu) * lax.rsqrt(var + EPS) * ln_g + ln_b
    v = v.reshape(b, s // A_CHUNK, A_CHUNK, A_HEADS, A_CH)
    causal = jnp.tril(jnp.ones((A_CHUNK, A_CHUNK), dtype=bool))
    w_s = jnp.where(causal[None], ws.astype(F32), 0.0)
    mixed = jnp.einsum("hts,bnshc->bnthc", w_s, v) + bs.astype(F32).T[None, None, :, :, None]
    return (u * mixed.reshape(b, s, GROUP)).astype(p.dtype)


def _rwkv7_mixer(p, mu, w0, w2, a0, a2, g2, k_k, k_a, r_k, lnx_g, lnx_b):
    b, s, _ = p.shape
    dtype = p.dtype
    p = p.astype(F32)
    prev = jnp.pad(p, ((0, 0), (1, 0), (0, 0)))[:, :s]
    p = p + (prev - p) * mu
    r, k, v, xw, xa, xg = jnp.split(p, B_SPLITS, axis=-1)
    w = -jax.nn.softplus(-(w0 + jnp.tanh(xw) @ w2)) - 0.5
    decay = jnp.exp(-jnp.exp(w))
    a = jax.nn.sigmoid(a0 + xa @ a2)
    g = jax.nn.sigmoid(xg) @ g2

    def heads(t):
        return t.reshape(b, s, B_HEADS, B_HD)

    kk = heads(k * k_k)
    kk = kk / jnp.maximum(jnp.linalg.norm(kk, axis=-1, keepdims=True), 1e-12)
    k = k * (1.0 + (a - 1.0) * k_a)
    r_h, k_h, v_h, a_h, d_h = heads(r), heads(k), heads(v), heads(a), heads(decay)
    b_h = kk * a_h
    xs = tuple(jnp.moveaxis(t, 1, 0) for t in (r_h, d_h, k_h, v_h, kk, b_h))

    def step(state, inp):
        r_t, d_t, k_t, v_t, kk_t, b_t = inp
        sa = jnp.einsum("bhvk,bhk->bhv", state, -kk_t)
        state = (state * d_t[:, :, None, :] + sa[..., None] * b_t[:, :, None, :]
                 + v_t[..., None] * k_t[:, :, None, :])
        return state, jnp.einsum("bhvk,bhk->bhv", state, r_t)

    state0 = jnp.zeros((b, B_HEADS, B_HD, B_HD), F32)
    _, y = lax.scan(step, state0, xs)
    y = jnp.moveaxis(y, 0, 1)
    ym = jnp.mean(y, axis=-1, keepdims=True)
    yv = jnp.mean(jnp.square(y - ym), axis=-1, keepdims=True)
    y = ((y - ym) * lax.rsqrt(yv + B_LNX_EPS)).reshape(b, s, GROUP) * lnx_g + lnx_b
    bonus = jnp.sum(r_h * k_h * r_k, axis=-1, keepdims=True) * v_h
    y = y + bonus.reshape(b, s, GROUP)
    return (y * g).astype(dtype)


def _moba_mixer(p):
    b, s, _ = p.shape
    dtype = p.dtype
    p = p.astype(F32)
    q, k, v = jnp.split(p, 3, axis=-1)
    shape = (b, s, C_HEADS, C_HD)
    pos = jnp.arange(s)
    q = _rope(q.reshape(shape), pos) * (C_HD ** -0.5)
    k = _rope(k.reshape(shape), pos)
    v = v.reshape(shape)
    nb = -(-s // C_BLOCK)
    pad = nb * C_BLOCK - s

    def blocks(t):
        t = jnp.pad(t, ((0, 0), (0, pad), (0, 0), (0, 0)))
        return t.reshape(b, nb, C_BLOCK, C_HEADS, C_HD).transpose(0, 3, 1, 2, 4)

    kb, vb = blocks(k), blocks(v)
    kmean = jnp.mean(kb, axis=3)
    qt = q.transpose(0, 2, 1, 3)
    bscore = jnp.einsum("bhsd,bhnd->bhsn", qt, kmean)
    fully_past = jnp.arange(nb)[None, :] < (pos // C_BLOCK)[:, None]
    bscore = jnp.where(fully_past, bscore, -jnp.inf)
    n_sel = min(C_TOPK, nb)
    top_s, top_i = lax.top_k(bscore, n_sel)
    top_ok = jnp.isfinite(top_s)
    gather = jax.vmap(jax.vmap(lambda blk, idx: blk[idx]))
    own_off = jnp.arange(C_BLOCK)
    q_off = jnp.arange(C_QBLOCK)

    def attend(qi):
        start = qi * C_QBLOCK
        q_blk = lax.dynamic_slice_in_dim(qt, start, C_QBLOCK, axis=2)
        idx = lax.dynamic_slice_in_dim(top_i, start, C_QBLOCK, axis=2)
        ok = lax.dynamic_slice_in_dim(top_ok, start, C_QBLOCK, axis=2)
        k_sel = gather(kb, idx)
        v_sel = gather(vb, idx)
        s_sel = jnp.einsum("bhqd,bhqkld->bhqkl", q_blk, k_sel)
        s_sel = jnp.where(ok[..., None], s_sel, -jnp.inf).reshape(b, C_HEADS, C_QBLOCK, n_sel * C_BLOCK)
        own = start // C_BLOCK
        k_own = lax.dynamic_index_in_dim(kb, own, axis=2, keepdims=False)
        v_own = lax.dynamic_index_in_dim(vb, own, axis=2, keepdims=False)
        s_own = jnp.einsum("bhqd,bhld->bhql", q_blk, k_own)
        visible = (own * C_BLOCK + own_off)[None, :] <= (start + q_off)[:, None]
        s_own = jnp.where(visible, s_own, -jnp.inf)
        probs = jax.nn.softmax(jnp.concatenate([s_sel, s_own], axis=-1), axis=-1)
        p_sel = probs[..., :n_sel * C_BLOCK].reshape(b, C_HEADS, C_QBLOCK, n_sel, C_BLOCK)
        p_own = probs[..., n_sel * C_BLOCK:]
        return (jnp.einsum("bhqkl,bhqkld->bhqd", p_sel, v_sel)
                + jnp.einsum("bhql,bhld->bhqd", p_own, v_own))

    out = lax.map(attend, jnp.arange(s // C_QBLOCK))
    out = out.transpose(1, 0, 3, 2, 4).reshape(b, s, GROUP)
    return out.astype(dtype)


def _gla_mixer(p, gate_w2, gate_b, norm_g):
    b, s, _ = p.shape
    dtype = p.dtype
    p = p.astype(F32)
    q, k, v, xg, og = jnp.split(p, D_SPLITS, axis=-1)
    log_a = jax.nn.log_sigmoid(xg @ gate_w2 + gate_b) / D_GATE_TEMP
    nc = s // D_CHUNK

    def chunks(t, d):
        return t.reshape(b, nc, D_CHUNK, D_HEADS, d).transpose(1, 0, 3, 2, 4)

    qc = chunks(q * (D_DK ** -0.5), D_DK)
    kc = chunks(k, D_DK)
    vc = chunks(v, D_DV)
    gc = chunks(log_a, D_DK)
    causal = jnp.tril(jnp.ones((D_CHUNK, D_CHUNK), dtype=bool))

    def step(state, inp):
        q_c, k_c, v_c, g_c = inp
        cum = jnp.cumsum(g_c, axis=2)
        diff = cum[:, :, :, None, :] - cum[:, :, None, :, :]
        dec = jnp.exp(jnp.where(causal[:, :, None], diff, -jnp.inf))
        scores = jnp.einsum("bhtd,bhsd,bhtsd->bhts", q_c, k_c, dec)
        o = scores @ v_c + jnp.einsum("bhtd,bhde->bhte", q_c * jnp.exp(cum), state)
        last = cum[:, :, -1, :]
        state = (jnp.exp(last)[..., None] * state
                 + jnp.einsum("bhsd,bhse->bhde", k_c * jnp.exp(last[:, :, None, :] - cum), v_c))
        return state, o

    state0 = jnp.zeros((b, D_HEADS, D_DK, D_DV), F32)
    _, o = lax.scan(step, state0, (qc, kc, vc, gc))
    o = o.transpose(1, 0, 3, 2, 4).reshape(b, s, D_HEADS, D_DV)
    o = o * lax.rsqrt(jnp.mean(o * o, axis=-1, keepdims=True) + EPS) * norm_g
    return (o.reshape(b, s, GROUP) * jax.nn.silu(og)).astype(dtype)


def _conv_ffn(x, w_up, conv_w, conv_b, w_down):
    s = x.shape[1]
    h = x @ w_up
    hp = jnp.pad(h, ((0, 0), (CONV_W - 1, 0), (0, 0)))
    acc = conv_b
    for j in range(CONV_W):
        acc = acc + hp[:, j:j + s] * conv_w[j]
    gate, up = jnp.split(acc, 2, axis=-1)
    return (jax.nn.silu(gate) * up) @ w_down


def setup_inputs(seed: int = 0) -> dict:
    key = jax.random.key(seed)
    ks = iter(jax.random.split(key, 32))

    def nrm(shape, scale):
        return jax.random.normal(next(ks), shape, F32) * scale

    def gain(shape):
        return 1.0 + nrm(shape, 0.02)

    L = DEPTH
    return {
        "x": nrm((BATCH, SEQ, D_MODEL), 1.0),
        "mix_norm_g": gain((L, D_MODEL)),
        "w_in": nrm((L, D_MODEL, N_IN), D_MODEL ** -0.5),
        "a_ln_g": gain((L, GROUP)),
        "a_ln_b": nrm((L, GROUP), 0.02),
        "a_ws": nrm((L, A_HEADS, A_CHUNK, A_CHUNK), A_CHUNK ** -0.5),
        "a_bs": 1.0 + nrm((L, A_HEADS, A_CHUNK), 0.1),
        "b_mu": jax.random.uniform(next(ks), (L, B_IN), F32),
        "b_w0": jax.random.uniform(next(ks), (L, GROUP), F32, -6.0, -1.0),
        "b_w2": nrm((L, B_W_RANK, GROUP), 0.1),
        "b_a0": nrm((L, GROUP), 0.1),
        "b_a2": nrm((L, B_A_RANK, GROUP), 0.1),
        "b_g2": nrm((L, B_G_RANK, GROUP), B_G_RANK ** -0.5),
        "b_kk": 0.85 + nrm((L, GROUP), 0.05),
        "b_ka": 1.0 + nrm((L, GROUP), 0.05),
        "b_rk": nrm((L, B_HEADS, B_HD), 0.1),
        "b_lnx_g": gain((L, GROUP)),
        "b_lnx_b": nrm((L, GROUP), 0.02),
        "d_gate_w2": nrm((L, D_GATE_RANK, D_HEADS * D_DK), D_GATE_RANK ** -0.5),
        "d_gate_b": 2.0 + nrm((L, D_HEADS * D_DK), 0.5),
        "d_norm_g": gain((L, D_DV)),
        "w_out": nrm((L, D_MIX, D_MODEL), D_MIX ** -0.5),
        "ffn_norm_g": gain((L, D_MODEL)),
        "w_up": nrm((L, D_MODEL, 2 * D_FF), D_MODEL ** -0.5),
        "conv_w": nrm((L, CONV_W, 2 * D_FF), CONV_W ** -0.5),
        "conv_b": nrm((L, 2 * D_FF), 0.02),
        "w_down": nrm((L, D_FF, D_MODEL), D_FF ** -0.5),
        "final_norm_g": gain((D_MODEL,)),
    }


def reference(x, mix_norm_g, w_in, a_ln_g, a_ln_b, a_ws, a_bs, b_mu, b_w0, b_w2, b_a0, b_a2,
              b_g2, b_kk, b_ka, b_rk, b_lnx_g, b_lnx_b, d_gate_w2, d_gate_b, d_norm_g, w_out,
              ffn_norm_g, w_up, conv_w, conv_b, w_down, final_norm_g):
    for l in range(DEPTH):
        h = _rmsnorm(x, mix_norm_g[l])
        p = h @ w_in[l]
        pa, pb, pc, pd = jnp.split(p, IN_SPLITS, axis=-1)
        ya = _gmlp_mixer(pa, a_ln_g[l], a_ln_b[l], a_ws[l], a_bs[l])
        yb = _rwkv7_mixer(pb, b_mu[l], b_w0[l], b_w2[l], b_a0[l], b_a2[l], b_g2[l],
                          b_kk[l], b_ka[l], b_rk[l], b_lnx_g[l], b_lnx_b[l])
        yc = _moba_mixer(pc)
        yd = _gla_mixer(pd, d_gate_w2[l], d_gate_b[l], d_norm_g[l])
        x = x + jnp.concatenate([ya, yb, yc, yd], axis=-1) @ w_out[l]
        x = x + _conv_ffn(_rmsnorm(x, ffn_norm_g[l]), w_up[l], conv_w[l], conv_b[l], w_down[l])
    return _rmsnorm(x, final_norm_g)
```

```cpp
#include <hip/hip_runtime.h>
#include <hip/hip_cooperative_groups.h>
#include <cstdio>
#include <cstdint>
namespace cg = cooperative_groups;

#define LAS __attribute__((address_space(3)))
typedef unsigned short bf16_t;
typedef short bf16x8 __attribute__((ext_vector_type(8)));
typedef float f32x4 __attribute__((ext_vector_type(4)));
typedef float f32x2 __attribute__((ext_vector_type(2)));
typedef unsigned u32x4 __attribute__((ext_vector_type(4)));
typedef unsigned u32x2 __attribute__((ext_vector_type(2)));

constexpr int SEQ = 8192, DM = 2048, NIN = 5808, NINP = 5888, DFF = 5632, NUP = 11264;
constexpr int PC_A = 0, PC_B = 1024, PC_C = 2720, PC_D = 4256;
constexpr float EPS = 1e-6f;
constexpr float QSCALE = 0.125f * 1.4426950408889634f;

constexpr size_t MiB = 1u << 20;
constexpr size_t WS_ROPE = 1 * MiB, WS_SSQ = 3 * MiB, WS_KMEAN = 4 * MiB, WS_IDZ = 5 * MiB, WS_SEL = 6 * MiB, WS_WT = 8 * MiB;
constexpr size_t WT_IN = 0, WT_OUT = 23 * MiB, WT_UP = 31 * MiB, WT_DOWN = 75 * MiB, WT_LAYER = 97 * MiB;
constexpr size_t WS_XB = 202 * MiB, WS_Y = 234 * MiB, WS_P = 266 * MiB;
constexpr size_t WS_QB = 358 * MiB, WS_KB = 366 * MiB, WS_VT = 374 * MiB, WS_VEC5 = 382 * MiB, WS_VV = 462 * MiB, WS_GG = 478 * MiB, WS_BV = 494 * MiB;
constexpr size_t WS_PCH = 510 * MiB, WS_LCH = 526 * MiB, WS_SIN = 542 * MiB, WS_OI = 558 * MiB, WS_U = 574 * MiB, WS_QT = 590 * MiB, WS_LAM = 598 * MiB;
constexpr size_t WS_PART = 600 * MiB, WS_H = 266 * MiB, WS_ACT = 442 * MiB, WS_END = 640 * MiB;
constexpr int LDS_BYTES = 147456;

__device__ __forceinline__ float bf2f(bf16_t v) { return __uint_as_float((unsigned)v << 16); }
__device__ __forceinline__ float bflo(unsigned u) { return __uint_as_float(u << 16); }
__device__ __forceinline__ float bfhi(unsigned u) { return __uint_as_float(u & 0xffff0000u); }
__device__ __forceinline__ unsigned cvt_pk_bf16(float lo, float hi) { unsigned r; asm volatile("v_cvt_pk_bf16_f32 %0, %1, %2" : "=v"(r) : "v"(lo), "v"(hi)); return r; }
__device__ __forceinline__ bf16_t f2bf(float f) { return (bf16_t)(cvt_pk_bf16(f, 0.f) & 0xffffu); }
__device__ __forceinline__ float wave_sum(float v) {
#pragma unroll
    for (int o = 32; o > 0; o >>= 1) v += __shfl_xor(v, o);
    return v;
}
__device__ __forceinline__ float sigmoidf_(float x) { return 1.f / (1.f + __expf(-x)); }
__device__ __forceinline__ float gelu_tanh(float x) { const float u = 0.7978845608f * (x + 0.044715f * x * x * x); const float e = __expf(2.f * u); const float th = 1.f - 2.f / (e + 1.f); return 0.5f * x * (1.f + th); }
__device__ __forceinline__ void unpack8(const u32x4 r, float (&z)[8]) { z[0] = bflo(r.x); z[1] = bfhi(r.x); z[2] = bflo(r.y); z[3] = bfhi(r.y); z[4] = bflo(r.z); z[5] = bfhi(r.z); z[6] = bflo(r.w); z[7] = bfhi(r.w); }

__device__ __forceinline__ void fast_barrier(unsigned* bar, unsigned epoch  , unsigned G) {
    asm volatile("s_waitcnt vmcnt(0) lgkmcnt(0)" ::: "memory");
    __syncthreads();
    if (threadIdx.x == 0) {
        __builtin_amdgcn_fence(__ATOMIC_RELEASE, "agent");
        asm volatile("s_waitcnt vmcnt(0)" ::: "memory");
        const unsigned grp = blockIdx.x & 7u; const unsigned gsz = (G - grp + 7u) >> 3; const unsigned ngrp = G < 8u ? G : 8u;
        const unsigned old = __hip_atomic_fetch_add(bar + 64u * (1u + grp), 1u, __ATOMIC_RELAXED, __HIP_MEMORY_SCOPE_AGENT);
        if (old + 1u == epoch * gsz) __hip_atomic_fetch_add(bar, 1u, __ATOMIC_RELAXED, __HIP_MEMORY_SCOPE_AGENT);
        unsigned spins = 0;
        while (__hip_atomic_load(bar, __ATOMIC_RELAXED, __HIP_MEMORY_SCOPE_AGENT) < epoch * ngrp) { __builtin_amdgcn_s_sleep(1); if (++spins > (1u << 26)) break; }
        __builtin_amdgcn_fence(__ATOMIC_ACQUIRE, "agent");
        asm volatile("s_waitcnt vmcnt(0)" ::: "memory");
    }
    __syncthreads();
}

namespace pg8 {
constexpr int BM = 256, BK = 64, HALF = 128, HTB = HALF * BK * 2, STAGE_BYTES = 8 * HTB, NXCD = 8, WGM = 8;
__host__ __device__ __forceinline__ int lds_byte(int r, int c) { const int st = (r >> 4) * 2 + (c >> 5), rr = r & 15, cc = c & 31, ob = rr * 64 + cc * 2; return st * 1024 + (ob ^ (((ob >> 9) & 1) << 5)); }
__host__ __device__ __forceinline__ void stage_rc(int b, int& R, int& C) { const int st = b / 1024, sb = b % 1024, swz = sb ^ (((sb >> 9) & 1) << 5); R = (st >> 1) * 16 + swz / 64; C = (st & 1) * 32 + (swz % 64) / 2; }
__host__ __device__ __forceinline__ int perm32(int rho) { const int n = rho >> 4, i = rho & 15; return 8 * (i >> 2) + 4 * n + (i & 3); }
struct Unit { int pm, pn; };
struct Gemm { const bf16_t* A; const bf16_t* Bt; int M, N, K; int a_step_rows; };
struct OneUnit { Unit u; __device__ __forceinline__ bool next(int i, Unit& o) const { if (i) return false; o = u; return true; } };
struct StaticOrder {
    int nM, nN, nwg, G, c;
    __device__ __forceinline__ void init(int M, int N, int G_, int c_) { nM = M / BM; nN = N / BM; nwg = nM * nN; G = G_; c = c_; }
    __device__ __forceinline__ bool next(int i, Unit& u) const {
        const long L = (long)i * G + c; if (L >= nwg) return false;
        int wgid = (int)L; { const int q = nwg / NXCD, r = nwg % NXCD, xcd = wgid % NXCD, off = wgid / NXCD; wgid = (xcd < r ? xcd * (q + 1) : r * (q + 1) + (xcd - r) * q) + off; }
        const int nig = WGM * nN, gid = wgid / nig, fm = gid * WGM, gsz = (nM - fm) < WGM ? (nM - fm) : WGM;
        u.pm = fm + ((wgid % nig) % gsz); u.pn = (wgid % nig) / gsz; return true;
    }
};
struct EpiScaleBf16 {
    static constexpr bool AFTER_DRAIN = false;
    bf16_t* O; int ldc; const float* ssq;
    __device__ __forceinline__ void operator()(const f32x4 (&acc)[2][2][4][2], const Unit& u, int wr, int wc, int fr, int fq) const {
        const int row0 = u.pm * BM + wr * 64 + fr; const int col0 = u.pn * BM + wc * 32 + 8 * fq;
#pragma unroll
        for (int ai = 0; ai < 2; ++ai)
#pragma unroll
            for (int m = 0; m < 4; ++m) {
                const int row = row0 + ai * HALF + m * 16;
                const f32x4* sp = (const f32x4*)(ssq + (size_t)row * 8);
                f32x4 s4 = sp[0] + sp[1];
                const float rs = rsqrtf(((s4[0] + s4[1]) + (s4[2] + s4[3])) * (1.0f / 2048.0f) + EPS);
                bf16_t* rowp = O + (size_t)row * ldc + col0;
#pragma unroll
                for (int bj = 0; bj < 2; ++bj) { const f32x4 v0 = acc[ai][bj][m][0] * rs, v1 = acc[ai][bj][m][1] * rs;
                    u32x4 w; w.x = cvt_pk_bf16(v0[0], v0[1]); w.y = cvt_pk_bf16(v0[2], v0[3]); w.z = cvt_pk_bf16(v1[0], v1[1]); w.w = cvt_pk_bf16(v1[2], v1[3]);
                    *(u32x4*)(rowp + bj * HALF) = w; }
            }
    }
};
struct EpiResid {
    static constexpr bool AFTER_DRAIN = false;
    const float* base; float* xr; bf16_t* xb; float* ssq; LAS unsigned char* lds;
    __device__ __forceinline__ void operator()(const f32x4 (&acc)[2][2][4][2], const Unit& u, int wr, int wc, int fr, int fq) const {
        const int row0 = u.pm * BM + wr * 64 + fr; const int col0 = u.pn * BM + wc * 32 + 8 * fq;
        LAS float* xq = (LAS float*)(lds + 131072);
#pragma unroll
        for (int ai = 0; ai < 2; ++ai)
#pragma unroll
            for (int m = 0; m < 4; ++m) {
                const int row = row0 + ai * HALF + m * 16; float q = 0.f;
#pragma unroll
                for (int bj = 0; bj < 2; ++bj) { const size_t off = (size_t)row * DM + col0 + bj * HALF;
                    const f32x4 b0 = *(const f32x4*)(base + off), b1 = *(const f32x4*)(base + off + 4);
                    const f32x4 v0 = acc[ai][bj][m][0] + b0, v1 = acc[ai][bj][m][1] + b1;
                    *(f32x4*)(xr + off) = v0; *(f32x4*)(xr + off + 4) = v1;
                    u32x4 w; w.x = cvt_pk_bf16(v0[0], v0[1]); w.y = cvt_pk_bf16(v0[2], v0[3]); w.z = cvt_pk_bf16(v1[0], v1[1]); w.w = cvt_pk_bf16(v1[2], v1[3]);
                    *(u32x4*)(xb + off) = w;
                    q += (v0[0] * v0[0] + v0[1] * v0[1]) + (v0[2] * v0[2] + v0[3] * v0[3]) + (v1[0] * v1[0] + v1[1] * v1[1]) + (v1[2] * v1[2] + v1[3] * v1[3]); }
                q += __shfl_xor(q, 16); q += __shfl_xor(q, 32);
                if (fq == 0) xq[(ai * HALF + wr * 64 + m * 16 + fr) * 4 + wc] = q;
            }
        asm volatile("s_waitcnt lgkmcnt(0)" ::: "memory"); __builtin_amdgcn_s_barrier(); asm volatile("" ::: "memory");
        { const int tid_ = (wr * 4 + wc) * 64 + fq * 16 + fr;
          if (tid_ < 256) { const f32x4 v = *(const LAS f32x4*)(xq + tid_ * 4); ssq[(size_t)(u.pm * BM + tid_) * 8 + u.pn] = (v[0] + v[1]) + (v[2] + v[3]); } }
    }
};

struct EpiConvSwiGLU {
    static constexpr bool AFTER_DRAIN = true;
    bf16_t* act; const float* ssq; const float* cw; const float* cb;
    __device__ __forceinline__ void fused(const f32x4 (&acc)[2][2][4][2], const Unit& u, int wr, int wc, int fr, int fq, LAS unsigned char* lds) const {
        const int rs = u.pm * 254;
#pragma unroll
        for (int ai = 0; ai < 2; ++ai)
#pragma unroll
            for (int m = 0; m < 4; ++m) {
                const int lr = ai * HALF + wr * 64 + m * 16 + fr; int row = rs + lr; row = row < SEQ ? row : SEQ - 1;
                const f32x4* sp = (const f32x4*)(ssq + (size_t)row * 8);
                const f32x4 s4 = sp[0] + sp[1];
                const float rsd = rsqrtf(((s4[0] + s4[1]) + (s4[2] + s4[3])) * (1.0f / 2048.0f) + EPS);
#pragma unroll
                for (int bj = 0; bj < 2; ++bj) { const f32x4 v0 = acc[ai][bj][m][0] * rsd, v1 = acc[ai][bj][m][1] * rsd;
                    u32x4 w; w.x = cvt_pk_bf16(v0[0], v0[1]); w.y = cvt_pk_bf16(v0[2], v0[3]); w.z = cvt_pk_bf16(v1[0], v1[1]); w.w = cvt_pk_bf16(v1[2], v1[3]);
                    const int c = 16 * bj + 4 * wc + fq;
                    *(LAS u32x4*)(lds + lr * 512 + ((c ^ ((lr & 7) << 2)) << 4)) = w; }
            }
        asm volatile("s_waitcnt lgkmcnt(0)" ::: "memory"); __builtin_amdgcn_s_barrier(); asm volatile("" ::: "memory");
        const int tid_ = (wr * 4 + wc) * 64 + fq * 16 + fr; const int cgp = tid_ & 15, rr = tid_ >> 4;
        const int j0 = u.pn * 128 + cgp * 8;
        float wg[3][8], wu[3][8], bg[8], bu[8];
#pragma unroll
        for (int k = 0; k < 3; ++k) { const f32x4 a0 = *(const f32x4*)(cw + (size_t)k * NUP + j0), a1 = *(const f32x4*)(cw + (size_t)k * NUP + j0 + 4), b0 = *(const f32x4*)(cw + (size_t)k * NUP + DFF + j0), b1 = *(const f32x4*)(cw + (size_t)k * NUP + DFF + j0 + 4);
#pragma unroll
            for (int e = 0; e < 4; ++e) { wg[k][e] = a0[e]; wg[k][4 + e] = a1[e]; wu[k][e] = b0[e]; wu[k][4 + e] = b1[e]; } }
        { const f32x4 a0 = *(const f32x4*)(cb + j0), a1 = *(const f32x4*)(cb + j0 + 4), b0 = *(const f32x4*)(cb + DFF + j0), b1 = *(const f32x4*)(cb + DFF + j0 + 4);
#pragma unroll
          for (int e = 0; e < 4; ++e) { bg[e] = a0[e]; bg[4 + e] = a1[e]; bu[e] = b0[e]; bu[4 + e] = b1[e]; } }
#pragma unroll 1
        for (int hh = 0; hh < 2; ++hh) {
            u32x4 hg[6], hu[6];
#pragma unroll
            for (int i = 0; i < 6; ++i) { const int lr = 8 * rr + 4 * hh - 2 + i;
                if (lr >= 0) { const int sw = (lr & 7) << 2; hg[i] = *(const LAS u32x4*)(lds + lr * 512 + ((cgp ^ sw) << 4)); hu[i] = *(const LAS u32x4*)(lds + lr * 512 + (((16 + cgp) ^ sw) << 4)); }
                else { hg[i] = (u32x4){0u, 0u, 0u, 0u}; hu[i] = (u32x4){0u, 0u, 0u, 0u}; } }
#pragma unroll
            for (int i = 0; i < 4; ++i) { const int lo = 8 * rr + 4 * hh + i; const int grow = rs + lo;
                float g2[8], g1[8], g0[8], u2[8], u1[8], u0[8];
                unpack8(hg[i], g2); unpack8(hg[i + 1], g1); unpack8(hg[i + 2], g0); unpack8(hu[i], u2); unpack8(hu[i + 1], u1); unpack8(hu[i + 2], u0);
                float o[8];
#pragma unroll
                for (int e = 0; e < 8; ++e) { const float ag = bg[e] + wg[0][e] * g2[e] + wg[1][e] * g1[e] + wg[2][e] * g0[e]; const float au = bu[e] + wu[0][e] * u2[e] + wu[1][e] * u1[e] + wu[2][e] * u0[e];
                    o[e] = ag * sigmoidf_(ag) * au; }
                u32x4 w; w.x = cvt_pk_bf16(o[0], o[1]); w.y = cvt_pk_bf16(o[2], o[3]); w.z = cvt_pk_bf16(o[4], o[5]); w.w = cvt_pk_bf16(o[6], o[7]);
                if ((u.pm == 0 || lo >= 2) && grow < SEQ) *(u32x4*)(act + (size_t)grow * DFF + j0) = w; }
        }
        asm volatile("s_waitcnt lgkmcnt(0)" ::: "memory"); __builtin_amdgcn_s_barrier(); asm volatile("" ::: "memory");
    }
};

template <class Epi, class Sched>
__device__ __forceinline__ void gemm_phase(LAS unsigned char* lds, const Gemm g, const Sched& S, const Epi& E) {
    int tid = threadIdx.x; asm volatile("" : "+v"(tid)); const int wid = __builtin_amdgcn_readfirstlane(tid >> 6), lane = tid & 63, wr = wid >> 2, wc = wid & 3, fr = lane & 15, fq = lane >> 4;
    const int K = g.K, nt = K / BK;
    unsigned voffA[2], voffB[2];
#pragma unroll
    for (int i = 0; i < 2; ++i) { int R, C; stage_rc(tid * 16 + i * 8192, R, C); const int Rb = (R & ~31) + perm32(R & 31);
        voffA[i] = (unsigned)(R * K + C) * 2u; voffB[i] = (unsigned)(Rb * K + C) * 2u; }
    const size_t kstep = (size_t)(BK * 2);
    const size_t hstep = (size_t)HALF * K * 2;
    const size_t tstep = 2 * hstep;
    const size_t tstepA = (size_t)g.a_step_rows * K * 2;
    const unsigned ldsw = (unsigned)wid * 1024u;
    const int aoff = lds_byte(wr * 64 + fr, fq * 8), boff = lds_byte(wc * 32 + fr, fq * 8);
#define PG8_SA(b, h) (((b) * 2 + (h)) * HTB)
#define PG8_SB(b, h) ((4 + (b) * 2 + (h)) * HTB)
#define PG8_STAGE(bufoff, gbase, voff) do { _Pragma("unroll") for (int _i = 0; _i < 2; ++_i) \
        __builtin_amdgcn_global_load_lds((const unsigned*)((const char*)(gbase) + (voff)[_i]), (LAS unsigned*)(lds + (bufoff) + ldsw + _i * 8192), 16, 0, 0); } while (0)
#define PG8_LDA(dst, b, h) do { _Pragma("unroll") for (int m = 0; m < 4; ++m) _Pragma("unroll") for (int k = 0; k < 2; ++k) dst[m][k] = *(const LAS bf16x8*)(lds + PG8_SA(b, h) + aoff + m * 2048 + k * 1024); } while (0)
#define PG8_LDB(dst, b, h) do { _Pragma("unroll") for (int n = 0; n < 2; ++n) _Pragma("unroll") for (int k = 0; k < 2; ++k) dst[n][k] = *(const LAS bf16x8*)(lds + PG8_SB(b, h) + boff + n * 2048 + k * 1024); } while (0)
#define PG8_MMA(ai, bj, At, Bt) do { __builtin_amdgcn_s_setprio(1); _Pragma("unroll") for (int m = 0; m < 4; ++m) _Pragma("unroll") for (int n = 0; n < 2; ++n) _Pragma("unroll") for (int k = 0; k < 2; ++k) \
        acc[ai][bj][m][n] = __builtin_amdgcn_mfma_f32_16x16x32_bf16(Bt[n][k], At[m][k], acc[ai][bj][m][n], 0, 0, 0); __builtin_amdgcn_s_setprio(0); } while (0)
#define PG8_WAIT_V(n) asm volatile("s_waitcnt vmcnt(" #n ")" ::: "memory")
#define PG8_WAIT_L(n) asm volatile("s_waitcnt lgkmcnt(" #n ")" ::: "memory")
#define PG8_BAR __builtin_amdgcn_s_barrier()
#define PG8_SCHED __builtin_amdgcn_sched_barrier(0)
    Unit cur, nxt; int ui = 0;
    if (!S.next(0, cur)) return;
    f32x4 acc[2][2][4][2];
#pragma unroll
    for (int a = 0; a < 2; ++a)
#pragma unroll
        for (int b = 0; b < 2; ++b)
#pragma unroll
            for (int m = 0; m < 4; ++m)
#pragma unroll
                for (int n = 0; n < 2; ++n) acc[a][b][m][n] = (f32x4){0.f, 0.f, 0.f, 0.f};
    bf16x8 At[4][2], B0[2][2], B1[2][2];
    const char* cA = (const char*)g.A + (size_t)cur.pm * tstepA; const char* cB = (const char*)g.Bt + (size_t)cur.pn * tstep;
    PG8_STAGE(PG8_SB(0, 0), cB, voffB); PG8_STAGE(PG8_SB(0, 1), cB + hstep, voffB); PG8_STAGE(PG8_SA(0, 0), cA, voffA); PG8_STAGE(PG8_SA(0, 1), cA + hstep, voffA);
    if (wr == 1) PG8_BAR;
    PG8_WAIT_V(2); PG8_BAR;
    PG8_STAGE(PG8_SB(1, 0), cB + kstep, voffB); PG8_STAGE(PG8_SA(1, 0), cA + kstep, voffA); PG8_STAGE(PG8_SB(1, 1), cB + hstep + kstep, voffB);
    PG8_WAIT_V(6); PG8_BAR;
    for (;;) {
        const bool has_next = S.next(ui + 1, nxt);
        const char* nA = has_next ? (const char*)g.A + (size_t)nxt.pm * tstepA : cA; const char* nB = has_next ? (const char*)g.Bt + (size_t)nxt.pn * tstep : cB;
        for (int t = 0; t < nt; t += 2) {
            const bool last = (t == nt - 2);
            const char* a1 = cA + (size_t)(t + 1) * kstep;
            const char* a2 = last ? nA : cA + (size_t)(t + 2) * kstep; const char* b2 = last ? nB : cB + (size_t)(t + 2) * kstep;
            const char* a3 = a2 + kstep; const char* b3 = b2 + kstep;
            PG8_LDB(B0, 0, 0); PG8_LDB(B1, 0, 1); PG8_SCHED; PG8_LDA(At, 0, 0); PG8_STAGE(PG8_SA(1, 1), a1 + hstep, voffA);
            PG8_WAIT_V(8); PG8_WAIT_L(0); PG8_BAR; PG8_MMA(0, 0, At, B0); PG8_MMA(0, 1, At, B1); PG8_BAR; PG8_SCHED;
            PG8_LDA(At, 0, 1); PG8_STAGE(PG8_SB(0, 0), b2, voffB); PG8_STAGE(PG8_SB(0, 1), b2 + hstep, voffB); PG8_STAGE(PG8_SA(0, 0), a2, voffA);
            PG8_WAIT_V(8); PG8_WAIT_L(0); PG8_BAR; PG8_MMA(1, 0, At, B0); PG8_MMA(1, 1, At, B1); PG8_BAR; PG8_SCHED;
            PG8_LDB(B0, 1, 0); PG8_LDB(B1, 1, 1); PG8_SCHED; PG8_LDA(At, 1, 0); PG8_STAGE(PG8_SA(0, 1), a2 + hstep, voffA);
            PG8_WAIT_V(8); PG8_WAIT_L(0); PG8_BAR; PG8_MMA(0, 0, At, B0); PG8_MMA(0, 1, At, B1); PG8_BAR; PG8_SCHED;
            PG8_LDA(At, 1, 1); PG8_STAGE(PG8_SB(1, 0), b3, voffB); PG8_STAGE(PG8_SB(1, 1), b3 + hstep, voffB); PG8_STAGE(PG8_SA(1, 0), a3, voffA);
            PG8_WAIT_V(8); PG8_WAIT_L(0); PG8_BAR; PG8_MMA(1, 0, At, B0); PG8_MMA(1, 1, At, B1); PG8_BAR; PG8_SCHED;
        }
        if (wr == 0) PG8_BAR;
        if constexpr (!Epi::AFTER_DRAIN) E(acc, cur, wr, wc, fr, fq);
        if (!has_next) break;
#pragma unroll
        for (int a = 0; a < 2; ++a)
#pragma unroll
            for (int b = 0; b < 2; ++b)
#pragma unroll
                for (int m = 0; m < 4; ++m)
#pragma unroll
                    for (int n = 0; n < 2; ++n) acc[a][b][m][n] = (f32x4){0.f, 0.f, 0.f, 0.f};
        cur = nxt; cA = nA; cB = nB; ++ui;
        if (wr == 1) PG8_BAR;
    }
    PG8_WAIT_V(0);
    PG8_BAR;
    if constexpr (Epi::AFTER_DRAIN) E.fused(acc, cur, wr, wc, fr, fq, lds);
#undef PG8_SA
#undef PG8_SB
#undef PG8_STAGE
#undef PG8_LDA
#undef PG8_LDB
#undef PG8_MMA
#undef PG8_WAIT_V
#undef PG8_WAIT_L
#undef PG8_BAR
#undef PG8_SCHED
}
}

struct Args { const float* in[28]; float* out; unsigned char* ws; };
enum { I_X = 0, I_MIXG, I_WIN, I_ALNG, I_ALNB, I_AWS, I_ABS, I_BMU, I_BW0, I_BW2, I_BA0, I_BA2, I_BG2, I_BKK, I_BKA, I_BRK, I_BLNG, I_BLNB, I_DGW2, I_DGB, I_DNG, I_WOUT, I_FFNG, I_WUP, I_CONVW, I_CONVB, I_WDOWN, I_FING };

__device__ __forceinline__ void p0_item(const float* W, int K, int N, bf16_t* WT, const float* gsc, LAS float* scr, int kb, int nb, int row_out0, int lane) {
    const int k0 = 64 * kb, n0 = 64 * nb;
    const int nn = n0 + 2 * (lane & 31); const bool ok = nn < N;
    f32x2 v[32];
#pragma unroll
    for (int i = 0; i < 32; ++i) { const int kk = 2 * i + (lane >> 5); v[i] = ok ? *(const f32x2*)(W + (size_t)(k0 + kk) * N + nn) : (f32x2){0.f, 0.f}; }
#pragma unroll
    for (int i = 0; i < 32; ++i) { const int kk = 2 * i + (lane >> 5); f32x2 x = v[i]; if (gsc) { const float g = gsc[k0 + kk]; x = x * g; }
        scr[kk * 65 + 2 * (lane & 31)] = x.x; scr[kk * 65 + 2 * (lane & 31) + 1] = x.y; }
    asm volatile("s_waitcnt lgkmcnt(0)" ::: "memory");
    const int c = lane & 7;
#pragma unroll
    for (int j = 0; j < 8; ++j) { const int n = (lane >> 3) + 8 * j; const LAS float* sp = scr + (8 * c) * 65 + n;
        u32x4 o; o.x = cvt_pk_bf16(sp[0 * 65], sp[1 * 65]); o.y = cvt_pk_bf16(sp[2 * 65], sp[3 * 65]); o.z = cvt_pk_bf16(sp[4 * 65], sp[5 * 65]); o.w = cvt_pk_bf16(sp[6 * 65], sp[7 * 65]);
        *(u32x4*)(WT + (size_t)(row_out0 + n) * K + k0 + 8 * c) = o; }
    asm volatile("s_waitcnt lgkmcnt(0)" ::: "memory");
}

__device__ __forceinline__ void convert_layer_weights(const Args& args, unsigned char* ws, int l, LAS float* scr, int w0, int nw, int lane, int it_lo, int it_hi) {
    constexpr int I_IN = 32 * 92, I_OUT = 32 * 32, I_UP = 32 * 176, I_DN = 88 * 32;
    unsigned char* wt = ws + WS_WT + (size_t)l * WT_LAYER;
    for (int it = it_lo + w0; it < it_hi; it += nw) {
        int r = it;
        if (r < I_IN) { const int kb = r / 92, nb = r % 92; p0_item(args.in[I_WIN] + (size_t)l * DM * NIN, DM, NIN, (bf16_t*)(wt + WT_IN), args.in[I_MIXG] + l * DM, scr, kb, nb, nb * 64, lane); continue; } r -= I_IN;
        if (r < I_OUT) { const int kb = r / 32, nb = r % 32; p0_item(args.in[I_WOUT] + (size_t)l * DM * DM, DM, DM, (bf16_t*)(wt + WT_OUT), nullptr, scr, kb, nb, nb * 64, lane); continue; } r -= I_OUT;
        if (r < I_UP) { const int kb = r / 176, nb = r % 176; const int n0 = nb * 64; const int j = n0 < DFF ? n0 : n0 - DFF; const int ro = (j >> 7) * 256 + (j & 127) + (n0 < DFF ? 0 : 128);
            p0_item(args.in[I_WUP] + (size_t)l * DM * NUP, DM, NUP, (bf16_t*)(wt + WT_UP), args.in[I_FFNG] + l * DM, scr, kb, nb, ro, lane); continue; } r -= I_UP;
        { const int kb = r / 32, nb = r % 32; p0_item(args.in[I_WDOWN] + (size_t)l * DFF * DM, DFF, DM, (bf16_t*)(wt + WT_DOWN), nullptr, scr, kb, nb, nb * 64, lane); }
    }
}

#define RWKV_LO(v) __builtin_shufflevector(v, v, 0, 1)
#define RWKV_HI(v) __builtin_shufflevector(v, v, 2, 3)
#define RWKV_LDB(set, g) do { _Pragma("unroll") for (int q = 0; q < 2; ++q) { lq_[set][q] = *(const LAS f32x4*)((st_) + 64 + (g) * 8 + q * 4); lq_[set][2 + q] = *(const LAS f32x4*)((st_) + 128 + (g) * 8 + q * 4); \
        lq_[set][4 + q] = *(const LAS f32x4*)((st_) + 192 + (g) * 8 + q * 4); if (WITH_Y_) lq_[set][6 + q] = *(const LAS f32x4*)((st_) + 256 + (g) * 8 + q * 4); } } while (0)
#define RWKV_STEP(st, vi, St, WITH_Y, WITH_V, yout) do { \
    const LAS float* st_ = (st); constexpr bool WITH_Y_ = (WITH_Y); \
    f32x2 a0_ = (f32x2){0.f, 0.f}, a1_ = (f32x2){0.f, 0.f}; \
    f32x4 na_[16]; f32x4 lq_[3][8]; \
    _Pragma("unroll") for (int q = 0; q < 16; ++q) na_[q] = *(const LAS f32x4*)(st_ + q * 4); \
    RWKV_LDB(0, 0); RWKV_LDB(1, 1); \
    __builtin_amdgcn_sched_barrier(0); \
    _Pragma("unroll") for (int q = 0; q < 16; ++q) { const f32x4 n = na_[q]; a0_ += St[2 * q] * RWKV_LO(n); a1_ += St[2 * q + 1] * RWKV_HI(n); } \
    const float sa_ = (a0_.x + a0_.y) + (a1_.x + a1_.y); const f32x2 sa2_ = (f32x2){sa_, sa_}; const f32x2 vi2_ = (f32x2){(vi), (vi)}; \
    f32x2 y0_ = (f32x2){0.f, 0.f}, y1_ = (f32x2){0.f, 0.f}; \
    __builtin_amdgcn_sched_barrier(0); \
    _Pragma("unroll") for (int gi = 0; gi < 8; ++gi) { \
        if (gi + 2 < 8) RWKV_LDB((gi + 2) % 3, gi + 2); \
        __builtin_amdgcn_sched_barrier(0); \
        _Pragma("unroll") for (int q = 0; q < 2; ++q) { const f32x4 dd = lq_[gi % 3][q], bb = lq_[gi % 3][2 + q], kk = lq_[gi % 3][4 + q]; const int k2 = gi * 4 + q * 2; \
            if (WITH_V) { St[k2] = St[k2] * RWKV_LO(dd) + sa2_ * RWKV_LO(bb) + vi2_ * RWKV_LO(kk); St[k2 + 1] = St[k2 + 1] * RWKV_HI(dd) + sa2_ * RWKV_HI(bb) + vi2_ * RWKV_HI(kk); } \
            else { St[k2] = St[k2] * RWKV_LO(dd) + sa2_ * RWKV_LO(bb); St[k2 + 1] = St[k2 + 1] * RWKV_HI(dd) + sa2_ * RWKV_HI(bb); } \
            if (WITH_Y_) { const f32x4 rr = lq_[gi % 3][6 + q]; y0_ += St[k2] * RWKV_LO(rr); y1_ += St[k2 + 1] * RWKV_HI(rr); } } \
        __builtin_amdgcn_sched_barrier(0); } \
    yout = (y0_.x + y0_.y) + (y1_.x + y1_.y); } while (0)

__global__ void __launch_bounds__(512, 2) mega_fwd(Args args) {
    extern __shared__ __attribute__((aligned(16))) unsigned char lds_raw[];
    LAS unsigned char* lds = (LAS unsigned char*)lds_raw;
    cg::grid_group grid = cg::this_grid();
    const int tid0 = threadIdx.x, wave = __builtin_amdgcn_readfirstlane(tid0 >> 6);
    const int bid = blockIdx.x, G = gridDim.x;
    const int gw = bid * 8 + wave, NGW = G * 8;
    unsigned char* ws = args.ws;
    float* XR = args.out;
    bf16_t* XB = (bf16_t*)(ws + WS_XB); bf16_t* Y = (bf16_t*)(ws + WS_Y); bf16_t* P = (bf16_t*)(ws + WS_P);
    float* IDZ = (float*)(ws + WS_IDZ); int* SEL = (int*)(ws + WS_SEL); float* PART = (float*)(ws + WS_PART);
    unsigned* BAR = (unsigned*)ws; unsigned bar_epoch = 0;
    float* SSQ = (float*)(ws + WS_SSQ); f32x2* ROPE = (f32x2*)(ws + WS_ROPE); float* KMEAN = (float*)(ws + WS_KMEAN);
    bf16_t* QB = (bf16_t*)(ws + WS_QB); bf16_t* KB = (bf16_t*)(ws + WS_KB); bf16_t* VT = (bf16_t*)(ws + WS_VT);
    float* VEC5 = (float*)(ws + WS_VEC5); float* VV = (float*)(ws + WS_VV); float* GG = (float*)(ws + WS_GG); float* BV = (float*)(ws + WS_BV);
    float* PCH = (float*)(ws + WS_PCH); float* LCH = (float*)(ws + WS_LCH); float* SIN = (float*)(ws + WS_SIN);
    float* OI = (float*)(ws + WS_OI); float* GU = (float*)(ws + WS_U); float* QT = (float*)(ws + WS_QT); float* LAM = (float*)(ws + WS_LAM);
    bf16_t* HB = (bf16_t*)(ws + WS_H); bf16_t* ACT = (bf16_t*)(ws + WS_ACT);

        { int tid = tid0; asm volatile("" : "+v"(tid)); const int lane = tid & 63; (void)lane;
    {
        LAS float* scr = (LAS float*)(lds + wave * 16896);
        const bool split_conv = (G >= 256);
        convert_layer_weights(args, ws, 0, scr, gw, NGW, lane, 0, split_conv ? 3968 : 12416);
        if (!split_conv) convert_layer_weights(args, ws, 1, scr, gw, NGW, lane, 0, 12416);
        for (int idx = bid * 512 + tid; idx < 8192; idx += G * 512) IDZ[idx] = (idx < 4096 && (idx >> 6) == (idx & 63)) ? 1.f : 0.f;
        for (int idx = bid * 512 + tid; idx < SEQ * 32; idx += G * 512) {
            const int t = idx >> 5, d = idx & 31;
            const float inv = exp2f(-(float)d * (13.287712379549449f / 32.0f));
            const float ang = (float)t * inv;
            const double rev = (double)ang * 0.15915494309189535; const float fr = (float)(rev - floor(rev));
            ROPE[idx] = (f32x2){__builtin_amdgcn_cosf(fr), __builtin_amdgcn_sinf(fr)};
        }
        const float* x = args.in[I_X];
        for (int row = gw; row < SEQ; row += NGW) {
            const f32x4* xr = (const f32x4*)(x + (size_t)row * DM) + lane; float s = 0.f;
            u32x2* ob = (u32x2*)(XB + (size_t)row * DM) + lane;
#pragma unroll
            for (int j = 0; j < 8; ++j) { const f32x4 v = xr[64 * j]; s += (v[0] * v[0] + v[1] * v[1]) + (v[2] * v[2] + v[3] * v[3]); u32x2 w; w.x = cvt_pk_bf16(v[0], v[1]); w.y = cvt_pk_bf16(v[2], v[3]); ob[64 * j] = w; }
            s = wave_sum(s);
            if (lane < 8) SSQ[(size_t)row * 8 + lane] = lane == 0 ? s : 0.f;
        }
    }
        }
    grid.sync();

    for (int l = 0; l < 2; ++l) {
        unsigned char* wt = ws + WS_WT + (size_t)l * WT_LAYER;
        { int tid = tid0; asm volatile("" : "+v"(tid)); const int lane = tid & 63; (void)lane;
        {
            pg8::Gemm g{XB, (const bf16_t*)(wt + WT_IN), SEQ, NINP, DM, 256}; pg8::StaticOrder S; S.init(SEQ, NINP, G, bid);
            pg8::EpiScaleBf16 E{P, NINP, SSQ};
            pg8::gemm_phase<pg8::EpiScaleBf16>(lds, g, S, E);
        }
        }
        fast_barrier(BAR, ++bar_epoch, (unsigned)G);
        { int tid = tid0; asm volatile("" : "+v"(tid)); const int lane = tid & 63; (void)lane;
        for (int unit = bid; unit < 256; unit += G) {
            const int n = unit >> 2, h = unit & 3, t0 = n * 128;
            LAS float* Vs = (LAS float*)lds; LAS float* Wt = (LAS float*)(lds + 65536); LAS float* st = (LAS float*)(lds + 65536 + 67584);
            const float* lng = args.in[I_ALNG] + l * 512; const float* lnb = args.in[I_ALNB] + l * 512;
            const float* wsrc = args.in[I_AWS] + ((size_t)l * 4 + h) * 16384; const float* bsrc = args.in[I_ABS] + (l * 4 + h) * 128;
            u32x4 raws[16];
#pragma unroll
            for (int i = 0; i < 16; ++i) raws[i] = *(const u32x4*)(P + (size_t)(t0 + wave * 16 + i) * NINP + PC_A + 512 + lane * 8);
#pragma unroll
            for (int i = 0; i < 16; ++i) { const int tt = wave * 16 + i;
                const u32x4 raw = raws[i]; float z[8]; unpack8(raw, z); float s = 0.f;
#pragma unroll
                for (int j = 0; j < 8; ++j) { z[j] = gelu_tanh(z[j]); s += z[j]; }
                const float mu = wave_sum(s) * (1.f / 512.f); float q = 0.f;
#pragma unroll
                for (int j = 0; j < 8; ++j) { const float d = z[j] - mu; q += d * d; }
                const float var = wave_sum(q) * (1.f / 512.f);
                if (lane == 0) { st[tt * 2] = mu; st[tt * 2 + 1] = rsqrtf(var + EPS); } }
            for (int i = 0; i < 32; ++i) { const int e = tid + 512 * i; const int t = e >> 7, s = e & 127; Wt[s * 132 + t] = (s <= t) ? wsrc[e] : 0.f; }
            __syncthreads();
            for (int i = 0; i < 4; ++i) { const int idx = tid + 512 * i; const int s = idx >> 4, c0 = (idx & 15) * 8;
                const u32x4 raw = *(const u32x4*)(P + (size_t)(t0 + s) * NINP + PC_A + 512 + h * 128 + c0); float z[8]; unpack8(raw, z);
                const float mu = st[s * 2], rs = st[s * 2 + 1];
#pragma unroll
                for (int j = 0; j < 8; ++j) Vs[s * 128 + c0 + j] = (gelu_tanh(z[j]) - mu) * rs * lng[h * 128 + c0 + j] + lnb[h * 128 + c0 + j]; }
            __syncthreads();
            const int tg = tid >> 4, cgp = tid & 15; const int s_end = wave * 16 + 16;
            float acc[4][8];
#pragma unroll
            for (int i = 0; i < 4; ++i)
#pragma unroll
                for (int j = 0; j < 8; ++j) acc[i][j] = 0.f;
            { f32x4 w4n[2], v0n[2], v1n[2];
#pragma unroll
              for (int q = 0; q < 2; ++q) { w4n[q] = *(const LAS f32x4*)(Wt + q * 132 + tg * 4); v0n[q] = *(const LAS f32x4*)(Vs + q * 128 + cgp * 8); v1n[q] = *(const LAS f32x4*)(Vs + q * 128 + cgp * 8 + 4); }
              for (int s = 0; s < s_end; s += 2) {
                f32x4 w4c[2], v0c[2], v1c[2];
#pragma unroll
                for (int q = 0; q < 2; ++q) { w4c[q] = w4n[q]; v0c[q] = v0n[q]; v1c[q] = v1n[q]; }
                const int sn = (s + 2 < 128) ? s + 2 : 126;
#pragma unroll
                for (int q = 0; q < 2; ++q) { w4n[q] = *(const LAS f32x4*)(Wt + (sn + q) * 132 + tg * 4); v0n[q] = *(const LAS f32x4*)(Vs + (sn + q) * 128 + cgp * 8); v1n[q] = *(const LAS f32x4*)(Vs + (sn + q) * 128 + cgp * 8 + 4); }
                __builtin_amdgcn_sched_barrier(0);
#pragma unroll
                for (int q = 0; q < 2; ++q)
#pragma unroll
                    for (int i = 0; i < 4; ++i) {
#pragma unroll
                        for (int j = 0; j < 4; ++j) { acc[i][j] += w4c[q][i] * v0c[q][j]; acc[i][4 + j] += w4c[q][i] * v1c[q][j]; } }
                __builtin_amdgcn_sched_barrier(0);
              } }
#pragma unroll
            for (int i = 0; i < 4; ++i) { const int t = tg * 4 + i; const float bias = bsrc[t];
                const u32x4 raw = *(const u32x4*)(P + (size_t)(t0 + t) * NINP + PC_A + h * 128 + cgp * 8); float z[8]; unpack8(raw, z); float o[8];
#pragma unroll
                for (int j = 0; j < 8; ++j) o[j] = gelu_tanh(z[j]) * (acc[i][j] + bias);
                u32x4 w; w.x = cvt_pk_bf16(o[0], o[1]); w.y = cvt_pk_bf16(o[2], o[3]); w.z = cvt_pk_bf16(o[4], o[5]); w.w = cvt_pk_bf16(o[6], o[7]);
                *(u32x4*)(Y + (size_t)(t0 + t) * DM + h * 128 + cgp * 8) = w; }
            __syncthreads();
        }
        }
        { int tid = tid0; asm volatile("" : "+v"(tid)); const int lane = tid & 63; (void)lane;
        for (int unit = bid; unit < 256; unit += G) {
            const int n = unit >> 3, h = unit & 7; const int tt = tid >> 1, half = tid & 1, t = n * 256 + tt, d0 = half * 16;
            LAS float* red = (LAS float*)lds;
            LAS bf16_t* vsT = (LAS bf16_t*)(lds + 4096);
            const bf16_t* prow = P + (size_t)t * NINP + PC_C + h * 64;
            float ql[16], qh[16], kl[16], kh[16];
            { u32x4 a0 = *(const u32x4*)(prow + d0), a1 = *(const u32x4*)(prow + d0 + 8), b0 = *(const u32x4*)(prow + 32 + d0), b1 = *(const u32x4*)(prow + 32 + d0 + 8);
              float z[8]; unpack8(a0, z);
#pragma unroll
              for (int j = 0; j < 8; ++j) ql[j] = z[j];
              unpack8(a1, z);
#pragma unroll
              for (int j = 0; j < 8; ++j) ql[8 + j] = z[j];
              unpack8(b0, z);
#pragma unroll
              for (int j = 0; j < 8; ++j) qh[j] = z[j];
              unpack8(b1, z);
#pragma unroll
              for (int j = 0; j < 8; ++j) qh[8 + j] = z[j]; }
            { u32x4 a0 = *(const u32x4*)(prow + 512 + d0), a1 = *(const u32x4*)(prow + 512 + d0 + 8), b0 = *(const u32x4*)(prow + 512 + 32 + d0), b1 = *(const u32x4*)(prow + 512 + 32 + d0 + 8);
              float z[8]; unpack8(a0, z);
#pragma unroll
              for (int j = 0; j < 8; ++j) kl[j] = z[j];
              unpack8(a1, z);
#pragma unroll
              for (int j = 0; j < 8; ++j) kl[8 + j] = z[j];
              unpack8(b0, z);
#pragma unroll
              for (int j = 0; j < 8; ++j) kh[j] = z[j];
              unpack8(b1, z);
#pragma unroll
              for (int j = 0; j < 8; ++j) kh[8 + j] = z[j]; }
            const f32x2* cs = ROPE + (size_t)t * 32 + d0;
#pragma unroll
            for (int j = 0; j < 16; ++j) { const f32x2 c = cs[j];
                const float q1 = ql[j], q2 = qh[j]; ql[j] = (q1 * c.x - q2 * c.y) * QSCALE; qh[j] = (q1 * c.y + q2 * c.x) * QSCALE;
                const float k1 = kl[j], k2 = kh[j]; kl[j] = k1 * c.x - k2 * c.y; kh[j] = k1 * c.y + k2 * c.x; }
            { bf16_t* qo = QB + (size_t)t * 512 + h * 64 + d0; bf16_t* ko = KB + (size_t)t * 512 + h * 64 + d0;
              u32x4 w;
              w.x = cvt_pk_bf16(ql[0], ql[1]); w.y = cvt_pk_bf16(ql[2], ql[3]); w.z = cvt_pk_bf16(ql[4], ql[5]); w.w = cvt_pk_bf16(ql[6], ql[7]); *(u32x4*)(qo) = w;
              w.x = cvt_pk_bf16(ql[8], ql[9]); w.y = cvt_pk_bf16(ql[10], ql[11]); w.z = cvt_pk_bf16(ql[12], ql[13]); w.w = cvt_pk_bf16(ql[14], ql[15]); *(u32x4*)(qo + 8) = w;
              w.x = cvt_pk_bf16(qh[0], qh[1]); w.y = cvt_pk_bf16(qh[2], qh[3]); w.z = cvt_pk_bf16(qh[4], qh[5]); w.w = cvt_pk_bf16(qh[6], qh[7]); *(u32x4*)(qo + 32) = w;
              w.x = cvt_pk_bf16(qh[8], qh[9]); w.y = cvt_pk_bf16(qh[10], qh[11]); w.z = cvt_pk_bf16(qh[12], qh[13]); w.w = cvt_pk_bf16(qh[14], qh[15]); *(u32x4*)(qo + 40) = w;
              w.x = cvt_pk_bf16(kl[0], kl[1]); w.y = cvt_pk_bf16(kl[2], kl[3]); w.z = cvt_pk_bf16(kl[4], kl[5]); w.w = cvt_pk_bf16(kl[6], kl[7]); *(u32x4*)(ko) = w;
              w.x = cvt_pk_bf16(kl[8], kl[9]); w.y = cvt_pk_bf16(kl[10], kl[11]); w.z = cvt_pk_bf16(kl[12], kl[13]); w.w = cvt_pk_bf16(kl[14], kl[15]); *(u32x4*)(ko + 8) = w;
              w.x = cvt_pk_bf16(kh[0], kh[1]); w.y = cvt_pk_bf16(kh[2], kh[3]); w.z = cvt_pk_bf16(kh[4], kh[5]); w.w = cvt_pk_bf16(kh[6], kh[7]); *(u32x4*)(ko + 32) = w;
              w.x = cvt_pk_bf16(kh[8], kh[9]); w.y = cvt_pk_bf16(kh[10], kh[11]); w.z = cvt_pk_bf16(kh[12], kh[13]); w.w = cvt_pk_bf16(kh[14], kh[15]); *(u32x4*)(ko + 40) = w; }
#pragma unroll
            for (int j = 0; j < 16; ++j) {
#pragma unroll
                for (int o = 2; o < 64; o <<= 1) { kl[j] += __shfl_xor(kl[j], o); kh[j] += __shfl_xor(kh[j], o); } }
            if (lane < 2) {
#pragma unroll
                for (int j = 0; j < 16; ++j) { red[(wave * 2 + lane) * 32 + j] = kl[j]; red[(wave * 2 + lane) * 32 + 16 + j] = kh[j]; } }
            { const bf16_t* vrow = prow + 1024 + half * 32;
#pragma unroll
              for (int q = 0; q < 4; ++q) { const u32x4 r = *(const u32x4*)(vrow + q * 8); const unsigned rr[4] = {r.x, r.y, r.z, r.w};
#pragma unroll
                  for (int j = 0; j < 4; ++j) { const int d = half * 32 + q * 8 + 2 * j; vsT[d * 264 + tt] = (bf16_t)(rr[j] & 0xffffu); vsT[(d + 1) * 264 + tt] = (bf16_t)(rr[j] >> 16); } } }
            __syncthreads();
            if (tid < 64) { const int hf = (tid & 31) >> 4, slot = (tid & 15) + (tid >= 32 ? 16 : 0); float s = 0.f;
#pragma unroll
                for (int w = 0; w < 8; ++w) s += red[(w * 2 + hf) * 32 + slot];
                KMEAN[(h * 32 + n) * 64 + tid] = s * (1.f / 256.f); }
            { const int d = tid >> 3, seg = tid & 7; const LAS u32x4* src = (const LAS u32x4*)(vsT + d * 264 + seg * 32); u32x4* dst = (u32x4*)(VT + (size_t)(h * 64 + d) * SEQ + n * 256 + seg * 32);
#pragma unroll
              for (int q = 0; q < 4; ++q) dst[q] = src[q]; }
            __syncthreads();
        }
        }
        { int tid = tid0; asm volatile("" : "+v"(tid)); const int lane = tid & 63; (void)lane;
        for (int unit = bid; unit < 256; unit += G) {
            const int t0 = unit * 32;
            LAS float* xs = (LAS float*)lds;
            const float* mu = args.in[I_BMU] + l * 1696;
            for (int i = 0; i < 10; ++i) { const int idx = tid + 512 * i; const int tt = idx / 160, j = idx - tt * 160; const int t = t0 + tt;
                const float cur = bf2f(P[(size_t)t * NINP + PC_B + 1536 + j]); const float prev = t > 0 ? bf2f(P[(size_t)(t - 1) * NINP + PC_B + 1536 + j]) : 0.f;
                const float x = cur + (prev - cur) * mu[1536 + j];
                xs[tt * 160 + j] = j < 32 ? tanhf(x) : (j < 64 ? x : sigmoidf_(x)); }
            const int c = tid, head = wave;
            const float w0c = args.in[I_BW0][l * 512 + c], a0c = args.in[I_BA0][l * 512 + c], kkc = args.in[I_BKK][l * 512 + c], kac = args.in[I_BKA][l * 512 + c], rkc = args.in[I_BRK][l * 512 + c];
            const float mur = mu[c], muk = mu[512 + c], muv = mu[1024 + c];
            const float* w2 = args.in[I_BW2] + (size_t)l * 32 * 512; const float* a2 = args.in[I_BA2] + (size_t)l * 32 * 512; const float* g2 = args.in[I_BG2] + (size_t)l * 96 * 512;
            __syncthreads();
            {
                float wr_[32], ar_[32];
                unsigned cu = (unsigned)c; asm volatile("" : "+v"(cu));
#pragma unroll
                for (int j = 0; j < 32; ++j) { const float* wj = w2 + j * 512; const float* aj = a2 + j * 512; wr_[j] = wj[cu]; ar_[j] = aj[cu]; }
                float rp = 0.f, kp = 0.f, vp = 0.f;
                { const bf16_t* pr = P + (size_t)t0 * NINP + PC_B + c; if (t0 > 0) { rp = bf2f(pr[-NINP]); kp = bf2f(pr[512 - NINP]); vp = bf2f(pr[1024 - NINP]); } }
                float rn, kn, vnx;
                { const bf16_t* pr = P + (size_t)t0 * NINP + PC_B + c; rn = bf2f(pr[0]); kn = bf2f(pr[512]); vnx = bf2f(pr[1024]); }
#pragma unroll 1
                for (int i = 0; i < 32; ++i) { const int t = t0 + i;
                    const float rc = rn, kc = kn, vc = vnx;
                    if (i + 1 < 32) { const bf16_t* pr = P + (size_t)(t + 1) * NINP + PC_B + c; rn = bf2f(pr[0]); kn = bf2f(pr[512]); vnx = bf2f(pr[1024]); }
                    float aw = w0c, aa = a0c, aw1 = 0.f, aa1 = 0.f;
                    const LAS float* xr = xs + i * 160;
#pragma unroll
                    for (int j = 0; j < 32; j += 4) { const f32x4 x = *(const LAS f32x4*)(xr + j), y = *(const LAS f32x4*)(xr + 32 + j);
                        aw += x[0] * wr_[j]; aw1 += x[1] * wr_[j + 1]; aw += x[2] * wr_[j + 2]; aw1 += x[3] * wr_[j + 3];
                        aa += y[0] * ar_[j]; aa1 += y[1] * ar_[j + 1]; aa += y[2] * ar_[j + 2]; aa1 += y[3] * ar_[j + 3]; }
                    aw += aw1; aa += aa1;
                    const float rr = rc + (rp - rc) * mur, kx = kc + (kp - kc) * muk, vx = vc + (vp - vc) * muv;
                    const float mz = -aw; const float sp = mz > 20.f ? mz : log1pf(__expf(mz));
                    const float wl = -sp - 0.5f; const float dec = __expf(-__expf(wl));
                    const float a = sigmoidf_(aa);
                    float kk = kx * kkc; const float n2 = wave_sum(kk * kk); kk = kk / fmaxf(sqrtf(n2), 1e-12f);
                    const float k2 = kx * (1.f + (a - 1.f) * kac); const float bb = kk * a;
                    const float bon = wave_sum(rr * k2 * rkc);
                    float* v5 = VEC5 + ((size_t)head * SEQ + t) * 320 + lane;
                    v5[0] = -kk; v5[64] = dec; v5[128] = bb; v5[192] = k2; v5[256] = rr;
                    VV[((size_t)head * SEQ + t) * 64 + lane] = vx; BV[(size_t)t * 512 + c] = bon * vx;
                    rp = rc; kp = kc; vp = vc; }
            }
            {
                float gr_[96];
                unsigned cu = (unsigned)c; asm volatile("" : "+v"(cu));
#pragma unroll
                for (int j = 0; j < 96; ++j) { const float* gj = g2 + j * 512; gr_[j] = gj[cu]; }
#pragma unroll 1
                for (int i = 0; i < 32; ++i) { const int t = t0 + i;
                    float ag = 0.f, ag1 = 0.f;
                    const LAS float* xr = xs + i * 160;
#pragma unroll
                    for (int j = 0; j < 96; j += 4) { const f32x4 x = *(const LAS f32x4*)(xr + 64 + j); ag += x[0] * gr_[j]; ag1 += x[1] * gr_[j + 1]; ag += x[2] * gr_[j + 2]; ag1 += x[3] * gr_[j + 3]; }
                    GG[(size_t)t * 512 + c] = ag + ag1; }
            }
            __syncthreads();
        }
        }
        fast_barrier(BAR, ++bar_epoch, (unsigned)G);
        { int tid = tid0; asm volatile("" : "+v"(tid)); const int lane = tid & 63; (void)lane;
        for (int pi = bid; pi < 256; pi += G) {
            const int h = pi & 7, r = pi >> 3, half = r & 1;
            for (int which = 0; which < 2; ++which) {
                const int qb = which ? 31 - (r >> 1) : (r >> 1);
                const int t0 = qb * 256 + half * 128;
                LAS bf16_t* Ks = (LAS bf16_t*)lds;
                LAS bf16_t* Vs = (LAS bf16_t*)(lds + 18432);
                LAS float* kmS = (LAS float*)(lds + 36864);
                LAS int* selS = (LAS int*)(lds + 36864 + 8192);
                for (int i = tid; i < qb * 64; i += 512) kmS[i] = KMEAN[h * 2048 + i];
                __syncthreads();
                if (tid < 128) {
                    const bf16_t* qr = QB + (size_t)(t0 + tid) * 512 + h * 64;
                    float q[64];
#pragma unroll
                    for (int j = 0; j < 8; ++j) { float z[8]; unpack8(*(const u32x4*)(qr + j * 8), z);
#pragma unroll
                        for (int e = 0; e < 8; ++e) q[j * 8 + e] = z[e]; }
                    float b0 = -INFINITY, b1 = -INFINITY, b2 = -INFINITY; int i0 = 255, i1 = 255, i2 = 255;
                    for (int n = 0; n < qb; ++n) { float s = 0.f, s1 = 0.f, s2 = 0.f, s3 = 0.f; f32x4 kv[16];
#pragma unroll
                        for (int j = 0; j < 16; ++j) kv[j] = *(const LAS f32x4*)(kmS + n * 64 + j * 4);
                        __builtin_amdgcn_sched_barrier(0);
#pragma unroll
                        for (int j = 0; j < 16; ++j) { s += q[4 * j] * kv[j][0]; s1 += q[4 * j + 1] * kv[j][1]; s2 += q[4 * j + 2] * kv[j][2]; s3 += q[4 * j + 3] * kv[j][3]; }
                        s = (s + s1) + (s2 + s3);
                        if (s > b0) { b2 = b1; i2 = i1; b1 = b0; i1 = i0; b0 = s; i0 = n; } else if (s > b1) { b2 = b1; i2 = i1; b1 = s; i1 = n; } else if (s > b2) { b2 = s; i2 = n; } }
                    selS[tid] = i0 | (i1 << 8) | (i2 << 16); SEL[h * SEQ + t0 + tid] = i0 | (i1 << 8) | (i2 << 16);
                }
                __syncthreads();
                const int ql = lane & 15, kg = lane >> 4;
                const int tq = t0 + wave * 16 + ql;
                const int sel = selS[wave * 16 + ql]; const int s0 = sel & 255, s1 = (sel >> 8) & 255, s2 = (sel >> 16) & 255;
                bf16x8 qf[2];
                qf[0] = *(const bf16x8*)(QB + (size_t)tq * 512 + h * 64 + kg * 8); qf[1] = *(const bf16x8*)(QB + (size_t)tq * 512 + h * 64 + 32 + kg * 8);
                const int nown = half ? 4 : 2, ntile = nown;
                float mrun = -1e30f, lrun = 0.f; f32x4 O[4];
#pragma unroll
                for (int d = 0; d < 4; ++d) O[d] = (f32x4){0.f, 0.f, 0.f, 0.f};
                const int lrow = tid >> 3, lseg = (tid & 7) ^ (lrow & 7);
                const bf16_t* kgp = KB + (size_t)lrow * 512 + h * 64 + lseg * 8; const bf16_t* vgp = VT + (size_t)(h * 64 + lrow) * SEQ + lseg * 8;
                LAS unsigned char* ring = lds + 49152;
#define ATT_KS(i_) ((i_) < nown ? qb * 256 + (i_) * 64 : ((i_) - nown) * 64)
#define ATT_ISSUE_S(i_, slot_) do { const int ks_ = ATT_KS(i_); LAS unsigned char* tb_ = ring + (slot_) * 16384 + wave * 1024; \
                    __builtin_amdgcn_global_load_lds((const unsigned*)(kgp + (size_t)ks_ * 512), (LAS unsigned*)tb_, 16, 0, 0); \
                    __builtin_amdgcn_global_load_lds((const unsigned*)(vgp + ks_), (LAS unsigned*)(tb_ + 8192), 16, 0, 0); } while (0)
                ATT_ISSUE_S(0, 0); if (ntile > 1) ATT_ISSUE_S(1, 1); if (ntile > 2) ATT_ISSUE_S(2, 2);
                const int sw = ql & 7;
                for (int i0 = 0; i0 < ntile; i0 += 4) {
#pragma unroll
                for (int ij = 0; ij < 4; ++ij) { const int i = i0 + ij; if (i < ntile) {
                    if (i + 2 < ntile) asm volatile("s_waitcnt vmcnt(4)" ::: "memory"); else if (i + 1 < ntile) asm volatile("s_waitcnt vmcnt(2)" ::: "memory"); else asm volatile("s_waitcnt vmcnt(0)" ::: "memory");
                    __builtin_amdgcn_s_barrier(); asm volatile("" ::: "memory");
                    if (i + 3 < ntile) ATT_ISSUE_S(i + 3, (ij + 3) & 3);
                    const int ks = ATT_KS(i);
                    const LAS unsigned char* Kc = ring + ij * 16384; const LAS unsigned char* Vc = Kc + 8192;
                    bf16x8 kfr[4][2];
#pragma unroll
                    for (int kt = 0; kt < 4; ++kt)
#pragma unroll
                        for (int c = 0; c < 2; ++c) kfr[kt][c] = *(const LAS bf16x8*)(Kc + (kt * 16 + ql) * 128 + (((c * 4 + kg) ^ sw) << 4));
                    u32x2 vfr[2][4][2];
#pragma unroll
                    for (int kc = 0; kc < 2; ++kc)
#pragma unroll
                        for (int d = 0; d < 4; ++d) { const LAS unsigned char* vr = Vc + (d * 16 + ql) * 128 + (kg & 1) * 8; const int sg = kc * 4 + (kg >> 1);
                            vfr[kc][d][0] = *(const LAS u32x2*)(vr + ((sg ^ sw) << 4)); vfr[kc][d][1] = *(const LAS u32x2*)(vr + (((sg + 2) ^ sw) << 4)); }
                    __builtin_amdgcn_sched_barrier(0);
                    f32x4 Sx[4];
#pragma unroll
                    for (int kt = 0; kt < 4; ++kt) Sx[kt] = __builtin_amdgcn_mfma_f32_16x16x32_bf16(kfr[kt][0], qf[0], (f32x4){0.f, 0.f, 0.f, 0.f}, 0, 0, 0);
#pragma unroll
                    for (int kt = 0; kt < 4; ++kt) Sx[kt] = __builtin_amdgcn_mfma_f32_16x16x32_bf16(kfr[kt][1], qf[1], Sx[kt], 0, 0, 0);
                    const int nblk = ks >> 8; const bool own = i < nown;
                    const bool keepl = true; (void)own; (void)nblk; (void)s0; (void)s1; (void)s2;
                    if (own && ks + 63 > t0) {
#pragma unroll
                        for (int kt = 0; kt < 4; ++kt)
#pragma unroll
                            for (int jj = 0; jj < 4; ++jj) { const int key = ks + kt * 16 + 4 * kg + jj; Sx[kt][jj] = (key <= tq) ? Sx[kt][jj] : -1e30f; }
                    }
                    float mx = fmaxf(fmaxf(fmaxf(Sx[0][0], Sx[0][1]), fmaxf(Sx[0][2], Sx[0][3])), fmaxf(fmaxf(Sx[1][0], Sx[1][1]), fmaxf(Sx[1][2], Sx[1][3])));
                    mx = fmaxf(mx, fmaxf(fmaxf(fmaxf(Sx[2][0], Sx[2][1]), fmaxf(Sx[2][2], Sx[2][3])), fmaxf(fmaxf(Sx[3][0], Sx[3][1]), fmaxf(Sx[3][2], Sx[3][3]))));
                    mx = keepl ? mx : -1e30f;
                    mx = fmaxf(mx, __shfl_xor(mx, 16)); mx = fmaxf(mx, __shfl_xor(mx, 32));
                    const float mnew = fmaxf(mrun, mx); const float alpha = __builtin_amdgcn_exp2f(mrun - mnew); mrun = mnew;
                    const float moff = keepl ? mnew : 1e30f;
                    float rs = 0.f;
#pragma unroll
                    for (int kt = 0; kt < 4; ++kt)
#pragma unroll
                        for (int jj = 0; jj < 4; ++jj) { const float p = __builtin_amdgcn_exp2f(Sx[kt][jj] - moff); Sx[kt][jj] = p; rs += p; }
                    lrun = lrun * alpha + rs;
#pragma unroll
                    for (int d = 0; d < 4; ++d) O[d] *= alpha;
#pragma unroll
                    for (int kc = 0; kc < 2; ++kc) {
                        u32x4 pw; pw.x = cvt_pk_bf16(Sx[2 * kc][0], Sx[2 * kc][1]); pw.y = cvt_pk_bf16(Sx[2 * kc][2], Sx[2 * kc][3]); pw.z = cvt_pk_bf16(Sx[2 * kc + 1][0], Sx[2 * kc + 1][1]); pw.w = cvt_pk_bf16(Sx[2 * kc + 1][2], Sx[2 * kc + 1][3]);
                        const bf16x8 pb = __builtin_bit_cast(bf16x8, pw);
#pragma unroll
                        for (int d = 0; d < 4; ++d) { u32x4 vw; vw.x = vfr[kc][d][0].x; vw.y = vfr[kc][d][0].y; vw.z = vfr[kc][d][1].x; vw.w = vfr[kc][d][1].y;
                            O[d] = __builtin_amdgcn_mfma_f32_16x16x32_bf16(__builtin_bit_cast(bf16x8, vw), pb, O[d], 0, 0, 0); }
                    }
                } } }
                lrun += __shfl_xor(lrun, 16); lrun += __shfl_xor(lrun, 32);
#undef ATT_KS
#undef ATT_ISSUE_S
                { float* pp = PART + ((size_t)(tq * 8 + h) * 4 + 3) * 36;
#pragma unroll
                  for (int d = 0; d < 4; ++d) { u32x2 w; w.x = cvt_pk_bf16(O[d][0], O[d][1]); w.y = cvt_pk_bf16(O[d][2], O[d][3]); *(u32x2*)(pp + d * 8 + 2 * kg) = w; }
                  if (kg == 0) { pp[32] = mrun; pp[33] = lrun; } }
                __syncthreads();
            }
        }
        }
        { int tid = tid0; asm volatile("" : "+v"(tid)); const int lane = tid & 63; (void)lane;
        for (int unit = bid; unit < 512; unit += G) {
            const int c = unit >> 2, h = unit & 3, t0 = c * 64;
            LAS float* qtT = (LAS float*)lds;
            LAS float* ktT = (LAS float*)(lds + 16384);
            LAS float* khS = (LAS float*)(lds + 32768);
            LAS float* vS = (LAS float*)(lds + 49152);
            LAS float* AT = (LAS float*)(lds + 81920);
            LAS float* xgs = (LAS float*)(lds + 98304);
            const bf16_t* pd = P + (size_t)t0 * NINP + PC_D;
            for (int i = tid; i < 1024; i += 512) { const int t = i >> 4, j = i & 15; xgs[i] = bf2f(pd[(size_t)t * NINP + 1024 + j]); }
            for (int i = 0; i < 2; ++i) { const int idx = tid + 512 * i; const int s = idx >> 4, e0 = (idx & 15) * 8; float z[8]; unpack8(*(const u32x4*)(pd + (size_t)s * NINP + 512 + h * 128 + e0), z);
#pragma unroll
                for (int j = 0; j < 8; ++j) vS[s * 128 + e0 + j] = z[j]; }
            __syncthreads();
            { const int t = tid >> 3, dg = (tid & 7) * 8; const float* gw2 = args.in[I_DGW2] + (size_t)l * 16 * 256 + h * 64 + dg; const float* gb = args.in[I_DGB] + l * 256 + h * 64 + dg;
              float a[8];
#pragma unroll
              for (int j = 0; j < 8; ++j) a[j] = gb[j];
              for (int r = 0; r < 16; ++r) { const float xv = xgs[t * 16 + r];
#pragma unroll
                  for (int j = 0; j < 8; ++j) a[j] += xv * gw2[r * 256 + j]; }
#pragma unroll
              for (int j = 0; j < 8; ++j) { const float x = a[j]; const float ls = fminf(x, 0.f) - log1pf(__expf(-fabsf(x))); AT[t * 64 + dg + j] = ls * (1.f / 16.f); } }
            __syncthreads();
            if (tid < 64) { float run = 0.f; for (int t = 0; t < 64; ++t) { run += AT[t * 64 + tid]; AT[t * 64 + tid] = run; } }
            __syncthreads();
            { const int t = tid >> 3, dg = (tid & 7) * 8; float qz[8], kz[8];
              unpack8(*(const u32x4*)(pd + (size_t)t * NINP + h * 64 + dg), qz); unpack8(*(const u32x4*)(pd + (size_t)t * NINP + 256 + h * 64 + dg), kz);
#pragma unroll
              for (int j = 0; j < 8; ++j) { const int d = dg + j; const float cm = AT[t * 64 + d], last = AT[63 * 64 + d];
                  const float qv = qz[j] * 0.125f * __expf(cm); qtT[d * 64 + t] = qv; ktT[d * 64 + t] = kz[j] * __expf(-cm); khS[t * 64 + d] = kz[j] * __expf(last - cm);
                  QT[(size_t)(t0 + t) * 256 + h * 64 + d] = qv;
                  if (t == 63) LAM[(c * 4 + h) * 64 + d] = __expf(last); } }
            __syncthreads();
            if (tid < 256) { const int tq0 = (tid & 15) * 4, sq0 = (tid >> 4) * 4; float a[4][4];
#pragma unroll
                for (int i = 0; i < 4; ++i)
#pragma unroll
                    for (int j = 0; j < 4; ++j) a[i][j] = 0.f;
                for (int d0 = 0; d0 < 64; d0 += 8) { f32x4 qv[8], kv[8];
#pragma unroll
                    for (int q = 0; q < 8; ++q) { qv[q] = *(const LAS f32x4*)(qtT + (d0 + q) * 64 + tq0); kv[q] = *(const LAS f32x4*)(ktT + (d0 + q) * 64 + sq0); }
                    __builtin_amdgcn_sched_barrier(0);
#pragma unroll
                    for (int q = 0; q < 8; ++q)
#pragma unroll
                        for (int i = 0; i < 4; ++i)
#pragma unroll
                            for (int j = 0; j < 4; ++j) a[i][j] += qv[q][i] * kv[q][j];
                    __builtin_amdgcn_sched_barrier(0); }
                asm volatile("" ::: "memory");
#pragma unroll
                for (int j = 0; j < 4; ++j) { f32x4 o;
#pragma unroll
                    for (int i = 0; i < 4; ++i) o[i] = (sq0 + j <= tq0 + i) ? a[i][j] : 0.f;
                    *(LAS f32x4*)(AT + (sq0 + j) * 64 + tq0) = o; } }
            __syncthreads();
            { const int x0 = (tid & 15) * 4, e0 = (tid >> 4) * 4; float o[4][4], u[4][4];
#pragma unroll
              for (int i = 0; i < 4; ++i)
#pragma unroll
                  for (int j = 0; j < 4; ++j) { o[i][j] = 0.f; u[i][j] = 0.f; }
              for (int s0 = 0; s0 < 64; s0 += 4) { f32x4 av[4], kv[4], vv[4];
#pragma unroll
                  for (int q = 0; q < 4; ++q) { av[q] = *(const LAS f32x4*)(AT + (s0 + q) * 64 + x0); kv[q] = *(const LAS f32x4*)(khS + (s0 + q) * 64 + x0); vv[q] = *(const LAS f32x4*)(vS + (s0 + q) * 128 + e0); }
                  __builtin_amdgcn_sched_barrier(0);
#pragma unroll
                  for (int q = 0; q < 4; ++q)
#pragma unroll
                      for (int i = 0; i < 4; ++i)
#pragma unroll
                          for (int j = 0; j < 4; ++j) { o[i][j] += av[q][i] * vv[q][j]; u[i][j] += kv[q][i] * vv[q][j]; }
                  __builtin_amdgcn_sched_barrier(0); }
#pragma unroll
              for (int i = 0; i < 4; ++i) { *(f32x4*)(OI + (size_t)(t0 + x0 + i) * 512 + h * 128 + e0) = (f32x4){o[i][0], o[i][1], o[i][2], o[i][3]};
                  *(f32x4*)(GU + ((size_t)(c * 4 + h) * 64 + x0 + i) * 128 + e0) = (f32x4){u[i][0], u[i][1], u[i][2], u[i][3]}; } }
            __syncthreads();
        }
        }
        { int tid = tid0; asm volatile("" : "+v"(tid)); const int lane = tid & 63; (void)lane;
        { const int wu = bid * 8 + wave; if (wu < 2048) {
            const int h = wu >> 8, c = (wu >> 1) & 127, kind = wu & 1; const size_t tb = (size_t)h * SEQ + c * 64;
            LAS float* buf = (LAS float*)(lds + wave * 10240);
            const f32x4* src = (const f32x4*)(VEC5 + tb * 320);
            const float* vsrc = VV + tb * 64 + lane;
            f32x2 St[32];
            { const f32x4* si = (const f32x4*)(IDZ + kind * 4096 + lane * 64);
#pragma unroll
              for (int k4 = 0; k4 < 16; ++k4) { const f32x4 v = si[k4]; St[2 * k4] = RWKV_LO(v); St[2 * k4 + 1] = RWKV_HI(v); } }
            float vn[4];
#pragma unroll
            for (int j = 0; j < 5; ++j) __builtin_amdgcn_global_load_lds((const unsigned*)(src + j * 64 + lane), (LAS unsigned*)(buf + j * 256), 16, 0, 0);
            const float vsc = kind ? 1.f : 0.f;
#pragma unroll
            for (int j = 0; j < 4; ++j) vn[j] = vsrc[j * 64];
            asm volatile("s_waitcnt vmcnt(0)" ::: "memory");
            for (int b = 0; b < 16; ++b) {
                const float vc0 = vn[0], vc1 = vn[1], vc2 = vn[2], vc3 = vn[3];
                if (b + 1 < 16) { LAS float* nb = buf + ((b + 1) & 1) * 1280;
#pragma unroll
                    for (int j = 0; j < 5; ++j) __builtin_amdgcn_global_load_lds((const unsigned*)(src + (b + 1) * 320 + j * 64 + lane), (LAS unsigned*)(nb + j * 256), 16, 0, 0);
#pragma unroll
                    for (int j = 0; j < 4; ++j) vn[j] = vsrc[((b + 1) * 4 + j) * 64];
                }
                const LAS float* cb = buf + (b & 1) * 1280;
#pragma unroll 1
                for (int s = 0; s < 4; ++s) {
                    const LAS float* st = cb + s * 320;
                    const float vi = (s == 0 ? vc0 : (s == 1 ? vc1 : (s == 2 ? vc2 : vc3))) * vsc;
                    float yy; RWKV_STEP(st, vi, St, false, true, yy); (void)yy;
                }
                asm volatile("s_waitcnt vmcnt(0)" ::: "memory");
            }
            f32x4* po = (f32x4*)((kind ? LCH : PCH) + ((size_t)(h * 128 + c) * 64 + lane) * 64);
#pragma unroll
            for (int k4 = 0; k4 < 16; ++k4) po[k4] = (f32x4){St[2 * k4].x, St[2 * k4].y, St[2 * k4 + 1].x, St[2 * k4 + 1].y};
        }
        }
        }
        fast_barrier(BAR, ++bar_epoch, (unsigned)G);
        { int tid = tid0; asm volatile("" : "+v"(tid)); const int lane = tid & 63; (void)lane;
        if (bid < 64) {
            const int h = bid >> 3, rg = bid & 7;
            LAS float* Pb = (LAS float*)lds;
            LAS float* Sb = (LAS float*)(lds + 32768);
            const int rl = (wave & 3) * 2 + (lane >> 5), cl = 2 * (lane & 31); const int row = rg * 8 + rl;
            const bool comp = wave < 4;
            float zz = 0.f; asm volatile("" : "+v"(zz)); const f32x2 z2 = (f32x2){zz, zz};
            const float* Pg = PCH + (size_t)(h * 128) * 4096; const float* Lg = LCH + (size_t)(h * 128) * 4096 + row * 64 + cl;
            f32x4 pq[4][2]; f32x2 lnq[4];
            { const f32x4* ps = (const f32x4*)Pg; *(LAS f32x4*)(Pb + tid * 4) = ps[tid]; *(LAS f32x4*)(Pb + 2048 + tid * 4) = ps[512 + tid]; }
#pragma unroll
            for (int q = 1; q <= 4; ++q) { const f32x4* ps = (const f32x4*)(Pg + (size_t)q * 4096); pq[q & 3][0] = ps[tid]; pq[q & 3][1] = ps[512 + tid]; }
#pragma unroll
            for (int q = 0; q < 4; ++q) lnq[q] = comp ? *(const f32x2*)(Lg + (size_t)q * 4096) : z2;
            if (comp) *(LAS f32x2*)(Sb + rl * 64 + cl) = z2;
            f32x2 sv = z2;
            asm volatile("s_waitcnt lgkmcnt(0)" ::: "memory"); __builtin_amdgcn_s_barrier(); asm volatile("" ::: "memory");
            for (int c0 = 0; c0 < 128; c0 += 4) {
#pragma unroll
                for (int ci = 0; ci < 4; ++ci) {
                    const int c = c0 + ci;
                    const LAS float* Pc = Pb + (c & 1) * 4096; const LAS float* Sc = Sb + (c & 1) * 512 + rl * 64;
                    if (comp) {
                        *(f32x2*)(SIN + (size_t)(h * 128 + c) * 4096 + row * 64 + cl) = sv;
                        f32x2 a0 = lnq[ci], a1 = z2;
                        if (c + 4 < 128) lnq[ci] = *(const f32x2*)(Lg + (size_t)(c + 4) * 4096);
                        f32x4 sr_[16]; f32x2 pr_[2][16];
#pragma unroll
                        for (int q = 0; q < 16; ++q) sr_[q] = *(const LAS f32x4*)(Sc + q * 4);
#pragma unroll
                        for (int q = 0; q < 16; ++q) pr_[0][q] = *(const LAS f32x2*)(Pc + q * 64 + cl);
#pragma unroll
                        for (int g = 0; g < 4; ++g) {
                            if (g + 1 < 4) {
#pragma unroll
                                for (int q = 0; q < 16; ++q) pr_[(g + 1) & 1][q] = *(const LAS f32x2*)(Pc + ((g + 1) * 16 + q) * 64 + cl); }
                            __builtin_amdgcn_sched_barrier(0);
#pragma unroll
                            for (int q = 0; q < 16; q += 2) { const int k = g * 16 + q; a0 += sr_[k >> 2][k & 3] * pr_[g & 1][q]; a1 += sr_[(k + 1) >> 2][(k + 1) & 3] * pr_[g & 1][q + 1]; }
                            __builtin_amdgcn_sched_barrier(0);
                        }
                        sv = a0 + a1;
                        *(LAS f32x2*)(Sb + ((c + 1) & 1) * 512 + rl * 64 + cl) = sv;
                    }
                    if (c + 1 < 128) { LAS float* Pn = Pb + ((c + 1) & 1) * 4096; *(LAS f32x4*)(Pn + tid * 4) = pq[(ci + 1) & 3][0]; *(LAS f32x4*)(Pn + 2048 + tid * 4) = pq[(ci + 1) & 3][1]; }
                    if (c + 5 < 128) { const f32x4* ps = (const f32x4*)(Pg + (size_t)(c + 5) * 4096); pq[(ci + 1) & 3][0] = ps[tid]; pq[(ci + 1) & 3][1] = ps[512 + tid]; }
                    asm volatile("s_waitcnt lgkmcnt(0)" ::: "memory"); __builtin_amdgcn_s_barrier(); asm volatile("" ::: "memory");
                }
            }
        } else if (bid < 128) {
            const int idx = (bid - 64) * 512 + tid; float S = 0.f;
            for (int c0 = 0; c0 < 128; c0 += 16) { float u[16], lam[16];
#pragma unroll
                for (int i = 0; i < 16; ++i) { u[i] = GU[(size_t)(c0 + i) * 32768 + idx]; lam[i] = LAM[(c0 + i) * 256 + (idx >> 7)]; }
#pragma unroll
                for (int i = 0; i < 16; ++i) { GU[(size_t)(c0 + i) * 32768 + idx] = S; S = lam[i] * S + u[i]; } }
        } else if (G >= 256) {
            convert_layer_weights(args, ws, l, (LAS float*)(lds + wave * 16896), (bid - 128) * 8 + wave, (G - 128) * 8, lane, 3968, 9600);
        }
        }
        { int tid = tid0; asm volatile("" : "+v"(tid)); const int lane = tid & 63; (void)lane;
        for (;;) {
            __syncthreads();
            if (tid == 0) *(LAS int*)(lds + 36864 + 4096 + 64) = (int)__hip_atomic_fetch_add(BAR + 1024 + 64 * l, 1u, __ATOMIC_RELAXED, __HIP_MEMORY_SCOPE_AGENT);
            __syncthreads();
            const int u = *(LAS int*)(lds + 36864 + 4096 + 64);
            if (u >= 1088) break;
            const int h = u & 7; int n = 0, r = 0;
            { int rem = u >> 3; for (n = 0; n < 31; ++n) { const int cn = 8 - ((n + 1) >> 2); if (rem < cn) { r = ((n + 1) >> 2) + rem; break; } rem -= cn; } }
            LAS int* listS = (LAS int*)(lds + 36864);
            LAS int* wcnt = (LAS int*)(lds + 36864 + 4096);
            LAS unsigned char* ring = lds + 49152;
            const int lrow = tid >> 3, lseg = (tid & 7) ^ (lrow & 7);
            const bf16_t* kgp = KB + (size_t)(n * 256 + lrow) * 512 + h * 64 + lseg * 8; const bf16_t* vgp = VT + (size_t)(h * 64 + lrow) * SEQ + n * 256 + lseg * 8;
#pragma unroll
            for (int j = 0; j < 4; ++j) { LAS unsigned char* tb_ = ring + j * 16384 + wave * 1024;
                __builtin_amdgcn_global_load_lds((const unsigned*)(kgp + (size_t)j * 64 * 512), (LAS unsigned*)tb_, 16, 0, 0);
                __builtin_amdgcn_global_load_lds((const unsigned*)(vgp + j * 64), (LAS unsigned*)(tb_ + 8192), 16, 0, 0); }
            int myslot[2], mypre[2];
#pragma unroll
            for (int p = 0; p < 2; ++p) { const int t = r * 1024 + p * 512 + tid; const int sv = SEL[h * SEQ + t];
                const int sl = ((sv & 255) == n) ? 0 : ((((sv >> 8) & 255) == n) ? 1 : ((((sv >> 16) & 255) == n) ? 2 : -1));
                const unsigned long long bal = __ballot(sl >= 0);
                myslot[p] = sl; mypre[p] = __popcll(bal & ((1ull << lane) - 1ull));
                if (lane == 0) wcnt[p * 8 + wave] = __popcll(bal); }
            __syncthreads();
            int cnt = 0, base0 = 0, base1 = 0;
#pragma unroll
            for (int q = 0; q < 16; ++q) { const int c = wcnt[q]; if (q == wave) base0 = cnt; if (q == 8 + wave) base1 = cnt; cnt += c; }
            if (myslot[0] >= 0) listS[base0 + mypre[0]] = ((r * 1024 + tid) << 2) | myslot[0];
            if (myslot[1] >= 0) listS[base1 + mypre[1]] = ((r * 1024 + 512 + tid) << 2) | myslot[1];
            asm volatile("s_waitcnt vmcnt(0)" ::: "memory");
            __syncthreads();
            const int ql = lane & 15, kg = lane >> 4, sw = ql & 7;
            for (int ch = 0; ch * 128 < cnt; ++ch) {
                const int e = ch * 128 + wave * 16 + ql; const bool has = e < cnt; const int ent = listS[has ? e : 0]; const int tq = ent >> 2, slot = ent & 3;
                bf16x8 qf[2];
                qf[0] = *(const bf16x8*)(QB + (size_t)tq * 512 + h * 64 + kg * 8); qf[1] = *(const bf16x8*)(QB + (size_t)tq * 512 + h * 64 + 32 + kg * 8);
                float mrun = -1e30f, lrun = 0.f; f32x4 O[4];
#pragma unroll
                for (int d = 0; d < 4; ++d) O[d] = (f32x4){0.f, 0.f, 0.f, 0.f};
#pragma unroll
                for (int ij = 0; ij < 4; ++ij) {
                    const LAS unsigned char* Kc = ring + ij * 16384; const LAS unsigned char* Vc = Kc + 8192;
                    bf16x8 kfr[4][2];
#pragma unroll
                    for (int kt = 0; kt < 4; ++kt)
#pragma unroll
                        for (int c = 0; c < 2; ++c) kfr[kt][c] = *(const LAS bf16x8*)(Kc + (kt * 16 + ql) * 128 + (((c * 4 + kg) ^ sw) << 4));
                    u32x2 vfr[2][4][2];
#pragma unroll
                    for (int kc = 0; kc < 2; ++kc)
#pragma unroll
                        for (int d = 0; d < 4; ++d) { const LAS unsigned char* vr = Vc + (d * 16 + ql) * 128 + (kg & 1) * 8; const int sg = kc * 4 + (kg >> 1);
                            vfr[kc][d][0] = *(const LAS u32x2*)(vr + ((sg ^ sw) << 4)); vfr[kc][d][1] = *(const LAS u32x2*)(vr + (((sg + 2) ^ sw) << 4)); }
                    __builtin_amdgcn_sched_barrier(0);
                    f32x4 Sx[4];
#pragma unroll
                    for (int kt = 0; kt < 4; ++kt) Sx[kt] = __builtin_amdgcn_mfma_f32_16x16x32_bf16(kfr[kt][0], qf[0], (f32x4){0.f, 0.f, 0.f, 0.f}, 0, 0, 0);
#pragma unroll
                    for (int kt = 0; kt < 4; ++kt) Sx[kt] = __builtin_amdgcn_mfma_f32_16x16x32_bf16(kfr[kt][1], qf[1], Sx[kt], 0, 0, 0);
                    float mx = fmaxf(fmaxf(fmaxf(Sx[0][0], Sx[0][1]), fmaxf(Sx[0][2], Sx[0][3])), fmaxf(fmaxf(Sx[1][0], Sx[1][1]), fmaxf(Sx[1][2], Sx[1][3])));
                    mx = fmaxf(mx, fmaxf(fmaxf(fmaxf(Sx[2][0], Sx[2][1]), fmaxf(Sx[2][2], Sx[2][3])), fmaxf(fmaxf(Sx[3][0], Sx[3][1]), fmaxf(Sx[3][2], Sx[3][3]))));
                    mx = fmaxf(mx, __shfl_xor(mx, 16)); mx = fmaxf(mx, __shfl_xor(mx, 32));
                    const float mnew = fmaxf(mrun, mx); const float alpha = __builtin_amdgcn_exp2f(mrun - mnew); mrun = mnew;
                    float rs = 0.f;
#pragma unroll
                    for (int kt = 0; kt < 4; ++kt)
#pragma unroll
                        for (int jj = 0; jj < 4; ++jj) { const float p = __builtin_amdgcn_exp2f(Sx[kt][jj] - mnew); Sx[kt][jj] = p; rs += p; }
                    lrun = lrun * alpha + rs;
#pragma unroll
                    for (int d = 0; d < 4; ++d) O[d] *= alpha;
#pragma unroll
                    for (int kc = 0; kc < 2; ++kc) {
                        u32x4 pw; pw.x = cvt_pk_bf16(Sx[2 * kc][0], Sx[2 * kc][1]); pw.y = cvt_pk_bf16(Sx[2 * kc][2], Sx[2 * kc][3]); pw.z = cvt_pk_bf16(Sx[2 * kc + 1][0], Sx[2 * kc + 1][1]); pw.w = cvt_pk_bf16(Sx[2 * kc + 1][2], Sx[2 * kc + 1][3]);
                        const bf16x8 pb = __builtin_bit_cast(bf16x8, pw);
#pragma unroll
                        for (int d = 0; d < 4; ++d) { u32x4 vw; vw.x = vfr[kc][d][0].x; vw.y = vfr[kc][d][0].y; vw.z = vfr[kc][d][1].x; vw.w = vfr[kc][d][1].y;
                            O[d] = __builtin_amdgcn_mfma_f32_16x16x32_bf16(__builtin_bit_cast(bf16x8, vw), pb, O[d], 0, 0, 0); }
                    }
                }
                lrun += __shfl_xor(lrun, 16); lrun += __shfl_xor(lrun, 32);
                if (has) { float* pp = PART + ((size_t)(tq * 8 + h) * 4 + slot) * 36;
#pragma unroll
                    for (int d = 0; d < 4; ++d) { u32x2 w; w.x = cvt_pk_bf16(O[d][0], O[d][1]); w.y = cvt_pk_bf16(O[d][2], O[d][3]); *(u32x2*)(pp + d * 8 + 2 * kg) = w; }
                    if (kg == 0) { pp[32] = mrun; pp[33] = lrun; } }
            }
            __syncthreads();
        }
        }
        fast_barrier(BAR, ++bar_epoch, (unsigned)G);
        { int tid = tid0; asm volatile("" : "+v"(tid)); const int lane = tid & 63; (void)lane;
        for (int t = bid * 8 + wave; t < SEQ; t += G * 8) {
            const int h = lane >> 3, dg = (lane & 7) * 8; const int qb = t >> 8; const int nv = qb < 3 ? qb : 3;
            const float* pp = PART + ((size_t)(t * 8 + h) * 4) * 36;
            const float m3 = pp[3 * 36 + 32], l3 = pp[3 * 36 + 33];
            float mk[3], lk[3]; float M = m3;
#pragma unroll
            for (int q = 0; q < 3; ++q) { mk[q] = q < nv ? pp[q * 36 + 32] : -1e30f; lk[q] = q < nv ? pp[q * 36 + 33] : 0.f; M = fmaxf(M, mk[q]); }
            const float w3 = __builtin_amdgcn_exp2f(m3 - M); float L = w3 * l3;
            float acc8[8];
            { float z[8]; unpack8(*(const u32x4*)(pp + 3 * 36 + (dg >> 1)), z);
#pragma unroll
              for (int e = 0; e < 8; ++e) acc8[e] = z[e] * w3; }
#pragma unroll
            for (int q = 0; q < 3; ++q) if (q < nv) { const float wq = __builtin_amdgcn_exp2f(mk[q] - M); L += wq * lk[q];
                float z[8]; unpack8(*(const u32x4*)(pp + q * 36 + (dg >> 1)), z);
#pragma unroll
                for (int e = 0; e < 8; ++e) acc8[e] += z[e] * wq; }
            const f32x4 a0 = (f32x4){acc8[0], acc8[1], acc8[2], acc8[3]}, a1 = (f32x4){acc8[4], acc8[5], acc8[6], acc8[7]};
            const float il = 1.f / L;
            u32x4 w; w.x = cvt_pk_bf16(a0[0] * il, a0[1] * il); w.y = cvt_pk_bf16(a0[2] * il, a0[3] * il); w.z = cvt_pk_bf16(a1[0] * il, a1[1] * il); w.w = cvt_pk_bf16(a1[2] * il, a1[3] * il);
            *(u32x4*)(Y + (size_t)t * DM + 1024 + h * 64 + dg) = w;
        }
        for (int unit = bid; unit < 512; unit += G) {
            const int c = unit >> 2, h = unit & 3, t0 = c * 64;
            LAS float* qtT = (LAS float*)lds;
            LAS float* Sd = (LAS float*)(lds + 16384);
            LAS float* red = (LAS float*)(lds + 49152);
            for (int i = 0; i < 8; ++i) { const int idx = tid + 512 * i; const int t = idx >> 6, d = idx & 63; qtT[d * 64 + t] = QT[(size_t)(t0 + t) * 256 + h * 64 + d]; }
            { const f32x4* ss = (const f32x4*)(GU + (size_t)(c * 4 + h) * 8192);
#pragma unroll
              for (int i = 0; i < 4; ++i) *(LAS f32x4*)(Sd + (tid + 512 * i) * 4) = ss[tid + 512 * i]; }
            __syncthreads();
            const int x0 = (tid & 15) * 4, e0 = (tid >> 4) * 4; float o[4][4];
#pragma unroll
            for (int i = 0; i < 4; ++i) { const f32x4 v = *(const f32x4*)(OI + (size_t)(t0 + x0 + i) * 512 + h * 128 + e0); o[i][0] = v[0]; o[i][1] = v[1]; o[i][2] = v[2]; o[i][3] = v[3]; }
            for (int d0 = 0; d0 < 64; d0 += 8) { f32x4 qv[8], sv[8];
#pragma unroll
                for (int q = 0; q < 8; ++q) { qv[q] = *(const LAS f32x4*)(qtT + (d0 + q) * 64 + x0); sv[q] = *(const LAS f32x4*)(Sd + (d0 + q) * 128 + e0); }
                __builtin_amdgcn_sched_barrier(0);
#pragma unroll
                for (int q = 0; q < 8; ++q)
#pragma unroll
                    for (int i = 0; i < 4; ++i)
#pragma unroll
                        for (int j = 0; j < 4; ++j) o[i][j] += qv[q][i] * sv[q][j];
                __builtin_amdgcn_sched_barrier(0); }
#pragma unroll
            for (int i = 0; i < 4; ++i) red[(x0 + i) * 32 + (tid >> 4)] = (o[i][0] * o[i][0] + o[i][1] * o[i][1]) + (o[i][2] * o[i][2] + o[i][3] * o[i][3]);
            __syncthreads();
            const float* ng = args.in[I_DNG] + l * 128 + e0;
#pragma unroll
            for (int i = 0; i < 4; ++i) { const int t = t0 + x0 + i; float s = 0.f;
#pragma unroll
                for (int j = 0; j < 8; ++j) { const f32x4 v = *(const LAS f32x4*)(red + (x0 + i) * 32 + j * 4); s += (v[0] + v[1]) + (v[2] + v[3]); }
                const float rs = rsqrtf(s * (1.f / 128.f) + EPS);
                const bf16_t* og = P + (size_t)t * NINP + PC_D + 1040 + h * 128 + e0; const u32x2 raw = *(const u32x2*)og;
                const float g0 = bflo(raw.x), g1 = bfhi(raw.x), g2 = bflo(raw.y), g3 = bfhi(raw.y);
                const float y0 = o[i][0] * rs * ng[0] * (g0 * sigmoidf_(g0)), y1 = o[i][1] * rs * ng[1] * (g1 * sigmoidf_(g1)), y2 = o[i][2] * rs * ng[2] * (g2 * sigmoidf_(g2)), y3 = o[i][3] * rs * ng[3] * (g3 * sigmoidf_(g3));
                u32x2 w; w.x = cvt_pk_bf16(y0, y1); w.y = cvt_pk_bf16(y2, y3);
                *(u32x2*)(Y + (size_t)t * DM + 1536 + h * 128 + e0) = w; }
            __syncthreads();
        }
        if (wave < 4) {
            const int u = bid * 4 + wave;
            if (u < 1024) {
                const int h = u >> 7, c = u & 127; const size_t tb = (size_t)h * SEQ + c * 64; const int tbase = c * 64;
                LAS float* buf = (LAS float*)(lds + wave * 10240);
                const f32x4* src = (const f32x4*)(VEC5 + tb * 320);
                const float* vsrc = VV + tb * 64 + lane;
                const int ch = h * 64 + lane;
                const float lg = args.in[I_BLNG][l * 512 + ch], lbias = args.in[I_BLNB][l * 512 + ch];
                const float* bvp = BV + (size_t)tbase * 512 + ch; const float* ggp = GG + (size_t)tbase * 512 + ch;
                f32x2 St[32];
                { const f32x4* si = (const f32x4*)(SIN + ((size_t)u * 64 + lane) * 64);
#pragma unroll
                  for (int k4 = 0; k4 < 16; ++k4) { const f32x4 v = si[k4]; St[2 * k4] = RWKV_LO(v); St[2 * k4 + 1] = RWKV_HI(v); } }
                float vn[4];
#pragma unroll
                for (int j = 0; j < 5; ++j) __builtin_amdgcn_global_load_lds((const unsigned*)(src + j * 64 + lane), (LAS unsigned*)(buf + j * 256), 16, 0, 0);
#pragma unroll
                for (int j = 0; j < 4; ++j) vn[j] = vsrc[j * 64];
                asm volatile("s_waitcnt vmcnt(0)" ::: "memory");
                for (int b = 0; b < 16; ++b) {
                    const float vc0 = vn[0], vc1 = vn[1], vc2 = vn[2], vc3 = vn[3];
                    float bvc[4], ggc[4];
#pragma unroll
                    for (int j = 0; j < 4; ++j) { bvc[j] = bvp[(b * 4 + j) * 512]; ggc[j] = ggp[(b * 4 + j) * 512]; }
                    float yv0 = 0.f, yv1 = 0.f, yv2 = 0.f, yv3 = 0.f;
                    if (b + 1 < 16) { LAS float* nb = buf + ((b + 1) & 1) * 1280;
#pragma unroll
                        for (int j = 0; j < 5; ++j) __builtin_amdgcn_global_load_lds((const unsigned*)(src + (b + 1) * 320 + j * 64 + lane), (LAS unsigned*)(nb + j * 256), 16, 0, 0);
#pragma unroll
                        for (int j = 0; j < 4; ++j) vn[j] = vsrc[((b + 1) * 4 + j) * 64];
                    }
                    const LAS float* cb = buf + (b & 1) * 1280;
#pragma unroll 1
                    for (int s = 0; s < 4; ++s) {
                        const LAS float* st = cb + s * 320;
                        const float vi = s == 0 ? vc0 : (s == 1 ? vc1 : (s == 2 ? vc2 : vc3));
                        float yy; RWKV_STEP(st, vi, St, true, true, yy);
                        yv0 = s == 0 ? yy : yv0; yv1 = s == 1 ? yy : yv1; yv2 = s == 2 ? yy : yv2; yv3 = s == 3 ? yy : yv3;
                    }
                    asm volatile("s_waitcnt vmcnt(0)" ::: "memory");
                    const float yv[4] = {yv0, yv1, yv2, yv3};
#pragma unroll
                    for (int s = 0; s < 4; ++s) { const int t = tbase + b * 4 + s;
                        const float m = wave_sum(yv[s]) * (1.f / 64.f); const float d = yv[s] - m; const float var = wave_sum(d * d) * (1.f / 64.f);
                        const float yn = d * rsqrtf(var + 64e-5f) * lg + lbias;
                        Y[(size_t)t * DM + 512 + ch] = f2bf((yn + bvc[s]) * ggc[s]); }
                }
            }
        } else if (G >= 256) {
            LAS float* scr = (LAS float*)(lds + 49152 + (wave - 4) * 16896);
            convert_layer_weights(args, ws, l, scr, bid * 4 + (wave - 4), G * 4, lane, 9600, 12416);
            if (l == 0) convert_layer_weights(args, ws, 1, scr, bid * 4 + (wave - 4), G * 4, lane, 0, 3968);
        }
        }
        fast_barrier(BAR, ++bar_epoch, (unsigned)G);
        { int tid = tid0; asm volatile("" : "+v"(tid)); const int lane = tid & 63; (void)lane;
        {
            pg8::Gemm g{Y, (const bf16_t*)(wt + WT_OUT), SEQ, DM, DM, 256}; pg8::StaticOrder S; S.init(SEQ, DM, G, bid);
            pg8::EpiResid E{l == 0 ? args.in[I_X] : (const float*)XR, XR, XB, SSQ, lds};
            pg8::gemm_phase<pg8::EpiResid>(lds, g, S, E);
        }
        }
        fast_barrier(BAR, ++bar_epoch, (unsigned)G);
        { int tid = tid0; asm volatile("" : "+v"(tid)); const int lane = tid & 63; (void)lane;
        {
            pg8::Gemm g{XB, (const bf16_t*)(wt + WT_UP), 33 * 256, NUP, DM, 254}; pg8::StaticOrder S; S.init(33 * 256, NUP, G, bid);
            pg8::EpiConvSwiGLU E{ACT, SSQ, args.in[I_CONVW] + (size_t)l * 3 * NUP, args.in[I_CONVB] + (size_t)l * NUP};
            pg8::Unit uu;
            for (int i = 0; S.next(i, uu); ++i) { pg8::OneUnit one{uu}; pg8::gemm_phase<pg8::EpiConvSwiGLU, pg8::OneUnit>(lds, g, one, E); }
        }
        }
        fast_barrier(BAR, ++bar_epoch, (unsigned)G);
        { int tid = tid0; asm volatile("" : "+v"(tid)); const int lane = tid & 63; (void)lane;
        {
            pg8::Gemm g{ACT, (const bf16_t*)(wt + WT_DOWN), SEQ, DM, DFF, 256}; pg8::StaticOrder S; S.init(SEQ, DM, G, bid);
            pg8::EpiResid E{(const float*)XR, XR, XB, SSQ, lds};
            pg8::gemm_phase<pg8::EpiResid>(lds, g, S, E);
        }
        }
        fast_barrier(BAR, ++bar_epoch, (unsigned)G);
    }
        { int tid = tid0; asm volatile("" : "+v"(tid)); const int lane = tid & 63; (void)lane;
    {
        const float* fg = args.in[I_FING];
        for (int row = gw; row < SEQ; row += NGW) {
            float s = SSQ[(size_t)row * 8 + (lane & 7)]; s = wave_sum(s) * 0.125f;
            const float rs = rsqrtf(s * (1.f / 2048.f) + EPS);
            f32x4* xr = (f32x4*)(XR + (size_t)row * DM) + lane; const f32x4* gp = (const f32x4*)fg + lane;
#pragma unroll
            for (int j = 0; j < 8; ++j) { f32x4 v = xr[64 * j]; const f32x4 gv = gp[64 * j]; v = v * rs * gv; xr[64 * j] = v; }
        }
    }
        }
}

extern "C" void kernel_launch(void* const* d_in, const int* in_sizes, int n_in, void* d_out, int out_size, void* d_ws, size_t ws_size, hipStream_t stream) {
    static int grid = 0;
    if (grid == 0) {
        if (n_in != 28 || ws_size < WS_END) { fprintf(stderr, "kernel_launch: unexpected n_in %d / ws_size %zu\n", n_in, ws_size); grid = -1; return; }
        int dev = 0, cus = 0, per_cu = 0;
        hipGetDevice(&dev); hipDeviceGetAttribute(&cus, hipDeviceAttributeMultiprocessorCount, dev);
        hipFuncSetAttribute((const void*)mega_fwd, hipFuncAttributeMaxDynamicSharedMemorySize, LDS_BYTES);
        hipOccupancyMaxActiveBlocksPerMultiprocessor(&per_cu, (const void*)mega_fwd, 512, LDS_BYTES);
        if (per_cu < 1) { fprintf(stderr, "kernel_launch: occupancy query says %d blocks/CU\n", per_cu); per_cu = 1; }
        grid = cus * (per_cu > 1 ? 1 : per_cu);
    }
    if (grid < 0) return;
    (void)hipMemsetAsync(d_ws, 0, 8192, stream);
    Args a{};
    for (int i = 0; i < 28; ++i) a.in[i] = (const float*)d_in[i];
    a.out = (float*)d_out; a.ws = (unsigned char*)d_ws;
    void* kargs[] = {&a};
    hipError_t e = hipLaunchCooperativeKernel((const void*)mega_fwd, dim3(grid), dim3(512), kargs, LDS_BYTES, stream);
    if (e != hipSuccess) fprintf(stderr, "cooperative launch failed: %s (grid %d)\n", hipGetErrorString(e), grid);
}
```

```cpp
#include <hip/hip_runtime.h>
#include <hip/hip_cooperative_groups.h>
#include <cstdio>
#include <cstdint>
namespace cg = cooperative_groups;

#define LAS __attribute__((address_space(3)))
typedef unsigned short bf16_t;
typedef short bf16x8 __attribute__((ext_vector_type(8)));
typedef float f32x4 __attribute__((ext_vector_type(4)));
typedef float f32x2 __attribute__((ext_vector_type(2)));
typedef unsigned u32x4 __attribute__((ext_vector_type(4)));
typedef unsigned u32x2 __attribute__((ext_vector_type(2)));

constexpr int SEQ = 8192, DM = 2048, NIN = 5808, NINP = 5888, DFF = 5632, NUP = 11264;
constexpr int PC_A = 0, PC_B = 1024, PC_C = 2720, PC_D = 4256;
constexpr float EPS = 1e-6f;
constexpr float QSCALE = 0.125f * 1.4426950408889634f;

constexpr size_t MiB = 1u << 20;
constexpr size_t WS_ROPE = 1 * MiB, WS_SSQ = 3 * MiB, WS_KMEAN = 4 * MiB, WS_IDZ = 5 * MiB, WS_SEL = 6 * MiB, WS_WT = 8 * MiB;
constexpr size_t WT_IN = 0, WT_OUT = 23 * MiB, WT_UP = 31 * MiB, WT_DOWN = 75 * MiB, WT_LAYER = 97 * MiB;
constexpr size_t WS_XB = 202 * MiB, WS_Y = 234 * MiB, WS_P = 266 * MiB;
constexpr size_t WS_QB = 358 * MiB, WS_KB = 366 * MiB, WS_VT = 374 * MiB, WS_VEC5 = 382 * MiB, WS_VV = 462 * MiB, WS_GG = 478 * MiB, WS_BV = 494 * MiB;
constexpr size_t WS_PCH = 510 * MiB, WS_LCH = 526 * MiB, WS_SIN = 542 * MiB, WS_OI = 558 * MiB, WS_U = 574 * MiB, WS_QT = 590 * MiB, WS_LAM = 598 * MiB;
constexpr size_t WS_PART = 600 * MiB, WS_H = 266 * MiB, WS_ACT = 442 * MiB, WS_END = 640 * MiB;
constexpr int LDS_BYTES = 147456;

__device__ __forceinline__ float bf2f(bf16_t v) { return __uint_as_float((unsigned)v << 16); }
__device__ __forceinline__ float bflo(unsigned u) { return __uint_as_float(u << 16); }
__device__ __forceinline__ float bfhi(unsigned u) { return __uint_as_float(u & 0xffff0000u); }
__device__ __forceinline__ unsigned cvt_pk_bf16(float lo, float hi) { unsigned r; asm volatile("v_cvt_pk_bf16_f32 %0, %1, %2" : "=v"(r) : "v"(lo), "v"(hi)); return r; }
__device__ __forceinline__ bf16_t f2bf(float f) { return (bf16_t)(cvt_pk_bf16(f, 0.f) & 0xffffu); }
__device__ __forceinline__ float wave_sum(float v) {
#pragma unroll
    for (int o = 32; o > 0; o >>= 1) v += __shfl_xor(v, o);
    return v;
}
__device__ __forceinline__ float sigmoidf_(float x) { return 1.f / (1.f + __expf(-x)); }
__device__ __forceinline__ float gelu_tanh(float x) { const float u = 0.7978845608f * (x + 0.044715f * x * x * x); const float e = __expf(2.f * u); const float th = 1.f - 2.f / (e + 1.f); return 0.5f * x * (1.f + th); }
__device__ __forceinline__ void unpack8(const u32x4 r, float (&z)[8]) { z[0] = bflo(r.x); z[1] = bfhi(r.x); z[2] = bflo(r.y); z[3] = bfhi(r.y); z[4] = bflo(r.z); z[5] = bfhi(r.z); z[6] = bflo(r.w); z[7] = bfhi(r.w); }

__device__ __forceinline__ void fast_barrier(unsigned* bar, unsigned epoch  , unsigned G) {
    asm volatile("s_waitcnt vmcnt(0) lgkmcnt(0)" ::: "memory");
    __syncthreads();
    if (threadIdx.x == 0) {
        __builtin_amdgcn_fence(__ATOMIC_RELEASE, "agent");
        asm volatile("s_waitcnt vmcnt(0)" ::: "memory");
        const unsigned grp = blockIdx.x & 7u; const unsigned gsz = (G - grp + 7u) >> 3; const unsigned ngrp = G < 8u ? G : 8u;
        const unsigned old = __hip_atomic_fetch_add(bar + 64u * (1u + grp), 1u, __ATOMIC_RELAXED, __HIP_MEMORY_SCOPE_AGENT);
        if (old + 1u == epoch * gsz) __hip_atomic_fetch_add(bar, 1u, __ATOMIC_RELAXED, __HIP_MEMORY_SCOPE_AGENT);
        unsigned spins = 0;
        while (__hip_atomic_load(bar, __ATOMIC_RELAXED, __HIP_MEMORY_SCOPE_AGENT) < epoch * ngrp) { __builtin_amdgcn_s_sleep(1); if (++spins > (1u << 26)) break; }
        __builtin_amdgcn_fence(__ATOMIC_ACQUIRE, "agent");
        asm volatile("s_waitcnt vmcnt(0)" ::: "memory");
    }
    __syncthreads();
}

namespace pg8 {
constexpr int BM = 256, BK = 64, HALF = 128, HTB = HALF * BK * 2, STAGE_BYTES = 8 * HTB, NXCD = 8, WGM = 8;
__host__ __device__ __forceinline__ int lds_byte(int r, int c) { const int st = (r >> 4) * 2 + (c >> 5), rr = r & 15, cc = c & 31, ob = rr * 64 + cc * 2; return st * 1024 + (ob ^ (((ob >> 9) & 1) << 5)); }
__host__ __device__ __forceinline__ void stage_rc(int b, int& R, int& C) { const int st = b / 1024, sb = b % 1024, swz = sb ^ (((sb >> 9) & 1) << 5); R = (st >> 1) * 16 + swz / 64; C = (st & 1) * 32 + (swz % 64) / 2; }
__host__ __device__ __forceinline__ int perm32(int rho) { const int n = rho >> 4, i = rho & 15; return 8 * (i >> 2) + 4 * n + (i & 3); }
struct Unit { int pm, pn; };
struct Gemm { const bf16_t* A; const bf16_t* Bt; int M, N, K; int a_step_rows; };
struct OneUnit { Unit u; __device__ __forceinline__ bool next(int i, Unit& o) const { if (i) return false; o = u; return true; } };
struct StaticOrder {
    int nM, nN, nwg, G, c;
    __device__ __forceinline__ void init(int M, int N, int G_, int c_) { nM = M / BM; nN = N / BM; nwg = nM * nN; G = G_; c = c_; }
    __device__ __forceinline__ bool next(int i, Unit& u) const {
        const long L = (long)i * G + c; if (L >= nwg) return false;
        int wgid = (int)L; { const int q = nwg / NXCD, r = nwg % NXCD, xcd = wgid % NXCD, off = wgid / NXCD; wgid = (xcd < r ? xcd * (q + 1) : r * (q + 1) + (xcd - r) * q) + off; }
        const int nig = WGM * nN, gid = wgid / nig, fm = gid * WGM, gsz = (nM - fm) < WGM ? (nM - fm) : WGM;
        u.pm = fm + ((wgid % nig) % gsz); u.pn = (wgid % nig) / gsz; return true;
    }
};
struct EpiScaleBf16 {
    static constexpr bool AFTER_DRAIN = false;
    bf16_t* O; int ldc; const float* ssq;
    __device__ __forceinline__ void operator()(const f32x4 (&acc)[2][2][4][2], const Unit& u, int wr, int wc, int fr, int fq) const {
        const int row0 = u.pm * BM + wr * 64 + fr; const int col0 = u.pn * BM + wc * 32 + 8 * fq;
#pragma unroll
        for (int ai = 0; ai < 2; ++ai)
#pragma unroll
            for (int m = 0; m < 4; ++m) {
                const int row = row0 + ai * HALF + m * 16;
                const f32x4* sp = (const f32x4*)(ssq + (size_t)row * 8);
                f32x4 s4 = sp[0] + sp[1];
                const float rs = rsqrtf(((s4[0] + s4[1]) + (s4[2] + s4[3])) * (1.0f / 2048.0f) + EPS);
                bf16_t* rowp = O + (size_t)row * ldc + col0;
#pragma unroll
                for (int bj = 0; bj < 2; ++bj) { const f32x4 v0 = acc[ai][bj][m][0] * rs, v1 = acc[ai][bj][m][1] * rs;
                    u32x4 w; w.x = cvt_pk_bf16(v0[0], v0[1]); w.y = cvt_pk_bf16(v0[2], v0[3]); w.z = cvt_pk_bf16(v1[0], v1[1]); w.w = cvt_pk_bf16(v1[2], v1[3]);
                    *(u32x4*)(rowp + bj * HALF) = w; }
            }
    }
};
struct EpiResid {
    static constexpr bool AFTER_DRAIN = false;
    const float* base; float* xr; bf16_t* xb; float* ssq; LAS unsigned char* lds;
    __device__ __forceinline__ void operator()(const f32x4 (&acc)[2][2][4][2], const Unit& u, int wr, int wc, int fr, int fq) const {
        const int row0 = u.pm * BM + wr * 64 + fr; const int col0 = u.pn * BM + wc * 32 + 8 * fq;
        LAS float* xq = (LAS float*)(lds + 131072);
#pragma unroll
        for (int ai = 0; ai < 2; ++ai)
#pragma unroll
            for (int m = 0; m < 4; ++m) {
                const int row = row0 + ai * HALF + m * 16; float q = 0.f;
#pragma unroll
                for (int bj = 0; bj < 2; ++bj) { const size_t off = (size_t)row * DM + col0 + bj * HALF;
                    const f32x4 b0 = *(const f32x4*)(base + off), b1 = *(const f32x4*)(base + off + 4);
                    const f32x4 v0 = acc[ai][bj][m][0] + b0, v1 = acc[ai][bj][m][1] + b1;
                    *(f32x4*)(xr + off) = v0; *(f32x4*)(xr + off + 4) = v1;
                    u32x4 w; w.x = cvt_pk_bf16(v0[0], v0[1]); w.y = cvt_pk_bf16(v0[2], v0[3]); w.z = cvt_pk_bf16(v1[0], v1[1]); w.w = cvt_pk_bf16(v1[2], v1[3]);
                    *(u32x4*)(xb + off) = w;
                    q += (v0[0] * v0[0] + v0[1] * v0[1]) + (v0[2] * v0[2] + v0[3] * v0[3]) + (v1[0] * v1[0] + v1[1] * v1[1]) + (v1[2] * v1[2] + v1[3] * v1[3]); }
                q += __shfl_xor(q, 16); q += __shfl_xor(q, 32);
                if (fq == 0) xq[(ai * HALF + wr * 64 + m * 16 + fr) * 4 + wc] = q;
            }
        asm volatile("s_waitcnt lgkmcnt(0)" ::: "memory"); __builtin_amdgcn_s_barrier(); asm volatile("" ::: "memory");
        { const int tid_ = (wr * 4 + wc) * 64 + fq * 16 + fr;
          if (tid_ < 256) { const f32x4 v = *(const LAS f32x4*)(xq + tid_ * 4); ssq[(size_t)(u.pm * BM + tid_) * 8 + u.pn] = (v[0] + v[1]) + (v[2] + v[3]); } }
    }
};

struct EpiConvSwiGLU {
    static constexpr bool AFTER_DRAIN = true;
    bf16_t* act; const float* ssq; const float* cw; const float* cb;
    __device__ __forceinline__ void fused(const f32x4 (&acc)[2][2][4][2], const Unit& u, int wr, int wc, int fr, int fq, LAS unsigned char* lds) const {
        const int rs = u.pm * 254;
#pragma unroll
        for (int ai = 0; ai < 2; ++ai)
#pragma unroll
            for (int m = 0; m < 4; ++m) {
                const int lr = ai * HALF + wr * 64 + m * 16 + fr; int row = rs + lr; row = row < SEQ ? row : SEQ - 1;
                const f32x4* sp = (const f32x4*)(ssq + (size_t)row * 8);
                const f32x4 s4 = sp[0] + sp[1];
                const float rsd = rsqrtf(((s4[0] + s4[1]) + (s4[2] + s4[3])) * (1.0f / 2048.0f) + EPS);
#pragma unroll
                for (int bj = 0; bj < 2; ++bj) { const f32x4 v0 = acc[ai][bj][m][0] * rsd, v1 = acc[ai][bj][m][1] * rsd;
                    u32x4 w; w.x = cvt_pk_bf16(v0[0], v0[1]); w.y = cvt_pk_bf16(v0[2], v0[3]); w.z = cvt_pk_bf16(v1[0], v1[1]); w.w = cvt_pk_bf16(v1[2], v1[3]);
                    const int c = 16 * bj + 4 * wc + fq;
                    *(LAS u32x4*)(lds + lr * 512 + ((c ^ ((lr & 7) << 2)) << 4)) = w; }
            }
        asm volatile("s_waitcnt lgkmcnt(0)" ::: "memory"); __builtin_amdgcn_s_barrier(); asm volatile("" ::: "memory");
        const int tid_ = (wr * 4 + wc) * 64 + fq * 16 + fr; const int cgp = tid_ & 15, rr = tid_ >> 4;
        const int j0 = u.pn * 128 + cgp * 8;
        float wg[3][8], wu[3][8], bg[8], bu[8];
#pragma unroll
        for (int k = 0; k < 3; ++k) { const f32x4 a0 = *(const f32x4*)(cw + (size_t)k * NUP + j0), a1 = *(const f32x4*)(cw + (size_t)k * NUP + j0 + 4), b0 = *(const f32x4*)(cw + (size_t)k * NUP + DFF + j0), b1 = *(const f32x4*)(cw + (size_t)k * NUP + DFF + j0 + 4);
#pragma unroll
            for (int e = 0; e < 4; ++e) { wg[k][e] = a0[e]; wg[k][4 + e] = a1[e]; wu[k][e] = b0[e]; wu[k][4 + e] = b1[e]; } }
        { const f32x4 a0 = *(const f32x4*)(cb + j0), a1 = *(const f32x4*)(cb + j0 + 4), b0 = *(const f32x4*)(cb + DFF + j0), b1 = *(const f32x4*)(cb + DFF + j0 + 4);
#pragma unroll
          for (int e = 0; e < 4; ++e) { bg[e] = a0[e]; bg[4 + e] = a1[e]; bu[e] = b0[e]; bu[4 + e] = b1[e]; } }
#pragma unroll 1
        for (int hh = 0; hh < 2; ++hh) {
            u32x4 hg[6], hu[6];
#pragma unroll
            for (int i = 0; i < 6; ++i) { const int lr = 8 * rr + 4 * hh - 2 + i;
                if (lr >= 0) { const int sw = (lr & 7) << 2; hg[i] = *(const LAS u32x4*)(lds + lr * 512 + ((cgp ^ sw) << 4)); hu[i] = *(const LAS u32x4*)(lds + lr * 512 + (((16 + cgp) ^ sw) << 4)); }
                else { hg[i] = (u32x4){0u, 0u, 0u, 0u}; hu[i] = (u32x4){0u, 0u, 0u, 0u}; } }
#pragma unroll
            for (int i = 0; i < 4; ++i) { const int lo = 8 * rr + 4 * hh + i; const int grow = rs + lo;
                float g2[8], g1[8], g0[8], u2[8], u1[8], u0[8];
                unpack8(hg[i], g2); unpack8(hg[i + 1], g1); unpack8(hg[i + 2], g0); unpack8(hu[i], u2); unpack8(hu[i + 1], u1); unpack8(hu[i + 2], u0);
                float o[8];
#pragma unroll
                for (int e = 0; e < 8; ++e) { const float ag = bg[e] + wg[0][e] * g2[e] + wg[1][e] * g1[e] + wg[2][e] * g0[e]; const float au = bu[e] + wu[0][e] * u2[e] + wu[1][e] * u1[e] + wu[2][e] * u0[e];
                    o[e] = ag * sigmoidf_(ag) * au; }
                u32x4 w; w.x = cvt_pk_bf16(o[0], o[1]); w.y = cvt_pk_bf16(o[2], o[3]); w.z = cvt_pk_bf16(o[4], o[5]); w.w = cvt_pk_bf16(o[6], o[7]);
                if ((u.pm == 0 || lo >= 2) && grow < SEQ) *(u32x4*)(act + (size_t)grow * DFF + j0) = w; }
        }
        asm volatile("s_waitcnt lgkmcnt(0)" ::: "memory"); __builtin_amdgcn_s_barrier(); asm volatile("" ::: "memory");
    }
};

template <class Epi, class Sched>
__device__ __forceinline__ void gemm_phase(LAS unsigned char* lds, const Gemm g, const Sched& S, const Epi& E) {
    int tid = threadIdx.x; asm volatile("" : "+v"(tid)); const int wid = __builtin_amdgcn_readfirstlane(tid >> 6), lane = tid & 63, wr = wid >> 2, wc = wid & 3, fr = lane & 15, fq = lane >> 4;
    const int K = g.K, nt = K / BK;
    unsigned voffA[2], voffB[2];
#pragma unroll
    for (int i = 0; i < 2; ++i) { int R, C; stage_rc(tid * 16 + i * 8192, R, C); const int Rb = (R & ~31) + perm32(R & 31);
        voffA[i] = (unsigned)(R * K + C) * 2u; voffB[i] = (unsigned)(Rb * K + C) * 2u; }
    const size_t kstep = (size_t)(BK * 2);
    const size_t hstep = (size_t)HALF * K * 2;
    const size_t tstep = 2 * hstep;
    const size_t tstepA = (size_t)g.a_step_rows * K * 2;
    const unsigned ldsw = (unsigned)wid * 1024u;
    const int aoff = lds_byte(wr * 64 + fr, fq * 8), boff = lds_byte(wc * 32 + fr, fq * 8);
#define PG8_SA(b, h) (((b) * 2 + (h)) * HTB)
#define PG8_SB(b, h) ((4 + (b) * 2 + (h)) * HTB)
#define PG8_STAGE(bufoff, gbase, voff) do { _Pragma("unroll") for (int _i = 0; _i < 2; ++_i) \
        __builtin_amdgcn_global_load_lds((const unsigned*)((const char*)(gbase) + (voff)[_i]), (LAS unsigned*)(lds + (bufoff) + ldsw + _i * 8192), 16, 0, 0); } while (0)
#define PG8_LDA(dst, b, h) do { _Pragma("unroll") for (int m = 0; m < 4; ++m) _Pragma("unroll") for (int k = 0; k < 2; ++k) dst[m][k] = *(const LAS bf16x8*)(lds + PG8_SA(b, h) + aoff + m * 2048 + k * 1024); } while (0)
#define PG8_LDB(dst, b, h) do { _Pragma("unroll") for (int n = 0; n < 2; ++n) _Pragma("unroll") for (int k = 0; k < 2; ++k) dst[n][k] = *(const LAS bf16x8*)(lds + PG8_SB(b, h) + boff + n * 2048 + k * 1024); } while (0)
#define PG8_MMA(ai, bj, At, Bt) do { __builtin_amdgcn_s_setprio(1); _Pragma("unroll") for (int m = 0; m < 4; ++m) _Pragma("unroll") for (int n = 0; n < 2; ++n) _Pragma("unroll") for (int k = 0; k < 2; ++k) \
        acc[ai][bj][m][n] = __builtin_amdgcn_mfma_f32_16x16x32_bf16(Bt[n][k], At[m][k], acc[ai][bj][m][n], 0, 0, 0); __builtin_amdgcn_s_setprio(0); } while (0)
#define PG8_WAIT_V(n) asm volatile("s_waitcnt vmcnt(" #n ")" ::: "memory")
#define PG8_WAIT_L(n) asm volatile("s_waitcnt lgkmcnt(" #n ")" ::: "memory")
#define PG8_BAR __builtin_amdgcn_s_barrier()
#define PG8_SCHED __builtin_amdgcn_sched_barrier(0)
    Unit cur, nxt; int ui = 0;
    if (!S.next(0, cur)) return;
    f32x4 acc[2][2][4][2];
#pragma unroll
    for (int a = 0; a < 2; ++a)
#pragma unroll
        for (int b = 0; b < 2; ++b)
#pragma unroll
            for (int m = 0; m < 4; ++m)
#pragma unroll
                for (int n = 0; n < 2; ++n) acc[a][b][m][n] = (f32x4){0.f, 0.f, 0.f, 0.f};
    bf16x8 At[4][2], B0[2][2], B1[2][2];
    const char* cA = (const char*)g.A + (size_t)cur.pm * tstepA; const char* cB = (const char*)g.Bt + (size_t)cur.pn * tstep;
    PG8_STAGE(PG8_SB(0, 0), cB, voffB); PG8_STAGE(PG8_SB(0, 1), cB + hstep, voffB); PG8_STAGE(PG8_SA(0, 0), cA, voffA); PG8_STAGE(PG8_SA(0, 1), cA + hstep, voffA);
    if (wr == 1) PG8_BAR;
    PG8_WAIT_V(2); PG8_BAR;
    PG8_STAGE(PG8_SB(1, 0), cB + kstep, voffB); PG8_STAGE(PG8_SA(1, 0), cA + kstep, voffA); PG8_STAGE(PG8_SB(1, 1), cB + hstep + kstep, voffB);
    PG8_WAIT_V(6); PG8_BAR;
    for (;;) {
        const bool has_next = S.next(ui + 1, nxt);
        const char* nA = has_next ? (const char*)g.A + (size_t)nxt.pm * tstepA : cA; const char* nB = has_next ? (const char*)g.Bt + (size_t)nxt.pn * tstep : cB;
        for (int t = 0; t < nt; t += 2) {
            const bool last = (t == nt - 2);
            const char* a1 = cA + (size_t)(t + 1) * kstep;
            const char* a2 = last ? nA : cA + (size_t)(t + 2) * kstep; const char* b2 = last ? nB : cB + (size_t)(t + 2) * kstep;
            const char* a3 = a2 + kstep; const char* b3 = b2 + kstep;
            PG8_LDB(B0, 0, 0); PG8_LDB(B1, 0, 1); PG8_SCHED; PG8_LDA(At, 0, 0); PG8_STAGE(PG8_SA(1, 1), a1 + hstep, voffA);
            PG8_WAIT_V(8); PG8_WAIT_L(0); PG8_BAR; PG8_MMA(0, 0, At, B0); PG8_MMA(0, 1, At, B1); PG8_BAR; PG8_SCHED;
            PG8_LDA(At, 0, 1); PG8_STAGE(PG8_SB(0, 0), b2, voffB); PG8_STAGE(PG8_SB(0, 1), b2 + hstep, voffB); PG8_STAGE(PG8_SA(0, 0), a2, voffA);
            PG8_WAIT_V(8); PG8_WAIT_L(0); PG8_BAR; PG8_MMA(1, 0, At, B0); PG8_MMA(1, 1, At, B1); PG8_BAR; PG8_SCHED;
            PG8_LDB(B0, 1, 0); PG8_LDB(B1, 1, 1); PG8_SCHED; PG8_LDA(At, 1, 0); PG8_STAGE(PG8_SA(0, 1), a2 + hstep, voffA);
            PG8_WAIT_V(8); PG8_WAIT_L(0); PG8_BAR; PG8_MMA(0, 0, At, B0); PG8_MMA(0, 1, At, B1); PG8_BAR; PG8_SCHED;
            PG8_LDA(At, 1, 1); PG8_STAGE(PG8_SB(1, 0), b3, voffB); PG8_STAGE(PG8_SB(1, 1), b3 + hstep, voffB); PG8_STAGE(PG8_SA(1, 0), a3, voffA);
            PG8_WAIT_V(8); PG8_WAIT_L(0); PG8_BAR; PG8_MMA(1, 0, At, B0); PG8_MMA(1, 1, At, B1); PG8_BAR; PG8_SCHED;
        }
        if (wr == 0) PG8_BAR;
        if constexpr (!Epi::AFTER_DRAIN) E(acc, cur, wr, wc, fr, fq);
        if (!has_next) break;
#pragma unroll
        for (int a = 0; a < 2; ++a)
#pragma unroll
            for (int b = 0; b < 2; ++b)
#pragma unroll
                for (int m = 0; m < 4; ++m)
#pragma unroll
                    for (int n = 0; n < 2; ++n) acc[a][b][m][n] = (f32x4){0.f, 0.f, 0.f, 0.f};
        cur = nxt; cA = nA; cB = nB; ++ui;
        if (wr == 1) PG8_BAR;
    }
    PG8_WAIT_V(0);
    PG8_BAR;
    if constexpr (Epi::AFTER_DRAIN) E.fused(acc, cur, wr, wc, fr, fq, lds);
#undef PG8_SA
#undef PG8_SB
#undef PG8_STAGE
#undef PG8_LDA
#undef PG8_LDB
#undef PG8_MMA
#undef PG8_WAIT_V
#undef PG8_WAIT_L
#undef PG8_BAR
#undef PG8_SCHED
}
}

struct Args { const float* in[28]; float* out; unsigned char* ws; };
enum { I_X = 0, I_MIXG, I_WIN, I_ALNG, I_ALNB, I_AWS, I_ABS, I_BMU, I_BW0, I_BW2, I_BA0, I_BA2, I_BG2, I_BKK, I_BKA, I_BRK, I_BLNG, I_BLNB, I_DGW2, I_DGB, I_DNG, I_WOUT, I_FFNG, I_WUP, I_CONVW, I_CONVB, I_WDOWN, I_FING };

__device__ __forceinline__ void p0_item(const float* W, int K, int N, bf16_t* WT, const float* gsc, LAS float* scr, int kb, int nb, int row_out0, int lane) {
    const int k0 = 64 * kb, n0 = 64 * nb;
    const int nn = n0 + 2 * (lane & 31); const bool ok = nn < N;
    f32x2 v[32];
#pragma unroll
    for (int i = 0; i < 32; ++i) { const int kk = 2 * i + (lane >> 5); v[i] = ok ? __builtin_nontemporal_load((const f32x2*)(W + (size_t)(k0 + kk) * N + nn)) : (f32x2){0.f, 0.f}; }
#pragma unroll
    for (int i = 0; i < 32; ++i) { const int kk = 2 * i + (lane >> 5); f32x2 x = v[i]; if (gsc) { const float g = gsc[k0 + kk]; x = x * g; }
        scr[kk * 65 + 2 * (lane & 31)] = x.x; scr[kk * 65 + 2 * (lane & 31) + 1] = x.y; }
    asm volatile("s_waitcnt lgkmcnt(0)" ::: "memory");
    const int c = lane & 7;
#pragma unroll
    for (int j = 0; j < 8; ++j) { const int n = (lane >> 3) + 8 * j; const LAS float* sp = scr + (8 * c) * 65 + n;
        u32x4 o; o.x = cvt_pk_bf16(sp[0 * 65], sp[1 * 65]); o.y = cvt_pk_bf16(sp[2 * 65], sp[3 * 65]); o.z = cvt_pk_bf16(sp[4 * 65], sp[5 * 65]); o.w = cvt_pk_bf16(sp[6 * 65], sp[7 * 65]);
        *(u32x4*)(WT + (size_t)(row_out0 + n) * K + k0 + 8 * c) = o; }
    asm volatile("s_waitcnt lgkmcnt(0)" ::: "memory");
}

__device__ __forceinline__ void convert_layer_weights(const Args& args, unsigned char* ws, int l, LAS float* scr, int w0, int nw, int lane, int it_lo, int it_hi) {
    constexpr int I_IN = 32 * 92, I_OUT = 32 * 32, I_UP = 32 * 176, I_DN = 88 * 32;
    unsigned char* wt = ws + WS_WT + (size_t)l * WT_LAYER;
    for (int it = it_lo + w0; it < it_hi; it += nw) {
        int r = it;
        if (r < I_IN) { const int kb = r / 92, nb = r % 92; p0_item(args.in[I_WIN] + (size_t)l * DM * NIN, DM, NIN, (bf16_t*)(wt + WT_IN), args.in[I_MIXG] + l * DM, scr, kb, nb, nb * 64, lane); continue; } r -= I_IN;
        if (r < I_OUT) { const int kb = r / 32, nb = r % 32; p0_item(args.in[I_WOUT] + (size_t)l * DM * DM, DM, DM, (bf16_t*)(wt + WT_OUT), nullptr, scr, kb, nb, nb * 64, lane); continue; } r -= I_OUT;
        if (r < I_UP) { const int kb = r / 176, nb = r % 176; const int n0 = nb * 64; const int j = n0 < DFF ? n0 : n0 - DFF; const int ro = (j >> 7) * 256 + (j & 127) + (n0 < DFF ? 0 : 128);
            p0_item(args.in[I_WUP] + (size_t)l * DM * NUP, DM, NUP, (bf16_t*)(wt + WT_UP), args.in[I_FFNG] + l * DM, scr, kb, nb, ro, lane); continue; } r -= I_UP;
        { const int kb = r / 32, nb = r % 32; p0_item(args.in[I_WDOWN] + (size_t)l * DFF * DM, DFF, DM, (bf16_t*)(wt + WT_DOWN), nullptr, scr, kb, nb, nb * 64, lane); }
    }
}

#define RWKV_LO(v) __builtin_shufflevector(v, v, 0, 1)
#define RWKV_HI(v) __builtin_shufflevector(v, v, 2, 3)
#define RWKV_LDB(set, g) do { _Pragma("unroll") for (int q = 0; q < 2; ++q) { lq_[set][q] = *(const LAS f32x4*)((st_) + 64 + (g) * 8 + q * 4); lq_[set][2 + q] = *(const LAS f32x4*)((st_) + 128 + (g) * 8 + q * 4); \
        lq_[set][4 + q] = *(const LAS f32x4*)((st_) + 192 + (g) * 8 + q * 4); if (WITH_Y_) lq_[set][6 + q] = *(const LAS f32x4*)((st_) + 256 + (g) * 8 + q * 4); } } while (0)
#define RWKV_STEP(st, vi, St, WITH_Y, WITH_V, yout) do { \
    const LAS float* st_ = (st); constexpr bool WITH_Y_ = (WITH_Y); \
    f32x2 a0_ = (f32x2){0.f, 0.f}, a1_ = (f32x2){0.f, 0.f}; \
    f32x4 na_[16]; f32x4 lq_[3][8]; \
    _Pragma("unroll") for (int q = 0; q < 16; ++q) na_[q] = *(const LAS f32x4*)(st_ + q * 4); \
    RWKV_LDB(0, 0); RWKV_LDB(1, 1); \
    __builtin_amdgcn_sched_barrier(0); \
    _Pragma("unroll") for (int q = 0; q < 16; ++q) { const f32x4 n = na_[q]; a0_ += St[2 * q] * RWKV_LO(n); a1_ += St[2 * q + 1] * RWKV_HI(n); } \
    const float sa_ = (a0_.x + a0_.y) + (a1_.x + a1_.y); const f32x2 sa2_ = (f32x2){sa_, sa_}; const f32x2 vi2_ = (f32x2){(vi), (vi)}; \
    f32x2 y0_ = (f32x2){0.f, 0.f}, y1_ = (f32x2){0.f, 0.f}; \
    __builtin_amdgcn_sched_barrier(0); \
    _Pragma("unroll") for (int gi = 0; gi < 8; ++gi) { \
        if (gi + 2 < 8) RWKV_LDB((gi + 2) % 3, gi + 2); \
        __builtin_amdgcn_sched_barrier(0); \
        _Pragma("unroll") for (int q = 0; q < 2; ++q) { const f32x4 dd = lq_[gi % 3][q], bb = lq_[gi % 3][2 + q], kk = lq_[gi % 3][4 + q]; const int k2 = gi * 4 + q * 2; \
            if (WITH_V) { St[k2] = St[k2] * RWKV_LO(dd) + sa2_ * RWKV_LO(bb) + vi2_ * RWKV_LO(kk); St[k2 + 1] = St[k2 + 1] * RWKV_HI(dd) + sa2_ * RWKV_HI(bb) + vi2_ * RWKV_HI(kk); } \
            else { St[k2] = St[k2] * RWKV_LO(dd) + sa2_ * RWKV_LO(bb); St[k2 + 1] = St[k2 + 1] * RWKV_HI(dd) + sa2_ * RWKV_HI(bb); } \
            if (WITH_Y_) { const f32x4 rr = lq_[gi % 3][6 + q]; y0_ += St[k2] * RWKV_LO(rr); y1_ += St[k2 + 1] * RWKV_HI(rr); } } \
        __builtin_amdgcn_sched_barrier(0); } \
    yout = (y0_.x + y0_.y) + (y1_.x + y1_.y); } while (0)

__global__ void __launch_bounds__(512, 2) mega_fwd(Args args) {
    extern __shared__ __attribute__((aligned(16))) unsigned char lds_raw[];
    LAS unsigned char* lds = (LAS unsigned char*)lds_raw;
    cg::grid_group grid = cg::this_grid();
    const int tid0 = threadIdx.x, wave = __builtin_amdgcn_readfirstlane(tid0 >> 6);
    const int bid = blockIdx.x, G = gridDim.x;
    const int gw = bid * 8 + wave, NGW = G * 8;
    unsigned char* ws = args.ws;
    float* XR = args.out;
    bf16_t* XB = (bf16_t*)(ws + WS_XB); bf16_t* Y = (bf16_t*)(ws + WS_Y); bf16_t* P = (bf16_t*)(ws + WS_P);
    float* IDZ = (float*)(ws + WS_IDZ); int* SEL = (int*)(ws + WS_SEL); float* PART = (float*)(ws + WS_PART);
    unsigned* BAR = (unsigned*)ws; unsigned bar_epoch = 0;
    float* SSQ = (float*)(ws + WS_SSQ); f32x2* ROPE = (f32x2*)(ws + WS_ROPE); float* KMEAN = (float*)(ws + WS_KMEAN);
    bf16_t* QB = (bf16_t*)(ws + WS_QB); bf16_t* KB = (bf16_t*)(ws + WS_KB); bf16_t* VT = (bf16_t*)(ws + WS_VT);
    float* VEC5 = (float*)(ws + WS_VEC5); float* VV = (float*)(ws + WS_VV); float* GG = (float*)(ws + WS_GG); float* BV = (float*)(ws + WS_BV);
    float* PCH = (float*)(ws + WS_PCH); float* LCH = (float*)(ws + WS_LCH); float* SIN = (float*)(ws + WS_SIN);
    float* OI = (float*)(ws + WS_OI); float* GU = (float*)(ws + WS_U); float* QT = (float*)(ws + WS_QT); float* LAM = (float*)(ws + WS_LAM);
    bf16_t* HB = (bf16_t*)(ws + WS_H); bf16_t* ACT = (bf16_t*)(ws + WS_ACT);

        { int tid = tid0; asm volatile("" : "+v"(tid)); const int lane = tid & 63; (void)lane;
    {
        LAS float* scr = (LAS float*)(lds + wave * 16896);
        const bool split_conv = (G >= 256);
        convert_layer_weights(args, ws, 0, scr, gw, NGW, lane, 0, split_conv ? 3968 : 12416);
        if (!split_conv) convert_layer_weights(args, ws, 1, scr, gw, NGW, lane, 0, 12416);
        for (int idx = bid * 512 + tid; idx < 8192; idx += G * 512) IDZ[idx] = (idx < 4096 && (idx >> 6) == (idx & 63)) ? 1.f : 0.f;
        for (int idx = bid * 512 + tid; idx < SEQ * 32; idx += G * 512) {
            const int t = idx >> 5, d = idx & 31;
            const float inv = exp2f(-(float)d * (13.287712379549449f / 32.0f));
            const float ang = (float)t * inv;
            const double rev = (double)ang * 0.15915494309189535; const float fr = (float)(rev - floor(rev));
            ROPE[idx] = (f32x2){__builtin_amdgcn_cosf(fr), __builtin_amdgcn_sinf(fr)};
        }
        const float* x = args.in[I_X];
        for (int row = gw; row < SEQ; row += NGW) {
            const f32x4* xr = (const f32x4*)(x + (size_t)row * DM) + lane; float s = 0.f;
            u32x2* ob = (u32x2*)(XB + (size_t)row * DM) + lane;
#pragma unroll
            for (int j = 0; j < 8; ++j) { const f32x4 v = xr[64 * j]; s += (v[0] * v[0] + v[1] * v[1]) + (v[2] * v[2] + v[3] * v[3]); u32x2 w; w.x = cvt_pk_bf16(v[0], v[1]); w.y = cvt_pk_bf16(v[2], v[3]); ob[64 * j] = w; }
            s = wave_sum(s);
            if (lane < 8) SSQ[(size_t)row * 8 + lane] = lane == 0 ? s : 0.f;
        }
    }
        }
    grid.sync();

    for (int l = 0; l < 2; ++l) {
        unsigned char* wt = ws + WS_WT + (size_t)l * WT_LAYER;
        { int tid = tid0; asm volatile("" : "+v"(tid)); const int lane = tid & 63; (void)lane;
        {
            pg8::Gemm g{XB, (const bf16_t*)(wt + WT_IN), SEQ, NINP, DM, 256}; pg8::StaticOrder S; S.init(SEQ, NINP, G, bid);
            pg8::EpiScaleBf16 E{P, NINP, SSQ};
            pg8::gemm_phase<pg8::EpiScaleBf16>(lds, g, S, E);
        }
        }
        fast_barrier(BAR, ++bar_epoch, (unsigned)G);
        { int tid = tid0; asm volatile("" : "+v"(tid)); const int lane = tid & 63; (void)lane;
        for (int unit = bid; unit < 256; unit += G) {
            const int n = unit >> 2, h = unit & 3, t0 = n * 128;
            LAS float* Vs = (LAS float*)lds; LAS float* Wt = (LAS float*)(lds + 65536); LAS float* st = (LAS float*)(lds + 65536 + 67584);
            const float* lng = args.in[I_ALNG] + l * 512; const float* lnb = args.in[I_ALNB] + l * 512;
            const float* wsrc = args.in[I_AWS] + ((size_t)l * 4 + h) * 16384; const float* bsrc = args.in[I_ABS] + (l * 4 + h) * 128;
            u32x4 raws[16];
#pragma unroll
            for (int i = 0; i < 16; ++i) raws[i] = *(const u32x4*)(P + (size_t)(t0 + wave * 16 + i) * NINP + PC_A + 512 + lane * 8);
#pragma unroll
            for (int i = 0; i < 16; ++i) { const int tt = wave * 16 + i;
                const u32x4 raw = raws[i]; float z[8]; unpack8(raw, z); float s = 0.f;
#pragma unroll
                for (int j = 0; j < 8; ++j) { z[j] = gelu_tanh(z[j]); s += z[j]; }
                const float mu = wave_sum(s) * (1.f / 512.f); float q = 0.f;
#pragma unroll
                for (int j = 0; j < 8; ++j) { const float d = z[j] - mu; q += d * d; }
                const float var = wave_sum(q) * (1.f / 512.f);
                if (lane == 0) { st[tt * 2] = mu; st[tt * 2 + 1] = rsqrtf(var + EPS); } }
            for (int i = 0; i < 32; ++i) { const int e = tid + 512 * i; const int t = e >> 7, s = e & 127; Wt[s * 132 + t] = (s <= t) ? wsrc[e] : 0.f; }
            __syncthreads();
            for (int i = 0; i < 4; ++i) { const int idx = tid + 512 * i; const int s = idx >> 4, c0 = (idx & 15) * 8;
                const u32x4 raw = *(const u32x4*)(P + (size_t)(t0 + s) * NINP + PC_A + 512 + h * 128 + c0); float z[8]; unpack8(raw, z);
                const float mu = st[s * 2], rs = st[s * 2 + 1];
#pragma unroll
                for (int j = 0; j < 8; ++j) Vs[s * 128 + c0 + j] = (gelu_tanh(z[j]) - mu) * rs * lng[h * 128 + c0 + j] + lnb[h * 128 + c0 + j]; }
            __syncthreads();
            const int tg = tid >> 4, cgp = tid & 15; const int s_end = wave * 16 + 16;
            float acc[4][8];
#pragma unroll
            for (int i = 0; i < 4; ++i)
#pragma unroll
                for (int j = 0; j < 8; ++j) acc[i][j] = 0.f;
            { f32x4 w4n[2], v0n[2], v1n[2];
#pragma unroll
              for (int q = 0; q < 2; ++q) { w4n[q] = *(const LAS f32x4*)(Wt + q * 132 + tg * 4); v0n[q] = *(const LAS f32x4*)(Vs + q * 128 + cgp * 8); v1n[q] = *(const LAS f32x4*)(Vs + q * 128 + cgp * 8 + 4); }
              for (int s = 0; s < s_end; s += 2) {
                f32x4 w4c[2], v0c[2], v1c[2];
#pragma unroll
                for (int q = 0; q < 2; ++q) { w4c[q] = w4n[q]; v0c[q] = v0n[q]; v1c[q] = v1n[q]; }
                const int sn = (s + 2 < 128) ? s + 2 : 126;
#pragma unroll
                for (int q = 0; q < 2; ++q) { w4n[q] = *(const LAS f32x4*)(Wt + (sn + q) * 132 + tg * 4); v0n[q] = *(const LAS f32x4*)(Vs + (sn + q) * 128 + cgp * 8); v1n[q] = *(const LAS f32x4*)(Vs + (sn + q) * 128 + cgp * 8 + 4); }
                __builtin_amdgcn_sched_barrier(0);
#pragma unroll
                for (int q = 0; q < 2; ++q)
#pragma unroll
                    for (int i = 0; i < 4; ++i) {
#pragma unroll
                        for (int j = 0; j < 4; ++j) { acc[i][j] += w4c[q][i] * v0c[q][j]; acc[i][4 + j] += w4c[q][i] * v1c[q][j]; } }
                __builtin_amdgcn_sched_barrier(0);
              } }
#pragma unroll
            for (int i = 0; i < 4; ++i) { const int t = tg * 4 + i; const float bias = bsrc[t];
                const u32x4 raw = *(const u32x4*)(P + (size_t)(t0 + t) * NINP + PC_A + h * 128 + cgp * 8); float z[8]; unpack8(raw, z); float o[8];
#pragma unroll
                for (int j = 0; j < 8; ++j) o[j] = gelu_tanh(z[j]) * (acc[i][j] + bias);
                u32x4 w; w.x = cvt_pk_bf16(o[0], o[1]); w.y = cvt_pk_bf16(o[2], o[3]); w.z = cvt_pk_bf16(o[4], o[5]); w.w = cvt_pk_bf16(o[6], o[7]);
                *(u32x4*)(Y + (size_t)(t0 + t) * DM + h * 128 + cgp * 8) = w; }
            __syncthreads();
        }
        }
        { int tid = tid0; asm volatile("" : "+v"(tid)); const int lane = tid & 63; (void)lane;
        for (int unit = bid; unit < 256; unit += G) {
            const int n = unit >> 3, h = unit & 7; const int tt = tid >> 1, half = tid & 1, t = n * 256 + tt, d0 = half * 16;
            LAS float* red = (LAS float*)lds;
            LAS bf16_t* vsT = (LAS bf16_t*)(lds + 4096);
            const bf16_t* prow = P + (size_t)t * NINP + PC_C + h * 64;
            float ql[16], qh[16], kl[16], kh[16];
            { u32x4 a0 = *(const u32x4*)(prow + d0), a1 = *(const u32x4*)(prow + d0 + 8), b0 = *(const u32x4*)(prow + 32 + d0), b1 = *(const u32x4*)(prow + 32 + d0 + 8);
              float z[8]; unpack8(a0, z);
#pragma unroll
              for (int j = 0; j < 8; ++j) ql[j] = z[j];
              unpack8(a1, z);
#pragma unroll
              for (int j = 0; j < 8; ++j) ql[8 + j] = z[j];
              unpack8(b0, z);
#pragma unroll
              for (int j = 0; j < 8; ++j) qh[j] = z[j];
              unpack8(b1, z);
#pragma unroll
              for (int j = 0; j < 8; ++j) qh[8 + j] = z[j]; }
            { u32x4 a0 = *(const u32x4*)(prow + 512 + d0), a1 = *(const u32x4*)(prow + 512 + d0 + 8), b0 = *(const u32x4*)(prow + 512 + 32 + d0), b1 = *(const u32x4*)(prow + 512 + 32 + d0 + 8);
              float z[8]; unpack8(a0, z);
#pragma unroll
              for (int j = 0; j < 8; ++j) kl[j] = z[j];
              unpack8(a1, z);
#pragma unroll
              for (int j = 0; j < 8; ++j) kl[8 + j] = z[j];
              unpack8(b0, z);
#pragma unroll
              for (int j = 0; j < 8; ++j) kh[j] = z[j];
              unpack8(b1, z);
#pragma unroll
              for (int j = 0; j < 8; ++j) kh[8 + j] = z[j]; }
            const f32x2* cs = ROPE + (size_t)t * 32 + d0;
#pragma unroll
            for (int j = 0; j < 16; ++j) { const f32x2 c = cs[j];
                const float q1 = ql[j], q2 = qh[j]; ql[j] = (q1 * c.x - q2 * c.y) * QSCALE; qh[j] = (q1 * c.y + q2 * c.x) * QSCALE;
                const float k1 = kl[j], k2 = kh[j]; kl[j] = k1 * c.x - k2 * c.y; kh[j] = k1 * c.y + k2 * c.x; }
            { bf16_t* qo = QB + (size_t)t * 512 + h * 64 + d0; bf16_t* ko = KB + (size_t)t * 512 + h * 64 + d0;
              u32x4 w;
              w.x = cvt_pk_bf16(ql[0], ql[1]); w.y = cvt_pk_bf16(ql[2], ql[3]); w.z = cvt_pk_bf16(ql[4], ql[5]); w.w = cvt_pk_bf16(ql[6], ql[7]); *(u32x4*)(qo) = w;
              w.x = cvt_pk_bf16(ql[8], ql[9]); w.y = cvt_pk_bf16(ql[10], ql[11]); w.z = cvt_pk_bf16(ql[12], ql[13]); w.w = cvt_pk_bf16(ql[14], ql[15]); *(u32x4*)(qo + 8) = w;
              w.x = cvt_pk_bf16(qh[0], qh[1]); w.y = cvt_pk_bf16(qh[2], qh[3]); w.z = cvt_pk_bf16(qh[4], qh[5]); w.w = cvt_pk_bf16(qh[6], qh[7]); *(u32x4*)(qo + 32) = w;
              w.x = cvt_pk_bf16(qh[8], qh[9]); w.y = cvt_pk_bf16(qh[10], qh[11]); w.z = cvt_pk_bf16(qh[12], qh[13]); w.w = cvt_pk_bf16(qh[14], qh[15]); *(u32x4*)(qo + 40) = w;
              w.x = cvt_pk_bf16(kl[0], kl[1]); w.y = cvt_pk_bf16(kl[2], kl[3]); w.z = cvt_pk_bf16(kl[4], kl[5]); w.w = cvt_pk_bf16(kl[6], kl[7]); *(u32x4*)(ko) = w;
              w.x = cvt_pk_bf16(kl[8], kl[9]); w.y = cvt_pk_bf16(kl[10], kl[11]); w.z = cvt_pk_bf16(kl[12], kl[13]); w.w = cvt_pk_bf16(kl[14], kl[15]); *(u32x4*)(ko + 8) = w;
              w.x = cvt_pk_bf16(kh[0], kh[1]); w.y = cvt_pk_bf16(kh[2], kh[3]); w.z = cvt_pk_bf16(kh[4], kh[5]); w.w = cvt_pk_bf16(kh[6], kh[7]); *(u32x4*)(ko + 32) = w;
              w.x = cvt_pk_bf16(kh[8], kh[9]); w.y = cvt_pk_bf16(kh[10], kh[11]); w.z = cvt_pk_bf16(kh[12], kh[13]); w.w = cvt_pk_bf16(kh[14], kh[15]); *(u32x4*)(ko + 40) = w; }
#pragma unroll
            for (int j = 0; j < 16; ++j) {
#pragma unroll
                for (int o = 2; o < 64; o <<= 1) { kl[j] += __shfl_xor(kl[j], o); kh[j] += __shfl_xor(kh[j], o); } }
            if (lane < 2) {
#pragma unroll
                for (int j = 0; j < 16; ++j) { red[(wave * 2 + lane) * 32 + j] = kl[j]; red[(wave * 2 + lane) * 32 + 16 + j] = kh[j]; } }
            { const bf16_t* vrow = prow + 1024 + half * 32;
#pragma unroll
              for (int q = 0; q < 4; ++q) { const u32x4 r = *(const u32x4*)(vrow + q * 8); const unsigned rr[4] = {r.x, r.y, r.z, r.w};
#pragma unroll
                  for (int j = 0; j < 4; ++j) { const int d = half * 32 + q * 8 + 2 * j; vsT[d * 264 + tt] = (bf16_t)(rr[j] & 0xffffu); vsT[(d + 1) * 264 + tt] = (bf16_t)(rr[j] >> 16); } } }
            __syncthreads();
            if (tid < 64) { const int hf = (tid & 31) >> 4, slot = (tid & 15) + (tid >= 32 ? 16 : 0); float s = 0.f;
#pragma unroll
                for (int w = 0; w < 8; ++w) s += red[(w * 2 + hf) * 32 + slot];
                KMEAN[(h * 32 + n) * 64 + tid] = s * (1.f / 256.f); }
            { const int d = tid >> 3, seg = tid & 7; const LAS u32x4* src = (const LAS u32x4*)(vsT + d * 264 + seg * 32); u32x4* dst = (u32x4*)(VT + (size_t)(h * 64 + d) * SEQ + n * 256 + seg * 32);
#pragma unroll
              for (int q = 0; q < 4; ++q) dst[q] = src[q]; }
            __syncthreads();
        }
        }
        { int tid = tid0; asm volatile("" : "+v"(tid)); const int lane = tid & 63; (void)lane;
        for (int unit = bid; unit < 256; unit += G) {
            const int t0 = unit * 32;
            LAS float* xs = (LAS float*)lds;
            const float* mu = args.in[I_BMU] + l * 1696;
            for (int i = 0; i < 10; ++i) { const int idx = tid + 512 * i; const int tt = idx / 160, j = idx - tt * 160; const int t = t0 + tt;
                const float cur = bf2f(P[(size_t)t * NINP + PC_B + 1536 + j]); const float prev = t > 0 ? bf2f(P[(size_t)(t - 1) * NINP + PC_B + 1536 + j]) : 0.f;
                const float x = cur + (prev - cur) * mu[1536 + j];
                xs[tt * 160 + j] = j < 32 ? tanhf(x) : (j < 64 ? x : sigmoidf_(x)); }
            const int c = tid, head = wave;
            const float w0c = args.in[I_BW0][l * 512 + c], a0c = args.in[I_BA0][l * 512 + c], kkc = args.in[I_BKK][l * 512 + c], kac = args.in[I_BKA][l * 512 + c], rkc = args.in[I_BRK][l * 512 + c];
            const float mur = mu[c], muk = mu[512 + c], muv = mu[1024 + c];
            const float* w2 = args.in[I_BW2] + (size_t)l * 32 * 512; const float* a2 = args.in[I_BA2] + (size_t)l * 32 * 512; const float* g2 = args.in[I_BG2] + (size_t)l * 96 * 512;
            __syncthreads();
            {
                float wr_[32], ar_[32];
                unsigned cu = (unsigned)c; asm volatile("" : "+v"(cu));
#pragma unroll
                for (int j = 0; j < 32; ++j) { const float* wj = w2 + j * 512; const float* aj = a2 + j * 512; wr_[j] = wj[cu]; ar_[j] = aj[cu]; }
                float rp = 0.f, kp = 0.f, vp = 0.f;
                { const bf16_t* pr = P + (size_t)t0 * NINP + PC_B + c; if (t0 > 0) { rp = bf2f(pr[-NINP]); kp = bf2f(pr[512 - NINP]); vp = bf2f(pr[1024 - NINP]); } }
                float rn, kn, vnx;
                { const bf16_t* pr = P + (size_t)t0 * NINP + PC_B + c; rn = bf2f(pr[0]); kn = bf2f(pr[512]); vnx = bf2f(pr[1024]); }
#pragma unroll 1
                for (int i = 0; i < 32; ++i) { const int t = t0 + i;
                    const float rc = rn, kc = kn, vc = vnx;
                    if (i + 1 < 32) { const bf16_t* pr = P + (size_t)(t + 1) * NINP + PC_B + c; rn = bf2f(pr[0]); kn = bf2f(pr[512]); vnx = bf2f(pr[1024]); }
                    float aw = w0c, aa = a0c, aw1 = 0.f, aa1 = 0.f;
                    const LAS float* xr = xs + i * 160;
#pragma unroll
                    for (int j = 0; j < 32; j += 4) { const f32x4 x = *(const LAS f32x4*)(xr + j), y = *(const LAS f32x4*)(xr + 32 + j);
                        aw += x[0] * wr_[j]; aw1 += x[1] * wr_[j + 1]; aw += x[2] * wr_[j + 2]; aw1 += x[3] * wr_[j + 3];
                        aa += y[0] * ar_[j]; aa1 += y[1] * ar_[j + 1]; aa += y[2] * ar_[j + 2]; aa1 += y[3] * ar_[j + 3]; }
                    aw += aw1; aa += aa1;
                    const float rr = rc + (rp - rc) * mur, kx = kc + (kp - kc) * muk, vx = vc + (vp - vc) * muv;
                    const float mz = -aw; const float sp = mz > 20.f ? mz : log1pf(__expf(mz));
                    const float wl = -sp - 0.5f; const float dec = __expf(-__expf(wl));
                    const float a = sigmoidf_(aa);
                    float kk = kx * kkc; const float n2 = wave_sum(kk * kk); kk = kk / fmaxf(sqrtf(n2), 1e-12f);
                    const float k2 = kx * (1.f + (a - 1.f) * kac); const float bb = kk * a;
                    const float bon = wave_sum(rr * k2 * rkc);
                    float* v5 = VEC5 + ((size_t)head * SEQ + t) * 320 + lane;
                    v5[0] = -kk; v5[64] = dec; v5[128] = bb; v5[192] = k2; v5[256] = rr;
                    VV[((size_t)head * SEQ + t) * 64 + lane] = vx; BV[(size_t)t * 512 + c] = bon * vx;
                    rp = rc; kp = kc; vp = vc; }
            }
            {
                float gr_[96];
                unsigned cu = (unsigned)c; asm volatile("" : "+v"(cu));
#pragma unroll
                for (int j = 0; j < 96; ++j) { const float* gj = g2 + j * 512; gr_[j] = gj[cu]; }
#pragma unroll 1
                for (int i = 0; i < 32; ++i) { const int t = t0 + i;
                    float ag = 0.f, ag1 = 0.f;
                    const LAS float* xr = xs + i * 160;
#pragma unroll
                    for (int j = 0; j < 96; j += 4) { const f32x4 x = *(const LAS f32x4*)(xr + 64 + j); ag += x[0] * gr_[j]; ag1 += x[1] * gr_[j + 1]; ag += x[2] * gr_[j + 2]; ag1 += x[3] * gr_[j + 3]; }
                    GG[(size_t)t * 512 + c] = ag + ag1; }
            }
            __syncthreads();
        }
        }
        fast_barrier(BAR, ++bar_epoch, (unsigned)G);
        { int tid = tid0; asm volatile("" : "+v"(tid)); const int lane = tid & 63; (void)lane;
        for (int pi = bid; pi < 256; pi += G) {
            const int h = pi & 7, r = pi >> 3, half = r & 1;
            for (int which = 0; which < 2; ++which) {
                const int qb = which ? 31 - (r >> 1) : (r >> 1);
                const int t0 = qb * 256 + half * 128;
                LAS bf16_t* Ks = (LAS bf16_t*)lds;
                LAS bf16_t* Vs = (LAS bf16_t*)(lds + 18432);
                LAS float* kmS = (LAS float*)(lds + 36864);
                LAS int* selS = (LAS int*)(lds + 36864 + 8192);
                for (int i = tid; i < qb * 64; i += 512) kmS[i] = KMEAN[h * 2048 + i];
                __syncthreads();
                if (tid < 128) {
                    const bf16_t* qr = QB + (size_t)(t0 + tid) * 512 + h * 64;
                    float q[64];
#pragma unroll
                    for (int j = 0; j < 8; ++j) { float z[8]; unpack8(*(const u32x4*)(qr + j * 8), z);
#pragma unroll
                        for (int e = 0; e < 8; ++e) q[j * 8 + e] = z[e]; }
                    float b0 = -INFINITY, b1 = -INFINITY, b2 = -INFINITY; int i0 = 255, i1 = 255, i2 = 255;
                    for (int n = 0; n < qb; ++n) { float s = 0.f, s1 = 0.f, s2 = 0.f, s3 = 0.f; f32x4 kv[16];
#pragma unroll
                        for (int j = 0; j < 16; ++j) kv[j] = *(const LAS f32x4*)(kmS + n * 64 + j * 4);
                        __builtin_amdgcn_sched_barrier(0);
#pragma unroll
                        for (int j = 0; j < 16; ++j) { s += q[4 * j] * kv[j][0]; s1 += q[4 * j + 1] * kv[j][1]; s2 += q[4 * j + 2] * kv[j][2]; s3 += q[4 * j + 3] * kv[j][3]; }
                        s = (s + s1) + (s2 + s3);
                        if (s > b0) { b2 = b1; i2 = i1; b1 = b0; i1 = i0; b0 = s; i0 = n; } else if (s > b1) { b2 = b1; i2 = i1; b1 = s; i1 = n; } else if (s > b2) { b2 = s; i2 = n; } }
                    selS[tid] = i0 | (i1 << 8) | (i2 << 16); SEL[h * SEQ + t0 + tid] = i0 | (i1 << 8) | (i2 << 16);
                }
                __syncthreads();
                const int ql = lane & 15, kg = lane >> 4;
                const int tq = t0 + wave * 16 + ql;
                const int sel = selS[wave * 16 + ql]; const int s0 = sel & 255, s1 = (sel >> 8) & 255, s2 = (sel >> 16) & 255;
                bf16x8 qf[2];
                qf[0] = *(const bf16x8*)(QB + (size_t)tq * 512 + h * 64 + kg * 8); qf[1] = *(const bf16x8*)(QB + (size_t)tq * 512 + h * 64 + 32 + kg * 8);
                const int nown = half ? 4 : 2, ntile = nown;
                float mrun = -1e30f, lrun = 0.f; f32x4 O[4];
#pragma unroll
                for (int d = 0; d < 4; ++d) O[d] = (f32x4){0.f, 0.f, 0.f, 0.f};
                const int lrow = tid >> 3, lseg = (tid & 7) ^ (lrow & 7);
                const bf16_t* kgp = KB + (size_t)lrow * 512 + h * 64 + lseg * 8; const bf16_t* vgp = VT + (size_t)(h * 64 + lrow) * SEQ + lseg * 8;
                LAS unsigned char* ring = lds + 49152;
#define ATT_KS(i_) ((i_) < nown ? qb * 256 + (i_) * 64 : ((i_) - nown) * 64)
#define ATT_ISSUE_S(i_, slot_) do { const int ks_ = ATT_KS(i_); LAS unsigned char* tb_ = ring + (slot_) * 16384 + wave * 1024; \
                    __builtin_amdgcn_global_load_lds((const unsigned*)(kgp + (size_t)ks_ * 512), (LAS unsigned*)tb_, 16, 0, 0); \
                    __builtin_amdgcn_global_load_lds((const unsigned*)(vgp + ks_), (LAS unsigned*)(tb_ + 8192), 16, 0, 0); } while (0)
                ATT_ISSUE_S(0, 0); if (ntile > 1) ATT_ISSUE_S(1, 1); if (ntile > 2) ATT_ISSUE_S(2, 2);
                const int sw = ql & 7;
                for (int i0 = 0; i0 < ntile; i0 += 4) {
#pragma unroll
                for (int ij = 0; ij < 4; ++ij) { const int i = i0 + ij; if (i < ntile) {
                    if (i + 2 < ntile) asm volatile("s_waitcnt vmcnt(4)" ::: "memory"); else if (i + 1 < ntile) asm volatile("s_waitcnt vmcnt(2)" ::: "memory"); else asm volatile("s_waitcnt vmcnt(0)" ::: "memory");
                    __builtin_amdgcn_s_barrier(); asm volatile("" ::: "memory");
                    if (i + 3 < ntile) ATT_ISSUE_S(i + 3, (ij + 3) & 3);
                    const int ks = ATT_KS(i);
                    const LAS unsigned char* Kc = ring + ij * 16384; const LAS unsigned char* Vc = Kc + 8192;
                    bf16x8 kfr[4][2];
#pragma unroll
                    for (int kt = 0; kt < 4; ++kt)
#pragma unroll
                        for (int c = 0; c < 2; ++c) kfr[kt][c] = *(const LAS bf16x8*)(Kc + (kt * 16 + ql) * 128 + (((c * 4 + kg) ^ sw) << 4));
                    u32x2 vfr[2][4][2];
#pragma unroll
                    for (int kc = 0; kc < 2; ++kc)
#pragma unroll
                        for (int d = 0; d < 4; ++d) { const LAS unsigned char* vr = Vc + (d * 16 + ql) * 128 + (kg & 1) * 8; const int sg = kc * 4 + (kg >> 1);
                            vfr[kc][d][0] = *(const LAS u32x2*)(vr + ((sg ^ sw) << 4)); vfr[kc][d][1] = *(const LAS u32x2*)(vr + (((sg + 2) ^ sw) << 4)); }
                    __builtin_amdgcn_sched_barrier(0);
                    f32x4 Sx[4];
#pragma unroll
                    for (int kt = 0; kt < 4; ++kt) Sx[kt] = __builtin_amdgcn_mfma_f32_16x16x32_bf16(kfr[kt][0], qf[0], (f32x4){0.f, 0.f, 0.f, 0.f}, 0, 0, 0);
#pragma unroll
                    for (int kt = 0; kt < 4; ++kt) Sx[kt] = __builtin_amdgcn_mfma_f32_16x16x32_bf16(kfr[kt][1], qf[1], Sx[kt], 0, 0, 0);
                    const int nblk = ks >> 8; const bool own = i < nown;
                    const bool keepl = true; (void)own; (void)nblk; (void)s0; (void)s1; (void)s2;
                    if (own && ks + 63 > t0) {
#pragma unroll
                        for (int kt = 0; kt < 4; ++kt)
#pragma unroll
                            for (int jj = 0; jj < 4; ++jj) { const int key = ks + kt * 16 + 4 * kg + jj; Sx[kt][jj] = (key <= tq) ? Sx[kt][jj] : -1e30f; }
                    }
                    float mx = fmaxf(fmaxf(fmaxf(Sx[0][0], Sx[0][1]), fmaxf(Sx[0][2], Sx[0][3])), fmaxf(fmaxf(Sx[1][0], Sx[1][1]), fmaxf(Sx[1][2], Sx[1][3])));
                    mx = fmaxf(mx, fmaxf(fmaxf(fmaxf(Sx[2][0], Sx[2][1]), fmaxf(Sx[2][2], Sx[2][3])), fmaxf(fmaxf(Sx[3][0], Sx[3][1]), fmaxf(Sx[3][2], Sx[3][3]))));
                    mx = keepl ? mx : -1e30f;
                    mx = fmaxf(mx, __shfl_xor(mx, 16)); mx = fmaxf(mx, __shfl_xor(mx, 32));
                    const float mnew = fmaxf(mrun, mx); const float alpha = __builtin_amdgcn_exp2f(mrun - mnew); mrun = mnew;
                    const float moff = keepl ? mnew : 1e30f;
                    float rs = 0.f;
#pragma unroll
                    for (int kt = 0; kt < 4; ++kt)
#pragma unroll
                        for (int jj = 0; jj < 4; ++jj) { const float p = __builtin_amdgcn_exp2f(Sx[kt][jj] - moff); Sx[kt][jj] = p; rs += p; }
                    lrun = lrun * alpha + rs;
#pragma unroll
                    for (int d = 0; d < 4; ++d) O[d] *= alpha;
#pragma unroll
                    for (int kc = 0; kc < 2; ++kc) {
                        u32x4 pw; pw.x = cvt_pk_bf16(Sx[2 * kc][0], Sx[2 * kc][1]); pw.y = cvt_pk_bf16(Sx[2 * kc][2], Sx[2 * kc][3]); pw.z = cvt_pk_bf16(Sx[2 * kc + 1][0], Sx[2 * kc + 1][1]); pw.w = cvt_pk_bf16(Sx[2 * kc + 1][2], Sx[2 * kc + 1][3]);
                        const bf16x8 pb = __builtin_bit_cast(bf16x8, pw);
#pragma unroll
                        for (int d = 0; d < 4; ++d) { u32x4 vw; vw.x = vfr[kc][d][0].x; vw.y = vfr[kc][d][0].y; vw.z = vfr[kc][d][1].x; vw.w = vfr[kc][d][1].y;
                            O[d] = __builtin_amdgcn_mfma_f32_16x16x32_bf16(__builtin_bit_cast(bf16x8, vw), pb, O[d], 0, 0, 0); }
                    }
                } } }
                lrun += __shfl_xor(lrun, 16); lrun += __shfl_xor(lrun, 32);
#undef ATT_KS
#undef ATT_ISSUE_S
                { float* pp = PART + ((size_t)(tq * 8 + h) * 4 + 3) * 36;
#pragma unroll
                  for (int d = 0; d < 4; ++d) { u32x2 w; w.x = cvt_pk_bf16(O[d][0], O[d][1]); w.y = cvt_pk_bf16(O[d][2], O[d][3]); *(u32x2*)(pp + d * 8 + 2 * kg) = w; }
                  if (kg == 0) { pp[32] = mrun; pp[33] = lrun; } }
                __syncthreads();
            }
        }
        }
        { int tid = tid0; asm volatile("" : "+v"(tid)); const int lane = tid & 63; (void)lane;
        for (int unit = bid; unit < 512; unit += G) {
            const int c = unit >> 2, h = unit & 3, t0 = c * 64;
            LAS float* qtT = (LAS float*)lds;
            LAS float* ktT = (LAS float*)(lds + 16384);
            LAS float* khS = (LAS float*)(lds + 32768);
            LAS float* vS = (LAS float*)(lds + 49152);
            LAS float* AT = (LAS float*)(lds + 81920);
            LAS float* xgs = (LAS float*)(lds + 98304);
            const bf16_t* pd = P + (size_t)t0 * NINP + PC_D;
            for (int i = tid; i < 1024; i += 512) { const int t = i >> 4, j = i & 15; xgs[i] = bf2f(pd[(size_t)t * NINP + 1024 + j]); }
            for (int i = 0; i < 2; ++i) { const int idx = tid + 512 * i; const int s = idx >> 4, e0 = (idx & 15) * 8; float z[8]; unpack8(*(const u32x4*)(pd + (size_t)s * NINP + 512 + h * 128 + e0), z);
#pragma unroll
                for (int j = 0; j < 8; ++j) vS[s * 128 + e0 + j] = z[j]; }
            __syncthreads();
            { const int t = tid >> 3, dg = (tid & 7) * 8; const float* gw2 = args.in[I_DGW2] + (size_t)l * 16 * 256 + h * 64 + dg; const float* gb = args.in[I_DGB] + l * 256 + h * 64 + dg;
              float a[8];
#pragma unroll
              for (int j = 0; j < 8; ++j) a[j] = gb[j];
              for (int r = 0; r < 16; ++r) { const float xv = xgs[t * 16 + r];
#pragma unroll
                  for (int j = 0; j < 8; ++j) a[j] += xv * gw2[r * 256 + j]; }
#pragma unroll
              for (int j = 0; j < 8; ++j) { const float x = a[j]; const float ls = fminf(x, 0.f) - log1pf(__expf(-fabsf(x))); AT[t * 64 + dg + j] = ls * (1.f / 16.f); } }
            __syncthreads();
            if (tid < 64) { float run = 0.f; for (int t = 0; t < 64; ++t) { run += AT[t * 64 + tid]; AT[t * 64 + tid] = run; } }
            __syncthreads();
            { const int t = tid >> 3, dg = (tid & 7) * 8; float qz[8], kz[8];
              unpack8(*(const u32x4*)(pd + (size_t)t * NINP + h * 64 + dg), qz); unpack8(*(const u32x4*)(pd + (size_t)t * NINP + 256 + h * 64 + dg), kz);
#pragma unroll
              for (int j = 0; j < 8; ++j) { const int d = dg + j; const float cm = AT[t * 64 + d], last = AT[63 * 64 + d];
                  const float qv = qz[j] * 0.125f * __expf(cm); qtT[d * 64 + t] = qv; ktT[d * 64 + t] = kz[j] * __expf(-cm); khS[t * 64 + d] = kz[j] * __expf(last - cm);
                  QT[(size_t)(t0 + t) * 256 + h * 64 + d] = qv;
                  if (t == 63) LAM[(c * 4 + h) * 64 + d] = __expf(last); } }
            __syncthreads();
            if (tid < 256) { const int tq0 = (tid & 15) * 4, sq0 = (tid >> 4) * 4; float a[4][4];
#pragma unroll
                for (int i = 0; i < 4; ++i)
#pragma unroll
                    for (int j = 0; j < 4; ++j) a[i][j] = 0.f;
                for (int d0 = 0; d0 < 64; d0 += 8) { f32x4 qv[8], kv[8];
#pragma unroll
                    for (int q = 0; q < 8; ++q) { qv[q] = *(const LAS f32x4*)(qtT + (d0 + q) * 64 + tq0); kv[q] = *(const LAS f32x4*)(ktT + (d0 + q) * 64 + sq0); }
                    __builtin_amdgcn_sched_barrier(0);
#pragma unroll
                    for (int q = 0; q < 8; ++q)
#pragma unroll
                        for (int i = 0; i < 4; ++i)
#pragma unroll
                            for (int j = 0; j < 4; ++j) a[i][j] += qv[q][i] * kv[q][j];
                    __builtin_amdgcn_sched_barrier(0); }
                asm volatile("" ::: "memory");
#pragma unroll
                for (int j = 0; j < 4; ++j) { f32x4 o;
#pragma unroll
                    for (int i = 0; i < 4; ++i) o[i] = (sq0 + j <= tq0 + i) ? a[i][j] : 0.f;
                    *(LAS f32x4*)(AT + (sq0 + j) * 64 + tq0) = o; } }
            __syncthreads();
            { const int x0 = (tid & 15) * 4, e0 = (tid >> 4) * 4; float o[4][4], u[4][4];
#pragma unroll
              for (int i = 0; i < 4; ++i)
#pragma unroll
                  for (int j = 0; j < 4; ++j) { o[i][j] = 0.f; u[i][j] = 0.f; }
              for (int s0 = 0; s0 < 64; s0 += 4) { f32x4 av[4], kv[4], vv[4];
#pragma unroll
                  for (int q = 0; q < 4; ++q) { av[q] = *(const LAS f32x4*)(AT + (s0 + q) * 64 + x0); kv[q] = *(const LAS f32x4*)(khS + (s0 + q) * 64 + x0); vv[q] = *(const LAS f32x4*)(vS + (s0 + q) * 128 + e0); }
                  __builtin_amdgcn_sched_barrier(0);
#pragma unroll
                  for (int q = 0; q < 4; ++q)
#pragma unroll
                      for (int i = 0; i < 4; ++i)
#pragma unroll
                          for (int j = 0; j < 4; ++j) { o[i][j] += av[q][i] * vv[q][j]; u[i][j] += kv[q][i] * vv[q][j]; }
                  __builtin_amdgcn_sched_barrier(0); }
#pragma unroll
              for (int i = 0; i < 4; ++i) { *(f32x4*)(OI + (size_t)(t0 + x0 + i) * 512 + h * 128 + e0) = (f32x4){o[i][0], o[i][1], o[i][2], o[i][3]};
                  *(f32x4*)(GU + ((size_t)(c * 4 + h) * 64 + x0 + i) * 128 + e0) = (f32x4){u[i][0], u[i][1], u[i][2], u[i][3]}; } }
            __syncthreads();
        }
        }
        { int tid = tid0; asm volatile("" : "+v"(tid)); const int lane = tid & 63; (void)lane;
        { const int wu = bid * 8 + wave; if (wu < 2048) {
            const int h = wu >> 8, c = (wu >> 1) & 127, kind = wu & 1; const size_t tb = (size_t)h * SEQ + c * 64;
            LAS float* buf = (LAS float*)(lds + wave * 10240);
            const f32x4* src = (const f32x4*)(VEC5 + tb * 320);
            const float* vsrc = VV + tb * 64 + lane;
            f32x2 St[32];
            { const f32x4* si = (const f32x4*)(IDZ + kind * 4096 + lane * 64);
#pragma unroll
              for (int k4 = 0; k4 < 16; ++k4) { const f32x4 v = si[k4]; St[2 * k4] = RWKV_LO(v); St[2 * k4 + 1] = RWKV_HI(v); } }
            float vn[4];
#pragma unroll
            for (int j = 0; j < 5; ++j) __builtin_amdgcn_global_load_lds((const unsigned*)(src + j * 64 + lane), (LAS unsigned*)(buf + j * 256), 16, 0, 0);
            const float vsc = kind ? 1.f : 0.f;
#pragma unroll
            for (int j = 0; j < 4; ++j) vn[j] = vsrc[j * 64];
            asm volatile("s_waitcnt vmcnt(0)" ::: "memory");
            for (int b = 0; b < 16; ++b) {
                const float vc0 = vn[0], vc1 = vn[1], vc2 = vn[2], vc3 = vn[3];
                if (b + 1 < 16) { LAS float* nb = buf + ((b + 1) & 1) * 1280;
#pragma unroll
                    for (int j = 0; j < 5; ++j) __builtin_amdgcn_global_load_lds((const unsigned*)(src + (b + 1) * 320 + j * 64 + lane), (LAS unsigned*)(nb + j * 256), 16, 0, 0);
#pragma unroll
                    for (int j = 0; j < 4; ++j) vn[j] = vsrc[((b + 1) * 4 + j) * 64];
                }
                const LAS float* cb = buf + (b & 1) * 1280;
#pragma unroll 1
                for (int s = 0; s < 4; ++s) {
                    const LAS float* st = cb + s * 320;
                    const float vi = (s == 0 ? vc0 : (s == 1 ? vc1 : (s == 2 ? vc2 : vc3))) * vsc;
                    float yy; RWKV_STEP(st, vi, St, false, true, yy); (void)yy;
                }
                asm volatile("s_waitcnt vmcnt(0)" ::: "memory");
            }
            f32x4* po = (f32x4*)((kind ? LCH : PCH) + ((size_t)(h * 128 + c) * 64 + lane) * 64);
#pragma unroll
            for (int k4 = 0; k4 < 16; ++k4) po[k4] = (f32x4){St[2 * k4].x, St[2 * k4].y, St[2 * k4 + 1].x, St[2 * k4 + 1].y};
        }
        }
        }
        fast_barrier(BAR, ++bar_epoch, (unsigned)G);
        { int tid = tid0; asm volatile("" : "+v"(tid)); const int lane = tid & 63; (void)lane;
        if (bid < 64) {
            const int h = bid >> 3, rg = bid & 7;
            LAS float* Pb = (LAS float*)lds;
            LAS float* Sb = (LAS float*)(lds + 32768);
            const int rl = (wave & 3) * 2 + (lane >> 5), cl = 2 * (lane & 31); const int row = rg * 8 + rl;
            const bool comp = wave < 4;
            float zz = 0.f; asm volatile("" : "+v"(zz)); const f32x2 z2 = (f32x2){zz, zz};
            const float* Pg = PCH + (size_t)(h * 128) * 4096; const float* Lg = LCH + (size_t)(h * 128) * 4096 + row * 64 + cl;
            f32x4 pq[4][2]; f32x2 lnq[4];
            { const f32x4* ps = (const f32x4*)Pg; *(LAS f32x4*)(Pb + tid * 4) = ps[tid]; *(LAS f32x4*)(Pb + 2048 + tid * 4) = ps[512 + tid]; }
#pragma unroll
            for (int q = 1; q <= 4; ++q) { const f32x4* ps = (const f32x4*)(Pg + (size_t)q * 4096); pq[q & 3][0] = ps[tid]; pq[q & 3][1] = ps[512 + tid]; }
#pragma unroll
            for (int q = 0; q < 4; ++q) lnq[q] = comp ? *(const f32x2*)(Lg + (size_t)q * 4096) : z2;
            if (comp) *(LAS f32x2*)(Sb + rl * 64 + cl) = z2;
            f32x2 sv = z2;
            asm volatile("s_waitcnt lgkmcnt(0)" ::: "memory"); __builtin_amdgcn_s_barrier(); asm volatile("" ::: "memory");
            for (int c0 = 0; c0 < 128; c0 += 4) {
#pragma unroll
                for (int ci = 0; ci < 4; ++ci) {
                    const int c = c0 + ci;
                    const LAS float* Pc = Pb + (c & 1) * 4096; const LAS float* Sc = Sb + (c & 1) * 512 + rl * 64;
                    if (comp) {
                        *(f32x2*)(SIN + (size_t)(h * 128 + c) * 4096 + row * 64 + cl) = sv;
                        f32x2 a0 = lnq[ci], a1 = z2;
                        if (c + 4 < 128) lnq[ci] = *(const f32x2*)(Lg + (size_t)(c + 4) * 4096);
                        f32x4 sr_[16]; f32x2 pr_[2][16];
#pragma unroll
                        for (int q = 0; q < 16; ++q) sr_[q] = *(const LAS f32x4*)(Sc + q * 4);
#pragma unroll
                        for (int q = 0; q < 16; ++q) pr_[0][q] = *(const LAS f32x2*)(Pc + q * 64 + cl);
#pragma unroll
                        for (int g = 0; g < 4; ++g) {
                            if (g + 1 < 4) {
#pragma unroll
                                for (int q = 0; q < 16; ++q) pr_[(g + 1) & 1][q] = *(const LAS f32x2*)(Pc + ((g + 1) * 16 + q) * 64 + cl); }
                            __builtin_amdgcn_sched_barrier(0);
#pragma unroll
                            for (int q = 0; q < 16; q += 2) { const int k = g * 16 + q; a0 += sr_[k >> 2][k & 3] * pr_[g & 1][q]; a1 += sr_[(k + 1) >> 2][(k + 1) & 3] * pr_[g & 1][q + 1]; }
                            __builtin_amdgcn_sched_barrier(0);
                        }
                        sv = a0 + a1;
                        *(LAS f32x2*)(Sb + ((c + 1) & 1) * 512 + rl * 64 + cl) = sv;
                    }
                    if (c + 1 < 128) { LAS float* Pn = Pb + ((c + 1) & 1) * 4096; *(LAS f32x4*)(Pn + tid * 4) = pq[(ci + 1) & 3][0]; *(LAS f32x4*)(Pn + 2048 + tid * 4) = pq[(ci + 1) & 3][1]; }
                    if (c + 5 < 128) { const f32x4* ps = (const f32x4*)(Pg + (size_t)(c + 5) * 4096); pq[(ci + 1) & 3][0] = ps[tid]; pq[(ci + 1) & 3][1] = ps[512 + tid]; }
                    asm volatile("s_waitcnt lgkmcnt(0)" ::: "memory"); __builtin_amdgcn_s_barrier(); asm volatile("" ::: "memory");
                }
            }
        } else if (bid < 128) {
            const int idx = (bid - 64) * 512 + tid; float S = 0.f;
            for (int c0 = 0; c0 < 128; c0 += 16) { float u[16], lam[16];
#pragma unroll
                for (int i = 0; i < 16; ++i) { u[i] = GU[(size_t)(c0 + i) * 32768 + idx]; lam[i] = LAM[(c0 + i) * 256 + (idx >> 7)]; }
#pragma unroll
                for (int i = 0; i < 16; ++i) { GU[(size_t)(c0 + i) * 32768 + idx] = S; S = lam[i] * S + u[i]; } }
        } else if (G >= 256) {
            convert_layer_weights(args, ws, l, (LAS float*)(lds + wave * 16896), (bid - 128) * 8 + wave, (G - 128) * 8, lane, 3968, 9600);
        }
        }
        { int tid = tid0; asm volatile("" : "+v"(tid)); const int lane = tid & 63; (void)lane;
        for (;;) {
            __syncthreads();
            if (tid == 0) *(LAS int*)(lds + 36864 + 4096 + 64) = (int)__hip_atomic_fetch_add(BAR + 1024 + 64 * l, 1u, __ATOMIC_RELAXED, __HIP_MEMORY_SCOPE_AGENT);
            __syncthreads();
            const int u = *(LAS int*)(lds + 36864 + 4096 + 64);
            if (u >= 1088) break;
            const int h = u & 7; int n = 0, r = 0;
            { int rem = u >> 3; for (n = 0; n < 31; ++n) { const int cn = 8 - ((n + 1) >> 2); if (rem < cn) { r = ((n + 1) >> 2) + rem; break; } rem -= cn; } }
            LAS int* listS = (LAS int*)(lds + 36864);
            LAS int* wcnt = (LAS int*)(lds + 36864 + 4096);
            LAS unsigned char* ring = lds + 49152;
            const int lrow = tid >> 3, lseg = (tid & 7) ^ (lrow & 7);
            const bf16_t* kgp = KB + (size_t)(n * 256 + lrow) * 512 + h * 64 + lseg * 8; const bf16_t* vgp = VT + (size_t)(h * 64 + lrow) * SEQ + n * 256 + lseg * 8;
#pragma unroll
            for (int j = 0; j < 4; ++j) { LAS unsigned char* tb_ = ring + j * 16384 + wave * 1024;
                __builtin_amdgcn_global_load_lds((const unsigned*)(kgp + (size_t)j * 64 * 512), (LAS unsigned*)tb_, 16, 0, 0);
                __builtin_amdgcn_global_load_lds((const unsigned*)(vgp + j * 64), (LAS unsigned*)(tb_ + 8192), 16, 0, 0); }
            int myslot[2], mypre[2];
#pragma unroll
            for (int p = 0; p < 2; ++p) { const int t = r * 1024 + p * 512 + tid; const int sv = SEL[h * SEQ + t];
                const int sl = ((sv & 255) == n) ? 0 : ((((sv >> 8) & 255) == n) ? 1 : ((((sv >> 16) & 255) == n) ? 2 : -1));
                const unsigned long long bal = __ballot(sl >= 0);
                myslot[p] = sl; mypre[p] = __popcll(bal & ((1ull << lane) - 1ull));
                if (lane == 0) wcnt[p * 8 + wave] = __popcll(bal); }
            __syncthreads();
            int cnt = 0, base0 = 0, base1 = 0;
#pragma unroll
            for (int q = 0; q < 16; ++q) { const int c = wcnt[q]; if (q == wave) base0 = cnt; if (q == 8 + wave) base1 = cnt; cnt += c; }
            if (myslot[0] >= 0) listS[base0 + mypre[0]] = ((r * 1024 + tid) << 2) | myslot[0];
            if (myslot[1] >= 0) listS[base1 + mypre[1]] = ((r * 1024 + 512 + tid) << 2) | myslot[1];
            asm volatile("s_waitcnt vmcnt(0)" ::: "memory");
            __syncthreads();
            const int ql = lane & 15, kg = lane >> 4, sw = ql & 7;
            for (int ch = 0; ch * 128 < cnt; ++ch) {
                const int e = ch * 128 + wave * 16 + ql; const bool has = e < cnt; const int ent = listS[has ? e : 0]; const int tq = ent >> 2, slot = ent & 3;
                bf16x8 qf[2];
                qf[0] = *(const bf16x8*)(QB + (size_t)tq * 512 + h * 64 + kg * 8); qf[1] = *(const bf16x8*)(QB + (size_t)tq * 512 + h * 64 + 32 + kg * 8);
                float mrun = -1e30f, lrun = 0.f; f32x4 O[4];
#pragma unroll
                for (int d = 0; d < 4; ++d) O[d] = (f32x4){0.f, 0.f, 0.f, 0.f};
#pragma unroll
                for (int ij = 0; ij < 4; ++ij) {
                    const LAS unsigned char* Kc = ring + ij * 16384; const LAS unsigned char* Vc = Kc + 8192;
                    bf16x8 kfr[4][2];
#pragma unroll
                    for (int kt = 0; kt < 4; ++kt)
#pragma unroll
                        for (int c = 0; c < 2; ++c) kfr[kt][c] = *(const LAS bf16x8*)(Kc + (kt * 16 + ql) * 128 + (((c * 4 + kg) ^ sw) << 4));
                    u32x2 vfr[2][4][2];
#pragma unroll
                    for (int kc = 0; kc < 2; ++kc)
#pragma unroll
                        for (int d = 0; d < 4; ++d) { const LAS unsigned char* vr = Vc + (d * 16 + ql) * 128 + (kg & 1) * 8; const int sg = kc * 4 + (kg >> 1);
                            vfr[kc][d][0] = *(const LAS u32x2*)(vr + ((sg ^ sw) << 4)); vfr[kc][d][1] = *(const LAS u32x2*)(vr + (((sg + 2) ^ sw) << 4)); }
                    __builtin_amdgcn_sched_barrier(0);
                    f32x4 Sx[4];
#pragma unroll
                    for (int kt = 0; kt < 4; ++kt) Sx[kt] = __builtin_amdgcn_mfma_f32_16x16x32_bf16(kfr[kt][0], qf[0], (f32x4){0.f, 0.f, 0.f, 0.f}, 0, 0, 0);
#pragma unroll
                    for (int kt = 0; kt < 4; ++kt) Sx[kt] = __builtin_amdgcn_mfma_f32_16x16x32_bf16(kfr[kt][1], qf[1], Sx[kt], 0, 0, 0);
                    float mx = fmaxf(fmaxf(fmaxf(Sx[0][0], Sx[0][1]), fmaxf(Sx[0][2], Sx[0][3])), fmaxf(fmaxf(Sx[1][0], Sx[1][1]), fmaxf(Sx[1][2], Sx[1][3])));
                    mx = fmaxf(mx, fmaxf(fmaxf(fmaxf(Sx[2][0], Sx[2][1]), fmaxf(Sx[2][2], Sx[2][3])), fmaxf(fmaxf(Sx[3][0], Sx[3][1]), fmaxf(Sx[3][2], Sx[3][3]))));
                    mx = fmaxf(mx, __shfl_xor(mx, 16)); mx = fmaxf(mx, __shfl_xor(mx, 32));
                    const float mnew = fmaxf(mrun, mx); const float alpha = __builtin_amdgcn_exp2f(mrun - mnew); mrun = mnew;
                    float rs = 0.f;
#pragma unroll
                    for (int kt = 0; kt < 4; ++kt)
#pragma unroll
                        for (int jj = 0; jj < 4; ++jj) { const float p = __builtin_amdgcn_exp2f(Sx[kt][jj] - mnew); Sx[kt][jj] = p; rs += p; }
                    lrun = lrun * alpha + rs;
#pragma unroll
                    for (int d = 0; d < 4; ++d) O[d] *= alpha;
#pragma unroll
                    for (int kc = 0; kc < 2; ++kc) {
                        u32x4 pw; pw.x = cvt_pk_bf16(Sx[2 * kc][0], Sx[2 * kc][1]); pw.y = cvt_pk_bf16(Sx[2 * kc][2], Sx[2 * kc][3]); pw.z = cvt_pk_bf16(Sx[2 * kc + 1][0], Sx[2 * kc + 1][1]); pw.w = cvt_pk_bf16(Sx[2 * kc + 1][2], Sx[2 * kc + 1][3]);
                        const bf16x8 pb = __builtin_bit_cast(bf16x8, pw);
#pragma unroll
                        for (int d = 0; d < 4; ++d) { u32x4 vw; vw.x = vfr[kc][d][0].x; vw.y = vfr[kc][d][0].y; vw.z = vfr[kc][d][1].x; vw.w = vfr[kc][d][1].y;
                            O[d] = __builtin_amdgcn_mfma_f32_16x16x32_bf16(__builtin_bit_cast(bf16x8, vw), pb, O[d], 0, 0, 0); }
                    }
                }
                lrun += __shfl_xor(lrun, 16); lrun += __shfl_xor(lrun, 32);
                if (has) { float* pp = PART + ((size_t)(tq * 8 + h) * 4 + slot) * 36;
#pragma unroll
                    for (int d = 0; d < 4; ++d) { u32x2 w; w.x = cvt_pk_bf16(O[d][0], O[d][1]); w.y = cvt_pk_bf16(O[d][2], O[d][3]); *(u32x2*)(pp + d * 8 + 2 * kg) = w; }
                    if (kg == 0) { pp[32] = mrun; pp[33] = lrun; } }
            }
            __syncthreads();
        }
        }
        fast_barrier(BAR, ++bar_epoch, (unsigned)G);
        { int tid = tid0; asm volatile("" : "+v"(tid)); const int lane = tid & 63; (void)lane;
        for (int t = bid * 8 + wave; t < SEQ; t += G * 8) {
            const int h = lane >> 3, dg = (lane & 7) * 8; const int qb = t >> 8; const int nv = qb < 3 ? qb : 3;
            const float* pp = PART + ((size_t)(t * 8 + h) * 4) * 36;
            const float m3 = pp[3 * 36 + 32], l3 = pp[3 * 36 + 33];
            float mk[3], lk[3]; float M = m3;
#pragma unroll
            for (int q = 0; q < 3; ++q) { mk[q] = q < nv ? pp[q * 36 + 32] : -1e30f; lk[q] = q < nv ? pp[q * 36 + 33] : 0.f; M = fmaxf(M, mk[q]); }
            const float w3 = __builtin_amdgcn_exp2f(m3 - M); float L = w3 * l3;
            float acc8[8];
            { float z[8]; unpack8(*(const u32x4*)(pp + 3 * 36 + (dg >> 1)), z);
#pragma unroll
              for (int e = 0; e < 8; ++e) acc8[e] = z[e] * w3; }
#pragma unroll
            for (int q = 0; q < 3; ++q) if (q < nv) { const float wq = __builtin_amdgcn_exp2f(mk[q] - M); L += wq * lk[q];
                float z[8]; unpack8(*(const u32x4*)(pp + q * 36 + (dg >> 1)), z);
#pragma unroll
                for (int e = 0; e < 8; ++e) acc8[e] += z[e] * wq; }
            const f32x4 a0 = (f32x4){acc8[0], acc8[1], acc8[2], acc8[3]}, a1 = (f32x4){acc8[4], acc8[5], acc8[6], acc8[7]};
            const float il = 1.f / L;
            u32x4 w; w.x = cvt_pk_bf16(a0[0] * il, a0[1] * il); w.y = cvt_pk_bf16(a0[2] * il, a0[3] * il); w.z = cvt_pk_bf16(a1[0] * il, a1[1] * il); w.w = cvt_pk_bf16(a1[2] * il, a1[3] * il);
            *(u32x4*)(Y + (size_t)t * DM + 1024 + h * 64 + dg) = w;
        }
        for (int unit = bid; unit < 512; unit += G) {
            const int c = unit >> 2, h = unit & 3, t0 = c * 64;
            LAS float* qtT = (LAS float*)lds;
            LAS float* Sd = (LAS float*)(lds + 16384);
            LAS float* red = (LAS float*)(lds + 49152);
            for (int i = 0; i < 8; ++i) { const int idx = tid + 512 * i; const int t = idx >> 6, d = idx & 63; qtT[d * 64 + t] = QT[(size_t)(t0 + t) * 256 + h * 64 + d]; }
            { const f32x4* ss = (const f32x4*)(GU + (size_t)(c * 4 + h) * 8192);
#pragma unroll
              for (int i = 0; i < 4; ++i) *(LAS f32x4*)(Sd + (tid + 512 * i) * 4) = ss[tid + 512 * i]; }
            __syncthreads();
            const int x0 = (tid & 15) * 4, e0 = (tid >> 4) * 4; float o[4][4];
#pragma unroll
            for (int i = 0; i < 4; ++i) { const f32x4 v = *(const f32x4*)(OI + (size_t)(t0 + x0 + i) * 512 + h * 128 + e0); o[i][0] = v[0]; o[i][1] = v[1]; o[i][2] = v[2]; o[i][3] = v[3]; }
            for (int d0 = 0; d0 < 64; d0 += 8) { f32x4 qv[8], sv[8];
#pragma unroll
                for (int q = 0; q < 8; ++q) { qv[q] = *(const LAS f32x4*)(qtT + (d0 + q) * 64 + x0); sv[q] = *(const LAS f32x4*)(Sd + (d0 + q) * 128 + e0); }
                __builtin_amdgcn_sched_barrier(0);
#pragma unroll
                for (int q = 0; q < 8; ++q)
#pragma unroll
                    for (int i = 0; i < 4; ++i)
#pragma unroll
                        for (int j = 0; j < 4; ++j) o[i][j] += qv[q][i] * sv[q][j];
                __builtin_amdgcn_sched_barrier(0); }
#pragma unroll
            for (int i = 0; i < 4; ++i) red[(x0 + i) * 32 + (tid >> 4)] = (o[i][0] * o[i][0] + o[i][1] * o[i][1]) + (o[i][2] * o[i][2] + o[i][3] * o[i][3]);
            __syncthreads();
            const float* ng = args.in[I_DNG] + l * 128 + e0;
#pragma unroll
            for (int i = 0; i < 4; ++i) { const int t = t0 + x0 + i; float s = 0.f;
#pragma unroll
                for (int j = 0; j < 8; ++j) { const f32x4 v = *(const LAS f32x4*)(red + (x0 + i) * 32 + j * 4); s += (v[0] + v[1]) + (v[2] + v[3]); }
                const float rs = rsqrtf(s * (1.f / 128.f) + EPS);
                const bf16_t* og = P + (size_t)t * NINP + PC_D + 1040 + h * 128 + e0; const u32x2 raw = *(const u32x2*)og;
                const float g0 = bflo(raw.x), g1 = bfhi(raw.x), g2 = bflo(raw.y), g3 = bfhi(raw.y);
                const float y0 = o[i][0] * rs * ng[0] * (g0 * sigmoidf_(g0)), y1 = o[i][1] * rs * ng[1] * (g1 * sigmoidf_(g1)), y2 = o[i][2] * rs * ng[2] * (g2 * sigmoidf_(g2)), y3 = o[i][3] * rs * ng[3] * (g3 * sigmoidf_(g3));
                u32x2 w; w.x = cvt_pk_bf16(y0, y1); w.y = cvt_pk_bf16(y2, y3);
                *(u32x2*)(Y + (size_t)t * DM + 1536 + h * 128 + e0) = w; }
            __syncthreads();
        }
        if (wave < 4) {
            const int u = bid * 4 + wave;
            if (u < 1024) {
                const int h = u >> 7, c = u & 127; const size_t tb = (size_t)h * SEQ + c * 64; const int tbase = c * 64;
                LAS float* buf = (LAS float*)(lds + wave * 10240);
                const f32x4* src = (const f32x4*)(VEC5 + tb * 320);
                const float* vsrc = VV + tb * 64 + lane;
                const int ch = h * 64 + lane;
                const float lg = args.in[I_BLNG][l * 512 + ch], lbias = args.in[I_BLNB][l * 512 + ch];
                const float* bvp = BV + (size_t)tbase * 512 + ch; const float* ggp = GG + (size_t)tbase * 512 + ch;
                f32x2 St[32];
                { const f32x4* si = (const f32x4*)(SIN + ((size_t)u * 64 + lane) * 64);
#pragma unroll
                  for (int k4 = 0; k4 < 16; ++k4) { const f32x4 v = si[k4]; St[2 * k4] = RWKV_LO(v); St[2 * k4 + 1] = RWKV_HI(v); } }
                float vn[4];
#pragma unroll
                for (int j = 0; j < 5; ++j) __builtin_amdgcn_global_load_lds((const unsigned*)(src + j * 64 + lane), (LAS unsigned*)(buf + j * 256), 16, 0, 0);
#pragma unroll
                for (int j = 0; j < 4; ++j) vn[j] = vsrc[j * 64];
                asm volatile("s_waitcnt vmcnt(0)" ::: "memory");
                for (int b = 0; b < 16; ++b) {
                    const float vc0 = vn[0], vc1 = vn[1], vc2 = vn[2], vc3 = vn[3];
                    float bvc[4], ggc[4];
#pragma unroll
                    for (int j = 0; j < 4; ++j) { bvc[j] = bvp[(b * 4 + j) * 512]; ggc[j] = ggp[(b * 4 + j) * 512]; }
                    float yv0 = 0.f, yv1 = 0.f, yv2 = 0.f, yv3 = 0.f;
                    if (b + 1 < 16) { LAS float* nb = buf + ((b + 1) & 1) * 1280;
#pragma unroll
                        for (int j = 0; j < 5; ++j) __builtin_amdgcn_global_load_lds((const unsigned*)(src + (b + 1) * 320 + j * 64 + lane), (LAS unsigned*)(nb + j * 256), 16, 0, 0);
#pragma unroll
                        for (int j = 0; j < 4; ++j) vn[j] = vsrc[((b + 1) * 4 + j) * 64];
                    }
                    const LAS float* cb = buf + (b & 1) * 1280;
#pragma unroll 1
                    for (int s = 0; s < 4; ++s) {
                        const LAS float* st = cb + s * 320;
                        const float vi = s == 0 ? vc0 : (s == 1 ? vc1 : (s == 2 ? vc2 : vc3));
                        float yy; RWKV_STEP(st, vi, St, true, true, yy);
                        yv0 = s == 0 ? yy : yv0; yv1 = s == 1 ? yy : yv1; yv2 = s == 2 ? yy : yv2; yv3 = s == 3 ? yy : yv3;
                    }
                    asm volatile("s_waitcnt vmcnt(0)" ::: "memory");
                    const float yv[4] = {yv0, yv1, yv2, yv3};
#pragma unroll
                    for (int s = 0; s < 4; ++s) { const int t = tbase + b * 4 + s;
                        const float m = wave_sum(yv[s]) * (1.f / 64.f); const float d = yv[s] - m; const float var = wave_sum(d * d) * (1.f / 64.f);
                        const float yn = d * rsqrtf(var + 64e-5f) * lg + lbias;
                        Y[(size_t)t * DM + 512 + ch] = f2bf((yn + bvc[s]) * ggc[s]); }
                }
            }
        } else if (G >= 256) {
            LAS float* scr = (LAS float*)(lds + 49152 + (wave - 4) * 16896);
            convert_layer_weights(args, ws, l, scr, bid * 4 + (wave - 4), G * 4, lane, 9600, 12416);
            if (l == 0) convert_layer_weights(args, ws, 1, scr, bid * 4 + (wave - 4), G * 4, lane, 0, 3968);
        }
        }
        fast_barrier(BAR, ++bar_epoch, (unsigned)G);
        { int tid = tid0; asm volatile("" : "+v"(tid)); const int lane = tid & 63; (void)lane;
        {
            pg8::Gemm g{Y, (const bf16_t*)(wt + WT_OUT), SEQ, DM, DM, 256}; pg8::StaticOrder S; S.init(SEQ, DM, G, bid);
            pg8::EpiResid E{l == 0 ? args.in[I_X] : (const float*)XR, XR, XB, SSQ, lds};
            pg8::gemm_phase<pg8::EpiResid>(lds, g, S, E);
        }
        }
        fast_barrier(BAR, ++bar_epoch, (unsigned)G);
        { int tid = tid0; asm volatile("" : "+v"(tid)); const int lane = tid & 63; (void)lane;
        {
            pg8::Gemm g{XB, (const bf16_t*)(wt + WT_UP), 33 * 256, NUP, DM, 254}; pg8::StaticOrder S; S.init(33 * 256, NUP, G, bid);
            pg8::EpiConvSwiGLU E{ACT, SSQ, args.in[I_CONVW] + (size_t)l * 3 * NUP, args.in[I_CONVB] + (size_t)l * NUP};
            pg8::Unit uu;
            for (int i = 0; S.next(i, uu); ++i) { pg8::OneUnit one{uu}; pg8::gemm_phase<pg8::EpiConvSwiGLU, pg8::OneUnit>(lds, g, one, E); }
        }
        }
        fast_barrier(BAR, ++bar_epoch, (unsigned)G);
        { int tid = tid0; asm volatile("" : "+v"(tid)); const int lane = tid & 63; (void)lane;
        {
            pg8::Gemm g{ACT, (const bf16_t*)(wt + WT_DOWN), SEQ, DM, DFF, 256}; pg8::StaticOrder S; S.init(SEQ, DM, G, bid);
            pg8::EpiResid E{(const float*)XR, XR, XB, SSQ, lds};
            pg8::gemm_phase<pg8::EpiResid>(lds, g, S, E);
        }
        }
        fast_barrier(BAR, ++bar_epoch, (unsigned)G);
    }
        { int tid = tid0; asm volatile("" : "+v"(tid)); const int lane = tid & 63; (void)lane;
    {
        const float* fg = args.in[I_FING];
        for (int row = gw; row < SEQ; row += NGW) {
            float s = SSQ[(size_t)row * 8 + (lane & 7)]; s = wave_sum(s) * 0.125f;
            const float rs = rsqrtf(s * (1.f / 2048.f) + EPS);
            f32x4* xr = (f32x4*)(XR + (size_t)row * DM) + lane; const f32x4* gp = (const f32x4*)fg + lane;
#pragma unroll
            for (int j = 0; j < 8; ++j) { f32x4 v = xr[64 * j]; const f32x4 gv = gp[64 * j]; v = v * rs * gv; xr[64 * j] = v; }
        }
    }
        }
}

extern "C" void kernel_launch(void* const* d_in, const int* in_sizes, int n_in, void* d_out, int out_size, void* d_ws, size_t ws_size, hipStream_t stream) {
    static int grid = 0;
    if (grid == 0) {
        if (n_in != 28 || ws_size < WS_END) { fprintf(stderr, "kernel_launch: unexpected n_in %d / ws_size %zu\n", n_in, ws_size); grid = -1; return; }
        int dev = 0, cus = 0, per_cu = 0;
        hipGetDevice(&dev); hipDeviceGetAttribute(&cus, hipDeviceAttributeMultiprocessorCount, dev);
        hipFuncSetAttribute((const void*)mega_fwd, hipFuncAttributeMaxDynamicSharedMemorySize, LDS_BYTES);
        hipOccupancyMaxActiveBlocksPerMultiprocessor(&per_cu, (const void*)mega_fwd, 512, LDS_BYTES);
        if (per_cu < 1) { fprintf(stderr, "kernel_launch: occupancy query says %d blocks/CU\n", per_cu); per_cu = 1; }
        grid = cus * (per_cu > 1 ? 1 : per_cu);
    }
    if (grid < 0) return;
    (void)hipMemsetAsync(d_ws, 0, 8192, stream);
    Args a{};
    for (int i = 0; i < 28; ++i) a.in[i] = (const float*)d_in[i];
    a.out = (float*)d_out; a.ws = (unsigned char*)d_ws;
    void* kargs[] = {&a};
    hipError_t e = hipLaunchCooperativeKernel((const void*)mega_fwd, dim3(grid), dim3(512), kargs, LDS_BYTES, stream);
    if (e != hipSuccess) fprintf(stderr, "cooperative launch failed: %s (grid %d)\n", hipGetErrorString(e), grid);
}
```

```cpp
#include <hip/hip_runtime.h>
#include <hip/hip_cooperative_groups.h>
#include <cstdio>
#include <cstdint>
namespace cg = cooperative_groups;

#define LAS __attribute__((address_space(3)))
typedef unsigned short bf16_t;
typedef short bf16x8 __attribute__((ext_vector_type(8)));
typedef float f32x4 __attribute__((ext_vector_type(4)));
typedef float f32x2 __attribute__((ext_vector_type(2)));
typedef unsigned u32x4 __attribute__((ext_vector_type(4)));
typedef unsigned u32x2 __attribute__((ext_vector_type(2)));

constexpr int SEQ = 8192, DM = 2048, NIN = 5808, NINP = 5888, DFF = 5632, NUP = 11264;
constexpr int PC_A = 0, PC_B = 1024, PC_C = 2720, PC_D = 4256;
constexpr float EPS = 1e-6f;
constexpr float QSCALE = 0.125f * 1.4426950408889634f;

constexpr size_t MiB = 1u << 20;
constexpr size_t WS_ROPE = 1 * MiB, WS_SSQ = 3 * MiB, WS_KMEAN = 4 * MiB, WS_IDZ = 5 * MiB, WS_SEL = 6 * MiB, WS_WT = 8 * MiB;
constexpr size_t WT_IN = 0, WT_OUT = 23 * MiB, WT_UP = 31 * MiB, WT_DOWN = 75 * MiB, WT_LAYER = 97 * MiB;
constexpr size_t WS_XB = 202 * MiB, WS_Y = 234 * MiB, WS_P = 266 * MiB;
constexpr size_t WS_QB = 358 * MiB, WS_KB = 366 * MiB, WS_VT = 374 * MiB, WS_VEC5 = 382 * MiB, WS_VV = 462 * MiB, WS_GG = 478 * MiB, WS_BV = 494 * MiB;
constexpr size_t WS_PCH = 510 * MiB, WS_LCH = 526 * MiB, WS_SIN = 542 * MiB, WS_OI = 558 * MiB, WS_U = 574 * MiB, WS_QT = 590 * MiB, WS_LAM = 598 * MiB;
constexpr size_t WS_PART = 600 * MiB, WS_H = 266 * MiB, WS_ACT = 442 * MiB, WS_END = 640 * MiB;
constexpr int LDS_BYTES = 147456;

__device__ __forceinline__ float bf2f(bf16_t v) { return __uint_as_float((unsigned)v << 16); }
__device__ __forceinline__ float bflo(unsigned u) { return __uint_as_float(u << 16); }
__device__ __forceinline__ float bfhi(unsigned u) { return __uint_as_float(u & 0xffff0000u); }
__device__ __forceinline__ unsigned cvt_pk_bf16(float lo, float hi) { unsigned r; asm volatile("v_cvt_pk_bf16_f32 %0, %1, %2" : "=v"(r) : "v"(lo), "v"(hi)); return r; }
__device__ __forceinline__ bf16_t f2bf(float f) { return (bf16_t)(cvt_pk_bf16(f, 0.f) & 0xffffu); }
__device__ __forceinline__ float wave_sum(float v) {
#pragma unroll
    for (int o = 32; o > 0; o >>= 1) v += __shfl_xor(v, o);
    return v;
}
__device__ __forceinline__ float sigmoidf_(float x) { return __builtin_amdgcn_rcpf(1.f + __expf(-x)); }
__device__ __forceinline__ float gelu_tanh(float x) { const float u = 0.7978845608f * (x + 0.044715f * x * x * x); const float e = __expf(2.f * u); const float th = 1.f - 2.f * __builtin_amdgcn_rcpf(e + 1.f); return 0.5f * x * (1.f + th); }
__device__ __forceinline__ void unpack8(const u32x4 r, float (&z)[8]) { z[0] = bflo(r.x); z[1] = bfhi(r.x); z[2] = bflo(r.y); z[3] = bfhi(r.y); z[4] = bflo(r.z); z[5] = bfhi(r.z); z[6] = bflo(r.w); z[7] = bfhi(r.w); }

__device__ __forceinline__ void fast_barrier(unsigned* bar, unsigned epoch  , unsigned G) {
    asm volatile("s_waitcnt vmcnt(0) lgkmcnt(0)" ::: "memory");
    __syncthreads();
    if (threadIdx.x == 0) {
        __builtin_amdgcn_fence(__ATOMIC_RELEASE, "agent");
        asm volatile("s_waitcnt vmcnt(0)" ::: "memory");
        const unsigned grp = blockIdx.x & 7u; const unsigned gsz = (G - grp + 7u) >> 3; const unsigned ngrp = G < 8u ? G : 8u;
        const unsigned old = __hip_atomic_fetch_add(bar + 64u * (1u + grp), 1u, __ATOMIC_RELAXED, __HIP_MEMORY_SCOPE_AGENT);
        if (old + 1u == epoch * gsz) __hip_atomic_fetch_add(bar, 1u, __ATOMIC_RELAXED, __HIP_MEMORY_SCOPE_AGENT);
        unsigned spins = 0;
        while (__hip_atomic_load(bar, __ATOMIC_RELAXED, __HIP_MEMORY_SCOPE_AGENT) < epoch * ngrp) { __builtin_amdgcn_s_sleep(1); if (++spins > (1u << 26)) break; }
        __builtin_amdgcn_fence(__ATOMIC_ACQUIRE, "agent");
        asm volatile("s_waitcnt vmcnt(0)" ::: "memory");
    }
    __syncthreads();
}

namespace pg8 {
constexpr int BM = 256, BK = 64, HALF = 128, HTB = HALF * BK * 2, STAGE_BYTES = 8 * HTB, NXCD = 8, WGM = 8;
__host__ __device__ __forceinline__ int lds_byte(int r, int c) { const int st = (r >> 4) * 2 + (c >> 5), rr = r & 15, cc = c & 31, ob = rr * 64 + cc * 2; return st * 1024 + (ob ^ (((ob >> 9) & 1) << 5)); }
__host__ __device__ __forceinline__ void stage_rc(int b, int& R, int& C) { const int st = b / 1024, sb = b % 1024, swz = sb ^ (((sb >> 9) & 1) << 5); R = (st >> 1) * 16 + swz / 64; C = (st & 1) * 32 + (swz % 64) / 2; }
__host__ __device__ __forceinline__ int perm32(int rho) { const int n = rho >> 4, i = rho & 15; return 8 * (i >> 2) + 4 * n + (i & 3); }
struct Unit { int pm, pn; };
struct Gemm { const bf16_t* A; const bf16_t* Bt; int M, N, K; int a_step_rows; };
struct OneUnit { Unit u; __device__ __forceinline__ bool next(int i, Unit& o) const { if (i) return false; o = u; return true; } };
struct StaticOrder {
    int nM, nN, nwg, G, c;
    __device__ __forceinline__ void init(int M, int N, int G_, int c_) { nM = M / BM; nN = N / BM; nwg = nM * nN; G = G_; c = c_; }
    __device__ __forceinline__ bool next(int i, Unit& u) const {
        const long L = (long)i * G + c; if (L >= nwg) return false;
        int wgid = (int)L; { const int q = nwg / NXCD, r = nwg % NXCD, xcd = wgid % NXCD, off = wgid / NXCD; wgid = (xcd < r ? xcd * (q + 1) : r * (q + 1) + (xcd - r) * q) + off; }
        const int nig = WGM * nN, gid = wgid / nig, fm = gid * WGM, gsz = (nM - fm) < WGM ? (nM - fm) : WGM;
        u.pm = fm + ((wgid % nig) % gsz); u.pn = (wgid % nig) / gsz; return true;
    }
};
struct EpiScaleBf16 {
    static constexpr bool AFTER_DRAIN = false;
    bf16_t* O; int ldc; const float* ssq;
    __device__ __forceinline__ void operator()(const f32x4 (&acc)[2][2][4][2], const Unit& u, int wr, int wc, int fr, int fq) const {
        const int row0 = u.pm * BM + wr * 64 + fr; const int col0 = u.pn * BM + wc * 32 + 8 * fq;
#pragma unroll
        for (int ai = 0; ai < 2; ++ai)
#pragma unroll
            for (int m = 0; m < 4; ++m) {
                const int row = row0 + ai * HALF + m * 16;
                const f32x4* sp = (const f32x4*)(ssq + (size_t)row * 8);
                f32x4 s4 = sp[0] + sp[1];
                const float rs = rsqrtf(((s4[0] + s4[1]) + (s4[2] + s4[3])) * (1.0f / 2048.0f) + EPS);
                bf16_t* rowp = O + (size_t)row * ldc + col0;
#pragma unroll
                for (int bj = 0; bj < 2; ++bj) { const f32x4 v0 = acc[ai][bj][m][0] * rs, v1 = acc[ai][bj][m][1] * rs;
                    u32x4 w; w.x = cvt_pk_bf16(v0[0], v0[1]); w.y = cvt_pk_bf16(v0[2], v0[3]); w.z = cvt_pk_bf16(v1[0], v1[1]); w.w = cvt_pk_bf16(v1[2], v1[3]);
                    *(u32x4*)(rowp + bj * HALF) = w; }
            }
    }
};
struct EpiResid {
    static constexpr bool AFTER_DRAIN = false;
    const float* base; float* xr; bf16_t* xb; float* ssq; LAS unsigned char* lds;
    __device__ __forceinline__ void operator()(const f32x4 (&acc)[2][2][4][2], const Unit& u, int wr, int wc, int fr, int fq) const {
        const int row0 = u.pm * BM + wr * 64 + fr; const int col0 = u.pn * BM + wc * 32 + 8 * fq;
        LAS float* xq = (LAS float*)(lds + 131072);
#pragma unroll
        for (int ai = 0; ai < 2; ++ai)
#pragma unroll
            for (int m = 0; m < 4; ++m) {
                const int row = row0 + ai * HALF + m * 16; float q = 0.f;
#pragma unroll
                for (int bj = 0; bj < 2; ++bj) { const size_t off = (size_t)row * DM + col0 + bj * HALF;
                    const f32x4 b0 = *(const f32x4*)(base + off), b1 = *(const f32x4*)(base + off + 4);
                    const f32x4 v0 = acc[ai][bj][m][0] + b0, v1 = acc[ai][bj][m][1] + b1;
                    *(f32x4*)(xr + off) = v0; *(f32x4*)(xr + off + 4) = v1;
                    u32x4 w; w.x = cvt_pk_bf16(v0[0], v0[1]); w.y = cvt_pk_bf16(v0[2], v0[3]); w.z = cvt_pk_bf16(v1[0], v1[1]); w.w = cvt_pk_bf16(v1[2], v1[3]);
                    *(u32x4*)(xb + off) = w;
                    q += (v0[0] * v0[0] + v0[1] * v0[1]) + (v0[2] * v0[2] + v0[3] * v0[3]) + (v1[0] * v1[0] + v1[1] * v1[1]) + (v1[2] * v1[2] + v1[3] * v1[3]); }
                q += __shfl_xor(q, 16); q += __shfl_xor(q, 32);
                if (fq == 0) xq[(ai * HALF + wr * 64 + m * 16 + fr) * 4 + wc] = q;
            }
        asm volatile("s_waitcnt lgkmcnt(0)" ::: "memory"); __builtin_amdgcn_s_barrier(); asm volatile("" ::: "memory");
        { const int tid_ = (wr * 4 + wc) * 64 + fq * 16 + fr;
          if (tid_ < 256) { const f32x4 v = *(const LAS f32x4*)(xq + tid_ * 4); ssq[(size_t)(u.pm * BM + tid_) * 8 + u.pn] = (v[0] + v[1]) + (v[2] + v[3]); } }
    }
};

struct EpiConvSwiGLU {
    static constexpr bool AFTER_DRAIN = true;
    bf16_t* act; const float* ssq; const float* cw; const float* cb;
    __device__ __forceinline__ void fused(const f32x4 (&acc)[2][2][4][2], const Unit& u, int wr, int wc, int fr, int fq, LAS unsigned char* lds) const {
        const int rs = u.pm * 254;
#pragma unroll
        for (int ai = 0; ai < 2; ++ai)
#pragma unroll
            for (int m = 0; m < 4; ++m) {
                const int lr = ai * HALF + wr * 64 + m * 16 + fr; int row = rs + lr; row = row < SEQ ? row : SEQ - 1;
                const f32x4* sp = (const f32x4*)(ssq + (size_t)row * 8);
                const f32x4 s4 = sp[0] + sp[1];
                const float rsd = rsqrtf(((s4[0] + s4[1]) + (s4[2] + s4[3])) * (1.0f / 2048.0f) + EPS);
#pragma unroll
                for (int bj = 0; bj < 2; ++bj) { const f32x4 v0 = acc[ai][bj][m][0] * rsd, v1 = acc[ai][bj][m][1] * rsd;
                    u32x4 w; w.x = cvt_pk_bf16(v0[0], v0[1]); w.y = cvt_pk_bf16(v0[2], v0[3]); w.z = cvt_pk_bf16(v1[0], v1[1]); w.w = cvt_pk_bf16(v1[2], v1[3]);
                    const int c = 16 * bj + 4 * wc + fq;
                    *(LAS u32x4*)(lds + lr * 512 + ((c ^ ((lr & 7) << 2)) << 4)) = w; }
            }
        asm volatile("s_waitcnt lgkmcnt(0)" ::: "memory"); __builtin_amdgcn_s_barrier(); asm volatile("" ::: "memory");
        const int tid_ = (wr * 4 + wc) * 64 + fq * 16 + fr; const int cgp = tid_ & 15, rr = tid_ >> 4;
        const int j0 = u.pn * 128 + cgp * 8;
        float wg[3][8], wu[3][8], bg[8], bu[8];
#pragma unroll
        for (int k = 0; k < 3; ++k) { const f32x4 a0 = *(const f32x4*)(cw + (size_t)k * NUP + j0), a1 = *(const f32x4*)(cw + (size_t)k * NUP + j0 + 4), b0 = *(const f32x4*)(cw + (size_t)k * NUP + DFF + j0), b1 = *(const f32x4*)(cw + (size_t)k * NUP + DFF + j0 + 4);
#pragma unroll
            for (int e = 0; e < 4; ++e) { wg[k][e] = a0[e]; wg[k][4 + e] = a1[e]; wu[k][e] = b0[e]; wu[k][4 + e] = b1[e]; } }
        { const f32x4 a0 = *(const f32x4*)(cb + j0), a1 = *(const f32x4*)(cb + j0 + 4), b0 = *(const f32x4*)(cb + DFF + j0), b1 = *(const f32x4*)(cb + DFF + j0 + 4);
#pragma unroll
          for (int e = 0; e < 4; ++e) { bg[e] = a0[e]; bg[4 + e] = a1[e]; bu[e] = b0[e]; bu[4 + e] = b1[e]; } }
#pragma unroll 1
        for (int hh = 0; hh < 2; ++hh) {
            u32x4 hg[6], hu[6];
#pragma unroll
            for (int i = 0; i < 6; ++i) { const int lr = 8 * rr + 4 * hh - 2 + i;
                if (lr >= 0) { const int sw = (lr & 7) << 2; hg[i] = *(const LAS u32x4*)(lds + lr * 512 + ((cgp ^ sw) << 4)); hu[i] = *(const LAS u32x4*)(lds + lr * 512 + (((16 + cgp) ^ sw) << 4)); }
                else { hg[i] = (u32x4){0u, 0u, 0u, 0u}; hu[i] = (u32x4){0u, 0u, 0u, 0u}; } }
#pragma unroll
            for (int i = 0; i < 4; ++i) { const int lo = 8 * rr + 4 * hh + i; const int grow = rs + lo;
                float g2[8], g1[8], g0[8], u2[8], u1[8], u0[8];
                unpack8(hg[i], g2); unpack8(hg[i + 1], g1); unpack8(hg[i + 2], g0); unpack8(hu[i], u2); unpack8(hu[i + 1], u1); unpack8(hu[i + 2], u0);
                float o[8];
#pragma unroll
                for (int e = 0; e < 8; ++e) { const float ag = bg[e] + wg[0][e] * g2[e] + wg[1][e] * g1[e] + wg[2][e] * g0[e]; const float au = bu[e] + wu[0][e] * u2[e] + wu[1][e] * u1[e] + wu[2][e] * u0[e];
                    o[e] = ag * sigmoidf_(ag) * au; }
                u32x4 w; w.x = cvt_pk_bf16(o[0], o[1]); w.y = cvt_pk_bf16(o[2], o[3]); w.z = cvt_pk_bf16(o[4], o[5]); w.w = cvt_pk_bf16(o[6], o[7]);
                if ((u.pm == 0 || lo >= 2) && grow < SEQ) *(u32x4*)(act + (size_t)grow * DFF + j0) = w; }
        }
        asm volatile("s_waitcnt lgkmcnt(0)" ::: "memory"); __builtin_amdgcn_s_barrier(); asm volatile("" ::: "memory");
    }
};

template <class Epi, class Sched>
__device__ __forceinline__ void gemm_phase(LAS unsigned char* lds, const Gemm g, const Sched& S, const Epi& E) {
    int tid = threadIdx.x; asm volatile("" : "+v"(tid)); const int wid = __builtin_amdgcn_readfirstlane(tid >> 6), lane = tid & 63, wr = wid >> 2, wc = wid & 3, fr = lane & 15, fq = lane >> 4;
    const int K = g.K, nt = K / BK;
    unsigned voffA[2], voffB[2];
#pragma unroll
    for (int i = 0; i < 2; ++i) { int R, C; stage_rc(tid * 16 + i * 8192, R, C); const int Rb = (R & ~31) + perm32(R & 31);
        voffA[i] = (unsigned)(R * K + C) * 2u; voffB[i] = (unsigned)(Rb * K + C) * 2u; }
    const size_t kstep = (size_t)(BK * 2);
    const size_t hstep = (size_t)HALF * K * 2;
    const size_t tstep = 2 * hstep;
    const size_t tstepA = (size_t)g.a_step_rows * K * 2;
    const unsigned ldsw = (unsigned)wid * 1024u;
    const int aoff = lds_byte(wr * 64 + fr, fq * 8), boff = lds_byte(wc * 32 + fr, fq * 8);
#define PG8_SA(b, h) (((b) * 2 + (h)) * HTB)
#define PG8_SB(b, h) ((4 + (b) * 2 + (h)) * HTB)
#define PG8_STAGE(bufoff, gbase, voff) do { _Pragma("unroll") for (int _i = 0; _i < 2; ++_i) \
        __builtin_amdgcn_global_load_lds((const unsigned*)((const char*)(gbase) + (voff)[_i]), (LAS unsigned*)(lds + (bufoff) + ldsw + _i * 8192), 16, 0, 0); } while (0)
#define PG8_LDA(dst, b, h) do { _Pragma("unroll") for (int m = 0; m < 4; ++m) _Pragma("unroll") for (int k = 0; k < 2; ++k) dst[m][k] = *(const LAS bf16x8*)(lds + PG8_SA(b, h) + aoff + m * 2048 + k * 1024); } while (0)
#define PG8_LDB(dst, b, h) do { _Pragma("unroll") for (int n = 0; n < 2; ++n) _Pragma("unroll") for (int k = 0; k < 2; ++k) dst[n][k] = *(const LAS bf16x8*)(lds + PG8_SB(b, h) + boff + n * 2048 + k * 1024); } while (0)
#define PG8_MMA(ai, bj, At, Bt) do { __builtin_amdgcn_s_setprio(1); _Pragma("unroll") for (int m = 0; m < 4; ++m) _Pragma("unroll") for (int n = 0; n < 2; ++n) _Pragma("unroll") for (int k = 0; k < 2; ++k) \
        acc[ai][bj][m][n] = __builtin_amdgcn_mfma_f32_16x16x32_bf16(Bt[n][k], At[m][k], acc[ai][bj][m][n], 0, 0, 0); __builtin_amdgcn_s_setprio(0); } while (0)
#define PG8_WAIT_V(n) asm volatile("s_waitcnt vmcnt(" #n ")" ::: "memory")
#define PG8_WAIT_L(n) asm volatile("s_waitcnt lgkmcnt(" #n ")" ::: "memory")
#define PG8_BAR __builtin_amdgcn_s_barrier()
#define PG8_SCHED __builtin_amdgcn_sched_barrier(0)
    Unit cur, nxt; int ui = 0;
    if (!S.next(0, cur)) return;
    f32x4 acc[2][2][4][2];
#pragma unroll
    for (int a = 0; a < 2; ++a)
#pragma unroll
        for (int b = 0; b < 2; ++b)
#pragma unroll
            for (int m = 0; m < 4; ++m)
#pragma unroll
                for (int n = 0; n < 2; ++n) acc[a][b][m][n] = (f32x4){0.f, 0.f, 0.f, 0.f};
    bf16x8 At[4][2], B0[2][2], B1[2][2];
    const char* cA = (const char*)g.A + (size_t)cur.pm * tstepA; const char* cB = (const char*)g.Bt + (size_t)cur.pn * tstep;
    PG8_STAGE(PG8_SB(0, 0), cB, voffB); PG8_STAGE(PG8_SB(0, 1), cB + hstep, voffB); PG8_STAGE(PG8_SA(0, 0), cA, voffA); PG8_STAGE(PG8_SA(0, 1), cA + hstep, voffA);
    if (wr == 1) PG8_BAR;
    PG8_WAIT_V(2); PG8_BAR;
    PG8_STAGE(PG8_SB(1, 0), cB + kstep, voffB); PG8_STAGE(PG8_SA(1, 0), cA + kstep, voffA); PG8_STAGE(PG8_SB(1, 1), cB + hstep + kstep, voffB);
    PG8_WAIT_V(6); PG8_BAR;
    for (;;) {
        const bool has_next = S.next(ui + 1, nxt);
        const char* nA = has_next ? (const char*)g.A + (size_t)nxt.pm * tstepA : cA; const char* nB = has_next ? (const char*)g.Bt + (size_t)nxt.pn * tstep : cB;
        for (int t = 0; t < nt; t += 2) {
            const bool last = (t == nt - 2);
            const char* a1 = cA + (size_t)(t + 1) * kstep;
            const char* a2 = last ? nA : cA + (size_t)(t + 2) * kstep; const char* b2 = last ? nB : cB + (size_t)(t + 2) * kstep;
            const char* a3 = a2 + kstep; const char* b3 = b2 + kstep;
            PG8_LDB(B0, 0, 0); PG8_LDB(B1, 0, 1); PG8_SCHED; PG8_LDA(At, 0, 0); PG8_STAGE(PG8_SA(1, 1), a1 + hstep, voffA);
            PG8_WAIT_V(8); PG8_WAIT_L(0); PG8_BAR; PG8_MMA(0, 0, At, B0); PG8_MMA(0, 1, At, B1); PG8_BAR; PG8_SCHED;
            PG8_LDA(At, 0, 1); PG8_STAGE(PG8_SB(0, 0), b2, voffB); PG8_STAGE(PG8_SB(0, 1), b2 + hstep, voffB); PG8_STAGE(PG8_SA(0, 0), a2, voffA);
            PG8_WAIT_V(8); PG8_WAIT_L(0); PG8_BAR; PG8_MMA(1, 0, At, B0); PG8_MMA(1, 1, At, B1); PG8_BAR; PG8_SCHED;
            PG8_LDB(B0, 1, 0); PG8_LDB(B1, 1, 1); PG8_SCHED; PG8_LDA(At, 1, 0); PG8_STAGE(PG8_SA(0, 1), a2 + hstep, voffA);
            PG8_WAIT_V(8); PG8_WAIT_L(0); PG8_BAR; PG8_MMA(0, 0, At, B0); PG8_MMA(0, 1, At, B1); PG8_BAR; PG8_SCHED;
            PG8_LDA(At, 1, 1); PG8_STAGE(PG8_SB(1, 0), b3, voffB); PG8_STAGE(PG8_SB(1, 1), b3 + hstep, voffB); PG8_STAGE(PG8_SA(1, 0), a3, voffA);
            PG8_WAIT_V(8); PG8_WAIT_L(0); PG8_BAR; PG8_MMA(1, 0, At, B0); PG8_MMA(1, 1, At, B1); PG8_BAR; PG8_SCHED;
        }
        if (wr == 0) PG8_BAR;
        if constexpr (!Epi::AFTER_DRAIN) E(acc, cur, wr, wc, fr, fq);
        if (!has_next) break;
#pragma unroll
        for (int a = 0; a < 2; ++a)
#pragma unroll
            for (int b = 0; b < 2; ++b)
#pragma unroll
                for (int m = 0; m < 4; ++m)
#pragma unroll
                    for (int n = 0; n < 2; ++n) acc[a][b][m][n] = (f32x4){0.f, 0.f, 0.f, 0.f};
        cur = nxt; cA = nA; cB = nB; ++ui;
        if (wr == 1) PG8_BAR;
    }
    PG8_WAIT_V(0);
    PG8_BAR;
    if constexpr (Epi::AFTER_DRAIN) E.fused(acc, cur, wr, wc, fr, fq, lds);
#undef PG8_SA
#undef PG8_SB
#undef PG8_STAGE
#undef PG8_LDA
#undef PG8_LDB
#undef PG8_MMA
#undef PG8_WAIT_V
#undef PG8_WAIT_L
#undef PG8_BAR
#undef PG8_SCHED
}
}

struct Args { const float* in[28]; float* out; unsigned char* ws; };
enum { I_X = 0, I_MIXG, I_WIN, I_ALNG, I_ALNB, I_AWS, I_ABS, I_BMU, I_BW0, I_BW2, I_BA0, I_BA2, I_BG2, I_BKK, I_BKA, I_BRK, I_BLNG, I_BLNB, I_DGW2, I_DGB, I_DNG, I_WOUT, I_FFNG, I_WUP, I_CONVW, I_CONVB, I_WDOWN, I_FING };

__device__ __forceinline__ void p0_item(const float* W, int K, int N, bf16_t* WT, const float* gsc, LAS float* scr, int kb, int nb, int row_out0, int lane) {
    const int k0 = 64 * kb, n0 = 64 * nb;
    const int nn = n0 + 2 * (lane & 31); const bool ok = nn < N;
    f32x2 v[32];
#pragma unroll
    for (int i = 0; i < 32; ++i) { const int kk = 2 * i + (lane >> 5); v[i] = ok ? __builtin_nontemporal_load((const f32x2*)(W + (size_t)(k0 + kk) * N + nn)) : (f32x2){0.f, 0.f}; }
#pragma unroll
    for (int i = 0; i < 32; ++i) { const int kk = 2 * i + (lane >> 5); f32x2 x = v[i]; if (gsc) { const float g = gsc[k0 + kk]; x = x * g; }
        scr[kk * 65 + 2 * (lane & 31)] = x.x; scr[kk * 65 + 2 * (lane & 31) + 1] = x.y; }
    asm volatile("s_waitcnt lgkmcnt(0)" ::: "memory");
    const int c = lane & 7;
#pragma unroll
    for (int j = 0; j < 8; ++j) { const int n = (lane >> 3) + 8 * j; const LAS float* sp = scr + (8 * c) * 65 + n;
        u32x4 o; o.x = cvt_pk_bf16(sp[0 * 65], sp[1 * 65]); o.y = cvt_pk_bf16(sp[2 * 65], sp[3 * 65]); o.z = cvt_pk_bf16(sp[4 * 65], sp[5 * 65]); o.w = cvt_pk_bf16(sp[6 * 65], sp[7 * 65]);
        *(u32x4*)(WT + (size_t)(row_out0 + n) * K + k0 + 8 * c) = o; }
    asm volatile("s_waitcnt lgkmcnt(0)" ::: "memory");
}

__device__ __forceinline__ void convert_layer_weights(const Args& args, unsigned char* ws, int l, LAS float* scr, int w0, int nw, int lane, int it_lo, int it_hi) {
    constexpr int I_IN = 32 * 92, I_OUT = 32 * 32, I_UP = 32 * 176, I_DN = 88 * 32;
    unsigned char* wt = ws + WS_WT + (size_t)l * WT_LAYER;
    for (int it = it_lo + w0; it < it_hi; it += nw) {
        int r = it;
        if (r < I_IN) { const int kb = r / 92, nb = r % 92; p0_item(args.in[I_WIN] + (size_t)l * DM * NIN, DM, NIN, (bf16_t*)(wt + WT_IN), args.in[I_MIXG] + l * DM, scr, kb, nb, nb * 64, lane); continue; } r -= I_IN;
        if (r < I_OUT) { const int kb = r / 32, nb = r % 32; p0_item(args.in[I_WOUT] + (size_t)l * DM * DM, DM, DM, (bf16_t*)(wt + WT_OUT), nullptr, scr, kb, nb, nb * 64, lane); continue; } r -= I_OUT;
        if (r < I_UP) { const int kb = r / 176, nb = r % 176; const int n0 = nb * 64; const int j = n0 < DFF ? n0 : n0 - DFF; const int ro = (j >> 7) * 256 + (j & 127) + (n0 < DFF ? 0 : 128);
            p0_item(args.in[I_WUP] + (size_t)l * DM * NUP, DM, NUP, (bf16_t*)(wt + WT_UP), args.in[I_FFNG] + l * DM, scr, kb, nb, ro, lane); continue; } r -= I_UP;
        { const int kb = r / 32, nb = r % 32; p0_item(args.in[I_WDOWN] + (size_t)l * DFF * DM, DFF, DM, (bf16_t*)(wt + WT_DOWN), nullptr, scr, kb, nb, nb * 64, lane); }
    }
}

#define RWKV_LO(v) __builtin_shufflevector(v, v, 0, 1)
#define RWKV_HI(v) __builtin_shufflevector(v, v, 2, 3)
#define RWKV_LDB(set, g) do { _Pragma("unroll") for (int q = 0; q < 2; ++q) { lq_[set][q] = *(const LAS f32x4*)((st_) + 64 + (g) * 8 + q * 4); lq_[set][2 + q] = *(const LAS f32x4*)((st_) + 128 + (g) * 8 + q * 4); \
        lq_[set][4 + q] = *(const LAS f32x4*)((st_) + 192 + (g) * 8 + q * 4); if (WITH_Y_) lq_[set][6 + q] = *(const LAS f32x4*)((st_) + 256 + (g) * 8 + q * 4); } } while (0)
#define RWKV_STEP(st, vi, St, WITH_Y, WITH_V, yout) do { \
    const LAS float* st_ = (st); constexpr bool WITH_Y_ = (WITH_Y); \
    f32x2 a0_ = (f32x2){0.f, 0.f}, a1_ = (f32x2){0.f, 0.f}; \
    f32x4 na_[16]; f32x4 lq_[3][8]; \
    _Pragma("unroll") for (int q = 0; q < 16; ++q) na_[q] = *(const LAS f32x4*)(st_ + q * 4); \
    RWKV_LDB(0, 0); RWKV_LDB(1, 1); \
    __builtin_amdgcn_sched_barrier(0); \
    _Pragma("unroll") for (int q = 0; q < 16; ++q) { const f32x4 n = na_[q]; a0_ += St[2 * q] * RWKV_LO(n); a1_ += St[2 * q + 1] * RWKV_HI(n); } \
    const float sa_ = (a0_.x + a0_.y) + (a1_.x + a1_.y); const f32x2 sa2_ = (f32x2){sa_, sa_}; const f32x2 vi2_ = (f32x2){(vi), (vi)}; \
    f32x2 y0_ = (f32x2){0.f, 0.f}, y1_ = (f32x2){0.f, 0.f}; \
    __builtin_amdgcn_sched_barrier(0); \
    _Pragma("unroll") for (int gi = 0; gi < 8; ++gi) { \
        if (gi + 2 < 8) RWKV_LDB((gi + 2) % 3, gi + 2); \
        __builtin_amdgcn_sched_barrier(0); \
        _Pragma("unroll") for (int q = 0; q < 2; ++q) { const f32x4 dd = lq_[gi % 3][q], bb = lq_[gi % 3][2 + q], kk = lq_[gi % 3][4 + q]; const int k2 = gi * 4 + q * 2; \
            if (WITH_V) { St[k2] = St[k2] * RWKV_LO(dd) + sa2_ * RWKV_LO(bb) + vi2_ * RWKV_LO(kk); St[k2 + 1] = St[k2 + 1] * RWKV_HI(dd) + sa2_ * RWKV_HI(bb) + vi2_ * RWKV_HI(kk); } \
            else { St[k2] = St[k2] * RWKV_LO(dd) + sa2_ * RWKV_LO(bb); St[k2 + 1] = St[k2 + 1] * RWKV_HI(dd) + sa2_ * RWKV_HI(bb); } \
            if (WITH_Y_) { const f32x4 rr = lq_[gi % 3][6 + q]; y0_ += St[k2] * RWKV_LO(rr); y1_ += St[k2 + 1] * RWKV_HI(rr); } } \
        __builtin_amdgcn_sched_barrier(0); } \
    yout = (y0_.x + y0_.y) + (y1_.x + y1_.y); } while (0)

__global__ void __launch_bounds__(512, 2) mega_fwd(Args args) {
    extern __shared__ __attribute__((aligned(16))) unsigned char lds_raw[];
    LAS unsigned char* lds = (LAS unsigned char*)lds_raw;
    cg::grid_group grid = cg::this_grid();
    const int tid0 = threadIdx.x, wave = __builtin_amdgcn_readfirstlane(tid0 >> 6);
    const int bid = blockIdx.x, G = gridDim.x;
    const int gw = bid * 8 + wave, NGW = G * 8;
    unsigned char* ws = args.ws;
    float* XR = args.out;
    bf16_t* XB = (bf16_t*)(ws + WS_XB); bf16_t* Y = (bf16_t*)(ws + WS_Y); bf16_t* P = (bf16_t*)(ws + WS_P);
    float* IDZ = (float*)(ws + WS_IDZ); int* SEL = (int*)(ws + WS_SEL); float* PART = (float*)(ws + WS_PART);
    unsigned* BAR = (unsigned*)ws; unsigned bar_epoch = 0;
    float* SSQ = (float*)(ws + WS_SSQ); f32x2* ROPE = (f32x2*)(ws + WS_ROPE); float* KMEAN = (float*)(ws + WS_KMEAN);
    bf16_t* QB = (bf16_t*)(ws + WS_QB); bf16_t* KB = (bf16_t*)(ws + WS_KB); bf16_t* VT = (bf16_t*)(ws + WS_VT);
    float* VEC5 = (float*)(ws + WS_VEC5); float* VV = (float*)(ws + WS_VV); float* GG = (float*)(ws + WS_GG); float* BV = (float*)(ws + WS_BV);
    float* PCH = (float*)(ws + WS_PCH); float* LCH = (float*)(ws + WS_LCH); float* SIN = (float*)(ws + WS_SIN);
    float* OI = (float*)(ws + WS_OI); float* GU = (float*)(ws + WS_U); float* QT = (float*)(ws + WS_QT); float* LAM = (float*)(ws + WS_LAM);
    bf16_t* HB = (bf16_t*)(ws + WS_H); bf16_t* ACT = (bf16_t*)(ws + WS_ACT);

        { int tid = tid0; asm volatile("" : "+v"(tid)); const int lane = tid & 63; (void)lane;
    {
        LAS float* scr = (LAS float*)(lds + wave * 16896);
        const bool split_conv = (G >= 256);
        convert_layer_weights(args, ws, 0, scr, gw, NGW, lane, 0, split_conv ? 3968 : 12416);
        if (!split_conv) convert_layer_weights(args, ws, 1, scr, gw, NGW, lane, 0, 12416);
        for (int idx = bid * 512 + tid; idx < 8192; idx += G * 512) IDZ[idx] = (idx < 4096 && (idx >> 6) == (idx & 63)) ? 1.f : 0.f;
        for (int idx = bid * 512 + tid; idx < SEQ * 32; idx += G * 512) {
            const int t = idx >> 5, d = idx & 31;
            const float inv = exp2f(-(float)d * (13.287712379549449f / 32.0f));
            const float ang = (float)t * inv;
            const double rev = (double)ang * 0.15915494309189535; const float fr = (float)(rev - floor(rev));
            ROPE[idx] = (f32x2){__builtin_amdgcn_cosf(fr), __builtin_amdgcn_sinf(fr)};
        }
        const float* x = args.in[I_X];
        for (int row = gw; row < SEQ; row += NGW) {
            const f32x4* xr = (const f32x4*)(x + (size_t)row * DM) + lane; float s = 0.f;
            u32x2* ob = (u32x2*)(XB + (size_t)row * DM) + lane;
#pragma unroll
            for (int j = 0; j < 8; ++j) { const f32x4 v = xr[64 * j]; s += (v[0] * v[0] + v[1] * v[1]) + (v[2] * v[2] + v[3] * v[3]); u32x2 w; w.x = cvt_pk_bf16(v[0], v[1]); w.y = cvt_pk_bf16(v[2], v[3]); ob[64 * j] = w; }
            s = wave_sum(s);
            if (lane < 8) SSQ[(size_t)row * 8 + lane] = lane == 0 ? s : 0.f;
        }
    }
        }
    grid.sync();

    for (int l = 0; l < 2; ++l) {
        unsigned char* wt = ws + WS_WT + (size_t)l * WT_LAYER;
        { int tid = tid0; asm volatile("" : "+v"(tid)); const int lane = tid & 63; (void)lane;
        {
            pg8::Gemm g{XB, (const bf16_t*)(wt + WT_IN), SEQ, NINP, DM, 256}; pg8::StaticOrder S; S.init(SEQ, NINP, G, bid);
            pg8::EpiScaleBf16 E{P, NINP, SSQ};
            pg8::gemm_phase<pg8::EpiScaleBf16>(lds, g, S, E);
        }
        }
        fast_barrier(BAR, ++bar_epoch, (unsigned)G);
        { int tid = tid0; asm volatile("" : "+v"(tid)); const int lane = tid & 63; (void)lane;
        for (int unit = bid; unit < 256; unit += G) {
            const int n = unit >> 2, h = unit & 3, t0 = n * 128;
            LAS float* Vs = (LAS float*)lds; LAS float* Wt = (LAS float*)(lds + 65536); LAS float* st = (LAS float*)(lds + 65536 + 67584);
            const float* lng = args.in[I_ALNG] + l * 512; const float* lnb = args.in[I_ALNB] + l * 512;
            const float* wsrc = args.in[I_AWS] + ((size_t)l * 4 + h) * 16384; const float* bsrc = args.in[I_ABS] + (l * 4 + h) * 128;
            u32x4 raws[16];
#pragma unroll
            for (int i = 0; i < 16; ++i) raws[i] = *(const u32x4*)(P + (size_t)(t0 + wave * 16 + i) * NINP + PC_A + 512 + lane * 8);
#pragma unroll
            for (int i = 0; i < 16; ++i) { const int tt = wave * 16 + i;
                const u32x4 raw = raws[i]; float z[8]; unpack8(raw, z); float s = 0.f;
#pragma unroll
                for (int j = 0; j < 8; ++j) { z[j] = gelu_tanh(z[j]); s += z[j]; }
                const float mu = wave_sum(s) * (1.f / 512.f); float q = 0.f;
#pragma unroll
                for (int j = 0; j < 8; ++j) { const float d = z[j] - mu; q += d * d; }
                const float var = wave_sum(q) * (1.f / 512.f);
                if (lane == 0) { st[tt * 2] = mu; st[tt * 2 + 1] = rsqrtf(var + EPS); } }
            for (int i = 0; i < 32; ++i) { const int e = tid + 512 * i; const int t = e >> 7, s = e & 127; Wt[s * 132 + t] = (s <= t) ? wsrc[e] : 0.f; }
            __syncthreads();
            for (int i = 0; i < 4; ++i) { const int idx = tid + 512 * i; const int s = idx >> 4, c0 = (idx & 15) * 8;
                const u32x4 raw = *(const u32x4*)(P + (size_t)(t0 + s) * NINP + PC_A + 512 + h * 128 + c0); float z[8]; unpack8(raw, z);
                const float mu = st[s * 2], rs = st[s * 2 + 1];
#pragma unroll
                for (int j = 0; j < 8; ++j) Vs[s * 128 + c0 + j] = (gelu_tanh(z[j]) - mu) * rs * lng[h * 128 + c0 + j] + lnb[h * 128 + c0 + j]; }
            __syncthreads();
            const int tg = tid >> 4, cgp = tid & 15; const int s_end = wave * 16 + 16;
            float acc[4][8];
#pragma unroll
            for (int i = 0; i < 4; ++i)
#pragma unroll
                for (int j = 0; j < 8; ++j) acc[i][j] = 0.f;
            { f32x4 w4n[2], v0n[2], v1n[2];
#pragma unroll
              for (int q = 0; q < 2; ++q) { w4n[q] = *(const LAS f32x4*)(Wt + q * 132 + tg * 4); v0n[q] = *(const LAS f32x4*)(Vs + q * 128 + cgp * 8); v1n[q] = *(const LAS f32x4*)(Vs + q * 128 + cgp * 8 + 4); }
              for (int s = 0; s < s_end; s += 2) {
                f32x4 w4c[2], v0c[2], v1c[2];
#pragma unroll
                for (int q = 0; q < 2; ++q) { w4c[q] = w4n[q]; v0c[q] = v0n[q]; v1c[q] = v1n[q]; }
                const int sn = (s + 2 < 128) ? s + 2 : 126;
#pragma unroll
                for (int q = 0; q < 2; ++q) { w4n[q] = *(const LAS f32x4*)(Wt + (sn + q) * 132 + tg * 4); v0n[q] = *(const LAS f32x4*)(Vs + (sn + q) * 128 + cgp * 8); v1n[q] = *(const LAS f32x4*)(Vs + (sn + q) * 128 + cgp * 8 + 4); }
                __builtin_amdgcn_sched_barrier(0);
#pragma unroll
                for (int q = 0; q < 2; ++q)
#pragma unroll
                    for (int i = 0; i < 4; ++i) {
#pragma unroll
                        for (int j = 0; j < 4; ++j) { acc[i][j] += w4c[q][i] * v0c[q][j]; acc[i][4 + j] += w4c[q][i] * v1c[q][j]; } }
                __builtin_amdgcn_sched_barrier(0);
              } }
#pragma unroll
            for (int i = 0; i < 4; ++i) { const int t = tg * 4 + i; const float bias = bsrc[t];
                const u32x4 raw = *(const u32x4*)(P + (size_t)(t0 + t) * NINP + PC_A + h * 128 + cgp * 8); float z[8]; unpack8(raw, z); float o[8];
#pragma unroll
                for (int j = 0; j < 8; ++j) o[j] = gelu_tanh(z[j]) * (acc[i][j] + bias);
                u32x4 w; w.x = cvt_pk_bf16(o[0], o[1]); w.y = cvt_pk_bf16(o[2], o[3]); w.z = cvt_pk_bf16(o[4], o[5]); w.w = cvt_pk_bf16(o[6], o[7]);
                *(u32x4*)(Y + (size_t)(t0 + t) * DM + h * 128 + cgp * 8) = w; }
            __syncthreads();
        }
        }
        { int tid = tid0; asm volatile("" : "+v"(tid)); const int lane = tid & 63; (void)lane;
        for (int unit = bid; unit < 256; unit += G) {
            const int n = unit >> 3, h = unit & 7; const int tt = tid >> 1, half = tid & 1, t = n * 256 + tt, d0 = half * 16;
            LAS float* red = (LAS float*)lds;
            LAS bf16_t* vsT = (LAS bf16_t*)(lds + 4096);
            const bf16_t* prow = P + (size_t)t * NINP + PC_C + h * 64;
            float ql[16], qh[16], kl[16], kh[16];
            { u32x4 a0 = *(const u32x4*)(prow + d0), a1 = *(const u32x4*)(prow + d0 + 8), b0 = *(const u32x4*)(prow + 32 + d0), b1 = *(const u32x4*)(prow + 32 + d0 + 8);
              float z[8]; unpack8(a0, z);
#pragma unroll
              for (int j = 0; j < 8; ++j) ql[j] = z[j];
              unpack8(a1, z);
#pragma unroll
              for (int j = 0; j < 8; ++j) ql[8 + j] = z[j];
              unpack8(b0, z);
#pragma unroll
              for (int j = 0; j < 8; ++j) qh[j] = z[j];
              unpack8(b1, z);
#pragma unroll
              for (int j = 0; j < 8; ++j) qh[8 + j] = z[j]; }
            { u32x4 a0 = *(const u32x4*)(prow + 512 + d0), a1 = *(const u32x4*)(prow + 512 + d0 + 8), b0 = *(const u32x4*)(prow + 512 + 32 + d0), b1 = *(const u32x4*)(prow + 512 + 32 + d0 + 8);
              float z[8]; unpack8(a0, z);
#pragma unroll
              for (int j = 0; j < 8; ++j) kl[j] = z[j];
              unpack8(a1, z);
#pragma unroll
              for (int j = 0; j < 8; ++j) kl[8 + j] = z[j];
              unpack8(b0, z);
#pragma unroll
              for (int j = 0; j < 8; ++j) kh[j] = z[j];
              unpack8(b1, z);
#pragma unroll
              for (int j = 0; j < 8; ++j) kh[8 + j] = z[j]; }
            const f32x2* cs = ROPE + (size_t)t * 32 + d0;
#pragma unroll
            for (int j = 0; j < 16; ++j) { const f32x2 c = cs[j];
                const float q1 = ql[j], q2 = qh[j]; ql[j] = (q1 * c.x - q2 * c.y) * QSCALE; qh[j] = (q1 * c.y + q2 * c.x) * QSCALE;
                const float k1 = kl[j], k2 = kh[j]; kl[j] = k1 * c.x - k2 * c.y; kh[j] = k1 * c.y + k2 * c.x; }
            { bf16_t* qo = QB + (size_t)t * 512 + h * 64 + d0; bf16_t* ko = KB + (size_t)t * 512 + h * 64 + d0;
              u32x4 w;
              w.x = cvt_pk_bf16(ql[0], ql[1]); w.y = cvt_pk_bf16(ql[2], ql[3]); w.z = cvt_pk_bf16(ql[4], ql[5]); w.w = cvt_pk_bf16(ql[6], ql[7]); *(u32x4*)(qo) = w;
              w.x = cvt_pk_bf16(ql[8], ql[9]); w.y = cvt_pk_bf16(ql[10], ql[11]); w.z = cvt_pk_bf16(ql[12], ql[13]); w.w = cvt_pk_bf16(ql[14], ql[15]); *(u32x4*)(qo + 8) = w;
              w.x = cvt_pk_bf16(qh[0], qh[1]); w.y = cvt_pk_bf16(qh[2], qh[3]); w.z = cvt_pk_bf16(qh[4], qh[5]); w.w = cvt_pk_bf16(qh[6], qh[7]); *(u32x4*)(qo + 32) = w;
              w.x = cvt_pk_bf16(qh[8], qh[9]); w.y = cvt_pk_bf16(qh[10], qh[11]); w.z = cvt_pk_bf16(qh[12], qh[13]); w.w = cvt_pk_bf16(qh[14], qh[15]); *(u32x4*)(qo + 40) = w;
              w.x = cvt_pk_bf16(kl[0], kl[1]); w.y = cvt_pk_bf16(kl[2], kl[3]); w.z = cvt_pk_bf16(kl[4], kl[5]); w.w = cvt_pk_bf16(kl[6], kl[7]); *(u32x4*)(ko) = w;
              w.x = cvt_pk_bf16(kl[8], kl[9]); w.y = cvt_pk_bf16(kl[10], kl[11]); w.z = cvt_pk_bf16(kl[12], kl[13]); w.w = cvt_pk_bf16(kl[14], kl[15]); *(u32x4*)(ko + 8) = w;
              w.x = cvt_pk_bf16(kh[0], kh[1]); w.y = cvt_pk_bf16(kh[2], kh[3]); w.z = cvt_pk_bf16(kh[4], kh[5]); w.w = cvt_pk_bf16(kh[6], kh[7]); *(u32x4*)(ko + 32) = w;
              w.x = cvt_pk_bf16(kh[8], kh[9]); w.y = cvt_pk_bf16(kh[10], kh[11]); w.z = cvt_pk_bf16(kh[12], kh[13]); w.w = cvt_pk_bf16(kh[14], kh[15]); *(u32x4*)(ko + 40) = w; }
#pragma unroll
            for (int j = 0; j < 16; ++j) {
#pragma unroll
                for (int o = 2; o < 64; o <<= 1) { kl[j] += __shfl_xor(kl[j], o); kh[j] += __shfl_xor(kh[j], o); } }
            if (lane < 2) {
#pragma unroll
                for (int j = 0; j < 16; ++j) { red[(wave * 2 + lane) * 32 + j] = kl[j]; red[(wave * 2 + lane) * 32 + 16 + j] = kh[j]; } }
            { const bf16_t* vrow = prow + 1024 + half * 32;
#pragma unroll
              for (int q = 0; q < 4; ++q) { const u32x4 r = *(const u32x4*)(vrow + q * 8); const unsigned rr[4] = {r.x, r.y, r.z, r.w};
#pragma unroll
                  for (int j = 0; j < 4; ++j) { const int d = half * 32 + q * 8 + 2 * j; vsT[d * 264 + tt] = (bf16_t)(rr[j] & 0xffffu); vsT[(d + 1) * 264 + tt] = (bf16_t)(rr[j] >> 16); } } }
            __syncthreads();
            if (tid < 64) { const int hf = (tid & 31) >> 4, slot = (tid & 15) + (tid >= 32 ? 16 : 0); float s = 0.f;
#pragma unroll
                for (int w = 0; w < 8; ++w) s += red[(w * 2 + hf) * 32 + slot];
                KMEAN[(h * 32 + n) * 64 + tid] = s * (1.f / 256.f); }
            { const int d = tid >> 3, seg = tid & 7; const LAS u32x4* src = (const LAS u32x4*)(vsT + d * 264 + seg * 32); u32x4* dst = (u32x4*)(VT + (size_t)(h * 64 + d) * SEQ + n * 256 + seg * 32);
#pragma unroll
              for (int q = 0; q < 4; ++q) dst[q] = src[q]; }
            __syncthreads();
        }
        }
        { int tid = tid0; asm volatile("" : "+v"(tid)); const int lane = tid & 63; (void)lane;
        for (int unit = bid; unit < 256; unit += G) {
            const int t0 = unit * 32;
            LAS float* xs = (LAS float*)lds;
            const float* mu = args.in[I_BMU] + l * 1696;
            for (int i = 0; i < 10; ++i) { const int idx = tid + 512 * i; const int tt = idx / 160, j = idx - tt * 160; const int t = t0 + tt;
                const float cur = bf2f(P[(size_t)t * NINP + PC_B + 1536 + j]); const float prev = t > 0 ? bf2f(P[(size_t)(t - 1) * NINP + PC_B + 1536 + j]) : 0.f;
                const float x = cur + (prev - cur) * mu[1536 + j];
                xs[tt * 160 + j] = j < 32 ? tanhf(x) : (j < 64 ? x : sigmoidf_(x)); }
            const int c = tid, head = wave;
            const float w0c = args.in[I_BW0][l * 512 + c], a0c = args.in[I_BA0][l * 512 + c], kkc = args.in[I_BKK][l * 512 + c], kac = args.in[I_BKA][l * 512 + c], rkc = args.in[I_BRK][l * 512 + c];
            const float mur = mu[c], muk = mu[512 + c], muv = mu[1024 + c];
            const float* w2 = args.in[I_BW2] + (size_t)l * 32 * 512; const float* a2 = args.in[I_BA2] + (size_t)l * 32 * 512; const float* g2 = args.in[I_BG2] + (size_t)l * 96 * 512;
            __syncthreads();
            {
                float wr_[32], ar_[32];
                unsigned cu = (unsigned)c; asm volatile("" : "+v"(cu));
#pragma unroll
                for (int j = 0; j < 32; ++j) { const float* wj = w2 + j * 512; const float* aj = a2 + j * 512; wr_[j] = wj[cu]; ar_[j] = aj[cu]; }
                float rp = 0.f, kp = 0.f, vp = 0.f;
                { const bf16_t* pr = P + (size_t)t0 * NINP + PC_B + c; if (t0 > 0) { rp = bf2f(pr[-NINP]); kp = bf2f(pr[512 - NINP]); vp = bf2f(pr[1024 - NINP]); } }
                float rn, kn, vnx;
                { const bf16_t* pr = P + (size_t)t0 * NINP + PC_B + c; rn = bf2f(pr[0]); kn = bf2f(pr[512]); vnx = bf2f(pr[1024]); }
#pragma unroll 1
                for (int i = 0; i < 32; ++i) { const int t = t0 + i;
                    const float rc = rn, kc = kn, vc = vnx;
                    if (i + 1 < 32) { const bf16_t* pr = P + (size_t)(t + 1) * NINP + PC_B + c; rn = bf2f(pr[0]); kn = bf2f(pr[512]); vnx = bf2f(pr[1024]); }
                    float aw = w0c, aa = a0c, aw1 = 0.f, aa1 = 0.f;
                    const LAS float* xr = xs + i * 160;
#pragma unroll
                    for (int j = 0; j < 32; j += 4) { const f32x4 x = *(const LAS f32x4*)(xr + j), y = *(const LAS f32x4*)(xr + 32 + j);
                        aw += x[0] * wr_[j]; aw1 += x[1] * wr_[j + 1]; aw += x[2] * wr_[j + 2]; aw1 += x[3] * wr_[j + 3];
                        aa += y[0] * ar_[j]; aa1 += y[1] * ar_[j + 1]; aa += y[2] * ar_[j + 2]; aa1 += y[3] * ar_[j + 3]; }
                    aw += aw1; aa += aa1;
                    const float rr = rc + (rp - rc) * mur, kx = kc + (kp - kc) * muk, vx = vc + (vp - vc) * muv;
                    const float mz = -aw; const float sp = mz > 20.f ? mz : log1pf(__expf(mz));
                    const float wl = -sp - 0.5f; const float dec = __expf(-__expf(wl));
                    const float a = sigmoidf_(aa);
                    float kk = kx * kkc; const float n2 = wave_sum(kk * kk); kk = kk * __builtin_amdgcn_rsqf(fmaxf(n2, 1e-24f));
                    const float k2 = kx * (1.f + (a - 1.f) * kac); const float bb = kk * a;
                    const float bon = wave_sum(rr * k2 * rkc);
                    float* v5 = VEC5 + ((size_t)head * SEQ + t) * 320 + lane;
                    v5[0] = -kk; v5[64] = dec; v5[128] = bb; v5[192] = k2; v5[256] = rr;
                    VV[((size_t)head * SEQ + t) * 64 + lane] = vx; BV[(size_t)t * 512 + c] = bon * vx;
                    rp = rc; kp = kc; vp = vc; }
            }
            {
                float gr_[96];
                unsigned cu = (unsigned)c; asm volatile("" : "+v"(cu));
#pragma unroll
                for (int j = 0; j < 96; ++j) { const float* gj = g2 + j * 512; gr_[j] = gj[cu]; }
#pragma unroll 1
                for (int i = 0; i < 32; ++i) { const int t = t0 + i;
                    float ag = 0.f, ag1 = 0.f;
                    const LAS float* xr = xs + i * 160;
#pragma unroll
                    for (int j = 0; j < 96; j += 4) { const f32x4 x = *(const LAS f32x4*)(xr + 64 + j); ag += x[0] * gr_[j]; ag1 += x[1] * gr_[j + 1]; ag += x[2] * gr_[j + 2]; ag1 += x[3] * gr_[j + 3]; }
                    GG[(size_t)t * 512 + c] = ag + ag1; }
            }
            __syncthreads();
        }
        }
        fast_barrier(BAR, ++bar_epoch, (unsigned)G);
        { int tid = tid0; asm volatile("" : "+v"(tid)); const int lane = tid & 63; (void)lane;
        for (int pi = bid; pi < 256; pi += G) {
            const int h = pi & 7, r = pi >> 3, half = r & 1;
            for (int which = 0; which < 2; ++which) {
                const int qb = which ? 31 - (r >> 1) : (r >> 1);
                const int t0 = qb * 256 + half * 128;
                LAS bf16_t* Ks = (LAS bf16_t*)lds;
                LAS bf16_t* Vs = (LAS bf16_t*)(lds + 18432);
                LAS float* kmS = (LAS float*)(lds + 36864);
                LAS int* selS = (LAS int*)(lds + 36864 + 8192);
                for (int i = tid; i < qb * 64; i += 512) kmS[i] = KMEAN[h * 2048 + i];
                __syncthreads();
                if (tid < 128) {
                    const bf16_t* qr = QB + (size_t)(t0 + tid) * 512 + h * 64;
                    float q[64];
#pragma unroll
                    for (int j = 0; j < 8; ++j) { float z[8]; unpack8(*(const u32x4*)(qr + j * 8), z);
#pragma unroll
                        for (int e = 0; e < 8; ++e) q[j * 8 + e] = z[e]; }
                    float b0 = -INFINITY, b1 = -INFINITY, b2 = -INFINITY; int i0 = 255, i1 = 255, i2 = 255;
                    for (int n = 0; n < qb; ++n) { float s = 0.f, s1 = 0.f, s2 = 0.f, s3 = 0.f; f32x4 kv[16];
#pragma unroll
                        for (int j = 0; j < 16; ++j) kv[j] = *(const LAS f32x4*)(kmS + n * 64 + j * 4);
                        __builtin_amdgcn_sched_barrier(0);
#pragma unroll
                        for (int j = 0; j < 16; ++j) { s += q[4 * j] * kv[j][0]; s1 += q[4 * j + 1] * kv[j][1]; s2 += q[4 * j + 2] * kv[j][2]; s3 += q[4 * j + 3] * kv[j][3]; }
                        s = (s + s1) + (s2 + s3);
                        if (s > b0) { b2 = b1; i2 = i1; b1 = b0; i1 = i0; b0 = s; i0 = n; } else if (s > b1) { b2 = b1; i2 = i1; b1 = s; i1 = n; } else if (s > b2) { b2 = s; i2 = n; } }
                    selS[tid] = i0 | (i1 << 8) | (i2 << 16); SEL[h * SEQ + t0 + tid] = i0 | (i1 << 8) | (i2 << 16);
                }
                __syncthreads();
                const int ql = lane & 15, kg = lane >> 4;
                const int tq = t0 + wave * 16 + ql;
                const int sel = selS[wave * 16 + ql]; const int s0 = sel & 255, s1 = (sel >> 8) & 255, s2 = (sel >> 16) & 255;
                bf16x8 qf[2];
                qf[0] = *(const bf16x8*)(QB + (size_t)tq * 512 + h * 64 + kg * 8); qf[1] = *(const bf16x8*)(QB + (size_t)tq * 512 + h * 64 + 32 + kg * 8);
                const int nown = half ? 4 : 2, ntile = nown;
                float mrun = -1e30f, lrun = 0.f; f32x4 O[4];
#pragma unroll
                for (int d = 0; d < 4; ++d) O[d] = (f32x4){0.f, 0.f, 0.f, 0.f};
                const int lrow = tid >> 3, lseg = (tid & 7) ^ (lrow & 7);
                const bf16_t* kgp = KB + (size_t)lrow * 512 + h * 64 + lseg * 8; const bf16_t* vgp = VT + (size_t)(h * 64 + lrow) * SEQ + lseg * 8;
                LAS unsigned char* ring = lds + 49152;
#define ATT_KS(i_) ((i_) < nown ? qb * 256 + (i_) * 64 : ((i_) - nown) * 64)
#define ATT_ISSUE_S(i_, slot_) do { const int ks_ = ATT_KS(i_); LAS unsigned char* tb_ = ring + (slot_) * 16384 + wave * 1024; \
                    __builtin_amdgcn_global_load_lds((const unsigned*)(kgp + (size_t)ks_ * 512), (LAS unsigned*)tb_, 16, 0, 0); \
                    __builtin_amdgcn_global_load_lds((const unsigned*)(vgp + ks_), (LAS unsigned*)(tb_ + 8192), 16, 0, 0); } while (0)
                ATT_ISSUE_S(0, 0); if (ntile > 1) ATT_ISSUE_S(1, 1); if (ntile > 2) ATT_ISSUE_S(2, 2);
                const int sw = ql & 7;
                for (int i0 = 0; i0 < ntile; i0 += 4) {
#pragma unroll
                for (int ij = 0; ij < 4; ++ij) { const int i = i0 + ij; if (i < ntile) {
                    if (i + 2 < ntile) asm volatile("s_waitcnt vmcnt(4)" ::: "memory"); else if (i + 1 < ntile) asm volatile("s_waitcnt vmcnt(2)" ::: "memory"); else asm volatile("s_waitcnt vmcnt(0)" ::: "memory");
                    __builtin_amdgcn_s_barrier(); asm volatile("" ::: "memory");
                    if (i + 3 < ntile) ATT_ISSUE_S(i + 3, (ij + 3) & 3);
                    const int ks = ATT_KS(i);
                    const LAS unsigned char* Kc = ring + ij * 16384; const LAS unsigned char* Vc = Kc + 8192;
                    bf16x8 kfr[4][2];
#pragma unroll
                    for (int kt = 0; kt < 4; ++kt)
#pragma unroll
                        for (int c = 0; c < 2; ++c) kfr[kt][c] = *(const LAS bf16x8*)(Kc + (kt * 16 + ql) * 128 + (((c * 4 + kg) ^ sw) << 4));
                    u32x2 vfr[2][4][2];
#pragma unroll
                    for (int kc = 0; kc < 2; ++kc)
#pragma unroll
                        for (int d = 0; d < 4; ++d) { const LAS unsigned char* vr = Vc + (d * 16 + ql) * 128 + (kg & 1) * 8; const int sg = kc * 4 + (kg >> 1);
                            vfr[kc][d][0] = *(const LAS u32x2*)(vr + ((sg ^ sw) << 4)); vfr[kc][d][1] = *(const LAS u32x2*)(vr + (((sg + 2) ^ sw) << 4)); }
                    __builtin_amdgcn_sched_barrier(0);
                    f32x4 Sx[4];
#pragma unroll
                    for (int kt = 0; kt < 4; ++kt) Sx[kt] = __builtin_amdgcn_mfma_f32_16x16x32_bf16(kfr[kt][0], qf[0], (f32x4){0.f, 0.f, 0.f, 0.f}, 0, 0, 0);
#pragma unroll
                    for (int kt = 0; kt < 4; ++kt) Sx[kt] = __builtin_amdgcn_mfma_f32_16x16x32_bf16(kfr[kt][1], qf[1], Sx[kt], 0, 0, 0);
                    const int nblk = ks >> 8; const bool own = i < nown;
                    const bool keepl = true; (void)own; (void)nblk; (void)s0; (void)s1; (void)s2;
                    if (own && ks + 63 > t0) {
#pragma unroll
                        for (int kt = 0; kt < 4; ++kt)
#pragma unroll
                            for (int jj = 0; jj < 4; ++jj) { const int key = ks + kt * 16 + 4 * kg + jj; Sx[kt][jj] = (key <= tq) ? Sx[kt][jj] : -1e30f; }
                    }
                    float mx = fmaxf(fmaxf(fmaxf(Sx[0][0], Sx[0][1]), fmaxf(Sx[0][2], Sx[0][3])), fmaxf(fmaxf(Sx[1][0], Sx[1][1]), fmaxf(Sx[1][2], Sx[1][3])));
                    mx = fmaxf(mx, fmaxf(fmaxf(fmaxf(Sx[2][0], Sx[2][1]), fmaxf(Sx[2][2], Sx[2][3])), fmaxf(fmaxf(Sx[3][0], Sx[3][1]), fmaxf(Sx[3][2], Sx[3][3]))));
                    mx = keepl ? mx : -1e30f;
                    mx = fmaxf(mx, __shfl_xor(mx, 16)); mx = fmaxf(mx, __shfl_xor(mx, 32));
                    const float mnew = fmaxf(mrun, mx); const float alpha = __builtin_amdgcn_exp2f(mrun - mnew); mrun = mnew;
                    const float moff = keepl ? mnew : 1e30f;
                    float rs = 0.f;
#pragma unroll
                    for (int kt = 0; kt < 4; ++kt)
#pragma unroll
                        for (int jj = 0; jj < 4; ++jj) { const float p = __builtin_amdgcn_exp2f(Sx[kt][jj] - moff); Sx[kt][jj] = p; rs += p; }
                    lrun = lrun * alpha + rs;
#pragma unroll
                    for (int d = 0; d < 4; ++d) O[d] *= alpha;
#pragma unroll
                    for (int kc = 0; kc < 2; ++kc) {
                        u32x4 pw; pw.x = cvt_pk_bf16(Sx[2 * kc][0], Sx[2 * kc][1]); pw.y = cvt_pk_bf16(Sx[2 * kc][2], Sx[2 * kc][3]); pw.z = cvt_pk_bf16(Sx[2 * kc + 1][0], Sx[2 * kc + 1][1]); pw.w = cvt_pk_bf16(Sx[2 * kc + 1][2], Sx[2 * kc + 1][3]);
                        const bf16x8 pb = __builtin_bit_cast(bf16x8, pw);
#pragma unroll
                        for (int d = 0; d < 4; ++d) { u32x4 vw; vw.x = vfr[kc][d][0].x; vw.y = vfr[kc][d][0].y; vw.z = vfr[kc][d][1].x; vw.w = vfr[kc][d][1].y;
                            O[d] = __builtin_amdgcn_mfma_f32_16x16x32_bf16(__builtin_bit_cast(bf16x8, vw), pb, O[d], 0, 0, 0); }
                    }
                } } }
                lrun += __shfl_xor(lrun, 16); lrun += __shfl_xor(lrun, 32);
#undef ATT_KS
#undef ATT_ISSUE_S
                { float* pp = PART + ((size_t)(tq * 8 + h) * 4 + 3) * 36;
#pragma unroll
                  for (int d = 0; d < 4; ++d) { u32x2 w; w.x = cvt_pk_bf16(O[d][0], O[d][1]); w.y = cvt_pk_bf16(O[d][2], O[d][3]); *(u32x2*)(pp + d * 8 + 2 * kg) = w; }
                  if (kg == 0) { pp[32] = mrun; pp[33] = lrun; } }
                __syncthreads();
            }
        }
        }
        { int tid = tid0; asm volatile("" : "+v"(tid)); const int lane = tid & 63; (void)lane;
        for (int unit = bid; unit < 512; unit += G) {
            const int c = unit >> 2, h = unit & 3, t0 = c * 64;
            LAS float* qtT = (LAS float*)lds;
            LAS float* ktT = (LAS float*)(lds + 16384);
            LAS float* khS = (LAS float*)(lds + 32768);
            LAS float* vS = (LAS float*)(lds + 49152);
            LAS float* AT = (LAS float*)(lds + 81920);
            LAS float* xgs = (LAS float*)(lds + 98304);
            const bf16_t* pd = P + (size_t)t0 * NINP + PC_D;
            for (int i = tid; i < 1024; i += 512) { const int t = i >> 4, j = i & 15; xgs[i] = bf2f(pd[(size_t)t * NINP + 1024 + j]); }
            for (int i = 0; i < 2; ++i) { const int idx = tid + 512 * i; const int s = idx >> 4, e0 = (idx & 15) * 8; float z[8]; unpack8(*(const u32x4*)(pd + (size_t)s * NINP + 512 + h * 128 + e0), z);
#pragma unroll
                for (int j = 0; j < 8; ++j) vS[s * 128 + e0 + j] = z[j]; }
            __syncthreads();
            { const int t = tid >> 3, dg = (tid & 7) * 8; const float* gw2 = args.in[I_DGW2] + (size_t)l * 16 * 256 + h * 64 + dg; const float* gb = args.in[I_DGB] + l * 256 + h * 64 + dg;
              float a[8];
#pragma unroll
              for (int j = 0; j < 8; ++j) a[j] = gb[j];
              for (int r = 0; r < 16; ++r) { const float xv = xgs[t * 16 + r];
#pragma unroll
                  for (int j = 0; j < 8; ++j) a[j] += xv * gw2[r * 256 + j]; }
#pragma unroll
              for (int j = 0; j < 8; ++j) { const float x = a[j]; const float ls = fminf(x, 0.f) - log1pf(__expf(-fabsf(x))); AT[t * 64 + dg + j] = ls * (1.f / 16.f); } }
            __syncthreads();
            if (tid < 64) { float run = 0.f; for (int t = 0; t < 64; ++t) { run += AT[t * 64 + tid]; AT[t * 64 + tid] = run; } }
            __syncthreads();
            { const int t = tid >> 3, dg = (tid & 7) * 8; float qz[8], kz[8];
              unpack8(*(const u32x4*)(pd + (size_t)t * NINP + h * 64 + dg), qz); unpack8(*(const u32x4*)(pd + (size_t)t * NINP + 256 + h * 64 + dg), kz);
#pragma unroll
              for (int j = 0; j < 8; ++j) { const int d = dg + j; const float cm = AT[t * 64 + d], last = AT[63 * 64 + d];
                  const float qv = qz[j] * 0.125f * __expf(cm); qtT[d * 64 + t] = qv; ktT[d * 64 + t] = kz[j] * __expf(-cm); khS[t * 64 + d] = kz[j] * __expf(last - cm);
                  QT[(size_t)(t0 + t) * 256 + h * 64 + d] = qv;
                  if (t == 63) LAM[(c * 4 + h) * 64 + d] = __expf(last); } }
            __syncthreads();
            if (tid < 256) { const int tq0 = (tid & 15) * 4, sq0 = (tid >> 4) * 4; float a[4][4];
#pragma unroll
                for (int i = 0; i < 4; ++i)
#pragma unroll
                    for (int j = 0; j < 4; ++j) a[i][j] = 0.f;
                for (int d0 = 0; d0 < 64; d0 += 8) { f32x4 qv[8], kv[8];
#pragma unroll
                    for (int q = 0; q < 8; ++q) { qv[q] = *(const LAS f32x4*)(qtT + (d0 + q) * 64 + tq0); kv[q] = *(const LAS f32x4*)(ktT + (d0 + q) * 64 + sq0); }
                    __builtin_amdgcn_sched_barrier(0);
#pragma unroll
                    for (int q = 0; q < 8; ++q)
#pragma unroll
                        for (int i = 0; i < 4; ++i)
#pragma unroll
                            for (int j = 0; j < 4; ++j) a[i][j] += qv[q][i] * kv[q][j];
                    __builtin_amdgcn_sched_barrier(0); }
                asm volatile("" ::: "memory");
#pragma unroll
                for (int j = 0; j < 4; ++j) { f32x4 o;
#pragma unroll
                    for (int i = 0; i < 4; ++i) o[i] = (sq0 + j <= tq0 + i) ? a[i][j] : 0.f;
                    *(LAS f32x4*)(AT + (sq0 + j) * 64 + tq0) = o; } }
            __syncthreads();
            { const int x0 = (tid & 15) * 4, e0 = (tid >> 4) * 4; float o[4][4], u[4][4];
#pragma unroll
              for (int i = 0; i < 4; ++i)
#pragma unroll
                  for (int j = 0; j < 4; ++j) { o[i][j] = 0.f; u[i][j] = 0.f; }
              for (int s0 = 0; s0 < 64; s0 += 4) { f32x4 av[4], kv[4], vv[4];
#pragma unroll
                  for (int q = 0; q < 4; ++q) { av[q] = *(const LAS f32x4*)(AT + (s0 + q) * 64 + x0); kv[q] = *(const LAS f32x4*)(khS + (s0 + q) * 64 + x0); vv[q] = *(const LAS f32x4*)(vS + (s0 + q) * 128 + e0); }
                  __builtin_amdgcn_sched_barrier(0);
#pragma unroll
                  for (int q = 0; q < 4; ++q)
#pragma unroll
                      for (int i = 0; i < 4; ++i)
#pragma unroll
                          for (int j = 0; j < 4; ++j) { o[i][j] += av[q][i] * vv[q][j]; u[i][j] += kv[q][i] * vv[q][j]; }
                  __builtin_amdgcn_sched_barrier(0); }
#pragma unroll
              for (int i = 0; i < 4; ++i) { *(f32x4*)(OI + (size_t)(t0 + x0 + i) * 512 + h * 128 + e0) = (f32x4){o[i][0], o[i][1], o[i][2], o[i][3]};
                  *(f32x4*)(GU + ((size_t)(c * 4 + h) * 64 + x0 + i) * 128 + e0) = (f32x4){u[i][0], u[i][1], u[i][2], u[i][3]}; } }
            __syncthreads();
        }
        }
        { int tid = tid0; asm volatile("" : "+v"(tid)); const int lane = tid & 63; (void)lane;
        { const int wu = bid * 8 + wave; if (wu < 2048) {
            const int h = wu >> 8, c = (wu >> 1) & 127, kind = wu & 1; const size_t tb = (size_t)h * SEQ + c * 64;
            LAS float* buf = (LAS float*)(lds + wave * 10240);
            const f32x4* src = (const f32x4*)(VEC5 + tb * 320);
            const float* vsrc = VV + tb * 64 + lane;
            f32x2 St[32];
            { const f32x4* si = (const f32x4*)(IDZ + kind * 4096 + lane * 64);
#pragma unroll
              for (int k4 = 0; k4 < 16; ++k4) { const f32x4 v = si[k4]; St[2 * k4] = RWKV_LO(v); St[2 * k4 + 1] = RWKV_HI(v); } }
            float vn[4];
#pragma unroll
            for (int j = 0; j < 5; ++j) __builtin_amdgcn_global_load_lds((const unsigned*)(src + j * 64 + lane), (LAS unsigned*)(buf + j * 256), 16, 0, 0);
            const float vsc = kind ? 1.f : 0.f;
#pragma unroll
            for (int j = 0; j < 4; ++j) vn[j] = vsrc[j * 64];
            asm volatile("s_waitcnt vmcnt(0)" ::: "memory");
            for (int b = 0; b < 16; ++b) {
                const float vc0 = vn[0], vc1 = vn[1], vc2 = vn[2], vc3 = vn[3];
                if (b + 1 < 16) { LAS float* nb = buf + ((b + 1) & 1) * 1280;
#pragma unroll
                    for (int j = 0; j < 5; ++j) __builtin_amdgcn_global_load_lds((const unsigned*)(src + (b + 1) * 320 + j * 64 + lane), (LAS unsigned*)(nb + j * 256), 16, 0, 0);
#pragma unroll
                    for (int j = 0; j < 4; ++j) vn[j] = vsrc[((b + 1) * 4 + j) * 64];
                }
                const LAS float* cb = buf + (b & 1) * 1280;
#pragma unroll 1
                for (int s = 0; s < 4; ++s) {
                    const LAS float* st = cb + s * 320;
                    const float vi = (s == 0 ? vc0 : (s == 1 ? vc1 : (s == 2 ? vc2 : vc3))) * vsc;
                    float yy; RWKV_STEP(st, vi, St, false, true, yy); (void)yy;
                }
                asm volatile("s_waitcnt vmcnt(0)" ::: "memory");
            }
            f32x4* po = (f32x4*)((kind ? LCH : PCH) + ((size_t)(h * 128 + c) * 64 + lane) * 64);
#pragma unroll
            for (int k4 = 0; k4 < 16; ++k4) po[k4] = (f32x4){St[2 * k4].x, St[2 * k4].y, St[2 * k4 + 1].x, St[2 * k4 + 1].y};
        }
        }
        }
        fast_barrier(BAR, ++bar_epoch, (unsigned)G);
        { int tid = tid0; asm volatile("" : "+v"(tid)); const int lane = tid & 63; (void)lane;
        if (bid < 64) {
            const int h = bid >> 3, rg = bid & 7;
            LAS float* Pb = (LAS float*)lds;
            LAS float* Sb = (LAS float*)(lds + 32768);
            const int rl = (wave & 3) * 2 + (lane >> 5), cl = 2 * (lane & 31); const int row = rg * 8 + rl;
            const bool comp = wave < 4;
            float zz = 0.f; asm volatile("" : "+v"(zz)); const f32x2 z2 = (f32x2){zz, zz};
            const float* Pg = PCH + (size_t)(h * 128) * 4096; const float* Lg = LCH + (size_t)(h * 128) * 4096 + row * 64 + cl;
            f32x4 pq[4][2]; f32x2 lnq[4];
            { const f32x4* ps = (const f32x4*)Pg; *(LAS f32x4*)(Pb + tid * 4) = ps[tid]; *(LAS f32x4*)(Pb + 2048 + tid * 4) = ps[512 + tid]; }
#pragma unroll
            for (int q = 1; q <= 4; ++q) { const f32x4* ps = (const f32x4*)(Pg + (size_t)q * 4096); pq[q & 3][0] = ps[tid]; pq[q & 3][1] = ps[512 + tid]; }
#pragma unroll
            for (int q = 0; q < 4; ++q) lnq[q] = comp ? *(const f32x2*)(Lg + (size_t)q * 4096) : z2;
            if (comp) *(LAS f32x2*)(Sb + rl * 64 + cl) = z2;
            f32x2 sv = z2;
            asm volatile("s_waitcnt lgkmcnt(0)" ::: "memory"); __builtin_amdgcn_s_barrier(); asm volatile("" ::: "memory");
            for (int c0 = 0; c0 < 128; c0 += 4) {
#pragma unroll
                for (int ci = 0; ci < 4; ++ci) {
                    const int c = c0 + ci;
                    const LAS float* Pc = Pb + (c & 1) * 4096; const LAS float* Sc = Sb + (c & 1) * 512 + rl * 64;
                    if (comp) {
                        *(f32x2*)(SIN + (size_t)(h * 128 + c) * 4096 + row * 64 + cl) = sv;
                        f32x2 a0 = lnq[ci], a1 = z2;
                        if (c + 4 < 128) lnq[ci] = *(const f32x2*)(Lg + (size_t)(c + 4) * 4096);
                        f32x4 sr_[16]; f32x2 pr_[2][16];
#pragma unroll
                        for (int q = 0; q < 16; ++q) sr_[q] = *(const LAS f32x4*)(Sc + q * 4);
#pragma unroll
                        for (int q = 0; q < 16; ++q) pr_[0][q] = *(const LAS f32x2*)(Pc + q * 64 + cl);
#pragma unroll
                        for (int g = 0; g < 4; ++g) {
                            if (g + 1 < 4) {
#pragma unroll
                                for (int q = 0; q < 16; ++q) pr_[(g + 1) & 1][q] = *(const LAS f32x2*)(Pc + ((g + 1) * 16 + q) * 64 + cl); }
                            __builtin_amdgcn_sched_barrier(0);
#pragma unroll
                            for (int q = 0; q < 16; q += 2) { const int k = g * 16 + q; a0 += sr_[k >> 2][k & 3] * pr_[g & 1][q]; a1 += sr_[(k + 1) >> 2][(k + 1) & 3] * pr_[g & 1][q + 1]; }
                            __builtin_amdgcn_sched_barrier(0);
                        }
                        sv = a0 + a1;
                        *(LAS f32x2*)(Sb + ((c + 1) & 1) * 512 + rl * 64 + cl) = sv;
                    }
                    if (c + 1 < 128) { LAS float* Pn = Pb + ((c + 1) & 1) * 4096; *(LAS f32x4*)(Pn + tid * 4) = pq[(ci + 1) & 3][0]; *(LAS f32x4*)(Pn + 2048 + tid * 4) = pq[(ci + 1) & 3][1]; }
                    if (c + 5 < 128) { const f32x4* ps = (const f32x4*)(Pg + (size_t)(c + 5) * 4096); pq[(ci + 1) & 3][0] = ps[tid]; pq[(ci + 1) & 3][1] = ps[512 + tid]; }
                    asm volatile("s_waitcnt lgkmcnt(0)" ::: "memory"); __builtin_amdgcn_s_barrier(); asm volatile("" ::: "memory");
                }
            }
        } else if (bid < 128) {
            const int idx = (bid - 64) * 512 + tid; float S = 0.f;
            for (int c0 = 0; c0 < 128; c0 += 16) { float u[16], lam[16];
#pragma unroll
                for (int i = 0; i < 16; ++i) { u[i] = GU[(size_t)(c0 + i) * 32768 + idx]; lam[i] = LAM[(c0 + i) * 256 + (idx >> 7)]; }
#pragma unroll
                for (int i = 0; i < 16; ++i) { GU[(size_t)(c0 + i) * 32768 + idx] = S; S = lam[i] * S + u[i]; } }
        } else if (G >= 256) {
            convert_layer_weights(args, ws, l, (LAS float*)(lds + wave * 16896), (bid - 128) * 8 + wave, (G - 128) * 8, lane, 3968, 9600);
        }
        }
        { int tid = tid0; asm volatile("" : "+v"(tid)); const int lane = tid & 63; (void)lane;
        for (;;) {
            __syncthreads();
            if (tid == 0) *(LAS int*)(lds + 36864 + 4096 + 64) = (int)__hip_atomic_fetch_add(BAR + 1024 + 64 * l, 1u, __ATOMIC_RELAXED, __HIP_MEMORY_SCOPE_AGENT);
            __syncthreads();
            const int u = *(LAS int*)(lds + 36864 + 4096 + 64);
            if (u >= 1088) break;
            const int h = u & 7; int n = 0, r = 0;
            { int rem = u >> 3; for (n = 0; n < 31; ++n) { const int cn = 8 - ((n + 1) >> 2); if (rem < cn) { r = ((n + 1) >> 2) + rem; break; } rem -= cn; } }
            LAS int* listS = (LAS int*)(lds + 36864);
            LAS int* wcnt = (LAS int*)(lds + 36864 + 4096);
            LAS unsigned char* ring = lds + 49152;
            const int lrow = tid >> 3, lseg = (tid & 7) ^ (lrow & 7);
            const bf16_t* kgp = KB + (size_t)(n * 256 + lrow) * 512 + h * 64 + lseg * 8; const bf16_t* vgp = VT + (size_t)(h * 64 + lrow) * SEQ + n * 256 + lseg * 8;
#pragma unroll
            for (int j = 0; j < 4; ++j) { LAS unsigned char* tb_ = ring + j * 16384 + wave * 1024;
                __builtin_amdgcn_global_load_lds((const unsigned*)(kgp + (size_t)j * 64 * 512), (LAS unsigned*)tb_, 16, 0, 0);
                __builtin_amdgcn_global_load_lds((const unsigned*)(vgp + j * 64), (LAS unsigned*)(tb_ + 8192), 16, 0, 0); }
            int myslot[2], mypre[2];
#pragma unroll
            for (int p = 0; p < 2; ++p) { const int t = r * 1024 + p * 512 + tid; const int sv = SEL[h * SEQ + t];
                const int sl = ((sv & 255) == n) ? 0 : ((((sv >> 8) & 255) == n) ? 1 : ((((sv >> 16) & 255) == n) ? 2 : -1));
                const unsigned long long bal = __ballot(sl >= 0);
                myslot[p] = sl; mypre[p] = __popcll(bal & ((1ull << lane) - 1ull));
                if (lane == 0) wcnt[p * 8 + wave] = __popcll(bal); }
            __syncthreads();
            int cnt = 0, base0 = 0, base1 = 0;
#pragma unroll
            for (int q = 0; q < 16; ++q) { const int c = wcnt[q]; if (q == wave) base0 = cnt; if (q == 8 + wave) base1 = cnt; cnt += c; }
            if (myslot[0] >= 0) listS[base0 + mypre[0]] = ((r * 1024 + tid) << 2) | myslot[0];
            if (myslot[1] >= 0) listS[base1 + mypre[1]] = ((r * 1024 + 512 + tid) << 2) | myslot[1];
            asm volatile("s_waitcnt vmcnt(0)" ::: "memory");
            __syncthreads();
            const int ql = lane & 15, kg = lane >> 4, sw = ql & 7;
            for (int ch = 0; ch * 128 < cnt; ++ch) {
                const int e = ch * 128 + wave * 16 + ql; const bool has = e < cnt; const int ent = listS[has ? e : 0]; const int tq = ent >> 2, slot = ent & 3;
                bf16x8 qf[2];
                qf[0] = *(const bf16x8*)(QB + (size_t)tq * 512 + h * 64 + kg * 8); qf[1] = *(const bf16x8*)(QB + (size_t)tq * 512 + h * 64 + 32 + kg * 8);
                float mrun = -1e30f, lrun = 0.f; f32x4 O[4];
#pragma unroll
                for (int d = 0; d < 4; ++d) O[d] = (f32x4){0.f, 0.f, 0.f, 0.f};
#pragma unroll
                for (int ij = 0; ij < 4; ++ij) {
                    const LAS unsigned char* Kc = ring + ij * 16384; const LAS unsigned char* Vc = Kc + 8192;
                    bf16x8 kfr[4][2];
#pragma unroll
                    for (int kt = 0; kt < 4; ++kt)
#pragma unroll
                        for (int c = 0; c < 2; ++c) kfr[kt][c] = *(const LAS bf16x8*)(Kc + (kt * 16 + ql) * 128 + (((c * 4 + kg) ^ sw) << 4));
                    u32x2 vfr[2][4][2];
#pragma unroll
                    for (int kc = 0; kc < 2; ++kc)
#pragma unroll
                        for (int d = 0; d < 4; ++d) { const LAS unsigned char* vr = Vc + (d * 16 + ql) * 128 + (kg & 1) * 8; const int sg = kc * 4 + (kg >> 1);
                            vfr[kc][d][0] = *(const LAS u32x2*)(vr + ((sg ^ sw) << 4)); vfr[kc][d][1] = *(const LAS u32x2*)(vr + (((sg + 2) ^ sw) << 4)); }
                    __builtin_amdgcn_sched_barrier(0);
                    f32x4 Sx[4];
#pragma unroll
                    for (int kt = 0; kt < 4; ++kt) Sx[kt] = __builtin_amdgcn_mfma_f32_16x16x32_bf16(kfr[kt][0], qf[0], (f32x4){0.f, 0.f, 0.f, 0.f}, 0, 0, 0);
#pragma unroll
                    for (int kt = 0; kt < 4; ++kt) Sx[kt] = __builtin_amdgcn_mfma_f32_16x16x32_bf16(kfr[kt][1], qf[1], Sx[kt], 0, 0, 0);
                    float mx = fmaxf(fmaxf(fmaxf(Sx[0][0], Sx[0][1]), fmaxf(Sx[0][2], Sx[0][3])), fmaxf(fmaxf(Sx[1][0], Sx[1][1]), fmaxf(Sx[1][2], Sx[1][3])));
                    mx = fmaxf(mx, fmaxf(fmaxf(fmaxf(Sx[2][0], Sx[2][1]), fmaxf(Sx[2][2], Sx[2][3])), fmaxf(fmaxf(Sx[3][0], Sx[3][1]), fmaxf(Sx[3][2], Sx[3][3]))));
                    mx = fmaxf(mx, __shfl_xor(mx, 16)); mx = fmaxf(mx, __shfl_xor(mx, 32));
                    const float mnew = fmaxf(mrun, mx); const float alpha = __builtin_amdgcn_exp2f(mrun - mnew); mrun = mnew;
                    float rs = 0.f;
#pragma unroll
                    for (int kt = 0; kt < 4; ++kt)
#pragma unroll
                        for (int jj = 0; jj < 4; ++jj) { const float p = __builtin_amdgcn_exp2f(Sx[kt][jj] - mnew); Sx[kt][jj] = p; rs += p; }
                    lrun = lrun * alpha + rs;
#pragma unroll
                    for (int d = 0; d < 4; ++d) O[d] *= alpha;
#pragma unroll
                    for (int kc = 0; kc < 2; ++kc) {
                        u32x4 pw; pw.x = cvt_pk_bf16(Sx[2 * kc][0], Sx[2 * kc][1]); pw.y = cvt_pk_bf16(Sx[2 * kc][2], Sx[2 * kc][3]); pw.z = cvt_pk_bf16(Sx[2 * kc + 1][0], Sx[2 * kc + 1][1]); pw.w = cvt_pk_bf16(Sx[2 * kc + 1][2], Sx[2 * kc + 1][3]);
                        const bf16x8 pb = __builtin_bit_cast(bf16x8, pw);
#pragma unroll
                        for (int d = 0; d < 4; ++d) { u32x4 vw; vw.x = vfr[kc][d][0].x; vw.y = vfr[kc][d][0].y; vw.z = vfr[kc][d][1].x; vw.w = vfr[kc][d][1].y;
                            O[d] = __builtin_amdgcn_mfma_f32_16x16x32_bf16(__builtin_bit_cast(bf16x8, vw), pb, O[d], 0, 0, 0); }
                    }
                }
                lrun += __shfl_xor(lrun, 16); lrun += __shfl_xor(lrun, 32);
                if (has) { float* pp = PART + ((size_t)(tq * 8 + h) * 4 + slot) * 36;
#pragma unroll
                    for (int d = 0; d < 4; ++d) { u32x2 w; w.x = cvt_pk_bf16(O[d][0], O[d][1]); w.y = cvt_pk_bf16(O[d][2], O[d][3]); *(u32x2*)(pp + d * 8 + 2 * kg) = w; }
                    if (kg == 0) { pp[32] = mrun; pp[33] = lrun; } }
            }
            __syncthreads();
        }
        }
        fast_barrier(BAR, ++bar_epoch, (unsigned)G);
        { int tid = tid0; asm volatile("" : "+v"(tid)); const int lane = tid & 63; (void)lane;
        for (int t = bid * 8 + wave; t < SEQ; t += G * 8) {
            const int h = lane >> 3, dg = (lane & 7) * 8; const int qb = t >> 8; const int nv = qb < 3 ? qb : 3;
            const float* pp = PART + ((size_t)(t * 8 + h) * 4) * 36;
            const float m3 = pp[3 * 36 + 32], l3 = pp[3 * 36 + 33];
            float mk[3], lk[3]; float M = m3;
#pragma unroll
            for (int q = 0; q < 3; ++q) { mk[q] = q < nv ? pp[q * 36 + 32] : -1e30f; lk[q] = q < nv ? pp[q * 36 + 33] : 0.f; M = fmaxf(M, mk[q]); }
            const float w3 = __builtin_amdgcn_exp2f(m3 - M); float L = w3 * l3;
            float acc8[8];
            { float z[8]; unpack8(*(const u32x4*)(pp + 3 * 36 + (dg >> 1)), z);
#pragma unroll
              for (int e = 0; e < 8; ++e) acc8[e] = z[e] * w3; }
#pragma unroll
            for (int q = 0; q < 3; ++q) if (q < nv) { const float wq = __builtin_amdgcn_exp2f(mk[q] - M); L += wq * lk[q];
                float z[8]; unpack8(*(const u32x4*)(pp + q * 36 + (dg >> 1)), z);
#pragma unroll
                for (int e = 0; e < 8; ++e) acc8[e] += z[e] * wq; }
            const f32x4 a0 = (f32x4){acc8[0], acc8[1], acc8[2], acc8[3]}, a1 = (f32x4){acc8[4], acc8[5], acc8[6], acc8[7]};
            const float il = 1.f / L;
            u32x4 w; w.x = cvt_pk_bf16(a0[0] * il, a0[1] * il); w.y = cvt_pk_bf16(a0[2] * il, a0[3] * il); w.z = cvt_pk_bf16(a1[0] * il, a1[1] * il); w.w = cvt_pk_bf16(a1[2] * il, a1[3] * il);
            *(u32x4*)(Y + (size_t)t * DM + 1024 + h * 64 + dg) = w;
        }
        for (int unit = bid; unit < 512; unit += G) {
            const int c = unit >> 2, h = unit & 3, t0 = c * 64;
            LAS float* qtT = (LAS float*)lds;
            LAS float* Sd = (LAS float*)(lds + 16384);
            LAS float* red = (LAS float*)(lds + 49152);
            for (int i = 0; i < 8; ++i) { const int idx = tid + 512 * i; const int t = idx >> 6, d = idx & 63; qtT[d * 64 + t] = QT[(size_t)(t0 + t) * 256 + h * 64 + d]; }
            { const f32x4* ss = (const f32x4*)(GU + (size_t)(c * 4 + h) * 8192);
#pragma unroll
              for (int i = 0; i < 4; ++i) *(LAS f32x4*)(Sd + (tid + 512 * i) * 4) = ss[tid + 512 * i]; }
            __syncthreads();
            const int x0 = (tid & 15) * 4, e0 = (tid >> 4) * 4; float o[4][4];
#pragma unroll
            for (int i = 0; i < 4; ++i) { const f32x4 v = *(const f32x4*)(OI + (size_t)(t0 + x0 + i) * 512 + h * 128 + e0); o[i][0] = v[0]; o[i][1] = v[1]; o[i][2] = v[2]; o[i][3] = v[3]; }
            for (int d0 = 0; d0 < 64; d0 += 8) { f32x4 qv[8], sv[8];
#pragma unroll
                for (int q = 0; q < 8; ++q) { qv[q] = *(const LAS f32x4*)(qtT + (d0 + q) * 64 + x0); sv[q] = *(const LAS f32x4*)(Sd + (d0 + q) * 128 + e0); }
                __builtin_amdgcn_sched_barrier(0);
#pragma unroll
                for (int q = 0; q < 8; ++q)
#pragma unroll
                    for (int i = 0; i < 4; ++i)
#pragma unroll
                        for (int j = 0; j < 4; ++j) o[i][j] += qv[q][i] * sv[q][j];
                __builtin_amdgcn_sched_barrier(0); }
#pragma unroll
            for (int i = 0; i < 4; ++i) red[(x0 + i) * 32 + (tid >> 4)] = (o[i][0] * o[i][0] + o[i][1] * o[i][1]) + (o[i][2] * o[i][2] + o[i][3] * o[i][3]);
            __syncthreads();
            const float* ng = args.in[I_DNG] + l * 128 + e0;
#pragma unroll
            for (int i = 0; i < 4; ++i) { const int t = t0 + x0 + i; float s = 0.f;
#pragma unroll
                for (int j = 0; j < 8; ++j) { const f32x4 v = *(const LAS f32x4*)(red + (x0 + i) * 32 + j * 4); s += (v[0] + v[1]) + (v[2] + v[3]); }
                const float rs = rsqrtf(s * (1.f / 128.f) + EPS);
                const bf16_t* og = P + (size_t)t * NINP + PC_D + 1040 + h * 128 + e0; const u32x2 raw = *(const u32x2*)og;
                const float g0 = bflo(raw.x), g1 = bfhi(raw.x), g2 = bflo(raw.y), g3 = bfhi(raw.y);
                const float y0 = o[i][0] * rs * ng[0] * (g0 * sigmoidf_(g0)), y1 = o[i][1] * rs * ng[1] * (g1 * sigmoidf_(g1)), y2 = o[i][2] * rs * ng[2] * (g2 * sigmoidf_(g2)), y3 = o[i][3] * rs * ng[3] * (g3 * sigmoidf_(g3));
                u32x2 w; w.x = cvt_pk_bf16(y0, y1); w.y = cvt_pk_bf16(y2, y3);
                *(u32x2*)(Y + (size_t)t * DM + 1536 + h * 128 + e0) = w; }
            __syncthreads();
        }
        if (wave < 4) {
            const int u = bid * 4 + wave;
            if (u < 1024) {
                const int h = u >> 7, c = u & 127; const size_t tb = (size_t)h * SEQ + c * 64; const int tbase = c * 64;
                LAS float* buf = (LAS float*)(lds + wave * 10240);
                const f32x4* src = (const f32x4*)(VEC5 + tb * 320);
                const float* vsrc = VV + tb * 64 + lane;
                const int ch = h * 64 + lane;
                const float lg = args.in[I_BLNG][l * 512 + ch], lbias = args.in[I_BLNB][l * 512 + ch];
                const float* bvp = BV + (size_t)tbase * 512 + ch; const float* ggp = GG + (size_t)tbase * 512 + ch;
                f32x2 St[32];
                { const f32x4* si = (const f32x4*)(SIN + ((size_t)u * 64 + lane) * 64);
#pragma unroll
                  for (int k4 = 0; k4 < 16; ++k4) { const f32x4 v = si[k4]; St[2 * k4] = RWKV_LO(v); St[2 * k4 + 1] = RWKV_HI(v); } }
                float vn[4];
#pragma unroll
                for (int j = 0; j < 5; ++j) __builtin_amdgcn_global_load_lds((const unsigned*)(src + j * 64 + lane), (LAS unsigned*)(buf + j * 256), 16, 0, 0);
#pragma unroll
                for (int j = 0; j < 4; ++j) vn[j] = vsrc[j * 64];
                asm volatile("s_waitcnt vmcnt(0)" ::: "memory");
                for (int b = 0; b < 16; ++b) {
                    const float vc0 = vn[0], vc1 = vn[1], vc2 = vn[2], vc3 = vn[3];
                    float bvc[4], ggc[4];
#pragma unroll
                    for (int j = 0; j < 4; ++j) { bvc[j] = bvp[(b * 4 + j) * 512]; ggc[j] = ggp[(b * 4 + j) * 512]; }
                    float yv0 = 0.f, yv1 = 0.f, yv2 = 0.f, yv3 = 0.f;
                    if (b + 1 < 16) { LAS float* nb = buf + ((b + 1) & 1) * 1280;
#pragma unroll
                        for (int j = 0; j < 5; ++j) __builtin_amdgcn_global_load_lds((const unsigned*)(src + (b + 1) * 320 + j * 64 + lane), (LAS unsigned*)(nb + j * 256), 16, 0, 0);
#pragma unroll
                        for (int j = 0; j < 4; ++j) vn[j] = vsrc[((b + 1) * 4 + j) * 64];
                    }
                    const LAS float* cb = buf + (b & 1) * 1280;
#pragma unroll 1
                    for (int s = 0; s < 4; ++s) {
                        const LAS float* st = cb + s * 320;
                        const float vi = s == 0 ? vc0 : (s == 1 ? vc1 : (s == 2 ? vc2 : vc3));
                        float yy; RWKV_STEP(st, vi, St, true, true, yy);
                        yv0 = s == 0 ? yy : yv0; yv1 = s == 1 ? yy : yv1; yv2 = s == 2 ? yy : yv2; yv3 = s == 3 ? yy : yv3;
                    }
                    asm volatile("s_waitcnt vmcnt(0)" ::: "memory");
                    const float yv[4] = {yv0, yv1, yv2, yv3};
#pragma unroll
                    for (int s = 0; s < 4; ++s) { const int t = tbase + b * 4 + s;
                        const float m = wave_sum(yv[s]) * (1.f / 64.f); const float d = yv[s] - m; const float var = wave_sum(d * d) * (1.f / 64.f);
                        const float yn = d * rsqrtf(var + 64e-5f) * lg + lbias;
                        Y[(size_t)t * DM + 512 + ch] = f2bf((yn + bvc[s]) * ggc[s]); }
                }
            }
        } else if (G >= 256) {
            LAS float* scr = (LAS float*)(lds + 49152 + (wave - 4) * 16896);
            convert_layer_weights(args, ws, l, scr, bid * 4 + (wave - 4), G * 4, lane, 9600, 12416);
            if (l == 0) convert_layer_weights(args, ws, 1, scr, bid * 4 + (wave - 4), G * 4, lane, 0, 3968);
        }
        }
        fast_barrier(BAR, ++bar_epoch, (unsigned)G);
        { int tid = tid0; asm volatile("" : "+v"(tid)); const int lane = tid & 63; (void)lane;
        {
            pg8::Gemm g{Y, (const bf16_t*)(wt + WT_OUT), SEQ, DM, DM, 256}; pg8::StaticOrder S; S.init(SEQ, DM, G, bid);
            pg8::EpiResid E{l == 0 ? args.in[I_X] : (const float*)XR, XR, XB, SSQ, lds};
            pg8::gemm_phase<pg8::EpiResid>(lds, g, S, E);
        }
        }
        fast_barrier(BAR, ++bar_epoch, (unsigned)G);
        { int tid = tid0; asm volatile("" : "+v"(tid)); const int lane = tid & 63; (void)lane;
        {
            pg8::Gemm g{XB, (const bf16_t*)(wt + WT_UP), 33 * 256, NUP, DM, 254}; pg8::StaticOrder S; S.init(33 * 256, NUP, G, bid);
            pg8::EpiConvSwiGLU E{ACT, SSQ, args.in[I_CONVW] + (size_t)l * 3 * NUP, args.in[I_CONVB] + (size_t)l * NUP};
            pg8::Unit uu;
            for (int i = 0; S.next(i, uu); ++i) { pg8::OneUnit one{uu}; pg8::gemm_phase<pg8::EpiConvSwiGLU, pg8::OneUnit>(lds, g, one, E); }
        }
        }
        fast_barrier(BAR, ++bar_epoch, (unsigned)G);
        { int tid = tid0; asm volatile("" : "+v"(tid)); const int lane = tid & 63; (void)lane;
        {
            pg8::Gemm g{ACT, (const bf16_t*)(wt + WT_DOWN), SEQ, DM, DFF, 256}; pg8::StaticOrder S; S.init(SEQ, DM, G, bid);
            pg8::EpiResid E{(const float*)XR, XR, XB, SSQ, lds};
            pg8::gemm_phase<pg8::EpiResid>(lds, g, S, E);
        }
        }
        fast_barrier(BAR, ++bar_epoch, (unsigned)G);
    }
        { int tid = tid0; asm volatile("" : "+v"(tid)); const int lane = tid & 63; (void)lane;
    {
        const float* fg = args.in[I_FING];
        for (int row = gw; row < SEQ; row += NGW) {
            float s = SSQ[(size_t)row * 8 + (lane & 7)]; s = wave_sum(s) * 0.125f;
            const float rs = rsqrtf(s * (1.f / 2048.f) + EPS);
            f32x4* xr = (f32x4*)(XR + (size_t)row * DM) + lane; const f32x4* gp = (const f32x4*)fg + lane;
#pragma unroll
            for (int j = 0; j < 8; ++j) { f32x4 v = xr[64 * j]; const f32x4 gv = gp[64 * j]; v = v * rs * gv; xr[64 * j] = v; }
        }
    }
        }
}

extern "C" void kernel_launch(void* const* d_in, const int* in_sizes, int n_in, void* d_out, int out_size, void* d_ws, size_t ws_size, hipStream_t stream) {
    static int grid = 0;
    if (grid == 0) {
        if (n_in != 28 || ws_size < WS_END) { fprintf(stderr, "kernel_launch: unexpected n_in %d / ws_size %zu\n", n_in, ws_size); grid = -1; return; }
        int dev = 0, cus = 0, per_cu = 0;
        hipGetDevice(&dev); hipDeviceGetAttribute(&cus, hipDeviceAttributeMultiprocessorCount, dev);
        hipFuncSetAttribute((const void*)mega_fwd, hipFuncAttributeMaxDynamicSharedMemorySize, LDS_BYTES);
        hipOccupancyMaxActiveBlocksPerMultiprocessor(&per_cu, (const void*)mega_fwd, 512, LDS_BYTES);
        if (per_cu < 1) { fprintf(stderr, "kernel_launch: occupancy query says %d blocks/CU\n", per_cu); per_cu = 1; }
        grid = cus * (per_cu > 1 ? 1 : per_cu);
    }
    if (grid < 0) return;
    (void)hipMemsetAsync(d_ws, 0, 8192, stream);
    Args a{};
    for (int i = 0; i < 28; ++i) a.in[i] = (const float*)d_in[i];
    a.out = (float*)d_out; a.ws = (unsigned char*)d_ws;
    void* kargs[] = {&a};
    hipError_t e = hipLaunchCooperativeKernel((const void*)mega_fwd, dim3(grid), dim3(512), kargs, LDS_BYTES, stream);
    if (e != hipSuccess) fprintf(stderr, "cooperative launch failed: %s (grid %d)\n", hipGetErrorString(e), grid);
}
```

```cpp
#include <hip/hip_runtime.h>
#include <hip/hip_cooperative_groups.h>
#include <cstdio>
#include <cstdint>
namespace cg = cooperative_groups;

#define LAS __attribute__((address_space(3)))
typedef unsigned short bf16_t;
typedef short bf16x8 __attribute__((ext_vector_type(8)));
typedef float f32x4 __attribute__((ext_vector_type(4)));
typedef float f32x2 __attribute__((ext_vector_type(2)));
typedef unsigned u32x4 __attribute__((ext_vector_type(4)));
typedef unsigned u32x2 __attribute__((ext_vector_type(2)));

constexpr int SEQ = 8192, DM = 2048, NIN = 5808, NINP = 5888, DFF = 5632, NUP = 11264;
constexpr int PC_A = 0, PC_B = 1024, PC_C = 2720, PC_D = 4256;
constexpr float EPS = 1e-6f;
constexpr float QSCALE = 0.125f * 1.4426950408889634f;

constexpr size_t MiB = 1u << 20;
constexpr size_t WS_ROPE = 1 * MiB, WS_SSQ = 3 * MiB, WS_KMEAN = 4 * MiB, WS_IDZ = 5 * MiB, WS_SEL = 6 * MiB, WS_WT = 8 * MiB;
constexpr size_t WT_IN = 0, WT_OUT = 23 * MiB, WT_UP = 31 * MiB, WT_DOWN = 75 * MiB, WT_LAYER = 97 * MiB;
constexpr size_t WS_XB = 202 * MiB, WS_Y = 234 * MiB, WS_P = 266 * MiB;
constexpr size_t WS_QB = 358 * MiB, WS_KB = 366 * MiB, WS_VT = 374 * MiB, WS_VEC5 = 382 * MiB, WS_VV = 462 * MiB, WS_GG = 478 * MiB, WS_BV = 494 * MiB;
constexpr size_t WS_PCH = 510 * MiB, WS_LCH = 526 * MiB, WS_SIN = 542 * MiB, WS_OI = 558 * MiB, WS_U = 574 * MiB, WS_QT = 590 * MiB, WS_LAM = 598 * MiB;
constexpr size_t WS_PART = 600 * MiB, WS_H = 266 * MiB, WS_ACT = 442 * MiB, WS_END = 640 * MiB;
constexpr int LDS_BYTES = 147456;

__device__ __forceinline__ float bf2f(bf16_t v) { return __uint_as_float((unsigned)v << 16); }
__device__ __forceinline__ float bflo(unsigned u) { return __uint_as_float(u << 16); }
__device__ __forceinline__ float bfhi(unsigned u) { return __uint_as_float(u & 0xffff0000u); }
__device__ __forceinline__ unsigned cvt_pk_bf16(float lo, float hi) { unsigned r; asm volatile("v_cvt_pk_bf16_f32 %0, %1, %2" : "=v"(r) : "v"(lo), "v"(hi)); return r; }
__device__ __forceinline__ bf16_t f2bf(float f) { return (bf16_t)(cvt_pk_bf16(f, 0.f) & 0xffffu); }
__device__ __forceinline__ float wave_sum(float v) {
#pragma unroll
    for (int o = 32; o > 0; o >>= 1) v += __shfl_xor(v, o);
    return v;
}

template <int N> __device__ __forceinline__ void wave_sum_n(float (&v)[N]) {
#pragma unroll
    for (int o = 32; o > 0; o >>= 1) { float t[N];
#pragma unroll
        for (int i = 0; i < N; ++i) t[i] = __shfl_xor(v[i], o);
#pragma unroll
        for (int i = 0; i < N; ++i) v[i] += t[i]; }
}
__device__ __forceinline__ float sigmoidf_(float x) { return __builtin_amdgcn_rcpf(1.f + __expf(-x)); }
__device__ __forceinline__ float gelu_tanh(float x) { const float u = 0.7978845608f * (x + 0.044715f * x * x * x); const float e = __expf(2.f * u); const float th = 1.f - 2.f * __builtin_amdgcn_rcpf(e + 1.f); return 0.5f * x * (1.f + th); }
__device__ __forceinline__ void unpack8(const u32x4 r, float (&z)[8]) { z[0] = bflo(r.x); z[1] = bfhi(r.x); z[2] = bflo(r.y); z[3] = bfhi(r.y); z[4] = bflo(r.z); z[5] = bfhi(r.z); z[6] = bflo(r.w); z[7] = bfhi(r.w); }

__device__ __forceinline__ void fast_barrier(unsigned* bar, unsigned epoch  , unsigned G) {
    asm volatile("s_waitcnt vmcnt(0) lgkmcnt(0)" ::: "memory");
    __syncthreads();
    if (threadIdx.x == 0) {
        __builtin_amdgcn_fence(__ATOMIC_RELEASE, "agent");
        asm volatile("s_waitcnt vmcnt(0)" ::: "memory");
        const unsigned grp = blockIdx.x & 7u; const unsigned gsz = (G - grp + 7u) >> 3; const unsigned ngrp = G < 8u ? G : 8u;
        const unsigned old = __hip_atomic_fetch_add(bar + 64u * (1u + grp), 1u, __ATOMIC_RELAXED, __HIP_MEMORY_SCOPE_AGENT);
        if (old + 1u == epoch * gsz) __hip_atomic_fetch_add(bar, 1u, __ATOMIC_RELAXED, __HIP_MEMORY_SCOPE_AGENT);
        unsigned spins = 0;
        while (__hip_atomic_load(bar, __ATOMIC_RELAXED, __HIP_MEMORY_SCOPE_AGENT) < epoch * ngrp) { __builtin_amdgcn_s_sleep(1); if (++spins > (1u << 26)) break; }
        __builtin_amdgcn_fence(__ATOMIC_ACQUIRE, "agent");
        asm volatile("s_waitcnt vmcnt(0)" ::: "memory");
    }
    __syncthreads();
}

namespace pg8 {
constexpr int BM = 256, BK = 64, HALF = 128, HTB = HALF * BK * 2, STAGE_BYTES = 8 * HTB, NXCD = 8, WGM = 8;
__host__ __device__ __forceinline__ int lds_byte(int r, int c) { const int st = (r >> 4) * 2 + (c >> 5), rr = r & 15, cc = c & 31, ob = rr * 64 + cc * 2; return st * 1024 + (ob ^ (((ob >> 9) & 1) << 5)); }
__host__ __device__ __forceinline__ void stage_rc(int b, int& R, int& C) { const int st = b / 1024, sb = b % 1024, swz = sb ^ (((sb >> 9) & 1) << 5); R = (st >> 1) * 16 + swz / 64; C = (st & 1) * 32 + (swz % 64) / 2; }
__host__ __device__ __forceinline__ int perm32(int rho) { const int n = rho >> 4, i = rho & 15; return 8 * (i >> 2) + 4 * n + (i & 3); }
struct Unit { int pm, pn; };
struct Gemm { const bf16_t* A; const bf16_t* Bt; int M, N, K; int a_step_rows; };
struct OneUnit { Unit u; __device__ __forceinline__ bool next(int i, Unit& o) const { if (i) return false; o = u; return true; } };
struct StaticOrder {
    int nM, nN, nwg, G, c;
    __device__ __forceinline__ void init(int M, int N, int G_, int c_) { nM = M / BM; nN = N / BM; nwg = nM * nN; G = G_; c = c_; }
    __device__ __forceinline__ bool next(int i, Unit& u) const {
        const long L = (long)i * G + c; if (L >= nwg) return false;
        int wgid = (int)L; { const int q = nwg / NXCD, r = nwg % NXCD, xcd = wgid % NXCD, off = wgid / NXCD; wgid = (xcd < r ? xcd * (q + 1) : r * (q + 1) + (xcd - r) * q) + off; }
        const int nig = WGM * nN, gid = wgid / nig, fm = gid * WGM, gsz = (nM - fm) < WGM ? (nM - fm) : WGM;
        u.pm = fm + ((wgid % nig) % gsz); u.pn = (wgid % nig) / gsz; return true;
    }
};
struct EpiScaleBf16 {
    static constexpr bool AFTER_DRAIN = false;
    bf16_t* O; int ldc; const float* ssq;
    __device__ __forceinline__ void operator()(const f32x4 (&acc)[2][2][4][2], const Unit& u, int wr, int wc, int fr, int fq) const {
        const int row0 = u.pm * BM + wr * 64 + fr; const int col0 = u.pn * BM + wc * 32 + 8 * fq;
#pragma unroll
        for (int ai = 0; ai < 2; ++ai)
#pragma unroll
            for (int m = 0; m < 4; ++m) {
                const int row = row0 + ai * HALF + m * 16;
                const f32x4* sp = (const f32x4*)(ssq + (size_t)row * 8);
                f32x4 s4 = sp[0] + sp[1];
                const float rs = rsqrtf(((s4[0] + s4[1]) + (s4[2] + s4[3])) * (1.0f / 2048.0f) + EPS);
                bf16_t* rowp = O + (size_t)row * ldc + col0;
#pragma unroll
                for (int bj = 0; bj < 2; ++bj) { const f32x4 v0 = acc[ai][bj][m][0] * rs, v1 = acc[ai][bj][m][1] * rs;
                    u32x4 w; w.x = cvt_pk_bf16(v0[0], v0[1]); w.y = cvt_pk_bf16(v0[2], v0[3]); w.z = cvt_pk_bf16(v1[0], v1[1]); w.w = cvt_pk_bf16(v1[2], v1[3]);
                    *(u32x4*)(rowp + bj * HALF) = w; }
            }
    }
};
struct EpiResid {
    static constexpr bool AFTER_DRAIN = false;
    const float* base; float* xr; bf16_t* xb; float* ssq; LAS unsigned char* lds;
    __device__ __forceinline__ void operator()(const f32x4 (&acc)[2][2][4][2], const Unit& u, int wr, int wc, int fr, int fq) const {
        const int row0 = u.pm * BM + wr * 64 + fr; const int col0 = u.pn * BM + wc * 32 + 8 * fq;
        LAS float* xq = (LAS float*)(lds + 131072);
#pragma unroll
        for (int ai = 0; ai < 2; ++ai)
#pragma unroll
            for (int m = 0; m < 4; ++m) {
                const int row = row0 + ai * HALF + m * 16; float q = 0.f;
#pragma unroll
                for (int bj = 0; bj < 2; ++bj) { const size_t off = (size_t)row * DM + col0 + bj * HALF;
                    const f32x4 b0 = *(const f32x4*)(base + off), b1 = *(const f32x4*)(base + off + 4);
                    const f32x4 v0 = acc[ai][bj][m][0] + b0, v1 = acc[ai][bj][m][1] + b1;
                    *(f32x4*)(xr + off) = v0; *(f32x4*)(xr + off + 4) = v1;
                    u32x4 w; w.x = cvt_pk_bf16(v0[0], v0[1]); w.y = cvt_pk_bf16(v0[2], v0[3]); w.z = cvt_pk_bf16(v1[0], v1[1]); w.w = cvt_pk_bf16(v1[2], v1[3]);
                    *(u32x4*)(xb + off) = w;
                    q += (v0[0] * v0[0] + v0[1] * v0[1]) + (v0[2] * v0[2] + v0[3] * v0[3]) + (v1[0] * v1[0] + v1[1] * v1[1]) + (v1[2] * v1[2] + v1[3] * v1[3]); }
                q += __shfl_xor(q, 16); q += __shfl_xor(q, 32);
                if (fq == 0) xq[(ai * HALF + wr * 64 + m * 16 + fr) * 4 + wc] = q;
            }
        asm volatile("s_waitcnt lgkmcnt(0)" ::: "memory"); __builtin_amdgcn_s_barrier(); asm volatile("" ::: "memory");
        { const int tid_ = (wr * 4 + wc) * 64 + fq * 16 + fr;
          if (tid_ < 256) { const f32x4 v = *(const LAS f32x4*)(xq + tid_ * 4); ssq[(size_t)(u.pm * BM + tid_) * 8 + u.pn] = (v[0] + v[1]) + (v[2] + v[3]); } }
    }
};

struct EpiConvSwiGLU {
    static constexpr bool AFTER_DRAIN = true;
    bf16_t* act; const float* ssq; const float* cw; const float* cb;
    __device__ __forceinline__ void fused(const f32x4 (&acc)[2][2][4][2], const Unit& u, int wr, int wc, int fr, int fq, LAS unsigned char* lds) const {
        const int rs = u.pm * 254;
#pragma unroll
        for (int ai = 0; ai < 2; ++ai)
#pragma unroll
            for (int m = 0; m < 4; ++m) {
                const int lr = ai * HALF + wr * 64 + m * 16 + fr; int row = rs + lr; row = row < SEQ ? row : SEQ - 1;
                const f32x4* sp = (const f32x4*)(ssq + (size_t)row * 8);
                const f32x4 s4 = sp[0] + sp[1];
                const float rsd = rsqrtf(((s4[0] + s4[1]) + (s4[2] + s4[3])) * (1.0f / 2048.0f) + EPS);
#pragma unroll
                for (int bj = 0; bj < 2; ++bj) { const f32x4 v0 = acc[ai][bj][m][0] * rsd, v1 = acc[ai][bj][m][1] * rsd;
                    u32x4 w; w.x = cvt_pk_bf16(v0[0], v0[1]); w.y = cvt_pk_bf16(v0[2], v0[3]); w.z = cvt_pk_bf16(v1[0], v1[1]); w.w = cvt_pk_bf16(v1[2], v1[3]);
                    const int c = 16 * bj + 4 * wc + fq;
                    *(LAS u32x4*)(lds + lr * 512 + ((c ^ ((lr & 7) << 2)) << 4)) = w; }
            }
        asm volatile("s_waitcnt lgkmcnt(0)" ::: "memory"); __builtin_amdgcn_s_barrier(); asm volatile("" ::: "memory");
        const int tid_ = (wr * 4 + wc) * 64 + fq * 16 + fr; const int cgp = tid_ & 15, rr = tid_ >> 4;
        const int j0 = u.pn * 128 + cgp * 8;
        float wg[3][8], wu[3][8], bg[8], bu[8];
#pragma unroll
        for (int k = 0; k < 3; ++k) { const f32x4 a0 = *(const f32x4*)(cw + (size_t)k * NUP + j0), a1 = *(const f32x4*)(cw + (size_t)k * NUP + j0 + 4), b0 = *(const f32x4*)(cw + (size_t)k * NUP + DFF + j0), b1 = *(const f32x4*)(cw + (size_t)k * NUP + DFF + j0 + 4);
#pragma unroll
            for (int e = 0; e < 4; ++e) { wg[k][e] = a0[e]; wg[k][4 + e] = a1[e]; wu[k][e] = b0[e]; wu[k][4 + e] = b1[e]; } }
        { const f32x4 a0 = *(const f32x4*)(cb + j0), a1 = *(const f32x4*)(cb + j0 + 4), b0 = *(const f32x4*)(cb + DFF + j0), b1 = *(const f32x4*)(cb + DFF + j0 + 4);
#pragma unroll
          for (int e = 0; e < 4; ++e) { bg[e] = a0[e]; bg[4 + e] = a1[e]; bu[e] = b0[e]; bu[4 + e] = b1[e]; } }
#pragma unroll 1
        for (int hh = 0; hh < 2; ++hh) {
            u32x4 hg[6], hu[6];
#pragma unroll
            for (int i = 0; i < 6; ++i) { const int lr = 8 * rr + 4 * hh - 2 + i;
                if (lr >= 0) { const int sw = (lr & 7) << 2; hg[i] = *(const LAS u32x4*)(lds + lr * 512 + ((cgp ^ sw) << 4)); hu[i] = *(const LAS u32x4*)(lds + lr * 512 + (((16 + cgp) ^ sw) << 4)); }
                else { hg[i] = (u32x4){0u, 0u, 0u, 0u}; hu[i] = (u32x4){0u, 0u, 0u, 0u}; } }
#pragma unroll
            for (int i = 0; i < 4; ++i) { const int lo = 8 * rr + 4 * hh + i; const int grow = rs + lo;
                float g2[8], g1[8], g0[8], u2[8], u1[8], u0[8];
                unpack8(hg[i], g2); unpack8(hg[i + 1], g1); unpack8(hg[i + 2], g0); unpack8(hu[i], u2); unpack8(hu[i + 1], u1); unpack8(hu[i + 2], u0);
                float o[8];
#pragma unroll
                for (int e = 0; e < 8; ++e) { const float ag = bg[e] + wg[0][e] * g2[e] + wg[1][e] * g1[e] + wg[2][e] * g0[e]; const float au = bu[e] + wu[0][e] * u2[e] + wu[1][e] * u1[e] + wu[2][e] * u0[e];
                    o[e] = ag * sigmoidf_(ag) * au; }
                u32x4 w; w.x = cvt_pk_bf16(o[0], o[1]); w.y = cvt_pk_bf16(o[2], o[3]); w.z = cvt_pk_bf16(o[4], o[5]); w.w = cvt_pk_bf16(o[6], o[7]);
                if ((u.pm == 0 || lo >= 2) && grow < SEQ) *(u32x4*)(act + (size_t)grow * DFF + j0) = w; }
        }
        asm volatile("s_waitcnt lgkmcnt(0)" ::: "memory"); __builtin_amdgcn_s_barrier(); asm volatile("" ::: "memory");
    }
};

template <class Epi, class Sched>
__device__ __forceinline__ void gemm_phase(LAS unsigned char* lds, const Gemm g, const Sched& S, const Epi& E) {
    int tid = threadIdx.x; asm volatile("" : "+v"(tid)); const int wid = __builtin_amdgcn_readfirstlane(tid >> 6), lane = tid & 63, wr = wid >> 2, wc = wid & 3, fr = lane & 15, fq = lane >> 4;
    const int K = g.K, nt = K / BK;
    unsigned voffA[2], voffB[2];
#pragma unroll
    for (int i = 0; i < 2; ++i) { int R, C; stage_rc(tid * 16 + i * 8192, R, C); const int Rb = (R & ~31) + perm32(R & 31);
        voffA[i] = (unsigned)(R * K + C) * 2u; voffB[i] = (unsigned)(Rb * K + C) * 2u; }
    const size_t kstep = (size_t)(BK * 2);
    const size_t hstep = (size_t)HALF * K * 2;
    const size_t tstep = 2 * hstep;
    const size_t tstepA = (size_t)g.a_step_rows * K * 2;
    const unsigned ldsw = (unsigned)wid * 1024u;
    const int aoff = lds_byte(wr * 64 + fr, fq * 8), boff = lds_byte(wc * 32 + fr, fq * 8);
#define PG8_SA(b, h) (((b) * 2 + (h)) * HTB)
#define PG8_SB(b, h) ((4 + (b) * 2 + (h)) * HTB)
#define PG8_STAGE(bufoff, gbase, voff) do { _Pragma("unroll") for (int _i = 0; _i < 2; ++_i) \
        __builtin_amdgcn_global_load_lds((const unsigned*)((const char*)(gbase) + (voff)[_i]), (LAS unsigned*)(lds + (bufoff) + ldsw + _i * 8192), 16, 0, 0); } while (0)
#define PG8_LDA(dst, b, h) do { _Pragma("unroll") for (int m = 0; m < 4; ++m) _Pragma("unroll") for (int k = 0; k < 2; ++k) dst[m][k] = *(const LAS bf16x8*)(lds + PG8_SA(b, h) + aoff + m * 2048 + k * 1024); } while (0)
#define PG8_LDB(dst, b, h) do { _Pragma("unroll") for (int n = 0; n < 2; ++n) _Pragma("unroll") for (int k = 0; k < 2; ++k) dst[n][k] = *(const LAS bf16x8*)(lds + PG8_SB(b, h) + boff + n * 2048 + k * 1024); } while (0)
#define PG8_MMA(ai, bj, At, Bt) do { __builtin_amdgcn_s_setprio(1); _Pragma("unroll") for (int m = 0; m < 4; ++m) _Pragma("unroll") for (int n = 0; n < 2; ++n) _Pragma("unroll") for (int k = 0; k < 2; ++k) \
        acc[ai][bj][m][n] = __builtin_amdgcn_mfma_f32_16x16x32_bf16(Bt[n][k], At[m][k], acc[ai][bj][m][n], 0, 0, 0); __builtin_amdgcn_s_setprio(0); } while (0)
#define PG8_WAIT_V(n) asm volatile("s_waitcnt vmcnt(" #n ")" ::: "memory")
#define PG8_WAIT_L(n) asm volatile("s_waitcnt lgkmcnt(" #n ")" ::: "memory")
#define PG8_BAR __builtin_amdgcn_s_barrier()
#define PG8_SCHED __builtin_amdgcn_sched_barrier(0)
    Unit cur, nxt; int ui = 0;
    if (!S.next(0, cur)) return;
    f32x4 acc[2][2][4][2];
#pragma unroll
    for (int a = 0; a < 2; ++a)
#pragma unroll
        for (int b = 0; b < 2; ++b)
#pragma unroll
            for (int m = 0; m < 4; ++m)
#pragma unroll
                for (int n = 0; n < 2; ++n) acc[a][b][m][n] = (f32x4){0.f, 0.f, 0.f, 0.f};
    bf16x8 At[4][2], B0[2][2], B1[2][2];
    const char* cA = (const char*)g.A + (size_t)cur.pm * tstepA; const char* cB = (const char*)g.Bt + (size_t)cur.pn * tstep;
    PG8_STAGE(PG8_SB(0, 0), cB, voffB); PG8_STAGE(PG8_SB(0, 1), cB + hstep, voffB); PG8_STAGE(PG8_SA(0, 0), cA, voffA); PG8_STAGE(PG8_SA(0, 1), cA + hstep, voffA);
    if (wr == 1) PG8_BAR;
    PG8_WAIT_V(2); PG8_BAR;
    PG8_STAGE(PG8_SB(1, 0), cB + kstep, voffB); PG8_STAGE(PG8_SA(1, 0), cA + kstep, voffA); PG8_STAGE(PG8_SB(1, 1), cB + hstep + kstep, voffB);
    PG8_WAIT_V(6); PG8_BAR;
    for (;;) {
        const bool has_next = S.next(ui + 1, nxt);
        const char* nA = has_next ? (const char*)g.A + (size_t)nxt.pm * tstepA : cA; const char* nB = has_next ? (const char*)g.Bt + (size_t)nxt.pn * tstep : cB;
        for (int t = 0; t < nt; t += 2) {
            const bool last = (t == nt - 2);
            const char* a1 = cA + (size_t)(t + 1) * kstep;
            const char* a2 = last ? nA : cA + (size_t)(t + 2) * kstep; const char* b2 = last ? nB : cB + (size_t)(t + 2) * kstep;
            const char* a3 = a2 + kstep; const char* b3 = b2 + kstep;
            PG8_LDB(B0, 0, 0); PG8_LDB(B1, 0, 1); PG8_SCHED; PG8_LDA(At, 0, 0); PG8_STAGE(PG8_SA(1, 1), a1 + hstep, voffA);
            PG8_WAIT_V(8); PG8_WAIT_L(0); PG8_BAR; PG8_MMA(0, 0, At, B0); PG8_MMA(0, 1, At, B1); PG8_BAR; PG8_SCHED;
            PG8_LDA(At, 0, 1); PG8_STAGE(PG8_SB(0, 0), b2, voffB); PG8_STAGE(PG8_SB(0, 1), b2 + hstep, voffB); PG8_STAGE(PG8_SA(0, 0), a2, voffA);
            PG8_WAIT_V(8); PG8_WAIT_L(0); PG8_BAR; PG8_MMA(1, 0, At, B0); PG8_MMA(1, 1, At, B1); PG8_BAR; PG8_SCHED;
            PG8_LDB(B0, 1, 0); PG8_LDB(B1, 1, 1); PG8_SCHED; PG8_LDA(At, 1, 0); PG8_STAGE(PG8_SA(0, 1), a2 + hstep, voffA);
            PG8_WAIT_V(8); PG8_WAIT_L(0); PG8_BAR; PG8_MMA(0, 0, At, B0); PG8_MMA(0, 1, At, B1); PG8_BAR; PG8_SCHED;
            PG8_LDA(At, 1, 1); PG8_STAGE(PG8_SB(1, 0), b3, voffB); PG8_STAGE(PG8_SB(1, 1), b3 + hstep, voffB); PG8_STAGE(PG8_SA(1, 0), a3, voffA);
            PG8_WAIT_V(8); PG8_WAIT_L(0); PG8_BAR; PG8_MMA(1, 0, At, B0); PG8_MMA(1, 1, At, B1); PG8_BAR; PG8_SCHED;
        }
        if (wr == 0) PG8_BAR;
        if constexpr (!Epi::AFTER_DRAIN) E(acc, cur, wr, wc, fr, fq);
        if (!has_next) break;
#pragma unroll
        for (int a = 0; a < 2; ++a)
#pragma unroll
            for (int b = 0; b < 2; ++b)
#pragma unroll
                for (int m = 0; m < 4; ++m)
#pragma unroll
                    for (int n = 0; n < 2; ++n) acc[a][b][m][n] = (f32x4){0.f, 0.f, 0.f, 0.f};
        cur = nxt; cA = nA; cB = nB; ++ui;
        if (wr == 1) PG8_BAR;
    }
    PG8_WAIT_V(0);
    PG8_BAR;
    if constexpr (Epi::AFTER_DRAIN) E.fused(acc, cur, wr, wc, fr, fq, lds);
#undef PG8_SA
#undef PG8_SB
#undef PG8_STAGE
#undef PG8_LDA
#undef PG8_LDB
#undef PG8_MMA
#undef PG8_WAIT_V
#undef PG8_WAIT_L
#undef PG8_BAR
#undef PG8_SCHED
}
}

struct Args { const float* in[28]; float* out; unsigned char* ws; };
enum { I_X = 0, I_MIXG, I_WIN, I_ALNG, I_ALNB, I_AWS, I_ABS, I_BMU, I_BW0, I_BW2, I_BA0, I_BA2, I_BG2, I_BKK, I_BKA, I_BRK, I_BLNG, I_BLNB, I_DGW2, I_DGB, I_DNG, I_WOUT, I_FFNG, I_WUP, I_CONVW, I_CONVB, I_WDOWN, I_FING };

__device__ __forceinline__ void p0_item(const float* W, int K, int N, bf16_t* WT, const float* gsc, LAS float* scr, int kb, int nb, int row_out0, int lane) {
    const int k0 = 64 * kb, n0 = 64 * nb;
    const int nn = n0 + 2 * (lane & 31); const bool ok = nn < N;
    f32x2 v[32];
#pragma unroll
    for (int i = 0; i < 32; ++i) { const int kk = 2 * i + (lane >> 5); v[i] = ok ? __builtin_nontemporal_load((const f32x2*)(W + (size_t)(k0 + kk) * N + nn)) : (f32x2){0.f, 0.f}; }
#pragma unroll
    for (int i = 0; i < 32; ++i) { const int kk = 2 * i + (lane >> 5); f32x2 x = v[i]; if (gsc) { const float g = gsc[k0 + kk]; x = x * g; }
        scr[kk * 65 + 2 * (lane & 31)] = x.x; scr[kk * 65 + 2 * (lane & 31) + 1] = x.y; }
    asm volatile("s_waitcnt lgkmcnt(0)" ::: "memory");
    const int c = lane & 7;
#pragma unroll
    for (int j = 0; j < 8; ++j) { const int n = (lane >> 3) + 8 * j; const LAS float* sp = scr + (8 * c) * 65 + n;
        u32x4 o; o.x = cvt_pk_bf16(sp[0 * 65], sp[1 * 65]); o.y = cvt_pk_bf16(sp[2 * 65], sp[3 * 65]); o.z = cvt_pk_bf16(sp[4 * 65], sp[5 * 65]); o.w = cvt_pk_bf16(sp[6 * 65], sp[7 * 65]);
        *(u32x4*)(WT + (size_t)(row_out0 + n) * K + k0 + 8 * c) = o; }
    asm volatile("s_waitcnt lgkmcnt(0)" ::: "memory");
}

__device__ __forceinline__ void convert_layer_weights(const Args& args, unsigned char* ws, int l, LAS float* scr, int w0, int nw, int lane, int it_lo, int it_hi) {
    constexpr int I_IN = 32 * 92, I_OUT = 32 * 32, I_UP = 32 * 176, I_DN = 88 * 32;
    unsigned char* wt = ws + WS_WT + (size_t)l * WT_LAYER;
    for (int it = it_lo + w0; it < it_hi; it += nw) {
        int r = it;
        if (r < I_IN) { const int kb = r / 92, nb = r % 92; p0_item(args.in[I_WIN] + (size_t)l * DM * NIN, DM, NIN, (bf16_t*)(wt + WT_IN), args.in[I_MIXG] + l * DM, scr, kb, nb, nb * 64, lane); continue; } r -= I_IN;
        if (r < I_OUT) { const int kb = r / 32, nb = r % 32; p0_item(args.in[I_WOUT] + (size_t)l * DM * DM, DM, DM, (bf16_t*)(wt + WT_OUT), nullptr, scr, kb, nb, nb * 64, lane); continue; } r -= I_OUT;
        if (r < I_UP) { const int kb = r / 176, nb = r % 176; const int n0 = nb * 64; const int j = n0 < DFF ? n0 : n0 - DFF; const int ro = (j >> 7) * 256 + (j & 127) + (n0 < DFF ? 0 : 128);
            p0_item(args.in[I_WUP] + (size_t)l * DM * NUP, DM, NUP, (bf16_t*)(wt + WT_UP), args.in[I_FFNG] + l * DM, scr, kb, nb, ro, lane); continue; } r -= I_UP;
        { const int kb = r / 32, nb = r % 32; p0_item(args.in[I_WDOWN] + (size_t)l * DFF * DM, DFF, DM, (bf16_t*)(wt + WT_DOWN), nullptr, scr, kb, nb, nb * 64, lane); }
    }
}

#define RWKV_LO(v) __builtin_shufflevector(v, v, 0, 1)
#define RWKV_HI(v) __builtin_shufflevector(v, v, 2, 3)
#define RWKV_LDB(set, g) do { _Pragma("unroll") for (int q = 0; q < 2; ++q) { lq_[set][q] = *(const LAS f32x4*)((st_) + 64 + (g) * 8 + q * 4); lq_[set][2 + q] = *(const LAS f32x4*)((st_) + 128 + (g) * 8 + q * 4); \
        lq_[set][4 + q] = *(const LAS f32x4*)((st_) + 192 + (g) * 8 + q * 4); if (WITH_Y_) lq_[set][6 + q] = *(const LAS f32x4*)((st_) + 256 + (g) * 8 + q * 4); } } while (0)
#define RWKV_STEP(st, vi, St, WITH_Y, WITH_V, yout) do { \
    const LAS float* st_ = (st); constexpr bool WITH_Y_ = (WITH_Y); \
    f32x2 a0_ = (f32x2){0.f, 0.f}, a1_ = (f32x2){0.f, 0.f}; \
    f32x4 na_[16]; f32x4 lq_[3][8]; \
    _Pragma("unroll") for (int q = 0; q < 16; ++q) na_[q] = *(const LAS f32x4*)(st_ + q * 4); \
    RWKV_LDB(0, 0); RWKV_LDB(1, 1); \
    __builtin_amdgcn_sched_barrier(0); \
    _Pragma("unroll") for (int q = 0; q < 16; ++q) { const f32x4 n = na_[q]; a0_ += St[2 * q] * RWKV_LO(n); a1_ += St[2 * q + 1] * RWKV_HI(n); } \
    const float sa_ = (a0_.x + a0_.y) + (a1_.x + a1_.y); const f32x2 sa2_ = (f32x2){sa_, sa_}; const f32x2 vi2_ = (f32x2){(vi), (vi)}; \
    f32x2 y0_ = (f32x2){0.f, 0.f}, y1_ = (f32x2){0.f, 0.f}; \
    __builtin_amdgcn_sched_barrier(0); \
    _Pragma("unroll") for (int gi = 0; gi < 8; ++gi) { \
        if (gi + 2 < 8) RWKV_LDB((gi + 2) % 3, gi + 2); \
        __builtin_amdgcn_sched_barrier(0); \
        _Pragma("unroll") for (int q = 0; q < 2; ++q) { const f32x4 dd = lq_[gi % 3][q], bb = lq_[gi % 3][2 + q], kk = lq_[gi % 3][4 + q]; const int k2 = gi * 4 + q * 2; \
            if (WITH_V) { St[k2] = St[k2] * RWKV_LO(dd) + sa2_ * RWKV_LO(bb) + vi2_ * RWKV_LO(kk); St[k2 + 1] = St[k2 + 1] * RWKV_HI(dd) + sa2_ * RWKV_HI(bb) + vi2_ * RWKV_HI(kk); } \
            else { St[k2] = St[k2] * RWKV_LO(dd) + sa2_ * RWKV_LO(bb); St[k2 + 1] = St[k2 + 1] * RWKV_HI(dd) + sa2_ * RWKV_HI(bb); } \
            if (WITH_Y_) { const f32x4 rr = lq_[gi % 3][6 + q]; y0_ += St[k2] * RWKV_LO(rr); y1_ += St[k2 + 1] * RWKV_HI(rr); } } \
        __builtin_amdgcn_sched_barrier(0); } \
    yout = (y0_.x + y0_.y) + (y1_.x + y1_.y); } while (0)

__global__ void __launch_bounds__(512, 2) mega_fwd(Args args) {
    extern __shared__ __attribute__((aligned(16))) unsigned char lds_raw[];
    LAS unsigned char* lds = (LAS unsigned char*)lds_raw;
    cg::grid_group grid = cg::this_grid();
    const int tid0 = threadIdx.x, wave = __builtin_amdgcn_readfirstlane(tid0 >> 6);
    const int bid = blockIdx.x, G = gridDim.x;
    const int gw = bid * 8 + wave, NGW = G * 8;
    unsigned char* ws = args.ws;
    float* XR = args.out;
    bf16_t* XB = (bf16_t*)(ws + WS_XB); bf16_t* Y = (bf16_t*)(ws + WS_Y); bf16_t* P = (bf16_t*)(ws + WS_P);
    float* IDZ = (float*)(ws + WS_IDZ); int* SEL = (int*)(ws + WS_SEL); float* PART = (float*)(ws + WS_PART);
    unsigned* BAR = (unsigned*)ws; unsigned bar_epoch = 0;
    float* SSQ = (float*)(ws + WS_SSQ); f32x2* ROPE = (f32x2*)(ws + WS_ROPE); float* KMEAN = (float*)(ws + WS_KMEAN);
    bf16_t* QB = (bf16_t*)(ws + WS_QB); bf16_t* KB = (bf16_t*)(ws + WS_KB); bf16_t* VT = (bf16_t*)(ws + WS_VT);
    float* VEC5 = (float*)(ws + WS_VEC5); float* VV = (float*)(ws + WS_VV); float* GG = (float*)(ws + WS_GG); float* BV = (float*)(ws + WS_BV);
    float* PCH = (float*)(ws + WS_PCH); float* LCH = (float*)(ws + WS_LCH); float* SIN = (float*)(ws + WS_SIN);
    float* OI = (float*)(ws + WS_OI); float* GU = (float*)(ws + WS_U); float* QT = (float*)(ws + WS_QT); float* LAM = (float*)(ws + WS_LAM);
    bf16_t* HB = (bf16_t*)(ws + WS_H); bf16_t* ACT = (bf16_t*)(ws + WS_ACT);

        { int tid = tid0; asm volatile("" : "+v"(tid)); const int lane = tid & 63; (void)lane;
    {
        LAS float* scr = (LAS float*)(lds + wave * 16896);
        const bool split_conv = (G >= 256);
        convert_layer_weights(args, ws, 0, scr, gw, NGW, lane, 0, split_conv ? 3968 : 12416);
        if (!split_conv) convert_layer_weights(args, ws, 1, scr, gw, NGW, lane, 0, 12416);
        for (int idx = bid * 512 + tid; idx < 8192; idx += G * 512) IDZ[idx] = (idx < 4096 && (idx >> 6) == (idx & 63)) ? 1.f : 0.f;
        for (int idx = bid * 512 + tid; idx < SEQ * 32; idx += G * 512) {
            const int t = idx >> 5, d = idx & 31;
            const float inv = exp2f(-(float)d * (13.287712379549449f / 32.0f));
            const float ang = (float)t * inv;
            const double rev = (double)ang * 0.15915494309189535; const float fr = (float)(rev - floor(rev));
            ROPE[idx] = (f32x2){__builtin_amdgcn_cosf(fr), __builtin_amdgcn_sinf(fr)};
        }
        const float* x = args.in[I_X];
        for (int row = gw; row < SEQ; row += NGW) {
            const f32x4* xr = (const f32x4*)(x + (size_t)row * DM) + lane; float s = 0.f;
            u32x2* ob = (u32x2*)(XB + (size_t)row * DM) + lane;
#pragma unroll
            for (int j = 0; j < 8; ++j) { const f32x4 v = xr[64 * j]; s += (v[0] * v[0] + v[1] * v[1]) + (v[2] * v[2] + v[3] * v[3]); u32x2 w; w.x = cvt_pk_bf16(v[0], v[1]); w.y = cvt_pk_bf16(v[2], v[3]); ob[64 * j] = w; }
            s = wave_sum(s);
            if (lane < 8) SSQ[(size_t)row * 8 + lane] = lane == 0 ? s : 0.f;
        }
    }
        }
    grid.sync();

    for (int l = 0; l < 2; ++l) {
        unsigned char* wt = ws + WS_WT + (size_t)l * WT_LAYER;
        { int tid = tid0; asm volatile("" : "+v"(tid)); const int lane = tid & 63; (void)lane;
        {
            pg8::Gemm g{XB, (const bf16_t*)(wt + WT_IN), SEQ, NINP, DM, 256}; pg8::StaticOrder S; S.init(SEQ, NINP, G, bid);
            pg8::EpiScaleBf16 E{P, NINP, SSQ};
            pg8::gemm_phase<pg8::EpiScaleBf16>(lds, g, S, E);
        }
        }
        fast_barrier(BAR, ++bar_epoch, (unsigned)G);
        { int tid = tid0; asm volatile("" : "+v"(tid)); const int lane = tid & 63; (void)lane;
        for (int unit = bid; unit < 256; unit += G) {
            const int n = unit >> 2, h = unit & 3, t0 = n * 128;
            LAS float* Vs = (LAS float*)lds; LAS float* Wt = (LAS float*)(lds + 65536); LAS float* st = (LAS float*)(lds + 65536 + 67584);
            const float* lng = args.in[I_ALNG] + l * 512; const float* lnb = args.in[I_ALNB] + l * 512;
            const float* wsrc = args.in[I_AWS] + ((size_t)l * 4 + h) * 16384; const float* bsrc = args.in[I_ABS] + (l * 4 + h) * 128;
            u32x4 raws[16];
#pragma unroll
            for (int i = 0; i < 16; ++i) raws[i] = *(const u32x4*)(P + (size_t)(t0 + wave * 16 + i) * NINP + PC_A + 512 + lane * 8);
#pragma unroll
            for (int i0 = 0; i0 < 16; i0 += 4) { float st8[8];
#pragma unroll
                for (int i = 0; i < 4; ++i) { float z[8]; unpack8(raws[i0 + i], z); float sm = 0.f, sq = 0.f;
#pragma unroll
                    for (int jj = 0; jj < 8; ++jj) { const float g = gelu_tanh(z[jj]); sm += g; sq += g * g; }
                    st8[i] = sm; st8[4 + i] = sq; }
                wave_sum_n<8>(st8);
                if (lane == 0) {
#pragma unroll
                    for (int i = 0; i < 4; ++i) { const int tt = wave * 16 + i0 + i; const float mu = st8[i] * (1.f / 512.f); const float var = fmaxf(st8[4 + i] * (1.f / 512.f) - mu * mu, 0.f);
                        st[tt * 2] = mu; st[tt * 2 + 1] = rsqrtf(var + EPS); } } }
            for (int i = 0; i < 32; ++i) { const int e = tid + 512 * i; const int t = e >> 7, s = e & 127; Wt[s * 132 + t] = (s <= t) ? wsrc[e] : 0.f; }
            __syncthreads();
            for (int i = 0; i < 4; ++i) { const int idx = tid + 512 * i; const int s = idx >> 4, c0 = (idx & 15) * 8;
                const u32x4 raw = *(const u32x4*)(P + (size_t)(t0 + s) * NINP + PC_A + 512 + h * 128 + c0); float z[8]; unpack8(raw, z);
                const float mu = st[s * 2], rs = st[s * 2 + 1];
#pragma unroll
                for (int j = 0; j < 8; ++j) Vs[s * 128 + c0 + j] = (gelu_tanh(z[j]) - mu) * rs * lng[h * 128 + c0 + j] + lnb[h * 128 + c0 + j]; }
            __syncthreads();
            const int tg = tid >> 4, cgp = tid & 15; const int s_end = wave * 16 + 16;
            float acc[4][8];
#pragma unroll
            for (int i = 0; i < 4; ++i)
#pragma unroll
                for (int j = 0; j < 8; ++j) acc[i][j] = 0.f;
            { f32x4 w4n[2], v0n[2], v1n[2];
#pragma unroll
              for (int q = 0; q < 2; ++q) { w4n[q] = *(const LAS f32x4*)(Wt + q * 132 + tg * 4); v0n[q] = *(const LAS f32x4*)(Vs + q * 128 + cgp * 8); v1n[q] = *(const LAS f32x4*)(Vs + q * 128 + cgp * 8 + 4); }
              for (int s = 0; s < s_end; s += 2) {
                f32x4 w4c[2], v0c[2], v1c[2];
#pragma unroll
                for (int q = 0; q < 2; ++q) { w4c[q] = w4n[q]; v0c[q] = v0n[q]; v1c[q] = v1n[q]; }
                const int sn = (s + 2 < 128) ? s + 2 : 126;
#pragma unroll
                for (int q = 0; q < 2; ++q) { w4n[q] = *(const LAS f32x4*)(Wt + (sn + q) * 132 + tg * 4); v0n[q] = *(const LAS f32x4*)(Vs + (sn + q) * 128 + cgp * 8); v1n[q] = *(const LAS f32x4*)(Vs + (sn + q) * 128 + cgp * 8 + 4); }
                __builtin_amdgcn_sched_barrier(0);
#pragma unroll
                for (int q = 0; q < 2; ++q)
#pragma unroll
                    for (int i = 0; i < 4; ++i) {
#pragma unroll
                        for (int j = 0; j < 4; ++j) { acc[i][j] += w4c[q][i] * v0c[q][j]; acc[i][4 + j] += w4c[q][i] * v1c[q][j]; } }
                __builtin_amdgcn_sched_barrier(0);
              } }
#pragma unroll
            for (int i = 0; i < 4; ++i) { const int t = tg * 4 + i; const float bias = bsrc[t];
                const u32x4 raw = *(const u32x4*)(P + (size_t)(t0 + t) * NINP + PC_A + h * 128 + cgp * 8); float z[8]; unpack8(raw, z); float o[8];
#pragma unroll
                for (int j = 0; j < 8; ++j) o[j] = gelu_tanh(z[j]) * (acc[i][j] + bias);
                u32x4 w; w.x = cvt_pk_bf16(o[0], o[1]); w.y = cvt_pk_bf16(o[2], o[3]); w.z = cvt_pk_bf16(o[4], o[5]); w.w = cvt_pk_bf16(o[6], o[7]);
                *(u32x4*)(Y + (size_t)(t0 + t) * DM + h * 128 + cgp * 8) = w; }
            __syncthreads();
        }
        }
        { int tid = tid0; asm volatile("" : "+v"(tid)); const int lane = tid & 63; (void)lane;
        for (int unit = bid; unit < 256; unit += G) {
            const int n = unit >> 3, h = unit & 7; const int tt = tid >> 1, half = tid & 1, t = n * 256 + tt, d0 = half * 16;
            LAS float* red = (LAS float*)lds;
            LAS bf16_t* vsT = (LAS bf16_t*)(lds + 4096);
            const bf16_t* prow = P + (size_t)t * NINP + PC_C + h * 64;
            float ql[16], qh[16], kl[16], kh[16];
            { u32x4 a0 = *(const u32x4*)(prow + d0), a1 = *(const u32x4*)(prow + d0 + 8), b0 = *(const u32x4*)(prow + 32 + d0), b1 = *(const u32x4*)(prow + 32 + d0 + 8);
              float z[8]; unpack8(a0, z);
#pragma unroll
              for (int j = 0; j < 8; ++j) ql[j] = z[j];
              unpack8(a1, z);
#pragma unroll
              for (int j = 0; j < 8; ++j) ql[8 + j] = z[j];
              unpack8(b0, z);
#pragma unroll
              for (int j = 0; j < 8; ++j) qh[j] = z[j];
              unpack8(b1, z);
#pragma unroll
              for (int j = 0; j < 8; ++j) qh[8 + j] = z[j]; }
            { u32x4 a0 = *(const u32x4*)(prow + 512 + d0), a1 = *(const u32x4*)(prow + 512 + d0 + 8), b0 = *(const u32x4*)(prow + 512 + 32 + d0), b1 = *(const u32x4*)(prow + 512 + 32 + d0 + 8);
              float z[8]; unpack8(a0, z);
#pragma unroll
              for (int j = 0; j < 8; ++j) kl[j] = z[j];
              unpack8(a1, z);
#pragma unroll
              for (int j = 0; j < 8; ++j) kl[8 + j] = z[j];
              unpack8(b0, z);
#pragma unroll
              for (int j = 0; j < 8; ++j) kh[j] = z[j];
              unpack8(b1, z);
#pragma unroll
              for (int j = 0; j < 8; ++j) kh[8 + j] = z[j]; }
            const f32x2* cs = ROPE + (size_t)t * 32 + d0;
#pragma unroll
            for (int j = 0; j < 16; ++j) { const f32x2 c = cs[j];
                const float q1 = ql[j], q2 = qh[j]; ql[j] = (q1 * c.x - q2 * c.y) * QSCALE; qh[j] = (q1 * c.y + q2 * c.x) * QSCALE;
                const float k1 = kl[j], k2 = kh[j]; kl[j] = k1 * c.x - k2 * c.y; kh[j] = k1 * c.y + k2 * c.x; }
            { bf16_t* qo = QB + (size_t)t * 512 + h * 64 + d0; bf16_t* ko = KB + (size_t)t * 512 + h * 64 + d0;
              u32x4 w;
              w.x = cvt_pk_bf16(ql[0], ql[1]); w.y = cvt_pk_bf16(ql[2], ql[3]); w.z = cvt_pk_bf16(ql[4], ql[5]); w.w = cvt_pk_bf16(ql[6], ql[7]); *(u32x4*)(qo) = w;
              w.x = cvt_pk_bf16(ql[8], ql[9]); w.y = cvt_pk_bf16(ql[10], ql[11]); w.z = cvt_pk_bf16(ql[12], ql[13]); w.w = cvt_pk_bf16(ql[14], ql[15]); *(u32x4*)(qo + 8) = w;
              w.x = cvt_pk_bf16(qh[0], qh[1]); w.y = cvt_pk_bf16(qh[2], qh[3]); w.z = cvt_pk_bf16(qh[4], qh[5]); w.w = cvt_pk_bf16(qh[6], qh[7]); *(u32x4*)(qo + 32) = w;
              w.x = cvt_pk_bf16(qh[8], qh[9]); w.y = cvt_pk_bf16(qh[10], qh[11]); w.z = cvt_pk_bf16(qh[12], qh[13]); w.w = cvt_pk_bf16(qh[14], qh[15]); *(u32x4*)(qo + 40) = w;
              w.x = cvt_pk_bf16(kl[0], kl[1]); w.y = cvt_pk_bf16(kl[2], kl[3]); w.z = cvt_pk_bf16(kl[4], kl[5]); w.w = cvt_pk_bf16(kl[6], kl[7]); *(u32x4*)(ko) = w;
              w.x = cvt_pk_bf16(kl[8], kl[9]); w.y = cvt_pk_bf16(kl[10], kl[11]); w.z = cvt_pk_bf16(kl[12], kl[13]); w.w = cvt_pk_bf16(kl[14], kl[15]); *(u32x4*)(ko + 8) = w;
              w.x = cvt_pk_bf16(kh[0], kh[1]); w.y = cvt_pk_bf16(kh[2], kh[3]); w.z = cvt_pk_bf16(kh[4], kh[5]); w.w = cvt_pk_bf16(kh[6], kh[7]); *(u32x4*)(ko + 32) = w;
              w.x = cvt_pk_bf16(kh[8], kh[9]); w.y = cvt_pk_bf16(kh[10], kh[11]); w.z = cvt_pk_bf16(kh[12], kh[13]); w.w = cvt_pk_bf16(kh[14], kh[15]); *(u32x4*)(ko + 40) = w; }
#pragma unroll
            for (int j = 0; j < 16; ++j) {
#pragma unroll
                for (int o = 2; o < 64; o <<= 1) { kl[j] += __shfl_xor(kl[j], o); kh[j] += __shfl_xor(kh[j], o); } }
            if (lane < 2) {
#pragma unroll
                for (int j = 0; j < 16; ++j) { red[(wave * 2 + lane) * 32 + j] = kl[j]; red[(wave * 2 + lane) * 32 + 16 + j] = kh[j]; } }
            { const bf16_t* vrow = prow + 1024 + half * 32;
#pragma unroll
              for (int q = 0; q < 4; ++q) { const u32x4 r = *(const u32x4*)(vrow + q * 8); const unsigned rr[4] = {r.x, r.y, r.z, r.w};
#pragma unroll
                  for (int j = 0; j < 4; ++j) { const int d = half * 32 + q * 8 + 2 * j; vsT[d * 264 + tt] = (bf16_t)(rr[j] & 0xffffu); vsT[(d + 1) * 264 + tt] = (bf16_t)(rr[j] >> 16); } } }
            __syncthreads();
            if (tid < 64) { const int hf = (tid & 31) >> 4, slot = (tid & 15) + (tid >= 32 ? 16 : 0); float s = 0.f;
#pragma unroll
                for (int w = 0; w < 8; ++w) s += red[(w * 2 + hf) * 32 + slot];
                KMEAN[(h * 32 + n) * 64 + tid] = s * (1.f / 256.f); }
            { const int d = tid >> 3, seg = tid & 7; const LAS u32x4* src = (const LAS u32x4*)(vsT + d * 264 + seg * 32); u32x4* dst = (u32x4*)(VT + (size_t)(h * 64 + d) * SEQ + n * 256 + seg * 32);
#pragma unroll
              for (int q = 0; q < 4; ++q) dst[q] = src[q]; }
            __syncthreads();
        }
        }
        { int tid = tid0; asm volatile("" : "+v"(tid)); const int lane = tid & 63; (void)lane;
        for (int unit = bid; unit < 256; unit += G) {
            const int t0 = unit * 32;
            LAS float* xs = (LAS float*)lds;
            const float* mu = args.in[I_BMU] + l * 1696;
            for (int i = 0; i < 10; ++i) { const int idx = tid + 512 * i; const int tt = idx / 160, j = idx - tt * 160; const int t = t0 + tt;
                const float cur = bf2f(P[(size_t)t * NINP + PC_B + 1536 + j]); const float prev = t > 0 ? bf2f(P[(size_t)(t - 1) * NINP + PC_B + 1536 + j]) : 0.f;
                const float x = cur + (prev - cur) * mu[1536 + j];
                xs[tt * 160 + j] = j < 32 ? tanhf(x) : (j < 64 ? x : sigmoidf_(x)); }
            const int c = tid, head = wave;
            const float w0c = args.in[I_BW0][l * 512 + c], a0c = args.in[I_BA0][l * 512 + c], kkc = args.in[I_BKK][l * 512 + c], kac = args.in[I_BKA][l * 512 + c], rkc = args.in[I_BRK][l * 512 + c];
            const float mur = mu[c], muk = mu[512 + c], muv = mu[1024 + c];
            const float* w2 = args.in[I_BW2] + (size_t)l * 32 * 512; const float* a2 = args.in[I_BA2] + (size_t)l * 32 * 512; const float* g2 = args.in[I_BG2] + (size_t)l * 96 * 512;
            __syncthreads();
            {
                float wr_[32], ar_[32];
                unsigned cu = (unsigned)c; asm volatile("" : "+v"(cu));
#pragma unroll
                for (int j = 0; j < 32; ++j) { const float* wj = w2 + j * 512; const float* aj = a2 + j * 512; wr_[j] = wj[cu]; ar_[j] = aj[cu]; }
                float rp = 0.f, kp = 0.f, vp = 0.f;
                { const bf16_t* pr = P + (size_t)t0 * NINP + PC_B + c; if (t0 > 0) { rp = bf2f(pr[-NINP]); kp = bf2f(pr[512 - NINP]); vp = bf2f(pr[1024 - NINP]); } }
                float rn, kn, vnx;
                { const bf16_t* pr = P + (size_t)t0 * NINP + PC_B + c; rn = bf2f(pr[0]); kn = bf2f(pr[512]); vnx = bf2f(pr[1024]); }
#pragma unroll 1
                for (int i = 0; i < 32; ++i) { const int t = t0 + i;
                    const float rc = rn, kc = kn, vc = vnx;
                    if (i + 1 < 32) { const bf16_t* pr = P + (size_t)(t + 1) * NINP + PC_B + c; rn = bf2f(pr[0]); kn = bf2f(pr[512]); vnx = bf2f(pr[1024]); }
                    float aw = w0c, aa = a0c, aw1 = 0.f, aa1 = 0.f;
                    const LAS float* xr = xs + i * 160;
#pragma unroll
                    for (int j = 0; j < 32; j += 4) { const f32x4 x = *(const LAS f32x4*)(xr + j), y = *(const LAS f32x4*)(xr + 32 + j);
                        aw += x[0] * wr_[j]; aw1 += x[1] * wr_[j + 1]; aw += x[2] * wr_[j + 2]; aw1 += x[3] * wr_[j + 3];
                        aa += y[0] * ar_[j]; aa1 += y[1] * ar_[j + 1]; aa += y[2] * ar_[j + 2]; aa1 += y[3] * ar_[j + 3]; }
                    aw += aw1; aa += aa1;
                    const float rr = rc + (rp - rc) * mur, kx = kc + (kp - kc) * muk, vx = vc + (vp - vc) * muv;
                    const float mz = -aw; const float sp = mz > 20.f ? mz : __logf(1.f + __expf(mz));
                    const float wl = -sp - 0.5f; const float dec = __expf(-__expf(wl));
                    const float a = sigmoidf_(aa);
                    float kk = kx * kkc; const float k2 = kx * (1.f + (a - 1.f) * kac);
                    float red2[2] = {kk * kk, rr * k2 * rkc}; wave_sum_n<2>(red2);
                    kk = kk * __builtin_amdgcn_rsqf(fmaxf(red2[0], 1e-24f)); const float bb = kk * a;
                    const float bon = red2[1];
                    float* v5 = VEC5 + ((size_t)head * SEQ + t) * 320 + lane;
                    v5[0] = -kk; v5[64] = dec; v5[128] = bb; v5[192] = k2; v5[256] = rr;
                    VV[((size_t)head * SEQ + t) * 64 + lane] = vx; BV[(size_t)t * 512 + c] = bon * vx;
                    rp = rc; kp = kc; vp = vc; }
            }
            {
                float gr_[96];
                unsigned cu = (unsigned)c; asm volatile("" : "+v"(cu));
#pragma unroll
                for (int j = 0; j < 96; ++j) { const float* gj = g2 + j * 512; gr_[j] = gj[cu]; }
#pragma unroll 1
                for (int i = 0; i < 32; ++i) { const int t = t0 + i;
                    float ag = 0.f, ag1 = 0.f;
                    const LAS float* xr = xs + i * 160;
#pragma unroll
                    for (int j = 0; j < 96; j += 4) { const f32x4 x = *(const LAS f32x4*)(xr + 64 + j); ag += x[0] * gr_[j]; ag1 += x[1] * gr_[j + 1]; ag += x[2] * gr_[j + 2]; ag1 += x[3] * gr_[j + 3]; }
                    GG[(size_t)t * 512 + c] = ag + ag1; }
            }
            __syncthreads();
        }
        }
        fast_barrier(BAR, ++bar_epoch, (unsigned)G);
        { int tid = tid0; asm volatile("" : "+v"(tid)); const int lane = tid & 63; (void)lane;
        for (int pi = bid; pi < 256; pi += G) {
            const int h = pi & 7, r = pi >> 3, half = r & 1;
            for (int which = 0; which < 2; ++which) {
                const int qb = which ? 31 - (r >> 1) : (r >> 1);
                const int t0 = qb * 256 + half * 128;
                LAS bf16_t* Ks = (LAS bf16_t*)lds;
                LAS bf16_t* Vs = (LAS bf16_t*)(lds + 18432);
                LAS float* kmS = (LAS float*)(lds + 36864);
                LAS int* selS = (LAS int*)(lds + 36864 + 8192);
                for (int i = tid; i < qb * 64; i += 512) kmS[i] = KMEAN[h * 2048 + i];
                __syncthreads();
                if (tid < 128) {
                    const bf16_t* qr = QB + (size_t)(t0 + tid) * 512 + h * 64;
                    float q[64];
#pragma unroll
                    for (int j = 0; j < 8; ++j) { float z[8]; unpack8(*(const u32x4*)(qr + j * 8), z);
#pragma unroll
                        for (int e = 0; e < 8; ++e) q[j * 8 + e] = z[e]; }
                    float b0 = -INFINITY, b1 = -INFINITY, b2 = -INFINITY; int i0 = 255, i1 = 255, i2 = 255;
                    for (int n = 0; n < qb; ++n) { float s = 0.f, s1 = 0.f, s2 = 0.f, s3 = 0.f; f32x4 kv[16];
#pragma unroll
                        for (int j = 0; j < 16; ++j) kv[j] = *(const LAS f32x4*)(kmS + n * 64 + j * 4);
                        __builtin_amdgcn_sched_barrier(0);
#pragma unroll
                        for (int j = 0; j < 16; ++j) { s += q[4 * j] * kv[j][0]; s1 += q[4 * j + 1] * kv[j][1]; s2 += q[4 * j + 2] * kv[j][2]; s3 += q[4 * j + 3] * kv[j][3]; }
                        s = (s + s1) + (s2 + s3);
                        if (s > b0) { b2 = b1; i2 = i1; b1 = b0; i1 = i0; b0 = s; i0 = n; } else if (s > b1) { b2 = b1; i2 = i1; b1 = s; i1 = n; } else if (s > b2) { b2 = s; i2 = n; } }
                    selS[tid] = i0 | (i1 << 8) | (i2 << 16); SEL[h * SEQ + t0 + tid] = i0 | (i1 << 8) | (i2 << 16);
                }
                __syncthreads();
                const int ql = lane & 15, kg = lane >> 4;
                const int tq = t0 + wave * 16 + ql;
                const int sel = selS[wave * 16 + ql]; const int s0 = sel & 255, s1 = (sel >> 8) & 255, s2 = (sel >> 16) & 255;
                bf16x8 qf[2];
                qf[0] = *(const bf16x8*)(QB + (size_t)tq * 512 + h * 64 + kg * 8); qf[1] = *(const bf16x8*)(QB + (size_t)tq * 512 + h * 64 + 32 + kg * 8);
                const int nown = half ? 4 : 2, ntile = nown;
                float mrun = -1e30f, lrun = 0.f; f32x4 O[4];
#pragma unroll
                for (int d = 0; d < 4; ++d) O[d] = (f32x4){0.f, 0.f, 0.f, 0.f};
                const int lrow = tid >> 3, lseg = (tid & 7) ^ (lrow & 7);
                const bf16_t* kgp = KB + (size_t)lrow * 512 + h * 64 + lseg * 8; const bf16_t* vgp = VT + (size_t)(h * 64 + lrow) * SEQ + lseg * 8;
                LAS unsigned char* ring = lds + 49152;
#define ATT_KS(i_) ((i_) < nown ? qb * 256 + (i_) * 64 : ((i_) - nown) * 64)
#define ATT_ISSUE_S(i_, slot_) do { const int ks_ = ATT_KS(i_); LAS unsigned char* tb_ = ring + (slot_) * 16384 + wave * 1024; \
                    __builtin_amdgcn_global_load_lds((const unsigned*)(kgp + (size_t)ks_ * 512), (LAS unsigned*)tb_, 16, 0, 0); \
                    __builtin_amdgcn_global_load_lds((const unsigned*)(vgp + ks_), (LAS unsigned*)(tb_ + 8192), 16, 0, 0); } while (0)
                ATT_ISSUE_S(0, 0); if (ntile > 1) ATT_ISSUE_S(1, 1); if (ntile > 2) ATT_ISSUE_S(2, 2);
                const int sw = ql & 7;
                for (int i0 = 0; i0 < ntile; i0 += 4) {
#pragma unroll
                for (int ij = 0; ij < 4; ++ij) { const int i = i0 + ij; if (i < ntile) {
                    if (i + 2 < ntile) asm volatile("s_waitcnt vmcnt(4)" ::: "memory"); else if (i + 1 < ntile) asm volatile("s_waitcnt vmcnt(2)" ::: "memory"); else asm volatile("s_waitcnt vmcnt(0)" ::: "memory");
                    __builtin_amdgcn_s_barrier(); asm volatile("" ::: "memory");
                    if (i + 3 < ntile) ATT_ISSUE_S(i + 3, (ij + 3) & 3);
                    const int ks = ATT_KS(i);
                    const LAS unsigned char* Kc = ring + ij * 16384; const LAS unsigned char* Vc = Kc + 8192;
                    bf16x8 kfr[4][2];
#pragma unroll
                    for (int kt = 0; kt < 4; ++kt)
#pragma unroll
                        for (int c = 0; c < 2; ++c) kfr[kt][c] = *(const LAS bf16x8*)(Kc + (kt * 16 + ql) * 128 + (((c * 4 + kg) ^ sw) << 4));
                    u32x2 vfr[2][4][2];
#pragma unroll
                    for (int kc = 0; kc < 2; ++kc)
#pragma unroll
                        for (int d = 0; d < 4; ++d) { const LAS unsigned char* vr = Vc + (d * 16 + ql) * 128 + (kg & 1) * 8; const int sg = kc * 4 + (kg >> 1);
                            vfr[kc][d][0] = *(const LAS u32x2*)(vr + ((sg ^ sw) << 4)); vfr[kc][d][1] = *(const LAS u32x2*)(vr + (((sg + 2) ^ sw) << 4)); }
                    __builtin_amdgcn_sched_barrier(0);
                    f32x4 Sx[4];
#pragma unroll
                    for (int kt = 0; kt < 4; ++kt) Sx[kt] = __builtin_amdgcn_mfma_f32_16x16x32_bf16(kfr[kt][0], qf[0], (f32x4){0.f, 0.f, 0.f, 0.f}, 0, 0, 0);
#pragma unroll
                    for (int kt = 0; kt < 4; ++kt) Sx[kt] = __builtin_amdgcn_mfma_f32_16x16x32_bf16(kfr[kt][1], qf[1], Sx[kt], 0, 0, 0);
                    const int nblk = ks >> 8; const bool own = i < nown;
                    const bool keepl = true; (void)own; (void)nblk; (void)s0; (void)s1; (void)s2;
                    if (own && ks + 63 > t0) {
#pragma unroll
                        for (int kt = 0; kt < 4; ++kt)
#pragma unroll
                            for (int jj = 0; jj < 4; ++jj) { const int key = ks + kt * 16 + 4 * kg + jj; Sx[kt][jj] = (key <= tq) ? Sx[kt][jj] : -1e30f; }
                    }
                    float mx = fmaxf(fmaxf(fmaxf(Sx[0][0], Sx[0][1]), fmaxf(Sx[0][2], Sx[0][3])), fmaxf(fmaxf(Sx[1][0], Sx[1][1]), fmaxf(Sx[1][2], Sx[1][3])));
                    mx = fmaxf(mx, fmaxf(fmaxf(fmaxf(Sx[2][0], Sx[2][1]), fmaxf(Sx[2][2], Sx[2][3])), fmaxf(fmaxf(Sx[3][0], Sx[3][1]), fmaxf(Sx[3][2], Sx[3][3]))));
                    mx = keepl ? mx : -1e30f;
                    mx = fmaxf(mx, __shfl_xor(mx, 16)); mx = fmaxf(mx, __shfl_xor(mx, 32));
                    const float mnew = fmaxf(mrun, mx); const float alpha = __builtin_amdgcn_exp2f(mrun - mnew); mrun = mnew;
                    const float moff = keepl ? mnew : 1e30f;
                    float rs = 0.f;
#pragma unroll
                    for (int kt = 0; kt < 4; ++kt)
#pragma unroll
                        for (int jj = 0; jj < 4; ++jj) { const float p = __builtin_amdgcn_exp2f(Sx[kt][jj] - moff); Sx[kt][jj] = p; rs += p; }
                    lrun = lrun * alpha + rs;
#pragma unroll
                    for (int d = 0; d < 4; ++d) O[d] *= alpha;
#pragma unroll
                    for (int kc = 0; kc < 2; ++kc) {
                        u32x4 pw; pw.x = cvt_pk_bf16(Sx[2 * kc][0], Sx[2 * kc][1]); pw.y = cvt_pk_bf16(Sx[2 * kc][2], Sx[2 * kc][3]); pw.z = cvt_pk_bf16(Sx[2 * kc + 1][0], Sx[2 * kc + 1][1]); pw.w = cvt_pk_bf16(Sx[2 * kc + 1][2], Sx[2 * kc + 1][3]);
                        const bf16x8 pb = __builtin_bit_cast(bf16x8, pw);
#pragma unroll
                        for (int d = 0; d < 4; ++d) { u32x4 vw; vw.x = vfr[kc][d][0].x; vw.y = vfr[kc][d][0].y; vw.z = vfr[kc][d][1].x; vw.w = vfr[kc][d][1].y;
                            O[d] = __builtin_amdgcn_mfma_f32_16x16x32_bf16(__builtin_bit_cast(bf16x8, vw), pb, O[d], 0, 0, 0); }
                    }
                } } }
                lrun += __shfl_xor(lrun, 16); lrun += __shfl_xor(lrun, 32);
#undef ATT_KS
#undef ATT_ISSUE_S
                { float* pp = PART + ((size_t)(tq * 8 + h) * 4 + 3) * 36;
#pragma unroll
                  for (int d = 0; d < 4; ++d) { u32x2 w; w.x = cvt_pk_bf16(O[d][0], O[d][1]); w.y = cvt_pk_bf16(O[d][2], O[d][3]); *(u32x2*)(pp + d * 8 + 2 * kg) = w; }
                  if (kg == 0) { pp[32] = mrun; pp[33] = lrun; } }
                __syncthreads();
            }
        }
        }
        { int tid = tid0; asm volatile("" : "+v"(tid)); const int lane = tid & 63; (void)lane;
        for (int unit = bid; unit < 512; unit += G) {
            const int c = unit >> 2, h = unit & 3, t0 = c * 64;
            LAS float* qtT = (LAS float*)lds;
            LAS float* ktT = (LAS float*)(lds + 16384);
            LAS float* khS = (LAS float*)(lds + 32768);
            LAS float* vS = (LAS float*)(lds + 49152);
            LAS float* AT = (LAS float*)(lds + 81920);
            LAS float* xgs = (LAS float*)(lds + 98304);
            const bf16_t* pd = P + (size_t)t0 * NINP + PC_D;
            for (int i = tid; i < 1024; i += 512) { const int t = i >> 4, j = i & 15; xgs[i] = bf2f(pd[(size_t)t * NINP + 1024 + j]); }
            for (int i = 0; i < 2; ++i) { const int idx = tid + 512 * i; const int s = idx >> 4, e0 = (idx & 15) * 8; float z[8]; unpack8(*(const u32x4*)(pd + (size_t)s * NINP + 512 + h * 128 + e0), z);
#pragma unroll
                for (int j = 0; j < 8; ++j) vS[s * 128 + e0 + j] = z[j]; }
            __syncthreads();
            { const int t = tid >> 3, dg = (tid & 7) * 8; const float* gw2 = args.in[I_DGW2] + (size_t)l * 16 * 256 + h * 64 + dg; const float* gb = args.in[I_DGB] + l * 256 + h * 64 + dg;
              float a[8];
#pragma unroll
              for (int j = 0; j < 8; ++j) a[j] = gb[j];
              for (int r = 0; r < 16; ++r) { const float xv = xgs[t * 16 + r];
#pragma unroll
                  for (int j = 0; j < 8; ++j) a[j] += xv * gw2[r * 256 + j]; }
#pragma unroll
              for (int j = 0; j < 8; ++j) { const float x = a[j]; const float ls = fminf(x, 0.f) - __logf(1.f + __expf(-fabsf(x))); AT[t * 64 + dg + j] = ls * (1.f / 16.f); } }
            __syncthreads();
            if (tid < 64) { float run = 0.f; for (int t = 0; t < 64; ++t) { run += AT[t * 64 + tid]; AT[t * 64 + tid] = run; } }
            __syncthreads();
            { const int t = tid >> 3, dg = (tid & 7) * 8; float qz[8], kz[8];
              unpack8(*(const u32x4*)(pd + (size_t)t * NINP + h * 64 + dg), qz); unpack8(*(const u32x4*)(pd + (size_t)t * NINP + 256 + h * 64 + dg), kz);
#pragma unroll
              for (int j = 0; j < 8; ++j) { const int d = dg + j; const float cm = AT[t * 64 + d], last = AT[63 * 64 + d];
                  const float qv = qz[j] * 0.125f * __expf(cm); qtT[d * 64 + t] = qv; ktT[d * 64 + t] = kz[j] * __expf(-cm); khS[t * 64 + d] = kz[j] * __expf(last - cm);
                  QT[(size_t)(t0 + t) * 256 + h * 64 + d] = qv;
                  if (t == 63) LAM[(c * 4 + h) * 64 + d] = __expf(last); } }
            __syncthreads();
            if (tid < 256) { const int tq0 = (tid & 15) * 4, sq0 = (tid >> 4) * 4; float a[4][4];
#pragma unroll
                for (int i = 0; i < 4; ++i)
#pragma unroll
                    for (int j = 0; j < 4; ++j) a[i][j] = 0.f;
                for (int d0 = 0; d0 < 64; d0 += 8) { f32x4 qv[8], kv[8];
#pragma unroll
                    for (int q = 0; q < 8; ++q) { qv[q] = *(const LAS f32x4*)(qtT + (d0 + q) * 64 + tq0); kv[q] = *(const LAS f32x4*)(ktT + (d0 + q) * 64 + sq0); }
                    __builtin_amdgcn_sched_barrier(0);
#pragma unroll
                    for (int q = 0; q < 8; ++q)
#pragma unroll
                        for (int i = 0; i < 4; ++i)
#pragma unroll
                            for (int j = 0; j < 4; ++j) a[i][j] += qv[q][i] * kv[q][j];
                    __builtin_amdgcn_sched_barrier(0); }
                asm volatile("" ::: "memory");
#pragma unroll
                for (int j = 0; j < 4; ++j) { f32x4 o;
#pragma unroll
                    for (int i = 0; i < 4; ++i) o[i] = (sq0 + j <= tq0 + i) ? a[i][j] : 0.f;
                    *(LAS f32x4*)(AT + (sq0 + j) * 64 + tq0) = o; } }
            __syncthreads();
            { const int x0 = (tid & 15) * 4, e0 = (tid >> 4) * 4; float o[4][4], u[4][4];
#pragma unroll
              for (int i = 0; i < 4; ++i)
#pragma unroll
                  for (int j = 0; j < 4; ++j) { o[i][j] = 0.f; u[i][j] = 0.f; }
              for (int s0 = 0; s0 < 64; s0 += 4) { f32x4 av[4], kv[4], vv[4];
#pragma unroll
                  for (int q = 0; q < 4; ++q) { av[q] = *(const LAS f32x4*)(AT + (s0 + q) * 64 + x0); kv[q] = *(const LAS f32x4*)(khS + (s0 + q) * 64 + x0); vv[q] = *(const LAS f32x4*)(vS + (s0 + q) * 128 + e0); }
                  __builtin_amdgcn_sched_barrier(0);
#pragma unroll
                  for (int q = 0; q < 4; ++q)
#pragma unroll
                      for (int i = 0; i < 4; ++i)
#pragma unroll
                          for (int j = 0; j < 4; ++j) { o[i][j] += av[q][i] * vv[q][j]; u[i][j] += kv[q][i] * vv[q][j]; }
                  __builtin_amdgcn_sched_barrier(0); }
#pragma unroll
              for (int i = 0; i < 4; ++i) { *(f32x4*)(OI + (size_t)(t0 + x0 + i) * 512 + h * 128 + e0) = (f32x4){o[i][0], o[i][1], o[i][2], o[i][3]};
                  *(f32x4*)(GU + ((size_t)(c * 4 + h) * 64 + x0 + i) * 128 + e0) = (f32x4){u[i][0], u[i][1], u[i][2], u[i][3]}; } }
            __syncthreads();
        }
        }
        { int tid = tid0; asm volatile("" : "+v"(tid)); const int lane = tid & 63; (void)lane;
        { const int wu = bid * 8 + wave; if (wu < 2048) {
            const int h = wu >> 8, c = (wu >> 1) & 127, kind = wu & 1; const size_t tb = (size_t)h * SEQ + c * 64;
            LAS float* buf = (LAS float*)(lds + wave * 10240);
            const f32x4* src = (const f32x4*)(VEC5 + tb * 320);
            const float* vsrc = VV + tb * 64 + lane;
            f32x2 St[32];
            { const f32x4* si = (const f32x4*)(IDZ + kind * 4096 + lane * 64);
#pragma unroll
              for (int k4 = 0; k4 < 16; ++k4) { const f32x4 v = si[k4]; St[2 * k4] = RWKV_LO(v); St[2 * k4 + 1] = RWKV_HI(v); } }
            float vn[4];
#pragma unroll
            for (int j = 0; j < 5; ++j) __builtin_amdgcn_global_load_lds((const unsigned*)(src + j * 64 + lane), (LAS unsigned*)(buf + j * 256), 16, 0, 0);
            const float vsc = kind ? 1.f : 0.f;
#pragma unroll
            for (int j = 0; j < 4; ++j) vn[j] = vsrc[j * 64];
            asm volatile("s_waitcnt vmcnt(0)" ::: "memory");
            for (int b = 0; b < 16; ++b) {
                const float vc0 = vn[0], vc1 = vn[1], vc2 = vn[2], vc3 = vn[3];
                if (b + 1 < 16) { LAS float* nb = buf + ((b + 1) & 1) * 1280;
#pragma unroll
                    for (int j = 0; j < 5; ++j) __builtin_amdgcn_global_load_lds((const unsigned*)(src + (b + 1) * 320 + j * 64 + lane), (LAS unsigned*)(nb + j * 256), 16, 0, 0);
#pragma unroll
                    for (int j = 0; j < 4; ++j) vn[j] = vsrc[((b + 1) * 4 + j) * 64];
                }
                const LAS float* cb = buf + (b & 1) * 1280;
#pragma unroll 1
                for (int s = 0; s < 4; ++s) {
                    const LAS float* st = cb + s * 320;
                    const float vi = (s == 0 ? vc0 : (s == 1 ? vc1 : (s == 2 ? vc2 : vc3))) * vsc;
                    float yy; RWKV_STEP(st, vi, St, false, true, yy); (void)yy;
                }
                asm volatile("s_waitcnt vmcnt(0)" ::: "memory");
            }
            f32x4* po = (f32x4*)((kind ? LCH : PCH) + ((size_t)(h * 128 + c) * 64 + lane) * 64);
#pragma unroll
            for (int k4 = 0; k4 < 16; ++k4) po[k4] = (f32x4){St[2 * k4].x, St[2 * k4].y, St[2 * k4 + 1].x, St[2 * k4 + 1].y};
        }
        }
        }
        fast_barrier(BAR, ++bar_epoch, (unsigned)G);
        { int tid = tid0; asm volatile("" : "+v"(tid)); const int lane = tid & 63; (void)lane;
        if (bid < 64) {
            const int h = bid >> 3, rg = bid & 7;
            LAS float* Pb = (LAS float*)lds;
            LAS float* Sb = (LAS float*)(lds + 32768);
            const int rl = (wave & 3) * 2 + (lane >> 5), cl = 2 * (lane & 31); const int row = rg * 8 + rl;
            const bool comp = wave < 4;
            float zz = 0.f; asm volatile("" : "+v"(zz)); const f32x2 z2 = (f32x2){zz, zz};
            const float* Pg = PCH + (size_t)(h * 128) * 4096; const float* Lg = LCH + (size_t)(h * 128) * 4096 + row * 64 + cl;
            f32x4 pq[4][2]; f32x2 lnq[4];
            { const f32x4* ps = (const f32x4*)Pg; *(LAS f32x4*)(Pb + tid * 4) = ps[tid]; *(LAS f32x4*)(Pb + 2048 + tid * 4) = ps[512 + tid]; }
#pragma unroll
            for (int q = 1; q <= 4; ++q) { const f32x4* ps = (const f32x4*)(Pg + (size_t)q * 4096); pq[q & 3][0] = ps[tid]; pq[q & 3][1] = ps[512 + tid]; }
#pragma unroll
            for (int q = 0; q < 4; ++q) lnq[q] = comp ? *(const f32x2*)(Lg + (size_t)q * 4096) : z2;
            if (comp) *(LAS f32x2*)(Sb + rl * 64 + cl) = z2;
            f32x2 sv = z2;
            asm volatile("s_waitcnt lgkmcnt(0)" ::: "memory"); __builtin_amdgcn_s_barrier(); asm volatile("" ::: "memory");
            for (int c0 = 0; c0 < 128; c0 += 4) {
#pragma unroll
                for (int ci = 0; ci < 4; ++ci) {
                    const int c = c0 + ci;
                    const LAS float* Pc = Pb + (c & 1) * 4096; const LAS float* Sc = Sb + (c & 1) * 512 + rl * 64;
                    if (comp) {
                        *(f32x2*)(SIN + (size_t)(h * 128 + c) * 4096 + row * 64 + cl) = sv;
                        f32x2 a0 = lnq[ci], a1 = z2;
                        if (c + 4 < 128) lnq[ci] = *(const f32x2*)(Lg + (size_t)(c + 4) * 4096);
                        f32x4 sr_[16]; f32x2 pr_[2][16];
#pragma unroll
                        for (int q = 0; q < 16; ++q) sr_[q] = *(const LAS f32x4*)(Sc + q * 4);
#pragma unroll
                        for (int q = 0; q < 16; ++q) pr_[0][q] = *(const LAS f32x2*)(Pc + q * 64 + cl);
#pragma unroll
                        for (int g = 0; g < 4; ++g) {
                            if (g + 1 < 4) {
#pragma unroll
                                for (int q = 0; q < 16; ++q) pr_[(g + 1) & 1][q] = *(const LAS f32x2*)(Pc + ((g + 1) * 16 + q) * 64 + cl); }
                            __builtin_amdgcn_sched_barrier(0);
#pragma unroll
                            for (int q = 0; q < 16; q += 2) { const int k = g * 16 + q; a0 += sr_[k >> 2][k & 3] * pr_[g & 1][q]; a1 += sr_[(k + 1) >> 2][(k + 1) & 3] * pr_[g & 1][q + 1]; }
                            __builtin_amdgcn_sched_barrier(0);
                        }
                        sv = a0 + a1;
                        *(LAS f32x2*)(Sb + ((c + 1) & 1) * 512 + rl * 64 + cl) = sv;
                    }
                    if (c + 1 < 128) { LAS float* Pn = Pb + ((c + 1) & 1) * 4096; *(LAS f32x4*)(Pn + tid * 4) = pq[(ci + 1) & 3][0]; *(LAS f32x4*)(Pn + 2048 + tid * 4) = pq[(ci + 1) & 3][1]; }
                    if (c + 5 < 128) { const f32x4* ps = (const f32x4*)(Pg + (size_t)(c + 5) * 4096); pq[(ci + 1) & 3][0] = ps[tid]; pq[(ci + 1) & 3][1] = ps[512 + tid]; }
                    asm volatile("s_waitcnt lgkmcnt(0)" ::: "memory"); __builtin_amdgcn_s_barrier(); asm volatile("" ::: "memory");
                }
            }
        } else if (bid < 128) {
            const int idx = (bid - 64) * 512 + tid; float S = 0.f;
            for (int c0 = 0; c0 < 128; c0 += 16) { float u[16], lam[16];
#pragma unroll
                for (int i = 0; i < 16; ++i) { u[i] = GU[(size_t)(c0 + i) * 32768 + idx]; lam[i] = LAM[(c0 + i) * 256 + (idx >> 7)]; }
#pragma unroll
                for (int i = 0; i < 16; ++i) { GU[(size_t)(c0 + i) * 32768 + idx] = S; S = lam[i] * S + u[i]; } }
        } else if (G >= 256) {
            convert_layer_weights(args, ws, l, (LAS float*)(lds + wave * 16896), (bid - 128) * 8 + wave, (G - 128) * 8, lane, 3968, 9600);
        }
        }
        { int tid = tid0; asm volatile("" : "+v"(tid)); const int lane = tid & 63; (void)lane;
        for (;;) {
            __syncthreads();
            if (tid == 0) *(LAS int*)(lds + 36864 + 4096 + 64) = (int)__hip_atomic_fetch_add(BAR + 1024 + 64 * l, 1u, __ATOMIC_RELAXED, __HIP_MEMORY_SCOPE_AGENT);
            __syncthreads();
            const int u = *(LAS int*)(lds + 36864 + 4096 + 64);
            if (u >= 1088) break;
            const int h = u & 7; int n = 0, r = 0;
            { int rem = u >> 3; for (n = 0; n < 31; ++n) { const int cn = 8 - ((n + 1) >> 2); if (rem < cn) { r = ((n + 1) >> 2) + rem; break; } rem -= cn; } }
            LAS int* listS = (LAS int*)(lds + 36864);
            LAS int* wcnt = (LAS int*)(lds + 36864 + 4096);
            LAS unsigned char* ring = lds + 49152;
            const int lrow = tid >> 3, lseg = (tid & 7) ^ (lrow & 7);
            const bf16_t* kgp = KB + (size_t)(n * 256 + lrow) * 512 + h * 64 + lseg * 8; const bf16_t* vgp = VT + (size_t)(h * 64 + lrow) * SEQ + n * 256 + lseg * 8;
#pragma unroll
            for (int j = 0; j < 4; ++j) { LAS unsigned char* tb_ = ring + j * 16384 + wave * 1024;
                __builtin_amdgcn_global_load_lds((const unsigned*)(kgp + (size_t)j * 64 * 512), (LAS unsigned*)tb_, 16, 0, 0);
                __builtin_amdgcn_global_load_lds((const unsigned*)(vgp + j * 64), (LAS unsigned*)(tb_ + 8192), 16, 0, 0); }
            int myslot[2], mypre[2];
#pragma unroll
            for (int p = 0; p < 2; ++p) { const int t = r * 1024 + p * 512 + tid; const int sv = SEL[h * SEQ + t];
                const int sl = ((sv & 255) == n) ? 0 : ((((sv >> 8) & 255) == n) ? 1 : ((((sv >> 16) & 255) == n) ? 2 : -1));
                const unsigned long long bal = __ballot(sl >= 0);
                myslot[p] = sl; mypre[p] = __popcll(bal & ((1ull << lane) - 1ull));
                if (lane == 0) wcnt[p * 8 + wave] = __popcll(bal); }
            __syncthreads();
            int cnt = 0, base0 = 0, base1 = 0;
#pragma unroll
            for (int q = 0; q < 16; ++q) { const int c = wcnt[q]; if (q == wave) base0 = cnt; if (q == 8 + wave) base1 = cnt; cnt += c; }
            if (myslot[0] >= 0) listS[base0 + mypre[0]] = ((r * 1024 + tid) << 2) | myslot[0];
            if (myslot[1] >= 0) listS[base1 + mypre[1]] = ((r * 1024 + 512 + tid) << 2) | myslot[1];
            asm volatile("s_waitcnt vmcnt(0)" ::: "memory");
            __syncthreads();
            const int ql = lane & 15, kg = lane >> 4, sw = ql & 7;
            for (int ch = 0; ch * 128 < cnt; ++ch) {
                const int e = ch * 128 + wave * 16 + ql; const bool has = e < cnt; const int ent = listS[has ? e : 0]; const int tq = ent >> 2, slot = ent & 3;
                bf16x8 qf[2];
                qf[0] = *(const bf16x8*)(QB + (size_t)tq * 512 + h * 64 + kg * 8); qf[1] = *(const bf16x8*)(QB + (size_t)tq * 512 + h * 64 + 32 + kg * 8);
                float mrun = -1e30f, lrun = 0.f; f32x4 O[4];
#pragma unroll
                for (int d = 0; d < 4; ++d) O[d] = (f32x4){0.f, 0.f, 0.f, 0.f};
#pragma unroll
                for (int ij = 0; ij < 4; ++ij) {
                    const LAS unsigned char* Kc = ring + ij * 16384; const LAS unsigned char* Vc = Kc + 8192;
                    bf16x8 kfr[4][2];
#pragma unroll
                    for (int kt = 0; kt < 4; ++kt)
#pragma unroll
                        for (int c = 0; c < 2; ++c) kfr[kt][c] = *(const LAS bf16x8*)(Kc + (kt * 16 + ql) * 128 + (((c * 4 + kg) ^ sw) << 4));
                    u32x2 vfr[2][4][2];
#pragma unroll
                    for (int kc = 0; kc < 2; ++kc)
#pragma unroll
                        for (int d = 0; d < 4; ++d) { const LAS unsigned char* vr = Vc + (d * 16 + ql) * 128 + (kg & 1) * 8; const int sg = kc * 4 + (kg >> 1);
                            vfr[kc][d][0] = *(const LAS u32x2*)(vr + ((sg ^ sw) << 4)); vfr[kc][d][1] = *(const LAS u32x2*)(vr + (((sg + 2) ^ sw) << 4)); }
                    __builtin_amdgcn_sched_barrier(0);
                    f32x4 Sx[4];
#pragma unroll
                    for (int kt = 0; kt < 4; ++kt) Sx[kt] = __builtin_amdgcn_mfma_f32_16x16x32_bf16(kfr[kt][0], qf[0], (f32x4){0.f, 0.f, 0.f, 0.f}, 0, 0, 0);
#pragma unroll
                    for (int kt = 0; kt < 4; ++kt) Sx[kt] = __builtin_amdgcn_mfma_f32_16x16x32_bf16(kfr[kt][1], qf[1], Sx[kt], 0, 0, 0);
                    float mx = fmaxf(fmaxf(fmaxf(Sx[0][0], Sx[0][1]), fmaxf(Sx[0][2], Sx[0][3])), fmaxf(fmaxf(Sx[1][0], Sx[1][1]), fmaxf(Sx[1][2], Sx[1][3])));
                    mx = fmaxf(mx, fmaxf(fmaxf(fmaxf(Sx[2][0], Sx[2][1]), fmaxf(Sx[2][2], Sx[2][3])), fmaxf(fmaxf(Sx[3][0], Sx[3][1]), fmaxf(Sx[3][2], Sx[3][3]))));
                    mx = fmaxf(mx, __shfl_xor(mx, 16)); mx = fmaxf(mx, __shfl_xor(mx, 32));
                    const float mnew = fmaxf(mrun, mx); const float alpha = __builtin_amdgcn_exp2f(mrun - mnew); mrun = mnew;
                    float rs = 0.f;
#pragma unroll
                    for (int kt = 0; kt < 4; ++kt)
#pragma unroll
                        for (int jj = 0; jj < 4; ++jj) { const float p = __builtin_amdgcn_exp2f(Sx[kt][jj] - mnew); Sx[kt][jj] = p; rs += p; }
                    lrun = lrun * alpha + rs;
#pragma unroll
                    for (int d = 0; d < 4; ++d) O[d] *= alpha;
#pragma unroll
                    for (int kc = 0; kc < 2; ++kc) {
                        u32x4 pw; pw.x = cvt_pk_bf16(Sx[2 * kc][0], Sx[2 * kc][1]); pw.y = cvt_pk_bf16(Sx[2 * kc][2], Sx[2 * kc][3]); pw.z = cvt_pk_bf16(Sx[2 * kc + 1][0], Sx[2 * kc + 1][1]); pw.w = cvt_pk_bf16(Sx[2 * kc + 1][2], Sx[2 * kc + 1][3]);
                        const bf16x8 pb = __builtin_bit_cast(bf16x8, pw);
#pragma unroll
                        for (int d = 0; d < 4; ++d) { u32x4 vw; vw.x = vfr[kc][d][0].x; vw.y = vfr[kc][d][0].y; vw.z = vfr[kc][d][1].x; vw.w = vfr[kc][d][1].y;
                            O[d] = __builtin_amdgcn_mfma_f32_16x16x32_bf16(__builtin_bit_cast(bf16x8, vw), pb, O[d], 0, 0, 0); }
                    }
                }
                lrun += __shfl_xor(lrun, 16); lrun += __shfl_xor(lrun, 32);
                if (has) { float* pp = PART + ((size_t)(tq * 8 + h) * 4 + slot) * 36;
#pragma unroll
                    for (int d = 0; d < 4; ++d) { u32x2 w; w.x = cvt_pk_bf16(O[d][0], O[d][1]); w.y = cvt_pk_bf16(O[d][2], O[d][3]); *(u32x2*)(pp + d * 8 + 2 * kg) = w; }
                    if (kg == 0) { pp[32] = mrun; pp[33] = lrun; } }
            }
            __syncthreads();
        }
        }
        fast_barrier(BAR, ++bar_epoch, (unsigned)G);
        { int tid = tid0; asm volatile("" : "+v"(tid)); const int lane = tid & 63; (void)lane;
        for (int t = bid * 8 + wave; t < SEQ; t += G * 8) {
            const int h = lane >> 3, dg = (lane & 7) * 8; const int qb = t >> 8; const int nv = qb < 3 ? qb : 3;
            const float* pp = PART + ((size_t)(t * 8 + h) * 4) * 36;
            const float m3 = pp[3 * 36 + 32], l3 = pp[3 * 36 + 33];
            float mk[3], lk[3]; float M = m3;
#pragma unroll
            for (int q = 0; q < 3; ++q) { mk[q] = q < nv ? pp[q * 36 + 32] : -1e30f; lk[q] = q < nv ? pp[q * 36 + 33] : 0.f; M = fmaxf(M, mk[q]); }
            const float w3 = __builtin_amdgcn_exp2f(m3 - M); float L = w3 * l3;
            float acc8[8];
            { float z[8]; unpack8(*(const u32x4*)(pp + 3 * 36 + (dg >> 1)), z);
#pragma unroll
              for (int e = 0; e < 8; ++e) acc8[e] = z[e] * w3; }
#pragma unroll
            for (int q = 0; q < 3; ++q) if (q < nv) { const float wq = __builtin_amdgcn_exp2f(mk[q] - M); L += wq * lk[q];
                float z[8]; unpack8(*(const u32x4*)(pp + q * 36 + (dg >> 1)), z);
#pragma unroll
                for (int e = 0; e < 8; ++e) acc8[e] += z[e] * wq; }
            const f32x4 a0 = (f32x4){acc8[0], acc8[1], acc8[2], acc8[3]}, a1 = (f32x4){acc8[4], acc8[5], acc8[6], acc8[7]};
            const float il = 1.f / L;
            u32x4 w; w.x = cvt_pk_bf16(a0[0] * il, a0[1] * il); w.y = cvt_pk_bf16(a0[2] * il, a0[3] * il); w.z = cvt_pk_bf16(a1[0] * il, a1[1] * il); w.w = cvt_pk_bf16(a1[2] * il, a1[3] * il);
            *(u32x4*)(Y + (size_t)t * DM + 1024 + h * 64 + dg) = w;
        }
        for (int unit = bid; unit < 512; unit += G) {
            const int c = unit >> 2, h = unit & 3, t0 = c * 64;
            LAS float* qtT = (LAS float*)lds;
            LAS float* Sd = (LAS float*)(lds + 16384);
            LAS float* red = (LAS float*)(lds + 49152);
            for (int i = 0; i < 8; ++i) { const int idx = tid + 512 * i; const int t = idx >> 6, d = idx & 63; qtT[d * 64 + t] = QT[(size_t)(t0 + t) * 256 + h * 64 + d]; }
            { const f32x4* ss = (const f32x4*)(GU + (size_t)(c * 4 + h) * 8192);
#pragma unroll
              for (int i = 0; i < 4; ++i) *(LAS f32x4*)(Sd + (tid + 512 * i) * 4) = ss[tid + 512 * i]; }
            __syncthreads();
            const int x0 = (tid & 15) * 4, e0 = (tid >> 4) * 4; float o[4][4];
#pragma unroll
            for (int i = 0; i < 4; ++i) { const f32x4 v = *(const f32x4*)(OI + (size_t)(t0 + x0 + i) * 512 + h * 128 + e0); o[i][0] = v[0]; o[i][1] = v[1]; o[i][2] = v[2]; o[i][3] = v[3]; }
            for (int d0 = 0; d0 < 64; d0 += 8) { f32x4 qv[8], sv[8];
#pragma unroll
                for (int q = 0; q < 8; ++q) { qv[q] = *(const LAS f32x4*)(qtT + (d0 + q) * 64 + x0); sv[q] = *(const LAS f32x4*)(Sd + (d0 + q) * 128 + e0); }
                __builtin_amdgcn_sched_barrier(0);
#pragma unroll
                for (int q = 0; q < 8; ++q)
#pragma unroll
                    for (int i = 0; i < 4; ++i)
#pragma unroll
                        for (int j = 0; j < 4; ++j) o[i][j] += qv[q][i] * sv[q][j];
                __builtin_amdgcn_sched_barrier(0); }
#pragma unroll
            for (int i = 0; i < 4; ++i) red[(x0 + i) * 32 + (tid >> 4)] = (o[i][0] * o[i][0] + o[i][1] * o[i][1]) + (o[i][2] * o[i][2] + o[i][3] * o[i][3]);
            __syncthreads();
            const float* ng = args.in[I_DNG] + l * 128 + e0;
#pragma unroll
            for (int i = 0; i < 4; ++i) { const int t = t0 + x0 + i; float s = 0.f;
#pragma unroll
                for (int j = 0; j < 8; ++j) { const f32x4 v = *(const LAS f32x4*)(red + (x0 + i) * 32 + j * 4); s += (v[0] + v[1]) + (v[2] + v[3]); }
                const float rs = rsqrtf(s * (1.f / 128.f) + EPS);
                const bf16_t* og = P + (size_t)t * NINP + PC_D + 1040 + h * 128 + e0; const u32x2 raw = *(const u32x2*)og;
                const float g0 = bflo(raw.x), g1 = bfhi(raw.x), g2 = bflo(raw.y), g3 = bfhi(raw.y);
                const float y0 = o[i][0] * rs * ng[0] * (g0 * sigmoidf_(g0)), y1 = o[i][1] * rs * ng[1] * (g1 * sigmoidf_(g1)), y2 = o[i][2] * rs * ng[2] * (g2 * sigmoidf_(g2)), y3 = o[i][3] * rs * ng[3] * (g3 * sigmoidf_(g3));
                u32x2 w; w.x = cvt_pk_bf16(y0, y1); w.y = cvt_pk_bf16(y2, y3);
                *(u32x2*)(Y + (size_t)t * DM + 1536 + h * 128 + e0) = w; }
            __syncthreads();
        }
        if (wave < 4) {
            const int u = bid * 4 + wave;
            if (u < 1024) {
                const int h = u >> 7, c = u & 127; const size_t tb = (size_t)h * SEQ + c * 64; const int tbase = c * 64;
                LAS float* buf = (LAS float*)(lds + wave * 10240);
                const f32x4* src = (const f32x4*)(VEC5 + tb * 320);
                const float* vsrc = VV + tb * 64 + lane;
                const int ch = h * 64 + lane;
                const float lg = args.in[I_BLNG][l * 512 + ch], lbias = args.in[I_BLNB][l * 512 + ch];
                const float* bvp = BV + (size_t)tbase * 512 + ch; const float* ggp = GG + (size_t)tbase * 512 + ch;
                f32x2 St[32];
                { const f32x4* si = (const f32x4*)(SIN + ((size_t)u * 64 + lane) * 64);
#pragma unroll
                  for (int k4 = 0; k4 < 16; ++k4) { const f32x4 v = si[k4]; St[2 * k4] = RWKV_LO(v); St[2 * k4 + 1] = RWKV_HI(v); } }
                float vn[4];
#pragma unroll
                for (int j = 0; j < 5; ++j) __builtin_amdgcn_global_load_lds((const unsigned*)(src + j * 64 + lane), (LAS unsigned*)(buf + j * 256), 16, 0, 0);
#pragma unroll
                for (int j = 0; j < 4; ++j) vn[j] = vsrc[j * 64];
                asm volatile("s_waitcnt vmcnt(0)" ::: "memory");
                for (int b = 0; b < 16; ++b) {
                    const float vc0 = vn[0], vc1 = vn[1], vc2 = vn[2], vc3 = vn[3];
                    float bvc[4], ggc[4];
#pragma unroll
                    for (int j = 0; j < 4; ++j) { bvc[j] = bvp[(b * 4 + j) * 512]; ggc[j] = ggp[(b * 4 + j) * 512]; }
                    float yv0 = 0.f, yv1 = 0.f, yv2 = 0.f, yv3 = 0.f;
                    if (b + 1 < 16) { LAS float* nb = buf + ((b + 1) & 1) * 1280;
#pragma unroll
                        for (int j = 0; j < 5; ++j) __builtin_amdgcn_global_load_lds((const unsigned*)(src + (b + 1) * 320 + j * 64 + lane), (LAS unsigned*)(nb + j * 256), 16, 0, 0);
#pragma unroll
                        for (int j = 0; j < 4; ++j) vn[j] = vsrc[((b + 1) * 4 + j) * 64];
                    }
                    const LAS float* cb = buf + (b & 1) * 1280;
#pragma unroll 1
                    for (int s = 0; s < 4; ++s) {
                        const LAS float* st = cb + s * 320;
                        const float vi = s == 0 ? vc0 : (s == 1 ? vc1 : (s == 2 ? vc2 : vc3));
                        float yy; RWKV_STEP(st, vi, St, true, true, yy);
                        yv0 = s == 0 ? yy : yv0; yv1 = s == 1 ? yy : yv1; yv2 = s == 2 ? yy : yv2; yv3 = s == 3 ? yy : yv3;
                    }
                    asm volatile("s_waitcnt vmcnt(0)" ::: "memory");
                    const float yv[4] = {yv0, yv1, yv2, yv3};
                    float st8[8] = {yv[0], yv[1], yv[2], yv[3], yv[0] * yv[0], yv[1] * yv[1], yv[2] * yv[2], yv[3] * yv[3]};
                    wave_sum_n<8>(st8);
#pragma unroll
                    for (int s = 0; s < 4; ++s) { const int t = tbase + b * 4 + s;
                        const float m = st8[s] * (1.f / 64.f); const float var = fmaxf(st8[4 + s] * (1.f / 64.f) - m * m, 0.f);
                        const float yn = (yv[s] - m) * rsqrtf(var + 64e-5f) * lg + lbias;
                        Y[(size_t)t * DM + 512 + ch] = f2bf((yn + bvc[s]) * ggc[s]); }
                }
            }
        } else if (G >= 256) {
            LAS float* scr = (LAS float*)(lds + 49152 + (wave - 4) * 16896);
            convert_layer_weights(args, ws, l, scr, bid * 4 + (wave - 4), G * 4, lane, 9600, 12416);
            if (l == 0) convert_layer_weights(args, ws, 1, scr, bid * 4 + (wave - 4), G * 4, lane, 0, 3968);
        }
        }
        fast_barrier(BAR, ++bar_epoch, (unsigned)G);
        { int tid = tid0; asm volatile("" : "+v"(tid)); const int lane = tid & 63; (void)lane;
        {
            pg8::Gemm g{Y, (const bf16_t*)(wt + WT_OUT), SEQ, DM, DM, 256}; pg8::StaticOrder S; S.init(SEQ, DM, G, bid);
            pg8::EpiResid E{l == 0 ? args.in[I_X] : (const float*)XR, XR, XB, SSQ, lds};
            pg8::gemm_phase<pg8::EpiResid>(lds, g, S, E);
        }
        }
        fast_barrier(BAR, ++bar_epoch, (unsigned)G);
        { int tid = tid0; asm volatile("" : "+v"(tid)); const int lane = tid & 63; (void)lane;
        {
            pg8::Gemm g{XB, (const bf16_t*)(wt + WT_UP), 33 * 256, NUP, DM, 254}; pg8::StaticOrder S; S.init(33 * 256, NUP, G, bid);
            pg8::EpiConvSwiGLU E{ACT, SSQ, args.in[I_CONVW] + (size_t)l * 3 * NUP, args.in[I_CONVB] + (size_t)l * NUP};
            pg8::Unit uu;
            for (int i = 0; S.next(i, uu); ++i) { pg8::OneUnit one{uu}; pg8::gemm_phase<pg8::EpiConvSwiGLU, pg8::OneUnit>(lds, g, one, E); }
        }
        }
        fast_barrier(BAR, ++bar_epoch, (unsigned)G);
        { int tid = tid0; asm volatile("" : "+v"(tid)); const int lane = tid & 63; (void)lane;
        {
            pg8::Gemm g{ACT, (const bf16_t*)(wt + WT_DOWN), SEQ, DM, DFF, 256}; pg8::StaticOrder S; S.init(SEQ, DM, G, bid);
            pg8::EpiResid E{(const float*)XR, XR, XB, SSQ, lds};
            pg8::gemm_phase<pg8::EpiResid>(lds, g, S, E);
        }
        }
        fast_barrier(BAR, ++bar_epoch, (unsigned)G);
    }
        { int tid = tid0; asm volatile("" : "+v"(tid)); const int lane = tid & 63; (void)lane;
    {
        const float* fg = args.in[I_FING];
        for (int row = gw; row < SEQ; row += NGW) {
            float s = SSQ[(size_t)row * 8 + (lane & 7)]; s = wave_sum(s) * 0.125f;
            const float rs = rsqrtf(s * (1.f / 2048.f) + EPS);
            f32x4* xr = (f32x4*)(XR + (size_t)row * DM) + lane; const f32x4* gp = (const f32x4*)fg + lane;
#pragma unroll
            for (int j = 0; j < 8; ++j) { f32x4 v = xr[64 * j]; const f32x4 gv = gp[64 * j]; v = v * rs * gv; xr[64 * j] = v; }
        }
    }
        }
}

extern "C" void kernel_launch(void* const* d_in, const int* in_sizes, int n_in, void* d_out, int out_size, void* d_ws, size_t ws_size, hipStream_t stream) {
    static int grid = 0;
    if (grid == 0) {
        if (n_in != 28 || ws_size < WS_END) { fprintf(stderr, "kernel_launch: unexpected n_in %d / ws_size %zu\n", n_in, ws_size); grid = -1; return; }
        int dev = 0, cus = 0, per_cu = 0;
        hipGetDevice(&dev); hipDeviceGetAttribute(&cus, hipDeviceAttributeMultiprocessorCount, dev);
        hipFuncSetAttribute((const void*)mega_fwd, hipFuncAttributeMaxDynamicSharedMemorySize, LDS_BYTES);
        hipOccupancyMaxActiveBlocksPerMultiprocessor(&per_cu, (const void*)mega_fwd, 512, LDS_BYTES);
        if (per_cu < 1) { fprintf(stderr, "kernel_launch: occupancy query says %d blocks/CU\n", per_cu); per_cu = 1; }
        grid = cus * (per_cu > 1 ? 1 : per_cu);
    }
    if (grid < 0) return;
    (void)hipMemsetAsync(d_ws, 0, 8192, stream);
    Args a{};
    for (int i = 0; i < 28; ++i) a.in[i] = (const float*)d_in[i];
    a.out = (float*)d_out; a.ws = (unsigned char*)d_ws;
    void* kargs[] = {&a};
    hipError_t e = hipLaunchCooperativeKernel((const void*)mega_fwd, dim3(grid), dim3(512), kargs, LDS_BYTES, stream);
    if (e != hipSuccess) fprintf(stderr, "cooperative launch failed: %s (grid %d)\n", hipGetErrorString(e), grid);
}
```

```cpp
#include <hip/hip_runtime.h>
#include <hip/hip_cooperative_groups.h>
#include <cstdio>
#include <cstdint>
namespace cg = cooperative_groups;

#define LAS __attribute__((address_space(3)))
typedef unsigned short bf16_t;
typedef short bf16x8 __attribute__((ext_vector_type(8)));
typedef float f32x4 __attribute__((ext_vector_type(4)));
typedef float f32x2 __attribute__((ext_vector_type(2)));
typedef unsigned u32x4 __attribute__((ext_vector_type(4)));
typedef unsigned u32x2 __attribute__((ext_vector_type(2)));

constexpr int SEQ = 8192, DM = 2048, NIN = 5808, NINP = 5888, DFF = 5632, NUP = 11264;
constexpr int PC_A = 0, PC_B = 1024, PC_C = 2720, PC_D = 4256;
constexpr float EPS = 1e-6f;
constexpr float QSCALE = 0.125f * 1.4426950408889634f;

constexpr size_t MiB = 1u << 20;
constexpr size_t WS_ROPE = 1 * MiB, WS_SSQ = 3 * MiB, WS_KMEAN = 4 * MiB, WS_IDZ = 5 * MiB, WS_SEL = 6 * MiB, WS_WT = 8 * MiB;
constexpr size_t WT_IN = 0, WT_OUT = 23 * MiB, WT_UP = 31 * MiB, WT_DOWN = 75 * MiB, WT_LAYER = 97 * MiB;
constexpr size_t WS_XB = 202 * MiB, WS_Y = 234 * MiB, WS_P = 266 * MiB;
constexpr size_t WS_QB = 358 * MiB, WS_KB = 366 * MiB, WS_VT = 374 * MiB, WS_VEC5 = 382 * MiB, WS_VV = 462 * MiB, WS_GG = 478 * MiB, WS_BV = 494 * MiB;
constexpr size_t WS_PCH = 510 * MiB, WS_LCH = 526 * MiB, WS_SIN = 542 * MiB, WS_OI = 558 * MiB, WS_U = 574 * MiB, WS_QT = 590 * MiB, WS_LAM = 598 * MiB;
constexpr size_t WS_PART = 600 * MiB, WS_H = 266 * MiB, WS_ACT = 442 * MiB, WS_END = 640 * MiB;
constexpr int LDS_BYTES = 147456;

__device__ __forceinline__ float bf2f(bf16_t v) { return __uint_as_float((unsigned)v << 16); }
__device__ __forceinline__ float bflo(unsigned u) { return __uint_as_float(u << 16); }
__device__ __forceinline__ float bfhi(unsigned u) { return __uint_as_float(u & 0xffff0000u); }
__device__ __forceinline__ unsigned cvt_pk_bf16(float lo, float hi) { unsigned r; asm volatile("v_cvt_pk_bf16_f32 %0, %1, %2" : "=v"(r) : "v"(lo), "v"(hi)); return r; }
__device__ __forceinline__ bf16_t f2bf(float f) { return (bf16_t)(cvt_pk_bf16(f, 0.f) & 0xffffu); }
__device__ __forceinline__ float wave_sum(float v) {
#pragma unroll
    for (int o = 32; o > 0; o >>= 1) v += __shfl_xor(v, o);
    return v;
}

template <int N> __device__ __forceinline__ void wave_sum_n(float (&v)[N]) {
#pragma unroll
    for (int o = 32; o > 0; o >>= 1) { float t[N];
#pragma unroll
        for (int i = 0; i < N; ++i) t[i] = __shfl_xor(v[i], o);
#pragma unroll
        for (int i = 0; i < N; ++i) v[i] += t[i]; }
}
__device__ __forceinline__ float sigmoidf_(float x) { return __builtin_amdgcn_rcpf(1.f + __expf(-x)); }
__device__ __forceinline__ float gelu_tanh(float x) { const float u = 0.7978845608f * (x + 0.044715f * x * x * x); const float e = __expf(2.f * u); const float th = 1.f - 2.f * __builtin_amdgcn_rcpf(e + 1.f); return 0.5f * x * (1.f + th); }
__device__ __forceinline__ void unpack8(const u32x4 r, float (&z)[8]) { z[0] = bflo(r.x); z[1] = bfhi(r.x); z[2] = bflo(r.y); z[3] = bfhi(r.y); z[4] = bflo(r.z); z[5] = bfhi(r.z); z[6] = bflo(r.w); z[7] = bfhi(r.w); }

__device__ __forceinline__ void fast_barrier(unsigned* bar, unsigned epoch  , unsigned G) {
    asm volatile("s_waitcnt vmcnt(0) lgkmcnt(0)" ::: "memory");
    __syncthreads();
    if (threadIdx.x == 0) {
        __builtin_amdgcn_fence(__ATOMIC_RELEASE, "agent");
        asm volatile("s_waitcnt vmcnt(0)" ::: "memory");
        const unsigned grp = blockIdx.x & 7u; const unsigned gsz = (G - grp + 7u) >> 3; const unsigned ngrp = G < 8u ? G : 8u;
        const unsigned old = __hip_atomic_fetch_add(bar + 64u * (1u + grp), 1u, __ATOMIC_RELAXED, __HIP_MEMORY_SCOPE_AGENT);
        if (old + 1u == epoch * gsz) __hip_atomic_fetch_add(bar, 1u, __ATOMIC_RELAXED, __HIP_MEMORY_SCOPE_AGENT);
        unsigned spins = 0;
        while (__hip_atomic_load(bar, __ATOMIC_RELAXED, __HIP_MEMORY_SCOPE_AGENT) < epoch * ngrp) { __builtin_amdgcn_s_sleep(1); if (++spins > (1u << 26)) break; }
        __builtin_amdgcn_fence(__ATOMIC_ACQUIRE, "agent");
        asm volatile("s_waitcnt vmcnt(0)" ::: "memory");
    }
    __syncthreads();
}

namespace pg8 {
constexpr int BM = 256, BK = 64, HALF = 128, HTB = HALF * BK * 2, STAGE_BYTES = 8 * HTB, NXCD = 8, WGM = 8;
__host__ __device__ __forceinline__ int lds_byte(int r, int c) { const int st = (r >> 4) * 2 + (c >> 5), rr = r & 15, cc = c & 31, ob = rr * 64 + cc * 2; return st * 1024 + (ob ^ (((ob >> 9) & 1) << 5)); }
__host__ __device__ __forceinline__ void stage_rc(int b, int& R, int& C) { const int st = b / 1024, sb = b % 1024, swz = sb ^ (((sb >> 9) & 1) << 5); R = (st >> 1) * 16 + swz / 64; C = (st & 1) * 32 + (swz % 64) / 2; }
__host__ __device__ __forceinline__ int perm32(int rho) { const int n = rho >> 4, i = rho & 15; return 8 * (i >> 2) + 4 * n + (i & 3); }
struct Unit { int pm, pn; };
struct Gemm { const bf16_t* A; const bf16_t* Bt; int M, N, K; int a_step_rows; };
struct OneUnit { Unit u; __device__ __forceinline__ bool next(int i, Unit& o) const { if (i) return false; o = u; return true; } };
struct StaticOrder {
    int nM, nN, nwg, G, c;
    __device__ __forceinline__ void init(int M, int N, int G_, int c_) { nM = M / BM; nN = N / BM; nwg = nM * nN; G = G_; c = c_; }
    __device__ __forceinline__ bool next(int i, Unit& u) const {
        const long L = (long)i * G + c; if (L >= nwg) return false;
        int wgid = (int)L; { const int q = nwg / NXCD, r = nwg % NXCD, xcd = wgid % NXCD, off = wgid / NXCD; wgid = (xcd < r ? xcd * (q + 1) : r * (q + 1) + (xcd - r) * q) + off; }
        const int nig = WGM * nN, gid = wgid / nig, fm = gid * WGM, gsz = (nM - fm) < WGM ? (nM - fm) : WGM;
        u.pm = fm + ((wgid % nig) % gsz); u.pn = (wgid % nig) / gsz; return true;
    }
};
struct EpiScaleBf16 {
    static constexpr bool AFTER_DRAIN = false;
    bf16_t* O; int ldc; const float* ssq;
    __device__ __forceinline__ void operator()(const f32x4 (&acc)[2][2][4][2], const Unit& u, int wr, int wc, int fr, int fq) const {
        const int row0 = u.pm * BM + wr * 64 + fr; const int col0 = u.pn * BM + wc * 32 + 8 * fq;
#pragma unroll
        for (int ai = 0; ai < 2; ++ai)
#pragma unroll
            for (int m = 0; m < 4; ++m) {
                const int row = row0 + ai * HALF + m * 16;
                const f32x4* sp = (const f32x4*)(ssq + (size_t)row * 8);
                f32x4 s4 = sp[0] + sp[1];
                const float rs = rsqrtf(((s4[0] + s4[1]) + (s4[2] + s4[3])) * (1.0f / 2048.0f) + EPS);
                bf16_t* rowp = O + (size_t)row * ldc + col0;
#pragma unroll
                for (int bj = 0; bj < 2; ++bj) { const f32x4 v0 = acc[ai][bj][m][0] * rs, v1 = acc[ai][bj][m][1] * rs;
                    u32x4 w; w.x = cvt_pk_bf16(v0[0], v0[1]); w.y = cvt_pk_bf16(v0[2], v0[3]); w.z = cvt_pk_bf16(v1[0], v1[1]); w.w = cvt_pk_bf16(v1[2], v1[3]);
                    *(u32x4*)(rowp + bj * HALF) = w; }
            }
    }
};
struct EpiResid {
    static constexpr bool AFTER_DRAIN = false;
    const float* base; float* xr; bf16_t* xb; float* ssq; LAS unsigned char* lds;
    __device__ __forceinline__ void operator()(const f32x4 (&acc)[2][2][4][2], const Unit& u, int wr, int wc, int fr, int fq) const {
        const int row0 = u.pm * BM + wr * 64 + fr; const int col0 = u.pn * BM + wc * 32 + 8 * fq;
        LAS float* xq = (LAS float*)(lds + 131072);
#pragma unroll
        for (int ai = 0; ai < 2; ++ai)
#pragma unroll
            for (int m = 0; m < 4; ++m) {
                const int row = row0 + ai * HALF + m * 16; float q = 0.f;
#pragma unroll
                for (int bj = 0; bj < 2; ++bj) { const size_t off = (size_t)row * DM + col0 + bj * HALF;
                    const f32x4 b0 = *(const f32x4*)(base + off), b1 = *(const f32x4*)(base + off + 4);
                    const f32x4 v0 = acc[ai][bj][m][0] + b0, v1 = acc[ai][bj][m][1] + b1;
                    *(f32x4*)(xr + off) = v0; *(f32x4*)(xr + off + 4) = v1;
                    u32x4 w; w.x = cvt_pk_bf16(v0[0], v0[1]); w.y = cvt_pk_bf16(v0[2], v0[3]); w.z = cvt_pk_bf16(v1[0], v1[1]); w.w = cvt_pk_bf16(v1[2], v1[3]);
                    *(u32x4*)(xb + off) = w;
                    q += (v0[0] * v0[0] + v0[1] * v0[1]) + (v0[2] * v0[2] + v0[3] * v0[3]) + (v1[0] * v1[0] + v1[1] * v1[1]) + (v1[2] * v1[2] + v1[3] * v1[3]); }
                q += __shfl_xor(q, 16); q += __shfl_xor(q, 32);
                if (fq == 0) xq[(ai * HALF + wr * 64 + m * 16 + fr) * 4 + wc] = q;
            }
        asm volatile("s_waitcnt lgkmcnt(0)" ::: "memory"); __builtin_amdgcn_s_barrier(); asm volatile("" ::: "memory");
        { const int tid_ = (wr * 4 + wc) * 64 + fq * 16 + fr;
          if (tid_ < 256) { const f32x4 v = *(const LAS f32x4*)(xq + tid_ * 4); ssq[(size_t)(u.pm * BM + tid_) * 8 + u.pn] = (v[0] + v[1]) + (v[2] + v[3]); } }
    }
};

struct EpiConvSwiGLU {
    static constexpr bool AFTER_DRAIN = true;
    bf16_t* act; const float* ssq; const float* cw; const float* cb;
    __device__ __forceinline__ void fused(const f32x4 (&acc)[2][2][4][2], const Unit& u, int wr, int wc, int fr, int fq, LAS unsigned char* lds) const {
        const int rs = u.pm * 254;
#pragma unroll
        for (int ai = 0; ai < 2; ++ai)
#pragma unroll
            for (int m = 0; m < 4; ++m) {
                const int lr = ai * HALF + wr * 64 + m * 16 + fr; int row = rs + lr; row = row < SEQ ? row : SEQ - 1;
                const f32x4* sp = (const f32x4*)(ssq + (size_t)row * 8);
                const f32x4 s4 = sp[0] + sp[1];
                const float rsd = rsqrtf(((s4[0] + s4[1]) + (s4[2] + s4[3])) * (1.0f / 2048.0f) + EPS);
#pragma unroll
                for (int bj = 0; bj < 2; ++bj) { const f32x4 v0 = acc[ai][bj][m][0] * rsd, v1 = acc[ai][bj][m][1] * rsd;
                    u32x4 w; w.x = cvt_pk_bf16(v0[0], v0[1]); w.y = cvt_pk_bf16(v0[2], v0[3]); w.z = cvt_pk_bf16(v1[0], v1[1]); w.w = cvt_pk_bf16(v1[2], v1[3]);
                    const int c = 16 * bj + 4 * wc + fq;
                    *(LAS u32x4*)(lds + lr * 512 + ((c ^ ((lr & 7) << 2)) << 4)) = w; }
            }
        asm volatile("s_waitcnt lgkmcnt(0)" ::: "memory"); __builtin_amdgcn_s_barrier(); asm volatile("" ::: "memory");
        const int tid_ = (wr * 4 + wc) * 64 + fq * 16 + fr; const int cgp = tid_ & 15, rr = tid_ >> 4;
        const int j0 = u.pn * 128 + cgp * 8;
        float wg[3][8], wu[3][8], bg[8], bu[8];
#pragma unroll
        for (int k = 0; k < 3; ++k) { const f32x4 a0 = *(const f32x4*)(cw + (size_t)k * NUP + j0), a1 = *(const f32x4*)(cw + (size_t)k * NUP + j0 + 4), b0 = *(const f32x4*)(cw + (size_t)k * NUP + DFF + j0), b1 = *(const f32x4*)(cw + (size_t)k * NUP + DFF + j0 + 4);
#pragma unroll
            for (int e = 0; e < 4; ++e) { wg[k][e] = a0[e]; wg[k][4 + e] = a1[e]; wu[k][e] = b0[e]; wu[k][4 + e] = b1[e]; } }
        { const f32x4 a0 = *(const f32x4*)(cb + j0), a1 = *(const f32x4*)(cb + j0 + 4), b0 = *(const f32x4*)(cb + DFF + j0), b1 = *(const f32x4*)(cb + DFF + j0 + 4);
#pragma unroll
          for (int e = 0; e < 4; ++e) { bg[e] = a0[e]; bg[4 + e] = a1[e]; bu[e] = b0[e]; bu[4 + e] = b1[e]; } }
#pragma unroll 1
        for (int hh = 0; hh < 2; ++hh) {
            u32x4 hg[6], hu[6];
#pragma unroll
            for (int i = 0; i < 6; ++i) { const int lr = 8 * rr + 4 * hh - 2 + i;
                if (lr >= 0) { const int sw = (lr & 7) << 2; hg[i] = *(const LAS u32x4*)(lds + lr * 512 + ((cgp ^ sw) << 4)); hu[i] = *(const LAS u32x4*)(lds + lr * 512 + (((16 + cgp) ^ sw) << 4)); }
                else { hg[i] = (u32x4){0u, 0u, 0u, 0u}; hu[i] = (u32x4){0u, 0u, 0u, 0u}; } }
#pragma unroll
            for (int i = 0; i < 4; ++i) { const int lo = 8 * rr + 4 * hh + i; const int grow = rs + lo;
                float g2[8], g1[8], g0[8], u2[8], u1[8], u0[8];
                unpack8(hg[i], g2); unpack8(hg[i + 1], g1); unpack8(hg[i + 2], g0); unpack8(hu[i], u2); unpack8(hu[i + 1], u1); unpack8(hu[i + 2], u0);
                float o[8];
#pragma unroll
                for (int e = 0; e < 8; ++e) { const float ag = bg[e] + wg[0][e] * g2[e] + wg[1][e] * g1[e] + wg[2][e] * g0[e]; const float au = bu[e] + wu[0][e] * u2[e] + wu[1][e] * u1[e] + wu[2][e] * u0[e];
                    o[e] = ag * sigmoidf_(ag) * au; }
                u32x4 w; w.x = cvt_pk_bf16(o[0], o[1]); w.y = cvt_pk_bf16(o[2], o[3]); w.z = cvt_pk_bf16(o[4], o[5]); w.w = cvt_pk_bf16(o[6], o[7]);
                if ((u.pm == 0 || lo >= 2) && grow < SEQ) *(u32x4*)(act + (size_t)grow * DFF + j0) = w; }
        }
        asm volatile("s_waitcnt lgkmcnt(0)" ::: "memory"); __builtin_amdgcn_s_barrier(); asm volatile("" ::: "memory");
    }
};

template <class Epi, class Sched>
__device__ __forceinline__ void gemm_phase(LAS unsigned char* lds, const Gemm g, const Sched& S, const Epi& E) {
    int tid = threadIdx.x; asm volatile("" : "+v"(tid)); const int wid = __builtin_amdgcn_readfirstlane(tid >> 6), lane = tid & 63, wr = wid >> 2, wc = wid & 3, fr = lane & 15, fq = lane >> 4;
    const int K = g.K, nt = K / BK;
    unsigned voffA[2], voffB[2];
#pragma unroll
    for (int i = 0; i < 2; ++i) { int R, C; stage_rc(tid * 16 + i * 8192, R, C); const int Rb = (R & ~31) + perm32(R & 31);
        voffA[i] = (unsigned)(R * K + C) * 2u; voffB[i] = (unsigned)(Rb * K + C) * 2u; }
    const size_t kstep = (size_t)(BK * 2);
    const size_t hstep = (size_t)HALF * K * 2;
    const size_t tstep = 2 * hstep;
    const size_t tstepA = (size_t)g.a_step_rows * K * 2;
    const unsigned ldsw = (unsigned)wid * 1024u;
    const int aoff = lds_byte(wr * 64 + fr, fq * 8), boff = lds_byte(wc * 32 + fr, fq * 8);
#define PG8_SA(b, h) (((b) * 2 + (h)) * HTB)
#define PG8_SB(b, h) ((4 + (b) * 2 + (h)) * HTB)
#define PG8_STAGE(bufoff, gbase, voff) do { _Pragma("unroll") for (int _i = 0; _i < 2; ++_i) \
        __builtin_amdgcn_global_load_lds((const unsigned*)((const char*)(gbase) + (voff)[_i]), (LAS unsigned*)(lds + (bufoff) + ldsw + _i * 8192), 16, 0, 0); } while (0)
#define PG8_LDA(dst, b, h) do { _Pragma("unroll") for (int m = 0; m < 4; ++m) _Pragma("unroll") for (int k = 0; k < 2; ++k) dst[m][k] = *(const LAS bf16x8*)(lds + PG8_SA(b, h) + aoff + m * 2048 + k * 1024); } while (0)
#define PG8_LDB(dst, b, h) do { _Pragma("unroll") for (int n = 0; n < 2; ++n) _Pragma("unroll") for (int k = 0; k < 2; ++k) dst[n][k] = *(const LAS bf16x8*)(lds + PG8_SB(b, h) + boff + n * 2048 + k * 1024); } while (0)
#define PG8_MMA(ai, bj, At, Bt) do { __builtin_amdgcn_s_setprio(1); _Pragma("unroll") for (int m = 0; m < 4; ++m) _Pragma("unroll") for (int n = 0; n < 2; ++n) _Pragma("unroll") for (int k = 0; k < 2; ++k) \
        acc[ai][bj][m][n] = __builtin_amdgcn_mfma_f32_16x16x32_bf16(Bt[n][k], At[m][k], acc[ai][bj][m][n], 0, 0, 0); __builtin_amdgcn_s_setprio(0); } while (0)
#define PG8_WAIT_V(n) asm volatile("s_waitcnt vmcnt(" #n ")" ::: "memory")
#define PG8_WAIT_L(n) asm volatile("s_waitcnt lgkmcnt(" #n ")" ::: "memory")
#define PG8_BAR __builtin_amdgcn_s_barrier()
#define PG8_SCHED __builtin_amdgcn_sched_barrier(0)
    Unit cur, nxt; int ui = 0;
    if (!S.next(0, cur)) return;
    f32x4 acc[2][2][4][2];
#pragma unroll
    for (int a = 0; a < 2; ++a)
#pragma unroll
        for (int b = 0; b < 2; ++b)
#pragma unroll
            for (int m = 0; m < 4; ++m)
#pragma unroll
                for (int n = 0; n < 2; ++n) acc[a][b][m][n] = (f32x4){0.f, 0.f, 0.f, 0.f};
    bf16x8 At[4][2], B0[2][2], B1[2][2];
    const char* cA = (const char*)g.A + (size_t)cur.pm * tstepA; const char* cB = (const char*)g.Bt + (size_t)cur.pn * tstep;
    PG8_STAGE(PG8_SB(0, 0), cB, voffB); PG8_STAGE(PG8_SB(0, 1), cB + hstep, voffB); PG8_STAGE(PG8_SA(0, 0), cA, voffA); PG8_STAGE(PG8_SA(0, 1), cA + hstep, voffA);
    if (wr == 1) PG8_BAR;
    PG8_WAIT_V(2); PG8_BAR;
    PG8_STAGE(PG8_SB(1, 0), cB + kstep, voffB); PG8_STAGE(PG8_SA(1, 0), cA + kstep, voffA); PG8_STAGE(PG8_SB(1, 1), cB + hstep + kstep, voffB);
    PG8_WAIT_V(6); PG8_BAR;
    for (;;) {
        const bool has_next = S.next(ui + 1, nxt);
        const char* nA = has_next ? (const char*)g.A + (size_t)nxt.pm * tstepA : cA; const char* nB = has_next ? (const char*)g.Bt + (size_t)nxt.pn * tstep : cB;
        for (int t = 0; t < nt; t += 2) {
            const bool last = (t == nt - 2);
            const char* a1 = cA + (size_t)(t + 1) * kstep;
            const char* a2 = last ? nA : cA + (size_t)(t + 2) * kstep; const char* b2 = last ? nB : cB + (size_t)(t + 2) * kstep;
            const char* a3 = a2 + kstep; const char* b3 = b2 + kstep;
            PG8_LDB(B0, 0, 0); PG8_LDB(B1, 0, 1); PG8_SCHED; PG8_LDA(At, 0, 0); PG8_STAGE(PG8_SA(1, 1), a1 + hstep, voffA);
            PG8_WAIT_V(8); PG8_WAIT_L(0); PG8_BAR; PG8_MMA(0, 0, At, B0); PG8_MMA(0, 1, At, B1); PG8_BAR; PG8_SCHED;
            PG8_LDA(At, 0, 1); PG8_STAGE(PG8_SB(0, 0), b2, voffB); PG8_STAGE(PG8_SB(0, 1), b2 + hstep, voffB); PG8_STAGE(PG8_SA(0, 0), a2, voffA);
            PG8_WAIT_V(8); PG8_WAIT_L(0); PG8_BAR; PG8_MMA(1, 0, At, B0); PG8_MMA(1, 1, At, B1); PG8_BAR; PG8_SCHED;
            PG8_LDB(B0, 1, 0); PG8_LDB(B1, 1, 1); PG8_SCHED; PG8_LDA(At, 1, 0); PG8_STAGE(PG8_SA(0, 1), a2 + hstep, voffA);
            PG8_WAIT_V(8); PG8_WAIT_L(0); PG8_BAR; PG8_MMA(0, 0, At, B0); PG8_MMA(0, 1, At, B1); PG8_BAR; PG8_SCHED;
            PG8_LDA(At, 1, 1); PG8_STAGE(PG8_SB(1, 0), b3, voffB); PG8_STAGE(PG8_SB(1, 1), b3 + hstep, voffB); PG8_STAGE(PG8_SA(1, 0), a3, voffA);
            PG8_WAIT_V(8); PG8_WAIT_L(0); PG8_BAR; PG8_MMA(1, 0, At, B0); PG8_MMA(1, 1, At, B1); PG8_BAR; PG8_SCHED;
        }
        if (wr == 0) PG8_BAR;
        if constexpr (!Epi::AFTER_DRAIN) E(acc, cur, wr, wc, fr, fq);
        if (!has_next) break;
#pragma unroll
        for (int a = 0; a < 2; ++a)
#pragma unroll
            for (int b = 0; b < 2; ++b)
#pragma unroll
                for (int m = 0; m < 4; ++m)
#pragma unroll
                    for (int n = 0; n < 2; ++n) acc[a][b][m][n] = (f32x4){0.f, 0.f, 0.f, 0.f};
        cur = nxt; cA = nA; cB = nB; ++ui;
        if (wr == 1) PG8_BAR;
    }
    PG8_WAIT_V(0);
    PG8_BAR;
    if constexpr (Epi::AFTER_DRAIN) E.fused(acc, cur, wr, wc, fr, fq, lds);
#undef PG8_SA
#undef PG8_SB
#undef PG8_STAGE
#undef PG8_LDA
#undef PG8_LDB
#undef PG8_MMA
#undef PG8_WAIT_V
#undef PG8_WAIT_L
#undef PG8_BAR
#undef PG8_SCHED
}
}

struct Args { const float* in[28]; float* out; unsigned char* ws; };
enum { I_X = 0, I_MIXG, I_WIN, I_ALNG, I_ALNB, I_AWS, I_ABS, I_BMU, I_BW0, I_BW2, I_BA0, I_BA2, I_BG2, I_BKK, I_BKA, I_BRK, I_BLNG, I_BLNB, I_DGW2, I_DGB, I_DNG, I_WOUT, I_FFNG, I_WUP, I_CONVW, I_CONVB, I_WDOWN, I_FING };

__device__ __forceinline__ void p0_item(const float* W, int K, int N, bf16_t* WT, const float* gsc, LAS float* scr, int kb, int nb, int row_out0, int lane) {
    const int k0 = 64 * kb, n0 = 64 * nb;
    const int nn = n0 + 2 * (lane & 31); const bool ok = nn < N;
    f32x2 v[32];
#pragma unroll
    for (int i = 0; i < 32; ++i) { const int kk = 2 * i + (lane >> 5); v[i] = ok ? __builtin_nontemporal_load((const f32x2*)(W + (size_t)(k0 + kk) * N + nn)) : (f32x2){0.f, 0.f}; }
#pragma unroll
    for (int i = 0; i < 32; ++i) { const int kk = 2 * i + (lane >> 5); f32x2 x = v[i]; if (gsc) { const float g = gsc[k0 + kk]; x = x * g; }
        scr[kk * 65 + 2 * (lane & 31)] = x.x; scr[kk * 65 + 2 * (lane & 31) + 1] = x.y; }
    asm volatile("s_waitcnt lgkmcnt(0)" ::: "memory");
    const int c = lane & 7;
#pragma unroll
    for (int j = 0; j < 8; ++j) { const int n = (lane >> 3) + 8 * j; const LAS float* sp = scr + (8 * c) * 65 + n;
        u32x4 o; o.x = cvt_pk_bf16(sp[0 * 65], sp[1 * 65]); o.y = cvt_pk_bf16(sp[2 * 65], sp[3 * 65]); o.z = cvt_pk_bf16(sp[4 * 65], sp[5 * 65]); o.w = cvt_pk_bf16(sp[6 * 65], sp[7 * 65]);
        *(u32x4*)(WT + (size_t)(row_out0 + n) * K + k0 + 8 * c) = o; }
    asm volatile("s_waitcnt lgkmcnt(0)" ::: "memory");
}

__device__ __forceinline__ void convert_layer_weights(const Args& args, unsigned char* ws, int l, LAS float* scr, int w0, int nw, int lane, int it_lo, int it_hi) {
    constexpr int I_IN = 32 * 92, I_OUT = 32 * 32, I_UP = 32 * 176, I_DN = 88 * 32;
    unsigned char* wt = ws + WS_WT + (size_t)l * WT_LAYER;
    for (int it = it_lo + w0; it < it_hi; it += nw) {
        int r = it;
        if (r < I_IN) { const int kb = r / 92, nb = r % 92; p0_item(args.in[I_WIN] + (size_t)l * DM * NIN, DM, NIN, (bf16_t*)(wt + WT_IN), args.in[I_MIXG] + l * DM, scr, kb, nb, nb * 64, lane); continue; } r -= I_IN;
        if (r < I_OUT) { const int kb = r / 32, nb = r % 32; p0_item(args.in[I_WOUT] + (size_t)l * DM * DM, DM, DM, (bf16_t*)(wt + WT_OUT), nullptr, scr, kb, nb, nb * 64, lane); continue; } r -= I_OUT;
        if (r < I_UP) { const int kb = r / 176, nb = r % 176; const int n0 = nb * 64; const int j = n0 < DFF ? n0 : n0 - DFF; const int ro = (j >> 7) * 256 + (j & 127) + (n0 < DFF ? 0 : 128);
            p0_item(args.in[I_WUP] + (size_t)l * DM * NUP, DM, NUP, (bf16_t*)(wt + WT_UP), args.in[I_FFNG] + l * DM, scr, kb, nb, ro, lane); continue; } r -= I_UP;
        { const int kb = r / 32, nb = r % 32; p0_item(args.in[I_WDOWN] + (size_t)l * DFF * DM, DFF, DM, (bf16_t*)(wt + WT_DOWN), nullptr, scr, kb, nb, nb * 64, lane); }
    }
}

#define RWKV_LO(v) __builtin_shufflevector(v, v, 0, 1)
#define RWKV_HI(v) __builtin_shufflevector(v, v, 2, 3)
#define RWKV_LDB(set, g) do { _Pragma("unroll") for (int q = 0; q < 2; ++q) { lq_[set][q] = *(const LAS f32x4*)((st_) + 64 + (g) * 8 + q * 4); lq_[set][2 + q] = *(const LAS f32x4*)((st_) + 128 + (g) * 8 + q * 4); \
        lq_[set][4 + q] = *(const LAS f32x4*)((st_) + 192 + (g) * 8 + q * 4); if (WITH_Y_) lq_[set][6 + q] = *(const LAS f32x4*)((st_) + 256 + (g) * 8 + q * 4); } } while (0)
#define RWKV_STEP(st, vi, St, WITH_Y, WITH_V, yout) do { \
    const LAS float* st_ = (st); constexpr bool WITH_Y_ = (WITH_Y); \
    f32x2 a0_ = (f32x2){0.f, 0.f}, a1_ = (f32x2){0.f, 0.f}; \
    f32x4 na_[16]; f32x4 lq_[3][8]; \
    _Pragma("unroll") for (int q = 0; q < 16; ++q) na_[q] = *(const LAS f32x4*)(st_ + q * 4); \
    RWKV_LDB(0, 0); RWKV_LDB(1, 1); \
    __builtin_amdgcn_sched_barrier(0); \
    _Pragma("unroll") for (int q = 0; q < 16; ++q) { const f32x4 n = na_[q]; a0_ += St[2 * q] * RWKV_LO(n); a1_ += St[2 * q + 1] * RWKV_HI(n); } \
    const float sa_ = (a0_.x + a0_.y) + (a1_.x + a1_.y); const f32x2 sa2_ = (f32x2){sa_, sa_}; const f32x2 vi2_ = (f32x2){(vi), (vi)}; \
    f32x2 y0_ = (f32x2){0.f, 0.f}, y1_ = (f32x2){0.f, 0.f}; \
    __builtin_amdgcn_sched_barrier(0); \
    _Pragma("unroll") for (int gi = 0; gi < 8; ++gi) { \
        if (gi + 2 < 8) RWKV_LDB((gi + 2) % 3, gi + 2); \
        __builtin_amdgcn_sched_barrier(0); \
        _Pragma("unroll") for (int q = 0; q < 2; ++q) { const f32x4 dd = lq_[gi % 3][q], bb = lq_[gi % 3][2 + q], kk = lq_[gi % 3][4 + q]; const int k2 = gi * 4 + q * 2; \
            if (WITH_V) { St[k2] = St[k2] * RWKV_LO(dd) + sa2_ * RWKV_LO(bb) + vi2_ * RWKV_LO(kk); St[k2 + 1] = St[k2 + 1] * RWKV_HI(dd) + sa2_ * RWKV_HI(bb) + vi2_ * RWKV_HI(kk); } \
            else { St[k2] = St[k2] * RWKV_LO(dd) + sa2_ * RWKV_LO(bb); St[k2 + 1] = St[k2 + 1] * RWKV_HI(dd) + sa2_ * RWKV_HI(bb); } \
            if (WITH_Y_) { const f32x4 rr = lq_[gi % 3][6 + q]; y0_ += St[k2] * RWKV_LO(rr); y1_ += St[k2 + 1] * RWKV_HI(rr); } } \
        __builtin_amdgcn_sched_barrier(0); } \
    yout = (y0_.x + y0_.y) + (y1_.x + y1_.y); } while (0)

__global__ void __launch_bounds__(512, 2) mega_fwd(Args args) {
    extern __shared__ __attribute__((aligned(16))) unsigned char lds_raw[];
    LAS unsigned char* lds = (LAS unsigned char*)lds_raw;
    cg::grid_group grid = cg::this_grid();
    const int tid0 = threadIdx.x, wave = __builtin_amdgcn_readfirstlane(tid0 >> 6);
    const int bid = blockIdx.x, G = gridDim.x;
    const int gw = bid * 8 + wave, NGW = G * 8;
    unsigned char* ws = args.ws;
    float* XR = args.out;
    bf16_t* XB = (bf16_t*)(ws + WS_XB); bf16_t* Y = (bf16_t*)(ws + WS_Y); bf16_t* P = (bf16_t*)(ws + WS_P);
    float* IDZ = (float*)(ws + WS_IDZ); int* SEL = (int*)(ws + WS_SEL); float* PART = (float*)(ws + WS_PART);
    unsigned* BAR = (unsigned*)ws; unsigned bar_epoch = 0;
    float* SSQ = (float*)(ws + WS_SSQ); f32x2* ROPE = (f32x2*)(ws + WS_ROPE); float* KMEAN = (float*)(ws + WS_KMEAN);
    bf16_t* QB = (bf16_t*)(ws + WS_QB); bf16_t* KB = (bf16_t*)(ws + WS_KB); bf16_t* VT = (bf16_t*)(ws + WS_VT);
    float* VEC5 = (float*)(ws + WS_VEC5); float* VV = (float*)(ws + WS_VV); float* GG = (float*)(ws + WS_GG); float* BV = (float*)(ws + WS_BV);
    float* PCH = (float*)(ws + WS_PCH); float* LCH = (float*)(ws + WS_LCH); float* SIN = (float*)(ws + WS_SIN);
    float* OI = (float*)(ws + WS_OI); float* GU = (float*)(ws + WS_U); float* QT = (float*)(ws + WS_QT); float* LAM = (float*)(ws + WS_LAM);
    bf16_t* HB = (bf16_t*)(ws + WS_H); bf16_t* ACT = (bf16_t*)(ws + WS_ACT);

        { int tid = tid0; asm volatile("" : "+v"(tid)); const int lane = tid & 63; (void)lane;
    {
        LAS float* scr = (LAS float*)(lds + wave * 16896);
        const bool split_conv = (G >= 256);
        convert_layer_weights(args, ws, 0, scr, gw, NGW, lane, 0, split_conv ? 3968 : 12416);
        if (!split_conv) convert_layer_weights(args, ws, 1, scr, gw, NGW, lane, 0, 12416);
        for (int idx = bid * 512 + tid; idx < 8192; idx += G * 512) IDZ[idx] = (idx < 4096 && (idx >> 6) == (idx & 63)) ? 1.f : 0.f;
        for (int idx = bid * 512 + tid; idx < SEQ * 32; idx += G * 512) {
            const int t = idx >> 5, d = idx & 31;
            const float inv = exp2f(-(float)d * (13.287712379549449f / 32.0f));
            const float ang = (float)t * inv;
            const double rev = (double)ang * 0.15915494309189535; const float fr = (float)(rev - floor(rev));
            ROPE[idx] = (f32x2){__builtin_amdgcn_cosf(fr), __builtin_amdgcn_sinf(fr)};
        }
        const float* x = args.in[I_X];
        for (int row = gw; row < SEQ; row += NGW) {
            const f32x4* xr = (const f32x4*)(x + (size_t)row * DM) + lane; float s = 0.f;
            u32x2* ob = (u32x2*)(XB + (size_t)row * DM) + lane;
#pragma unroll
            for (int j = 0; j < 8; ++j) { const f32x4 v = xr[64 * j]; s += (v[0] * v[0] + v[1] * v[1]) + (v[2] * v[2] + v[3] * v[3]); u32x2 w; w.x = cvt_pk_bf16(v[0], v[1]); w.y = cvt_pk_bf16(v[2], v[3]); ob[64 * j] = w; }
            s = wave_sum(s);
            if (lane < 8) SSQ[(size_t)row * 8 + lane] = lane == 0 ? s : 0.f;
        }
    }
        }
    grid.sync();

    for (int l = 0; l < 2; ++l) {
        unsigned char* wt = ws + WS_WT + (size_t)l * WT_LAYER;
        { int tid = tid0; asm volatile("" : "+v"(tid)); const int lane = tid & 63; (void)lane;
        {
            pg8::Gemm g{XB, (const bf16_t*)(wt + WT_IN), SEQ, NINP, DM, 256}; pg8::StaticOrder S; S.init(SEQ, NINP, G, bid);
            pg8::EpiScaleBf16 E{P, NINP, SSQ};
            pg8::gemm_phase<pg8::EpiScaleBf16>(lds, g, S, E);
        }
        }
        fast_barrier(BAR, ++bar_epoch, (unsigned)G);
        { int tid = tid0; asm volatile("" : "+v"(tid)); const int lane = tid & 63; (void)lane;
        for (int unit = bid; unit < 256; unit += G) {
            const int n = unit >> 2, h = unit & 3, t0 = n * 128;
            LAS float* Vs = (LAS float*)lds; LAS float* Wt = (LAS float*)(lds + 65536); LAS float* st = (LAS float*)(lds + 65536 + 67584);
            const float* lng = args.in[I_ALNG] + l * 512; const float* lnb = args.in[I_ALNB] + l * 512;
            const float* wsrc = args.in[I_AWS] + ((size_t)l * 4 + h) * 16384; const float* bsrc = args.in[I_ABS] + (l * 4 + h) * 128;
            u32x4 raws[16];
#pragma unroll
            for (int i = 0; i < 16; ++i) raws[i] = *(const u32x4*)(P + (size_t)(t0 + wave * 16 + i) * NINP + PC_A + 512 + lane * 8);
#pragma unroll
            for (int i0 = 0; i0 < 16; i0 += 4) { float st8[8];
#pragma unroll
                for (int i = 0; i < 4; ++i) { float z[8]; unpack8(raws[i0 + i], z); float sm = 0.f, sq = 0.f;
#pragma unroll
                    for (int jj = 0; jj < 8; ++jj) { const float g = gelu_tanh(z[jj]); sm += g; sq += g * g; }
                    st8[i] = sm; st8[4 + i] = sq; }
                wave_sum_n<8>(st8);
                if (lane == 0) {
#pragma unroll
                    for (int i = 0; i < 4; ++i) { const int tt = wave * 16 + i0 + i; const float mu = st8[i] * (1.f / 512.f); const float var = fmaxf(st8[4 + i] * (1.f / 512.f) - mu * mu, 0.f);
                        st[tt * 2] = mu; st[tt * 2 + 1] = rsqrtf(var + EPS); } } }
            for (int i = 0; i < 32; ++i) { const int e = tid + 512 * i; const int t = e >> 7, s = e & 127; Wt[s * 132 + t] = (s <= t) ? wsrc[e] : 0.f; }
            __syncthreads();
            for (int i = 0; i < 4; ++i) { const int idx = tid + 512 * i; const int s = idx >> 4, c0 = (idx & 15) * 8;
                const u32x4 raw = *(const u32x4*)(P + (size_t)(t0 + s) * NINP + PC_A + 512 + h * 128 + c0); float z[8]; unpack8(raw, z);
                const float mu = st[s * 2], rs = st[s * 2 + 1];
#pragma unroll
                for (int j = 0; j < 8; ++j) Vs[s * 128 + c0 + j] = (gelu_tanh(z[j]) - mu) * rs * lng[h * 128 + c0 + j] + lnb[h * 128 + c0 + j]; }
            __syncthreads();
            const int tg = tid >> 4, cgp = tid & 15; const int s_end = wave * 16 + 16;
            float acc[4][8];
#pragma unroll
            for (int i = 0; i < 4; ++i)
#pragma unroll
                for (int j = 0; j < 8; ++j) acc[i][j] = 0.f;
            { f32x4 w4n[2], v0n[2], v1n[2];
#pragma unroll
              for (int q = 0; q < 2; ++q) { w4n[q] = *(const LAS f32x4*)(Wt + q * 132 + tg * 4); v0n[q] = *(const LAS f32x4*)(Vs + q * 128 + cgp * 8); v1n[q] = *(const LAS f32x4*)(Vs + q * 128 + cgp * 8 + 4); }
              for (int s = 0; s < s_end; s += 2) {
                f32x4 w4c[2], v0c[2], v1c[2];
#pragma unroll
                for (int q = 0; q < 2; ++q) { w4c[q] = w4n[q]; v0c[q] = v0n[q]; v1c[q] = v1n[q]; }
                const int sn = (s + 2 < 128) ? s + 2 : 126;
#pragma unroll
                for (int q = 0; q < 2; ++q) { w4n[q] = *(const LAS f32x4*)(Wt + (sn + q) * 132 + tg * 4); v0n[q] = *(const LAS f32x4*)(Vs + (sn + q) * 128 + cgp * 8); v1n[q] = *(const LAS f32x4*)(Vs + (sn + q) * 128 + cgp * 8 + 4); }
                __builtin_amdgcn_sched_barrier(0);
#pragma unroll
                for (int q = 0; q < 2; ++q)
#pragma unroll
                    for (int i = 0; i < 4; ++i) {
#pragma unroll
                        for (int j = 0; j < 4; ++j) { acc[i][j] += w4c[q][i] * v0c[q][j]; acc[i][4 + j] += w4c[q][i] * v1c[q][j]; } }
                __builtin_amdgcn_sched_barrier(0);
              } }
#pragma unroll
            for (int i = 0; i < 4; ++i) { const int t = tg * 4 + i; const float bias = bsrc[t];
                const u32x4 raw = *(const u32x4*)(P + (size_t)(t0 + t) * NINP + PC_A + h * 128 + cgp * 8); float z[8]; unpack8(raw, z); float o[8];
#pragma unroll
                for (int j = 0; j < 8; ++j) o[j] = gelu_tanh(z[j]) * (acc[i][j] + bias);
                u32x4 w; w.x = cvt_pk_bf16(o[0], o[1]); w.y = cvt_pk_bf16(o[2], o[3]); w.z = cvt_pk_bf16(o[4], o[5]); w.w = cvt_pk_bf16(o[6], o[7]);
                *(u32x4*)(Y + (size_t)(t0 + t) * DM + h * 128 + cgp * 8) = w; }
            __syncthreads();
        }
        }
        { int tid = tid0; asm volatile("" : "+v"(tid)); const int lane = tid & 63; (void)lane;
        for (int unit = bid; unit < 256; unit += G) {
            const int n = unit >> 3, h = unit & 7; const int tt = tid >> 1, half = tid & 1, t = n * 256 + tt, d0 = half * 16;
            LAS float* red = (LAS float*)lds;
            LAS bf16_t* vsT = (LAS bf16_t*)(lds + 4096);
            const bf16_t* prow = P + (size_t)t * NINP + PC_C + h * 64;
            float ql[16], qh[16], kl[16], kh[16];
            { u32x4 a0 = *(const u32x4*)(prow + d0), a1 = *(const u32x4*)(prow + d0 + 8), b0 = *(const u32x4*)(prow + 32 + d0), b1 = *(const u32x4*)(prow + 32 + d0 + 8);
              float z[8]; unpack8(a0, z);
#pragma unroll
              for (int j = 0; j < 8; ++j) ql[j] = z[j];
              unpack8(a1, z);
#pragma unroll
              for (int j = 0; j < 8; ++j) ql[8 + j] = z[j];
              unpack8(b0, z);
#pragma unroll
              for (int j = 0; j < 8; ++j) qh[j] = z[j];
              unpack8(b1, z);
#pragma unroll
              for (int j = 0; j < 8; ++j) qh[8 + j] = z[j]; }
            { u32x4 a0 = *(const u32x4*)(prow + 512 + d0), a1 = *(const u32x4*)(prow + 512 + d0 + 8), b0 = *(const u32x4*)(prow + 512 + 32 + d0), b1 = *(const u32x4*)(prow + 512 + 32 + d0 + 8);
              float z[8]; unpack8(a0, z);
#pragma unroll
              for (int j = 0; j < 8; ++j) kl[j] = z[j];
              unpack8(a1, z);
#pragma unroll
              for (int j = 0; j < 8; ++j) kl[8 + j] = z[j];
              unpack8(b0, z);
#pragma unroll
              for (int j = 0; j < 8; ++j) kh[j] = z[j];
              unpack8(b1, z);
#pragma unroll
              for (int j = 0; j < 8; ++j) kh[8 + j] = z[j]; }
            const f32x2* cs = ROPE + (size_t)t * 32 + d0;
#pragma unroll
            for (int j = 0; j < 16; ++j) { const f32x2 c = cs[j];
                const float q1 = ql[j], q2 = qh[j]; ql[j] = (q1 * c.x - q2 * c.y) * QSCALE; qh[j] = (q1 * c.y + q2 * c.x) * QSCALE;
                const float k1 = kl[j], k2 = kh[j]; kl[j] = k1 * c.x - k2 * c.y; kh[j] = k1 * c.y + k2 * c.x; }
            { bf16_t* qo = QB + (size_t)t * 512 + h * 64 + d0; bf16_t* ko = KB + (size_t)t * 512 + h * 64 + d0;
              u32x4 w;
              w.x = cvt_pk_bf16(ql[0], ql[1]); w.y = cvt_pk_bf16(ql[2], ql[3]); w.z = cvt_pk_bf16(ql[4], ql[5]); w.w = cvt_pk_bf16(ql[6], ql[7]); *(u32x4*)(qo) = w;
              w.x = cvt_pk_bf16(ql[8], ql[9]); w.y = cvt_pk_bf16(ql[10], ql[11]); w.z = cvt_pk_bf16(ql[12], ql[13]); w.w = cvt_pk_bf16(ql[14], ql[15]); *(u32x4*)(qo + 8) = w;
              w.x = cvt_pk_bf16(qh[0], qh[1]); w.y = cvt_pk_bf16(qh[2], qh[3]); w.z = cvt_pk_bf16(qh[4], qh[5]); w.w = cvt_pk_bf16(qh[6], qh[7]); *(u32x4*)(qo + 32) = w;
              w.x = cvt_pk_bf16(qh[8], qh[9]); w.y = cvt_pk_bf16(qh[10], qh[11]); w.z = cvt_pk_bf16(qh[12], qh[13]); w.w = cvt_pk_bf16(qh[14], qh[15]); *(u32x4*)(qo + 40) = w;
              w.x = cvt_pk_bf16(kl[0], kl[1]); w.y = cvt_pk_bf16(kl[2], kl[3]); w.z = cvt_pk_bf16(kl[4], kl[5]); w.w = cvt_pk_bf16(kl[6], kl[7]); *(u32x4*)(ko) = w;
              w.x = cvt_pk_bf16(kl[8], kl[9]); w.y = cvt_pk_bf16(kl[10], kl[11]); w.z = cvt_pk_bf16(kl[12], kl[13]); w.w = cvt_pk_bf16(kl[14], kl[15]); *(u32x4*)(ko + 8) = w;
              w.x = cvt_pk_bf16(kh[0], kh[1]); w.y = cvt_pk_bf16(kh[2], kh[3]); w.z = cvt_pk_bf16(kh[4], kh[5]); w.w = cvt_pk_bf16(kh[6], kh[7]); *(u32x4*)(ko + 32) = w;
              w.x = cvt_pk_bf16(kh[8], kh[9]); w.y = cvt_pk_bf16(kh[10], kh[11]); w.z = cvt_pk_bf16(kh[12], kh[13]); w.w = cvt_pk_bf16(kh[14], kh[15]); *(u32x4*)(ko + 40) = w; }
#pragma unroll
            for (int j = 0; j < 16; ++j) {
#pragma unroll
                for (int o = 2; o < 64; o <<= 1) { kl[j] += __shfl_xor(kl[j], o); kh[j] += __shfl_xor(kh[j], o); } }
            if (lane < 2) {
#pragma unroll
                for (int j = 0; j < 16; ++j) { red[(wave * 2 + lane) * 32 + j] = kl[j]; red[(wave * 2 + lane) * 32 + 16 + j] = kh[j]; } }
            { const bf16_t* vrow = prow + 1024 + half * 32;
#pragma unroll
              for (int q = 0; q < 4; ++q) { const u32x4 r = *(const u32x4*)(vrow + q * 8); const unsigned rr[4] = {r.x, r.y, r.z, r.w};
#pragma unroll
                  for (int j = 0; j < 4; ++j) { const int d = half * 32 + q * 8 + 2 * j; vsT[d * 264 + tt] = (bf16_t)(rr[j] & 0xffffu); vsT[(d + 1) * 264 + tt] = (bf16_t)(rr[j] >> 16); } } }
            __syncthreads();
            if (tid < 64) { const int hf = (tid & 31) >> 4, slot = (tid & 15) + (tid >= 32 ? 16 : 0); float s = 0.f;
#pragma unroll
                for (int w = 0; w < 8; ++w) s += red[(w * 2 + hf) * 32 + slot];
                KMEAN[(h * 32 + n) * 64 + tid] = s * (1.f / 256.f); }
            { const int d = tid >> 3, seg = tid & 7; const LAS u32x4* src = (const LAS u32x4*)(vsT + d * 264 + seg * 32); u32x4* dst = (u32x4*)(VT + (size_t)(h * 64 + d) * SEQ + n * 256 + seg * 32);
#pragma unroll
              for (int q = 0; q < 4; ++q) dst[q] = src[q]; }
            __syncthreads();
        }
        }
        { int tid = tid0; asm volatile("" : "+v"(tid)); const int lane = tid & 63; (void)lane;
        for (int unit = bid; unit < 256; unit += G) {
            const int t0 = unit * 32;
            LAS float* xs = (LAS float*)lds;
            const float* mu = args.in[I_BMU] + l * 1696;
            for (int i = 0; i < 10; ++i) { const int idx = tid + 512 * i; const int tt = idx / 160, j = idx - tt * 160; const int t = t0 + tt;
                const float cur = bf2f(P[(size_t)t * NINP + PC_B + 1536 + j]); const float prev = t > 0 ? bf2f(P[(size_t)(t - 1) * NINP + PC_B + 1536 + j]) : 0.f;
                const float x = cur + (prev - cur) * mu[1536 + j];
                xs[tt * 160 + j] = j < 32 ? tanhf(x) : (j < 64 ? x : sigmoidf_(x)); }
            const int c = tid, head = wave;
            const float w0c = args.in[I_BW0][l * 512 + c], a0c = args.in[I_BA0][l * 512 + c], kkc = args.in[I_BKK][l * 512 + c], kac = args.in[I_BKA][l * 512 + c], rkc = args.in[I_BRK][l * 512 + c];
            const float mur = mu[c], muk = mu[512 + c], muv = mu[1024 + c];
            const float* w2 = args.in[I_BW2] + (size_t)l * 32 * 512; const float* a2 = args.in[I_BA2] + (size_t)l * 32 * 512; const float* g2 = args.in[I_BG2] + (size_t)l * 96 * 512;
            __syncthreads();
            {
                float wr_[32], ar_[32];
                unsigned cu = (unsigned)c; asm volatile("" : "+v"(cu));
#pragma unroll
                for (int j = 0; j < 32; ++j) { const float* wj = w2 + j * 512; const float* aj = a2 + j * 512; wr_[j] = wj[cu]; ar_[j] = aj[cu]; }
                float rp = 0.f, kp = 0.f, vp = 0.f;
                { const bf16_t* pr = P + (size_t)t0 * NINP + PC_B + c; if (t0 > 0) { rp = bf2f(pr[-NINP]); kp = bf2f(pr[512 - NINP]); vp = bf2f(pr[1024 - NINP]); } }
                unsigned rnr, knr, vnr;
                { const bf16_t* pr = P + (size_t)t0 * NINP + PC_B + c; rnr = pr[0]; knr = pr[512]; vnr = pr[1024]; }
                {
                    float zf = 0.f; asm volatile("" : "+v"(zf));
                    float* v5 = VEC5 + ((size_t)head * SEQ + t0) * 320 + lane; v5[0] = zf; v5[64] = zf; v5[128] = zf; v5[192] = zf; v5[256] = zf;
                    VV[((size_t)head * SEQ + t0) * 64 + lane] = zf; BV[(size_t)t0 * 512 + c] = zf; }
#pragma unroll 1
                for (int i = 0; i < 32; ++i) { const int t = t0 + i;
                    asm volatile("" : "+v"(rnr), "+v"(knr), "+v"(vnr));
                    const float rc = __uint_as_float(rnr << 16), kc = __uint_as_float(knr << 16), vc = __uint_as_float(vnr << 16);
                    { const int tn = i + 1 < 32 ? t + 1 : t; const bf16_t* pr = P + (size_t)tn * NINP + PC_B + c; rnr = pr[0]; knr = pr[512]; vnr = pr[1024]; }
                    float aw = w0c, aa = a0c, aw1 = 0.f, aa1 = 0.f;
                    const LAS float* xr = xs + i * 160;
#pragma unroll
                    for (int j = 0; j < 32; j += 4) { const f32x4 x = *(const LAS f32x4*)(xr + j), y = *(const LAS f32x4*)(xr + 32 + j);
                        aw += x[0] * wr_[j]; aw1 += x[1] * wr_[j + 1]; aw += x[2] * wr_[j + 2]; aw1 += x[3] * wr_[j + 3];
                        aa += y[0] * ar_[j]; aa1 += y[1] * ar_[j + 1]; aa += y[2] * ar_[j + 2]; aa1 += y[3] * ar_[j + 3]; }
                    aw += aw1; aa += aa1;
                    const float rr = rc + (rp - rc) * mur, kx = kc + (kp - kc) * muk, vx = vc + (vp - vc) * muv;
                    const float mz = -aw; const float sp = mz > 20.f ? mz : __logf(1.f + __expf(mz));
                    const float wl = -sp - 0.5f; const float dec = __expf(-__expf(wl));
                    const float a = sigmoidf_(aa);
                    float kk = kx * kkc; const float k2 = kx * (1.f + (a - 1.f) * kac);
                    float red2[2] = {kk * kk, rr * k2 * rkc}; wave_sum_n<2>(red2);
                    kk = kk * __builtin_amdgcn_rsqf(fmaxf(red2[0], 1e-24f)); const float bb = kk * a;
                    const float bon = red2[1];
                    float* v5 = VEC5 + ((size_t)head * SEQ + t) * 320 + lane;
                    v5[0] = -kk; v5[64] = dec; v5[128] = bb; v5[192] = k2; v5[256] = rr;
                    VV[((size_t)head * SEQ + t) * 64 + lane] = vx; BV[(size_t)t * 512 + c] = bon * vx;
                    rp = rc; kp = kc; vp = vc; }
            }
            {
                float gr_[96];
                unsigned cu = (unsigned)c; asm volatile("" : "+v"(cu));
#pragma unroll
                for (int j = 0; j < 96; ++j) { const float* gj = g2 + j * 512; gr_[j] = gj[cu]; }
#pragma unroll 1
                for (int i = 0; i < 32; ++i) { const int t = t0 + i;
                    float ag = 0.f, ag1 = 0.f;
                    const LAS float* xr = xs + i * 160;
#pragma unroll
                    for (int j = 0; j < 96; j += 4) { const f32x4 x = *(const LAS f32x4*)(xr + 64 + j); ag += x[0] * gr_[j]; ag1 += x[1] * gr_[j + 1]; ag += x[2] * gr_[j + 2]; ag1 += x[3] * gr_[j + 3]; }
                    GG[(size_t)t * 512 + c] = ag + ag1; }
            }
            __syncthreads();
        }
        }
        fast_barrier(BAR, ++bar_epoch, (unsigned)G);
        { int tid = tid0; asm volatile("" : "+v"(tid)); const int lane = tid & 63; (void)lane;
        for (int pi = bid; pi < 256; pi += G) {
            const int h = pi & 7, r = pi >> 3, half = r & 1;
            for (int which = 0; which < 2; ++which) {
                const int qb = which ? 31 - (r >> 1) : (r >> 1);
                const int t0 = qb * 256 + half * 128;
                LAS bf16_t* Ks = (LAS bf16_t*)lds;
                LAS bf16_t* Vs = (LAS bf16_t*)(lds + 18432);
                LAS float* kmS = (LAS float*)(lds + 36864);
                LAS int* selS = (LAS int*)(lds + 36864 + 8192);
                for (int i = tid; i < qb * 64; i += 512) kmS[i] = KMEAN[h * 2048 + i];
                __syncthreads();
                if (tid < 128) {
                    const bf16_t* qr = QB + (size_t)(t0 + tid) * 512 + h * 64;
                    float q[64];
#pragma unroll
                    for (int j = 0; j < 8; ++j) { float z[8]; unpack8(*(const u32x4*)(qr + j * 8), z);
#pragma unroll
                        for (int e = 0; e < 8; ++e) q[j * 8 + e] = z[e]; }
                    float b0 = -INFINITY, b1 = -INFINITY, b2 = -INFINITY; int i0 = 255, i1 = 255, i2 = 255;
                    for (int n = 0; n < qb; ++n) { float s = 0.f, s1 = 0.f, s2 = 0.f, s3 = 0.f; f32x4 kv[16];
#pragma unroll
                        for (int j = 0; j < 16; ++j) kv[j] = *(const LAS f32x4*)(kmS + n * 64 + j * 4);
                        __builtin_amdgcn_sched_barrier(0);
#pragma unroll
                        for (int j = 0; j < 16; ++j) { s += q[4 * j] * kv[j][0]; s1 += q[4 * j + 1] * kv[j][1]; s2 += q[4 * j + 2] * kv[j][2]; s3 += q[4 * j + 3] * kv[j][3]; }
                        s = (s + s1) + (s2 + s3);
                        if (s > b0) { b2 = b1; i2 = i1; b1 = b0; i1 = i0; b0 = s; i0 = n; } else if (s > b1) { b2 = b1; i2 = i1; b1 = s; i1 = n; } else if (s > b2) { b2 = s; i2 = n; } }
                    selS[tid] = i0 | (i1 << 8) | (i2 << 16); SEL[h * SEQ + t0 + tid] = i0 | (i1 << 8) | (i2 << 16);
                }
                __syncthreads();
                const int ql = lane & 15, kg = lane >> 4;
                const int tq = t0 + wave * 16 + ql;
                const int sel = selS[wave * 16 + ql]; const int s0 = sel & 255, s1 = (sel >> 8) & 255, s2 = (sel >> 16) & 255;
                bf16x8 qf[2];
                qf[0] = *(const bf16x8*)(QB + (size_t)tq * 512 + h * 64 + kg * 8); qf[1] = *(const bf16x8*)(QB + (size_t)tq * 512 + h * 64 + 32 + kg * 8);
                const int nown = half ? 4 : 2, ntile = nown;
                float mrun = -1e30f, lrun = 0.f; f32x4 O[4];
#pragma unroll
                for (int d = 0; d < 4; ++d) O[d] = (f32x4){0.f, 0.f, 0.f, 0.f};
                const int lrow = tid >> 3, lseg = (tid & 7) ^ (lrow & 7);
                const bf16_t* kgp = KB + (size_t)lrow * 512 + h * 64 + lseg * 8; const bf16_t* vgp = VT + (size_t)(h * 64 + lrow) * SEQ + lseg * 8;
                LAS unsigned char* ring = lds + 49152;
#define ATT_KS(i_) ((i_) < nown ? qb * 256 + (i_) * 64 : ((i_) - nown) * 64)
#define ATT_ISSUE_S(i_, slot_) do { const int ks_ = ATT_KS(i_); LAS unsigned char* tb_ = ring + (slot_) * 16384 + wave * 1024; \
                    __builtin_amdgcn_global_load_lds((const unsigned*)(kgp + (size_t)ks_ * 512), (LAS unsigned*)tb_, 16, 0, 0); \
                    __builtin_amdgcn_global_load_lds((const unsigned*)(vgp + ks_), (LAS unsigned*)(tb_ + 8192), 16, 0, 0); } while (0)
                ATT_ISSUE_S(0, 0); if (ntile > 1) ATT_ISSUE_S(1, 1); if (ntile > 2) ATT_ISSUE_S(2, 2);
                const int sw = ql & 7;
                for (int i0 = 0; i0 < ntile; i0 += 4) {
#pragma unroll
                for (int ij = 0; ij < 4; ++ij) { const int i = i0 + ij; if (i < ntile) {
                    if (i + 2 < ntile) asm volatile("s_waitcnt vmcnt(4)" ::: "memory"); else if (i + 1 < ntile) asm volatile("s_waitcnt vmcnt(2)" ::: "memory"); else asm volatile("s_waitcnt vmcnt(0)" ::: "memory");
                    __builtin_amdgcn_s_barrier(); asm volatile("" ::: "memory");
                    if (i + 3 < ntile) ATT_ISSUE_S(i + 3, (ij + 3) & 3);
                    const int ks = ATT_KS(i);
                    const LAS unsigned char* Kc = ring + ij * 16384; const LAS unsigned char* Vc = Kc + 8192;
                    bf16x8 kfr[4][2];
#pragma unroll
                    for (int kt = 0; kt < 4; ++kt)
#pragma unroll
                        for (int c = 0; c < 2; ++c) kfr[kt][c] = *(const LAS bf16x8*)(Kc + (kt * 16 + ql) * 128 + (((c * 4 + kg) ^ sw) << 4));
                    u32x2 vfr[2][4][2];
#pragma unroll
                    for (int kc = 0; kc < 2; ++kc)
#pragma unroll
                        for (int d = 0; d < 4; ++d) { const LAS unsigned char* vr = Vc + (d * 16 + ql) * 128 + (kg & 1) * 8; const int sg = kc * 4 + (kg >> 1);
                            vfr[kc][d][0] = *(const LAS u32x2*)(vr + ((sg ^ sw) << 4)); vfr[kc][d][1] = *(const LAS u32x2*)(vr + (((sg + 2) ^ sw) << 4)); }
                    __builtin_amdgcn_sched_barrier(0);
                    f32x4 Sx[4];
#pragma unroll
                    for (int kt = 0; kt < 4; ++kt) Sx[kt] = __builtin_amdgcn_mfma_f32_16x16x32_bf16(kfr[kt][0], qf[0], (f32x4){0.f, 0.f, 0.f, 0.f}, 0, 0, 0);
#pragma unroll
                    for (int kt = 0; kt < 4; ++kt) Sx[kt] = __builtin_amdgcn_mfma_f32_16x16x32_bf16(kfr[kt][1], qf[1], Sx[kt], 0, 0, 0);
                    const int nblk = ks >> 8; const bool own = i < nown;
                    const bool keepl = true; (void)own; (void)nblk; (void)s0; (void)s1; (void)s2;
                    if (own && ks + 63 > t0) {
#pragma unroll
                        for (int kt = 0; kt < 4; ++kt)
#pragma unroll
                            for (int jj = 0; jj < 4; ++jj) { const int key = ks + kt * 16 + 4 * kg + jj; Sx[kt][jj] = (key <= tq) ? Sx[kt][jj] : -1e30f; }
                    }
                    float mx = fmaxf(fmaxf(fmaxf(Sx[0][0], Sx[0][1]), fmaxf(Sx[0][2], Sx[0][3])), fmaxf(fmaxf(Sx[1][0], Sx[1][1]), fmaxf(Sx[1][2], Sx[1][3])));
                    mx = fmaxf(mx, fmaxf(fmaxf(fmaxf(Sx[2][0], Sx[2][1]), fmaxf(Sx[2][2], Sx[2][3])), fmaxf(fmaxf(Sx[3][0], Sx[3][1]), fmaxf(Sx[3][2], Sx[3][3]))));
                    mx = keepl ? mx : -1e30f;
                    mx = fmaxf(mx, __shfl_xor(mx, 16)); mx = fmaxf(mx, __shfl_xor(mx, 32));
                    const float mnew = fmaxf(mrun, mx); const float alpha = __builtin_amdgcn_exp2f(mrun - mnew); mrun = mnew;
                    const float moff = keepl ? mnew : 1e30f;
                    float rs = 0.f;
#pragma unroll
                    for (int kt = 0; kt < 4; ++kt)
#pragma unroll
                        for (int jj = 0; jj < 4; ++jj) { const float p = __builtin_amdgcn_exp2f(Sx[kt][jj] - moff); Sx[kt][jj] = p; rs += p; }
                    lrun = lrun * alpha + rs;
#pragma unroll
                    for (int d = 0; d < 4; ++d) O[d] *= alpha;
#pragma unroll
                    for (int kc = 0; kc < 2; ++kc) {
                        u32x4 pw; pw.x = cvt_pk_bf16(Sx[2 * kc][0], Sx[2 * kc][1]); pw.y = cvt_pk_bf16(Sx[2 * kc][2], Sx[2 * kc][3]); pw.z = cvt_pk_bf16(Sx[2 * kc + 1][0], Sx[2 * kc + 1][1]); pw.w = cvt_pk_bf16(Sx[2 * kc + 1][2], Sx[2 * kc + 1][3]);
                        const bf16x8 pb = __builtin_bit_cast(bf16x8, pw);
#pragma unroll
                        for (int d = 0; d < 4; ++d) { u32x4 vw; vw.x = vfr[kc][d][0].x; vw.y = vfr[kc][d][0].y; vw.z = vfr[kc][d][1].x; vw.w = vfr[kc][d][1].y;
                            O[d] = __builtin_amdgcn_mfma_f32_16x16x32_bf16(__builtin_bit_cast(bf16x8, vw), pb, O[d], 0, 0, 0); }
                    }
                } } }
                lrun += __shfl_xor(lrun, 16); lrun += __shfl_xor(lrun, 32);
#undef ATT_KS
#undef ATT_ISSUE_S
                { float* pp = PART + ((size_t)(tq * 8 + h) * 4 + 3) * 36;
#pragma unroll
                  for (int d = 0; d < 4; ++d) { u32x2 w; w.x = cvt_pk_bf16(O[d][0], O[d][1]); w.y = cvt_pk_bf16(O[d][2], O[d][3]); *(u32x2*)(pp + d * 8 + 2 * kg) = w; }
                  if (kg == 0) { pp[32] = mrun; pp[33] = lrun; } }
                __syncthreads();
            }
        }
        }
        { int tid = tid0; asm volatile("" : "+v"(tid)); const int lane = tid & 63; (void)lane;
        for (int unit = bid; unit < 512; unit += G) {
            const int c = unit >> 2, h = unit & 3, t0 = c * 64;
            LAS float* qtT = (LAS float*)lds;
            LAS float* ktT = (LAS float*)(lds + 16384);
            LAS float* khS = (LAS float*)(lds + 32768);
            LAS float* vS = (LAS float*)(lds + 49152);
            LAS float* AT = (LAS float*)(lds + 81920);
            LAS float* xgs = (LAS float*)(lds + 98304);
            const bf16_t* pd = P + (size_t)t0 * NINP + PC_D;
            for (int i = tid; i < 1024; i += 512) { const int t = i >> 4, j = i & 15; xgs[i] = bf2f(pd[(size_t)t * NINP + 1024 + j]); }
            for (int i = 0; i < 2; ++i) { const int idx = tid + 512 * i; const int s = idx >> 4, e0 = (idx & 15) * 8; float z[8]; unpack8(*(const u32x4*)(pd + (size_t)s * NINP + 512 + h * 128 + e0), z);
#pragma unroll
                for (int j = 0; j < 8; ++j) vS[s * 128 + e0 + j] = z[j]; }
            __syncthreads();
            { const int t = tid >> 3, dg = (tid & 7) * 8; const float* gw2 = args.in[I_DGW2] + (size_t)l * 16 * 256 + h * 64 + dg; const float* gb = args.in[I_DGB] + l * 256 + h * 64 + dg;
              float a[8];
#pragma unroll
              for (int j = 0; j < 8; ++j) a[j] = gb[j];
              for (int r = 0; r < 16; ++r) { const float xv = xgs[t * 16 + r];
#pragma unroll
                  for (int j = 0; j < 8; ++j) a[j] += xv * gw2[r * 256 + j]; }
#pragma unroll
              for (int j = 0; j < 8; ++j) { const float x = a[j]; const float ls = fminf(x, 0.f) - __logf(1.f + __expf(-fabsf(x))); AT[t * 64 + dg + j] = ls * (1.f / 16.f); } }
            __syncthreads();
            if (tid < 64) { float run = 0.f; for (int t = 0; t < 64; ++t) { run += AT[t * 64 + tid]; AT[t * 64 + tid] = run; } }
            __syncthreads();
            { const int t = tid >> 3, dg = (tid & 7) * 8; float qz[8], kz[8];
              unpack8(*(const u32x4*)(pd + (size_t)t * NINP + h * 64 + dg), qz); unpack8(*(const u32x4*)(pd + (size_t)t * NINP + 256 + h * 64 + dg), kz);
#pragma unroll
              for (int j = 0; j < 8; ++j) { const int d = dg + j; const float cm = AT[t * 64 + d], last = AT[63 * 64 + d];
                  const float qv = qz[j] * 0.125f * __expf(cm); qtT[d * 64 + t] = qv; ktT[d * 64 + t] = kz[j] * __expf(-cm); khS[t * 64 + d] = kz[j] * __expf(last - cm);
                  QT[(size_t)(t0 + t) * 256 + h * 64 + d] = qv;
                  if (t == 63) LAM[(c * 4 + h) * 64 + d] = __expf(last); } }
            __syncthreads();
            if (tid < 256) { const int tq0 = (tid & 15) * 4, sq0 = (tid >> 4) * 4; float a[4][4];
#pragma unroll
                for (int i = 0; i < 4; ++i)
#pragma unroll
                    for (int j = 0; j < 4; ++j) a[i][j] = 0.f;
                for (int d0 = 0; d0 < 64; d0 += 8) { f32x4 qv[8], kv[8];
#pragma unroll
                    for (int q = 0; q < 8; ++q) { qv[q] = *(const LAS f32x4*)(qtT + (d0 + q) * 64 + tq0); kv[q] = *(const LAS f32x4*)(ktT + (d0 + q) * 64 + sq0); }
                    __builtin_amdgcn_sched_barrier(0);
#pragma unroll
                    for (int q = 0; q < 8; ++q)
#pragma unroll
                        for (int i = 0; i < 4; ++i)
#pragma unroll
                            for (int j = 0; j < 4; ++j) a[i][j] += qv[q][i] * kv[q][j];
                    __builtin_amdgcn_sched_barrier(0); }
                asm volatile("" ::: "memory");
#pragma unroll
                for (int j = 0; j < 4; ++j) { f32x4 o;
#pragma unroll
                    for (int i = 0; i < 4; ++i) o[i] = (sq0 + j <= tq0 + i) ? a[i][j] : 0.f;
                    *(LAS f32x4*)(AT + (sq0 + j) * 64 + tq0) = o; } }
            __syncthreads();
            { const int x0 = (tid & 15) * 4, e0 = (tid >> 4) * 4; float o[4][4], u[4][4];
#pragma unroll
              for (int i = 0; i < 4; ++i)
#pragma unroll
                  for (int j = 0; j < 4; ++j) { o[i][j] = 0.f; u[i][j] = 0.f; }
              for (int s0 = 0; s0 < 64; s0 += 4) { f32x4 av[4], kv[4], vv[4];
#pragma unroll
                  for (int q = 0; q < 4; ++q) { av[q] = *(const LAS f32x4*)(AT + (s0 + q) * 64 + x0); kv[q] = *(const LAS f32x4*)(khS + (s0 + q) * 64 + x0); vv[q] = *(const LAS f32x4*)(vS + (s0 + q) * 128 + e0); }
                  __builtin_amdgcn_sched_barrier(0);
#pragma unroll
                  for (int q = 0; q < 4; ++q)
#pragma unroll
                      for (int i = 0; i < 4; ++i)
#pragma unroll
                          for (int j = 0; j < 4; ++j) { o[i][j] += av[q][i] * vv[q][j]; u[i][j] += kv[q][i] * vv[q][j]; }
                  __builtin_amdgcn_sched_barrier(0); }
#pragma unroll
              for (int i = 0; i < 4; ++i) { *(f32x4*)(OI + (size_t)(t0 + x0 + i) * 512 + h * 128 + e0) = (f32x4){o[i][0], o[i][1], o[i][2], o[i][3]};
                  *(f32x4*)(GU + ((size_t)(c * 4 + h) * 64 + x0 + i) * 128 + e0) = (f32x4){u[i][0], u[i][1], u[i][2], u[i][3]}; } }
            __syncthreads();
        }
        }
        { int tid = tid0; asm volatile("" : "+v"(tid)); const int lane = tid & 63; (void)lane;
        { const int wu = bid * 8 + wave; if (wu < 2048) {
            const int h = wu >> 8, c = (wu >> 1) & 127, kind = wu & 1; const size_t tb = (size_t)h * SEQ + c * 64;
            LAS float* buf = (LAS float*)(lds + wave * 10240);
            const f32x4* src = (const f32x4*)(VEC5 + tb * 320);
            const float* vsrc = VV + tb * 64 + lane;
            f32x2 St[32];
            { const f32x4* si = (const f32x4*)(IDZ + kind * 4096 + lane * 64);
#pragma unroll
              for (int k4 = 0; k4 < 16; ++k4) { const f32x4 v = si[k4]; St[2 * k4] = RWKV_LO(v); St[2 * k4 + 1] = RWKV_HI(v); } }
            float vn[4];
#pragma unroll
            for (int j = 0; j < 5; ++j) __builtin_amdgcn_global_load_lds((const unsigned*)(src + j * 64 + lane), (LAS unsigned*)(buf + j * 256), 16, 0, 0);
            const float vsc = kind ? 1.f : 0.f;
#pragma unroll
            for (int j = 0; j < 4; ++j) vn[j] = vsrc[j * 64];
            asm volatile("s_waitcnt vmcnt(0)" ::: "memory");
            for (int b = 0; b < 16; ++b) {
                const float vc0 = vn[0], vc1 = vn[1], vc2 = vn[2], vc3 = vn[3];
                if (b + 1 < 16) { LAS float* nb = buf + ((b + 1) & 1) * 1280;
#pragma unroll
                    for (int j = 0; j < 5; ++j) __builtin_amdgcn_global_load_lds((const unsigned*)(src + (b + 1) * 320 + j * 64 + lane), (LAS unsigned*)(nb + j * 256), 16, 0, 0);
#pragma unroll
                    for (int j = 0; j < 4; ++j) vn[j] = vsrc[((b + 1) * 4 + j) * 64];
                }
                const LAS float* cb = buf + (b & 1) * 1280;
#pragma unroll 1
                for (int s = 0; s < 4; ++s) {
                    const LAS float* st = cb + s * 320;
                    const float vi = (s == 0 ? vc0 : (s == 1 ? vc1 : (s == 2 ? vc2 : vc3))) * vsc;
                    float yy; RWKV_STEP(st, vi, St, false, true, yy); (void)yy;
                }
                asm volatile("s_waitcnt vmcnt(0)" ::: "memory");
            }
            f32x4* po = (f32x4*)((kind ? LCH : PCH) + ((size_t)(h * 128 + c) * 64 + lane) * 64);
#pragma unroll
            for (int k4 = 0; k4 < 16; ++k4) po[k4] = (f32x4){St[2 * k4].x, St[2 * k4].y, St[2 * k4 + 1].x, St[2 * k4 + 1].y};
        }
        }
        }
        fast_barrier(BAR, ++bar_epoch, (unsigned)G);
        { int tid = tid0; asm volatile("" : "+v"(tid)); const int lane = tid & 63; (void)lane;
        if (bid < 64) {
            const int h = bid >> 3, rg = bid & 7;
            LAS float* Pb = (LAS float*)lds;
            LAS float* Sb = (LAS float*)(lds + 32768);
            if (wave < 4) {
                const int rl = wave * 2 + (lane >> 5), cl = 2 * (lane & 31); const int row = rg * 8 + rl;
                float zz = 0.f; asm volatile("" : "+v"(zz)); const f32x2 z2 = (f32x2){zz, zz};
                const float* Pg = PCH + (size_t)(h * 128) * 4096; const float* Lg = LCH + (size_t)(h * 128) * 4096 + row * 64 + cl;
                f32x4 pq[4][4]; f32x2 lnq[4];
                { const f32x4* ps = (const f32x4*)Pg + tid * 4;
#pragma unroll
                  for (int q = 0; q < 4; ++q) *(LAS f32x4*)(Pb + tid * 16 + q * 4) = ps[q]; }
#pragma unroll
                for (int p = 1; p <= 4; ++p) { const f32x4* ps = (const f32x4*)(Pg + (size_t)p * 4096) + tid * 4;
#pragma unroll
                    for (int q = 0; q < 4; ++q) pq[p & 3][q] = ps[q]; }
#pragma unroll
                for (int q = 0; q < 4; ++q) lnq[q] = *(const f32x2*)(Lg + (size_t)q * 4096);
                *(LAS f32x2*)(Sb + rl * 64 + cl) = z2;
                f32x2 sv = z2;
                asm volatile("s_waitcnt lgkmcnt(0)" ::: "memory"); __builtin_amdgcn_s_barrier(); asm volatile("" ::: "memory");
                for (int c0 = 0; c0 < 128; c0 += 4) {
#pragma unroll
                    for (int ci = 0; ci < 4; ++ci) {
                        const int c = c0 + ci;
                        const LAS float* Pc = Pb + (c & 1) * 4096; const LAS float* Sc = Sb + (c & 1) * 512 + rl * 64;
                        *(f32x2*)(SIN + (size_t)(h * 128 + c) * 4096 + row * 64 + cl) = sv;
                        f32x2 a0 = lnq[ci], a1 = z2;
                        { const int cn = c + 4 < 128 ? c + 4 : 127; lnq[ci] = *(const f32x2*)(Lg + (size_t)cn * 4096); }
                        f32x4 sr_[16]; f32x2 pr_[2][16];
#pragma unroll
                        for (int q = 0; q < 16; ++q) sr_[q] = *(const LAS f32x4*)(Sc + q * 4);
#pragma unroll
                        for (int q = 0; q < 16; ++q) pr_[0][q] = *(const LAS f32x2*)(Pc + q * 64 + cl);
#pragma unroll
                        for (int g = 0; g < 4; ++g) {
                            if (g + 1 < 4) {
#pragma unroll
                                for (int q = 0; q < 16; ++q) pr_[(g + 1) & 1][q] = *(const LAS f32x2*)(Pc + ((g + 1) * 16 + q) * 64 + cl); }
                            __builtin_amdgcn_sched_barrier(0);
#pragma unroll
                            for (int q = 0; q < 16; q += 2) { const int k = g * 16 + q; a0 += sr_[k >> 2][k & 3] * pr_[g & 1][q]; a1 += sr_[(k + 1) >> 2][(k + 1) & 3] * pr_[g & 1][q + 1]; }
                            __builtin_amdgcn_sched_barrier(0);
                        }
                        sv = a0 + a1;
                        *(LAS f32x2*)(Sb + ((c + 1) & 1) * 512 + rl * 64 + cl) = sv;
                        { LAS float* Pn = Pb + ((c + 1) & 1) * 4096 + tid * 16;
#pragma unroll
                          for (int q = 0; q < 4; ++q) *(LAS f32x4*)(Pn + q * 4) = pq[(ci + 1) & 3][q]; }
                        { const int cn = c + 5 < 128 ? c + 5 : 127; const f32x4* ps = (const f32x4*)(Pg + (size_t)cn * 4096) + tid * 4;
#pragma unroll
                          for (int q = 0; q < 4; ++q) pq[(ci + 1) & 3][q] = ps[q]; }
                        asm volatile("s_waitcnt lgkmcnt(0)" ::: "memory"); __builtin_amdgcn_s_barrier(); asm volatile("" ::: "memory");
                    }
                }
            } else {
                for (int c = 0; c < 129; ++c) { __builtin_amdgcn_s_barrier(); asm volatile("" ::: "memory"); }
            }
        } else if (bid < 128) {
            const int idx = (bid - 64) * 512 + tid; float S = 0.f;
            for (int c0 = 0; c0 < 128; c0 += 16) { float u[16], lam[16];
#pragma unroll
                for (int i = 0; i < 16; ++i) { u[i] = GU[(size_t)(c0 + i) * 32768 + idx]; lam[i] = LAM[(c0 + i) * 256 + (idx >> 7)]; }
#pragma unroll
                for (int i = 0; i < 16; ++i) { GU[(size_t)(c0 + i) * 32768 + idx] = S; S = lam[i] * S + u[i]; } }
        } else if (G >= 256) {
            convert_layer_weights(args, ws, l, (LAS float*)(lds + wave * 16896), (bid - 128) * 8 + wave, (G - 128) * 8, lane, 3968, 9600);
        }
        }
        { int tid = tid0; asm volatile("" : "+v"(tid)); const int lane = tid & 63; (void)lane;
        for (;;) {
            __syncthreads();
            if (tid == 0) *(LAS int*)(lds + 36864 + 4096 + 64) = (int)__hip_atomic_fetch_add(BAR + 1024 + 64 * l, 1u, __ATOMIC_RELAXED, __HIP_MEMORY_SCOPE_AGENT);
            __syncthreads();
            const int u = *(LAS int*)(lds + 36864 + 4096 + 64);
            if (u >= 1088) break;
            const int h = u & 7; int n = 0, r = 0;
            { int rem = u >> 3; for (n = 0; n < 31; ++n) { const int cn = 8 - ((n + 1) >> 2); if (rem < cn) { r = ((n + 1) >> 2) + rem; break; } rem -= cn; } }
            LAS int* listS = (LAS int*)(lds + 36864);
            LAS int* wcnt = (LAS int*)(lds + 36864 + 4096);
            LAS unsigned char* ring = lds + 49152;
            const int lrow = tid >> 3, lseg = (tid & 7) ^ (lrow & 7);
            const bf16_t* kgp = KB + (size_t)(n * 256 + lrow) * 512 + h * 64 + lseg * 8; const bf16_t* vgp = VT + (size_t)(h * 64 + lrow) * SEQ + n * 256 + lseg * 8;
#pragma unroll
            for (int j = 0; j < 4; ++j) { LAS unsigned char* tb_ = ring + j * 16384 + wave * 1024;
                __builtin_amdgcn_global_load_lds((const unsigned*)(kgp + (size_t)j * 64 * 512), (LAS unsigned*)tb_, 16, 0, 0);
                __builtin_amdgcn_global_load_lds((const unsigned*)(vgp + j * 64), (LAS unsigned*)(tb_ + 8192), 16, 0, 0); }
            int myslot[2], mypre[2];
#pragma unroll
            for (int p = 0; p < 2; ++p) { const int t = r * 1024 + p * 512 + tid; const int sv = SEL[h * SEQ + t];
                const int sl = ((sv & 255) == n) ? 0 : ((((sv >> 8) & 255) == n) ? 1 : ((((sv >> 16) & 255) == n) ? 2 : -1));
                const unsigned long long bal = __ballot(sl >= 0);
                myslot[p] = sl; mypre[p] = __popcll(bal & ((1ull << lane) - 1ull));
                if (lane == 0) wcnt[p * 8 + wave] = __popcll(bal); }
            __syncthreads();
            int cnt = 0, base0 = 0, base1 = 0;
#pragma unroll
            for (int q = 0; q < 16; ++q) { const int c = wcnt[q]; if (q == wave) base0 = cnt; if (q == 8 + wave) base1 = cnt; cnt += c; }
            if (myslot[0] >= 0) listS[base0 + mypre[0]] = ((r * 1024 + tid) << 2) | myslot[0];
            if (myslot[1] >= 0) listS[base1 + mypre[1]] = ((r * 1024 + 512 + tid) << 2) | myslot[1];
            asm volatile("s_waitcnt vmcnt(0)" ::: "memory");
            __syncthreads();
            const int ql = lane & 15, kg = lane >> 4, sw = ql & 7;
            for (int ch = 0; ch * 128 < cnt; ++ch) {
                const int e = ch * 128 + wave * 16 + ql; const bool has = e < cnt; const int ent = listS[has ? e : 0]; const int tq = ent >> 2, slot = ent & 3;
                bf16x8 qf[2];
                qf[0] = *(const bf16x8*)(QB + (size_t)tq * 512 + h * 64 + kg * 8); qf[1] = *(const bf16x8*)(QB + (size_t)tq * 512 + h * 64 + 32 + kg * 8);
                float mrun = -1e30f, lrun = 0.f; f32x4 O[4];
#pragma unroll
                for (int d = 0; d < 4; ++d) O[d] = (f32x4){0.f, 0.f, 0.f, 0.f};
#pragma unroll
                for (int ij = 0; ij < 4; ++ij) {
                    const LAS unsigned char* Kc = ring + ij * 16384; const LAS unsigned char* Vc = Kc + 8192;
                    bf16x8 kfr[4][2];
#pragma unroll
                    for (int kt = 0; kt < 4; ++kt)
#pragma unroll
                        for (int c = 0; c < 2; ++c) kfr[kt][c] = *(const LAS bf16x8*)(Kc + (kt * 16 + ql) * 128 + (((c * 4 + kg) ^ sw) << 4));
                    u32x2 vfr[2][4][2];
#pragma unroll
                    for (int kc = 0; kc < 2; ++kc)
#pragma unroll
                        for (int d = 0; d < 4; ++d) { const LAS unsigned char* vr = Vc + (d * 16 + ql) * 128 + (kg & 1) * 8; const int sg = kc * 4 + (kg >> 1);
                            vfr[kc][d][0] = *(const LAS u32x2*)(vr + ((sg ^ sw) << 4)); vfr[kc][d][1] = *(const LAS u32x2*)(vr + (((sg + 2) ^ sw) << 4)); }
                    __builtin_amdgcn_sched_barrier(0);
                    f32x4 Sx[4];
#pragma unroll
                    for (int kt = 0; kt < 4; ++kt) Sx[kt] = __builtin_amdgcn_mfma_f32_16x16x32_bf16(kfr[kt][0], qf[0], (f32x4){0.f, 0.f, 0.f, 0.f}, 0, 0, 0);
#pragma unroll
                    for (int kt = 0; kt < 4; ++kt) Sx[kt] = __builtin_amdgcn_mfma_f32_16x16x32_bf16(kfr[kt][1], qf[1], Sx[kt], 0, 0, 0);
                    float mx = fmaxf(fmaxf(fmaxf(Sx[0][0], Sx[0][1]), fmaxf(Sx[0][2], Sx[0][3])), fmaxf(fmaxf(Sx[1][0], Sx[1][1]), fmaxf(Sx[1][2], Sx[1][3])));
                    mx = fmaxf(mx, fmaxf(fmaxf(fmaxf(Sx[2][0], Sx[2][1]), fmaxf(Sx[2][2], Sx[2][3])), fmaxf(fmaxf(Sx[3][0], Sx[3][1]), fmaxf(Sx[3][2], Sx[3][3]))));
                    mx = fmaxf(mx, __shfl_xor(mx, 16)); mx = fmaxf(mx, __shfl_xor(mx, 32));
                    const float mnew = fmaxf(mrun, mx); const float alpha = __builtin_amdgcn_exp2f(mrun - mnew); mrun = mnew;
                    float rs = 0.f;
#pragma unroll
                    for (int kt = 0; kt < 4; ++kt)
#pragma unroll
                        for (int jj = 0; jj < 4; ++jj) { const float p = __builtin_amdgcn_exp2f(Sx[kt][jj] - mnew); Sx[kt][jj] = p; rs += p; }
                    lrun = lrun * alpha + rs;
#pragma unroll
                    for (int d = 0; d < 4; ++d) O[d] *= alpha;
#pragma unroll
                    for (int kc = 0; kc < 2; ++kc) {
                        u32x4 pw; pw.x = cvt_pk_bf16(Sx[2 * kc][0], Sx[2 * kc][1]); pw.y = cvt_pk_bf16(Sx[2 * kc][2], Sx[2 * kc][3]); pw.z = cvt_pk_bf16(Sx[2 * kc + 1][0], Sx[2 * kc + 1][1]); pw.w = cvt_pk_bf16(Sx[2 * kc + 1][2], Sx[2 * kc + 1][3]);
                        const bf16x8 pb = __builtin_bit_cast(bf16x8, pw);
#pragma unroll
                        for (int d = 0; d < 4; ++d) { u32x4 vw; vw.x = vfr[kc][d][0].x; vw.y = vfr[kc][d][0].y; vw.z = vfr[kc][d][1].x; vw.w = vfr[kc][d][1].y;
                            O[d] = __builtin_amdgcn_mfma_f32_16x16x32_bf16(__builtin_bit_cast(bf16x8, vw), pb, O[d], 0, 0, 0); }
                    }
                }
                lrun += __shfl_xor(lrun, 16); lrun += __shfl_xor(lrun, 32);
                if (has) { float* pp = PART + ((size_t)(tq * 8 + h) * 4 + slot) * 36;
#pragma unroll
                    for (int d = 0; d < 4; ++d) { u32x2 w; w.x = cvt_pk_bf16(O[d][0], O[d][1]); w.y = cvt_pk_bf16(O[d][2], O[d][3]); *(u32x2*)(pp + d * 8 + 2 * kg) = w; }
                    if (kg == 0) { pp[32] = mrun; pp[33] = lrun; } }
            }
            __syncthreads();
        }
        }
        fast_barrier(BAR, ++bar_epoch, (unsigned)G);
        { int tid = tid0; asm volatile("" : "+v"(tid)); const int lane = tid & 63; (void)lane;
        for (int t = bid * 8 + wave; t < SEQ; t += G * 8) {
            const int h = lane >> 3, dg = (lane & 7) * 8; const int qb = t >> 8; const int nv = qb < 3 ? qb : 3;
            const float* pp = PART + ((size_t)(t * 8 + h) * 4) * 36;
            const float m3 = pp[3 * 36 + 32], l3 = pp[3 * 36 + 33];
            float mk[3], lk[3]; float M = m3;
#pragma unroll
            for (int q = 0; q < 3; ++q) { mk[q] = q < nv ? pp[q * 36 + 32] : -1e30f; lk[q] = q < nv ? pp[q * 36 + 33] : 0.f; M = fmaxf(M, mk[q]); }
            const float w3 = __builtin_amdgcn_exp2f(m3 - M); float L = w3 * l3;
            float acc8[8];
            { float z[8]; unpack8(*(const u32x4*)(pp + 3 * 36 + (dg >> 1)), z);
#pragma unroll
              for (int e = 0; e < 8; ++e) acc8[e] = z[e] * w3; }
#pragma unroll
            for (int q = 0; q < 3; ++q) if (q < nv) { const float wq = __builtin_amdgcn_exp2f(mk[q] - M); L += wq * lk[q];
                float z[8]; unpack8(*(const u32x4*)(pp + q * 36 + (dg >> 1)), z);
#pragma unroll
                for (int e = 0; e < 8; ++e) acc8[e] += z[e] * wq; }
            const f32x4 a0 = (f32x4){acc8[0], acc8[1], acc8[2], acc8[3]}, a1 = (f32x4){acc8[4], acc8[5], acc8[6], acc8[7]};
            const float il = 1.f / L;
            u32x4 w; w.x = cvt_pk_bf16(a0[0] * il, a0[1] * il); w.y = cvt_pk_bf16(a0[2] * il, a0[3] * il); w.z = cvt_pk_bf16(a1[0] * il, a1[1] * il); w.w = cvt_pk_bf16(a1[2] * il, a1[3] * il);
            *(u32x4*)(Y + (size_t)t * DM + 1024 + h * 64 + dg) = w;
        }
        for (int unit = bid; unit < 512; unit += G) {
            const int c = unit >> 2, h = unit & 3, t0 = c * 64;
            LAS float* qtT = (LAS float*)lds;
            LAS float* Sd = (LAS float*)(lds + 16384);
            LAS float* red = (LAS float*)(lds + 49152);
            for (int i = 0; i < 8; ++i) { const int idx = tid + 512 * i; const int t = idx >> 6, d = idx & 63; qtT[d * 64 + t] = QT[(size_t)(t0 + t) * 256 + h * 64 + d]; }
            { const f32x4* ss = (const f32x4*)(GU + (size_t)(c * 4 + h) * 8192);
#pragma unroll
              for (int i = 0; i < 4; ++i) *(LAS f32x4*)(Sd + (tid + 512 * i) * 4) = ss[tid + 512 * i]; }
            __syncthreads();
            const int x0 = (tid & 15) * 4, e0 = (tid >> 4) * 4; float o[4][4];
#pragma unroll
            for (int i = 0; i < 4; ++i) { const f32x4 v = *(const f32x4*)(OI + (size_t)(t0 + x0 + i) * 512 + h * 128 + e0); o[i][0] = v[0]; o[i][1] = v[1]; o[i][2] = v[2]; o[i][3] = v[3]; }
            for (int d0 = 0; d0 < 64; d0 += 8) { f32x4 qv[8], sv[8];
#pragma unroll
                for (int q = 0; q < 8; ++q) { qv[q] = *(const LAS f32x4*)(qtT + (d0 + q) * 64 + x0); sv[q] = *(const LAS f32x4*)(Sd + (d0 + q) * 128 + e0); }
                __builtin_amdgcn_sched_barrier(0);
#pragma unroll
                for (int q = 0; q < 8; ++q)
#pragma unroll
                    for (int i = 0; i < 4; ++i)
#pragma unroll
                        for (int j = 0; j < 4; ++j) o[i][j] += qv[q][i] * sv[q][j];
                __builtin_amdgcn_sched_barrier(0); }
#pragma unroll
            for (int i = 0; i < 4; ++i) red[(x0 + i) * 32 + (tid >> 4)] = (o[i][0] * o[i][0] + o[i][1] * o[i][1]) + (o[i][2] * o[i][2] + o[i][3] * o[i][3]);
            __syncthreads();
            const float* ng = args.in[I_DNG] + l * 128 + e0;
#pragma unroll
            for (int i = 0; i < 4; ++i) { const int t = t0 + x0 + i; float s = 0.f;
#pragma unroll
                for (int j = 0; j < 8; ++j) { const f32x4 v = *(const LAS f32x4*)(red + (x0 + i) * 32 + j * 4); s += (v[0] + v[1]) + (v[2] + v[3]); }
                const float rs = rsqrtf(s * (1.f / 128.f) + EPS);
                const bf16_t* og = P + (size_t)t * NINP + PC_D + 1040 + h * 128 + e0; const u32x2 raw = *(const u32x2*)og;
                const float g0 = bflo(raw.x), g1 = bfhi(raw.x), g2 = bflo(raw.y), g3 = bfhi(raw.y);
                const float y0 = o[i][0] * rs * ng[0] * (g0 * sigmoidf_(g0)), y1 = o[i][1] * rs * ng[1] * (g1 * sigmoidf_(g1)), y2 = o[i][2] * rs * ng[2] * (g2 * sigmoidf_(g2)), y3 = o[i][3] * rs * ng[3] * (g3 * sigmoidf_(g3));
                u32x2 w; w.x = cvt_pk_bf16(y0, y1); w.y = cvt_pk_bf16(y2, y3);
                *(u32x2*)(Y + (size_t)t * DM + 1536 + h * 128 + e0) = w; }
            __syncthreads();
        }
        if (wave < 4) {
            const int u = bid * 4 + wave;
            if (u < 1024) {
                const int h = u >> 7, c = u & 127; const size_t tb = (size_t)h * SEQ + c * 64; const int tbase = c * 64;
                LAS float* buf = (LAS float*)(lds + wave * 10240);
                const f32x4* src = (const f32x4*)(VEC5 + tb * 320);
                const float* vsrc = VV + tb * 64 + lane;
                const int ch = h * 64 + lane;
                const float lg = args.in[I_BLNG][l * 512 + ch], lbias = args.in[I_BLNB][l * 512 + ch];
                const float* bvp = BV + (size_t)tbase * 512 + ch; const float* ggp = GG + (size_t)tbase * 512 + ch;
                f32x2 St[32];
                { const f32x4* si = (const f32x4*)(SIN + ((size_t)u * 64 + lane) * 64);
#pragma unroll
                  for (int k4 = 0; k4 < 16; ++k4) { const f32x4 v = si[k4]; St[2 * k4] = RWKV_LO(v); St[2 * k4 + 1] = RWKV_HI(v); } }
                float vn[4];
#pragma unroll
                for (int j = 0; j < 5; ++j) __builtin_amdgcn_global_load_lds((const unsigned*)(src + j * 64 + lane), (LAS unsigned*)(buf + j * 256), 16, 0, 0);
#pragma unroll
                for (int j = 0; j < 4; ++j) vn[j] = vsrc[j * 64];
                asm volatile("s_waitcnt vmcnt(0)" ::: "memory");
                for (int b = 0; b < 16; ++b) {
                    const float vc0 = vn[0], vc1 = vn[1], vc2 = vn[2], vc3 = vn[3];
                    float bvc[4], ggc[4];
#pragma unroll
                    for (int j = 0; j < 4; ++j) { bvc[j] = bvp[(b * 4 + j) * 512]; ggc[j] = ggp[(b * 4 + j) * 512]; }
                    float yv0 = 0.f, yv1 = 0.f, yv2 = 0.f, yv3 = 0.f;
                    if (b + 1 < 16) { LAS float* nb = buf + ((b + 1) & 1) * 1280;
#pragma unroll
                        for (int j = 0; j < 5; ++j) __builtin_amdgcn_global_load_lds((const unsigned*)(src + (b + 1) * 320 + j * 64 + lane), (LAS unsigned*)(nb + j * 256), 16, 0, 0);
#pragma unroll
                        for (int j = 0; j < 4; ++j) vn[j] = vsrc[((b + 1) * 4 + j) * 64];
                    }
                    const LAS float* cb = buf + (b & 1) * 1280;
#pragma unroll 1
                    for (int s = 0; s < 4; ++s) {
                        const LAS float* st = cb + s * 320;
                        const float vi = s == 0 ? vc0 : (s == 1 ? vc1 : (s == 2 ? vc2 : vc3));
                        float yy; RWKV_STEP(st, vi, St, true, true, yy);
                        yv0 = s == 0 ? yy : yv0; yv1 = s == 1 ? yy : yv1; yv2 = s == 2 ? yy : yv2; yv3 = s == 3 ? yy : yv3;
                    }
                    asm volatile("s_waitcnt vmcnt(0)" ::: "memory");
                    const float yv[4] = {yv0, yv1, yv2, yv3};
                    float st8[8] = {yv[0], yv[1], yv[2], yv[3], yv[0] * yv[0], yv[1] * yv[1], yv[2] * yv[2], yv[3] * yv[3]};
                    wave_sum_n<8>(st8);
#pragma unroll
                    for (int s = 0; s < 4; ++s) { const int t = tbase + b * 4 + s;
                        const float m = st8[s] * (1.f / 64.f); const float var = fmaxf(st8[4 + s] * (1.f / 64.f) - m * m, 0.f);
                        const float yn = (yv[s] - m) * rsqrtf(var + 64e-5f) * lg + lbias;
                        Y[(size_t)t * DM + 512 + ch] = f2bf((yn + bvc[s]) * ggc[s]); }
                }
            }
        } else if (G >= 256) {
            LAS float* scr = (LAS float*)(lds + 49152 + (wave - 4) * 16896);
            convert_layer_weights(args, ws, l, scr, bid * 4 + (wave - 4), G * 4, lane, 9600, 12416);
            if (l == 0) convert_layer_weights(args, ws, 1, scr, bid * 4 + (wave - 4), G * 4, lane, 0, 3968);
        }
        }
        fast_barrier(BAR, ++bar_epoch, (unsigned)G);
        { int tid = tid0; asm volatile("" : "+v"(tid)); const int lane = tid & 63; (void)lane;
        {
            pg8::Gemm g{Y, (const bf16_t*)(wt + WT_OUT), SEQ, DM, DM, 256}; pg8::StaticOrder S; S.init(SEQ, DM, G, bid);
            pg8::EpiResid E{l == 0 ? args.in[I_X] : (const float*)XR, XR, XB, SSQ, lds};
            pg8::gemm_phase<pg8::EpiResid>(lds, g, S, E);
        }
        }
        fast_barrier(BAR, ++bar_epoch, (unsigned)G);
        { int tid = tid0; asm volatile("" : "+v"(tid)); const int lane = tid & 63; (void)lane;
        {
            pg8::Gemm g{XB, (const bf16_t*)(wt + WT_UP), 33 * 256, NUP, DM, 254}; pg8::StaticOrder S; S.init(33 * 256, NUP, G, bid);
            pg8::EpiConvSwiGLU E{ACT, SSQ, args.in[I_CONVW] + (size_t)l * 3 * NUP, args.in[I_CONVB] + (size_t)l * NUP};
            pg8::Unit uu;
            for (int i = 0; S.next(i, uu); ++i) { pg8::OneUnit one{uu}; pg8::gemm_phase<pg8::EpiConvSwiGLU, pg8::OneUnit>(lds, g, one, E); }
        }
        }
        fast_barrier(BAR, ++bar_epoch, (unsigned)G);
        { int tid = tid0; asm volatile("" : "+v"(tid)); const int lane = tid & 63; (void)lane;
        {
            pg8::Gemm g{ACT, (const bf16_t*)(wt + WT_DOWN), SEQ, DM, DFF, 256}; pg8::StaticOrder S; S.init(SEQ, DM, G, bid);
            pg8::EpiResid E{(const float*)XR, XR, XB, SSQ, lds};
            pg8::gemm_phase<pg8::EpiResid>(lds, g, S, E);
        }
        }
        fast_barrier(BAR, ++bar_epoch, (unsigned)G);
    }
        { int tid = tid0; asm volatile("" : "+v"(tid)); const int lane = tid & 63; (void)lane;
    {
        const float* fg = args.in[I_FING];
        for (int row = gw; row < SEQ; row += NGW) {
            float s = SSQ[(size_t)row * 8 + (lane & 7)]; s = wave_sum(s) * 0.125f;
            const float rs = rsqrtf(s * (1.f / 2048.f) + EPS);
            f32x4* xr = (f32x4*)(XR + (size_t)row * DM) + lane; const f32x4* gp = (const f32x4*)fg + lane;
#pragma unroll
            for (int j = 0; j < 8; ++j) { f32x4 v = xr[64 * j]; const f32x4 gv = gp[64 * j]; v = v * rs * gv; xr[64 * j] = v; }
        }
    }
        }
}

extern "C" void kernel_launch(void* const* d_in, const int* in_sizes, int n_in, void* d_out, int out_size, void* d_ws, size_t ws_size, hipStream_t stream) {
    static int grid = 0;
    if (grid == 0) {
        if (n_in != 28 || ws_size < WS_END) { fprintf(stderr, "kernel_launch: unexpected n_in %d / ws_size %zu\n", n_in, ws_size); grid = -1; return; }
        int dev = 0, cus = 0, per_cu = 0;
        hipGetDevice(&dev); hipDeviceGetAttribute(&cus, hipDeviceAttributeMultiprocessorCount, dev);
        hipFuncSetAttribute((const void*)mega_fwd, hipFuncAttributeMaxDynamicSharedMemorySize, LDS_BYTES);
        hipOccupancyMaxActiveBlocksPerMultiprocessor(&per_cu, (const void*)mega_fwd, 512, LDS_BYTES);
        if (per_cu < 1) { fprintf(stderr, "kernel_launch: occupancy query says %d blocks/CU\n", per_cu); per_cu = 1; }
        grid = cus * (per_cu > 1 ? 1 : per_cu);
    }
    if (grid < 0) return;
    (void)hipMemsetAsync(d_ws, 0, 8192, stream);
    Args a{};
    for (int i = 0; i < 28; ++i) a.in[i] = (const float*)d_in[i];
    a.out = (float*)d_out; a.ws = (unsigned char*)d_ws;
    void* kargs[] = {&a};
    hipError_t e = hipLaunchCooperativeKernel((const void*)mega_fwd, dim3(grid), dim3(512), kargs, LDS_BYTES, stream);
    if (e != hipSuccess) fprintf(stderr, "cooperative launch failed: %s (grid %d)\n", hipGetErrorString(e), grid);
}
```

```cpp
#include <hip/hip_runtime.h>
#include <hip/hip_cooperative_groups.h>
#include <cstdio>
#include <cstdint>
namespace cg = cooperative_groups;

#define LAS __attribute__((address_space(3)))
typedef unsigned short bf16_t;
typedef short bf16x8 __attribute__((ext_vector_type(8)));
typedef float f32x4 __attribute__((ext_vector_type(4)));
typedef float f32x2 __attribute__((ext_vector_type(2)));
typedef unsigned u32x4 __attribute__((ext_vector_type(4)));
typedef unsigned u32x2 __attribute__((ext_vector_type(2)));

constexpr int SEQ = 8192, DM = 2048, NIN = 5808, NINP = 5888, DFF = 5632, NUP = 11264;
constexpr int PC_A = 0, PC_B = 1024, PC_C = 2720, PC_D = 4256;
constexpr float EPS = 1e-6f;
constexpr float QSCALE = 0.125f * 1.4426950408889634f;

constexpr size_t MiB = 1u << 20;
constexpr size_t WS_ROPE = 1 * MiB, WS_SSQ = 3 * MiB, WS_KMEAN = 4 * MiB, WS_IDZ = 5 * MiB, WS_SEL = 6 * MiB, WS_WT = 8 * MiB;
constexpr size_t WT_IN = 0, WT_OUT = 23 * MiB, WT_UP = 31 * MiB, WT_DOWN = 75 * MiB, WT_LAYER = 97 * MiB;
constexpr size_t WS_XB = 202 * MiB, WS_Y = 234 * MiB, WS_P = 266 * MiB;
constexpr size_t WS_QB = 358 * MiB, WS_KB = 366 * MiB, WS_VT = 374 * MiB, WS_VEC5 = 382 * MiB, WS_VV = 462 * MiB, WS_GG = 478 * MiB, WS_BV = 494 * MiB;
constexpr size_t WS_PCH = 510 * MiB, WS_LCH = 526 * MiB, WS_SIN = 542 * MiB, WS_OI = 558 * MiB, WS_U = 574 * MiB, WS_QT = 590 * MiB, WS_LAM = 598 * MiB;
constexpr size_t WS_PART = 600 * MiB, WS_H = 266 * MiB, WS_ACT = 442 * MiB, WS_END = 640 * MiB;
constexpr int LDS_BYTES = 147456;

__device__ __forceinline__ float bf2f(bf16_t v) { return __uint_as_float((unsigned)v << 16); }
__device__ __forceinline__ float bflo(unsigned u) { return __uint_as_float(u << 16); }
__device__ __forceinline__ float bfhi(unsigned u) { return __uint_as_float(u & 0xffff0000u); }
__device__ __forceinline__ unsigned cvt_pk_bf16(float lo, float hi) { unsigned r; asm volatile("v_cvt_pk_bf16_f32 %0, %1, %2" : "=v"(r) : "v"(lo), "v"(hi)); return r; }
__device__ __forceinline__ bf16_t f2bf(float f) { return (bf16_t)(cvt_pk_bf16(f, 0.f) & 0xffffu); }
__device__ __forceinline__ float wave_sum(float v) {
#pragma unroll
    for (int o = 32; o > 0; o >>= 1) v += __shfl_xor(v, o);
    return v;
}

template <int N> __device__ __forceinline__ void wave_sum_n(float (&v)[N]) {
#pragma unroll
    for (int o = 32; o > 0; o >>= 1) { float t[N];
#pragma unroll
        for (int i = 0; i < N; ++i) t[i] = __shfl_xor(v[i], o);
#pragma unroll
        for (int i = 0; i < N; ++i) v[i] += t[i]; }
}
__device__ __forceinline__ float sigmoidf_(float x) { return __builtin_amdgcn_rcpf(1.f + __expf(-x)); }
__device__ __forceinline__ float gelu_tanh(float x) { const float u = 0.7978845608f * (x + 0.044715f * x * x * x); const float e = __expf(2.f * u); const float th = 1.f - 2.f * __builtin_amdgcn_rcpf(e + 1.f); return 0.5f * x * (1.f + th); }
__device__ __forceinline__ void unpack8(const u32x4 r, float (&z)[8]) { z[0] = bflo(r.x); z[1] = bfhi(r.x); z[2] = bflo(r.y); z[3] = bfhi(r.y); z[4] = bflo(r.z); z[5] = bfhi(r.z); z[6] = bflo(r.w); z[7] = bfhi(r.w); }

__device__ __forceinline__ void fast_barrier(unsigned* bar, unsigned epoch  , unsigned G) {
    asm volatile("s_waitcnt vmcnt(0) lgkmcnt(0)" ::: "memory");
    __syncthreads();
    if (threadIdx.x == 0) {
        __builtin_amdgcn_fence(__ATOMIC_RELEASE, "agent");
        asm volatile("s_waitcnt vmcnt(0)" ::: "memory");
        const unsigned grp = blockIdx.x & 7u; const unsigned gsz = (G - grp + 7u) >> 3; const unsigned ngrp = G < 8u ? G : 8u;
        const unsigned old = __hip_atomic_fetch_add(bar + 64u * (1u + grp), 1u, __ATOMIC_RELAXED, __HIP_MEMORY_SCOPE_AGENT);
        if (old + 1u == epoch * gsz) __hip_atomic_fetch_add(bar, 1u, __ATOMIC_RELAXED, __HIP_MEMORY_SCOPE_AGENT);
        unsigned spins = 0;
        while (__hip_atomic_load(bar, __ATOMIC_RELAXED, __HIP_MEMORY_SCOPE_AGENT) < epoch * ngrp) { __builtin_amdgcn_s_sleep(1); if (++spins > (1u << 26)) break; }
        __builtin_amdgcn_fence(__ATOMIC_ACQUIRE, "agent");
        asm volatile("s_waitcnt vmcnt(0)" ::: "memory");
    }
    __syncthreads();
}

namespace pg8 {
constexpr int BM = 256, BK = 64, HALF = 128, HTB = HALF * BK * 2, STAGE_BYTES = 8 * HTB, NXCD = 8, WGM = 8;
__host__ __device__ __forceinline__ int lds_byte(int r, int c) { const int st = (r >> 4) * 2 + (c >> 5), rr = r & 15, cc = c & 31, ob = rr * 64 + cc * 2; return st * 1024 + (ob ^ (((ob >> 9) & 1) << 5)); }
__host__ __device__ __forceinline__ void stage_rc(int b, int& R, int& C) { const int st = b / 1024, sb = b % 1024, swz = sb ^ (((sb >> 9) & 1) << 5); R = (st >> 1) * 16 + swz / 64; C = (st & 1) * 32 + (swz % 64) / 2; }
__host__ __device__ __forceinline__ int perm32(int rho) { const int n = rho >> 4, i = rho & 15; return 8 * (i >> 2) + 4 * n + (i & 3); }
struct Unit { int pm, pn; };
struct Gemm { const bf16_t* A; const bf16_t* Bt; int M, N, K; int a_step_rows; };
struct OneUnit { Unit u; __device__ __forceinline__ bool next(int i, Unit& o) const { if (i) return false; o = u; return true; } };
struct StaticOrder {
    int nM, nN, nwg, G, c;
    __device__ __forceinline__ void init(int M, int N, int G_, int c_) { nM = M / BM; nN = N / BM; nwg = nM * nN; G = G_; c = c_; }
    __device__ __forceinline__ bool next(int i, Unit& u) const {
        const long L = (long)i * G + c; if (L >= nwg) return false;
        int wgid = (int)L; { const int q = nwg / NXCD, r = nwg % NXCD, xcd = wgid % NXCD, off = wgid / NXCD; wgid = (xcd < r ? xcd * (q + 1) : r * (q + 1) + (xcd - r) * q) + off; }
        const int nig = WGM * nN, gid = wgid / nig, fm = gid * WGM, gsz = (nM - fm) < WGM ? (nM - fm) : WGM;
        u.pm = fm + ((wgid % nig) % gsz); u.pn = (wgid % nig) / gsz; return true;
    }
};
struct EpiScaleBf16 {
    static constexpr bool AFTER_DRAIN = false;
    bf16_t* O; int ldc; const float* ssq;
    __device__ __forceinline__ void operator()(const f32x4 (&acc)[2][2][4][2], const Unit& u, int wr, int wc, int fr, int fq) const {
        const int row0 = u.pm * BM + wr * 64 + fr; const int col0 = u.pn * BM + wc * 32 + 8 * fq;
#pragma unroll
        for (int ai = 0; ai < 2; ++ai)
#pragma unroll
            for (int m = 0; m < 4; ++m) {
                const int row = row0 + ai * HALF + m * 16;
                const f32x4* sp = (const f32x4*)(ssq + (size_t)row * 8);
                f32x4 s4 = sp[0] + sp[1];
                const float rs = rsqrtf(((s4[0] + s4[1]) + (s4[2] + s4[3])) * (1.0f / 2048.0f) + EPS);
                bf16_t* rowp = O + (size_t)row * ldc + col0;
#pragma unroll
                for (int bj = 0; bj < 2; ++bj) { const f32x4 v0 = acc[ai][bj][m][0] * rs, v1 = acc[ai][bj][m][1] * rs;
                    u32x4 w; w.x = cvt_pk_bf16(v0[0], v0[1]); w.y = cvt_pk_bf16(v0[2], v0[3]); w.z = cvt_pk_bf16(v1[0], v1[1]); w.w = cvt_pk_bf16(v1[2], v1[3]);
                    *(u32x4*)(rowp + bj * HALF) = w; }
            }
    }
};
struct EpiResid {
    static constexpr bool AFTER_DRAIN = false;
    const float* base; float* xr; bf16_t* xb; float* ssq; LAS unsigned char* lds;
    __device__ __forceinline__ void operator()(const f32x4 (&acc)[2][2][4][2], const Unit& u, int wr, int wc, int fr, int fq) const {
        const int row0 = u.pm * BM + wr * 64 + fr; const int col0 = u.pn * BM + wc * 32 + 8 * fq;
        LAS float* xq = (LAS float*)(lds + 131072);
#pragma unroll
        for (int ai = 0; ai < 2; ++ai)
#pragma unroll
            for (int m = 0; m < 4; ++m) {
                const int row = row0 + ai * HALF + m * 16; float q = 0.f;
#pragma unroll
                for (int bj = 0; bj < 2; ++bj) { const size_t off = (size_t)row * DM + col0 + bj * HALF;
                    const f32x4 b0 = *(const f32x4*)(base + off), b1 = *(const f32x4*)(base + off + 4);
                    const f32x4 v0 = acc[ai][bj][m][0] + b0, v1 = acc[ai][bj][m][1] + b1;
                    *(f32x4*)(xr + off) = v0; *(f32x4*)(xr + off + 4) = v1;
                    u32x4 w; w.x = cvt_pk_bf16(v0[0], v0[1]); w.y = cvt_pk_bf16(v0[2], v0[3]); w.z = cvt_pk_bf16(v1[0], v1[1]); w.w = cvt_pk_bf16(v1[2], v1[3]);
                    *(u32x4*)(xb + off) = w;
                    q += (v0[0] * v0[0] + v0[1] * v0[1]) + (v0[2] * v0[2] + v0[3] * v0[3]) + (v1[0] * v1[0] + v1[1] * v1[1]) + (v1[2] * v1[2] + v1[3] * v1[3]); }
                q += __shfl_xor(q, 16); q += __shfl_xor(q, 32);
                if (fq == 0) xq[(ai * HALF + wr * 64 + m * 16 + fr) * 4 + wc] = q;
            }
        asm volatile("s_waitcnt lgkmcnt(0)" ::: "memory"); __builtin_amdgcn_s_barrier(); asm volatile("" ::: "memory");
        { const int tid_ = (wr * 4 + wc) * 64 + fq * 16 + fr;
          if (tid_ < 256) { const f32x4 v = *(const LAS f32x4*)(xq + tid_ * 4); ssq[(size_t)(u.pm * BM + tid_) * 8 + u.pn] = (v[0] + v[1]) + (v[2] + v[3]); } }
    }
};

struct EpiConvSwiGLU {
    static constexpr bool AFTER_DRAIN = true;
    bf16_t* act; const float* ssq; const float* cw; const float* cb;
    __device__ __forceinline__ void fused(const f32x4 (&acc)[2][2][4][2], const Unit& u, int wr, int wc, int fr, int fq, LAS unsigned char* lds) const {
        const int rs = u.pm * 254;
#pragma unroll
        for (int ai = 0; ai < 2; ++ai)
#pragma unroll
            for (int m = 0; m < 4; ++m) {
                const int lr = ai * HALF + wr * 64 + m * 16 + fr; int row = rs + lr; row = row < SEQ ? row : SEQ - 1;
                const f32x4* sp = (const f32x4*)(ssq + (size_t)row * 8);
                const f32x4 s4 = sp[0] + sp[1];
                const float rsd = rsqrtf(((s4[0] + s4[1]) + (s4[2] + s4[3])) * (1.0f / 2048.0f) + EPS);
#pragma unroll
                for (int bj = 0; bj < 2; ++bj) { const f32x4 v0 = acc[ai][bj][m][0] * rsd, v1 = acc[ai][bj][m][1] * rsd;
                    u32x4 w; w.x = cvt_pk_bf16(v0[0], v0[1]); w.y = cvt_pk_bf16(v0[2], v0[3]); w.z = cvt_pk_bf16(v1[0], v1[1]); w.w = cvt_pk_bf16(v1[2], v1[3]);
                    const int c = 16 * bj + 4 * wc + fq;
                    *(LAS u32x4*)(lds + lr * 512 + ((c ^ ((lr & 7) << 2)) << 4)) = w; }
            }
        asm volatile("s_waitcnt lgkmcnt(0)" ::: "memory"); __builtin_amdgcn_s_barrier(); asm volatile("" ::: "memory");
        const int tid_ = (wr * 4 + wc) * 64 + fq * 16 + fr; const int cgp = tid_ & 15, rr = tid_ >> 4;
        const int j0 = u.pn * 128 + cgp * 8;
        float wg[3][8], wu[3][8], bg[8], bu[8];
#pragma unroll
        for (int k = 0; k < 3; ++k) { const f32x4 a0 = *(const f32x4*)(cw + (size_t)k * NUP + j0), a1 = *(const f32x4*)(cw + (size_t)k * NUP + j0 + 4), b0 = *(const f32x4*)(cw + (size_t)k * NUP + DFF + j0), b1 = *(const f32x4*)(cw + (size_t)k * NUP + DFF + j0 + 4);
#pragma unroll
            for (int e = 0; e < 4; ++e) { wg[k][e] = a0[e]; wg[k][4 + e] = a1[e]; wu[k][e] = b0[e]; wu[k][4 + e] = b1[e]; } }
        { const f32x4 a0 = *(const f32x4*)(cb + j0), a1 = *(const f32x4*)(cb + j0 + 4), b0 = *(const f32x4*)(cb + DFF + j0), b1 = *(const f32x4*)(cb + DFF + j0 + 4);
#pragma unroll
          for (int e = 0; e < 4; ++e) { bg[e] = a0[e]; bg[4 + e] = a1[e]; bu[e] = b0[e]; bu[4 + e] = b1[e]; } }
#pragma unroll 1
        for (int hh = 0; hh < 2; ++hh) {
            u32x4 hg[6], hu[6];
#pragma unroll
            for (int i = 0; i < 6; ++i) { const int lr = 8 * rr + 4 * hh - 2 + i;
                if (lr >= 0) { const int sw = (lr & 7) << 2; hg[i] = *(const LAS u32x4*)(lds + lr * 512 + ((cgp ^ sw) << 4)); hu[i] = *(const LAS u32x4*)(lds + lr * 512 + (((16 + cgp) ^ sw) << 4)); }
                else { hg[i] = (u32x4){0u, 0u, 0u, 0u}; hu[i] = (u32x4){0u, 0u, 0u, 0u}; } }
#pragma unroll
            for (int i = 0; i < 4; ++i) { const int lo = 8 * rr + 4 * hh + i; const int grow = rs + lo;
                float g2[8], g1[8], g0[8], u2[8], u1[8], u0[8];
                unpack8(hg[i], g2); unpack8(hg[i + 1], g1); unpack8(hg[i + 2], g0); unpack8(hu[i], u2); unpack8(hu[i + 1], u1); unpack8(hu[i + 2], u0);
                float o[8];
#pragma unroll
                for (int e = 0; e < 8; ++e) { const float ag = bg[e] + wg[0][e] * g2[e] + wg[1][e] * g1[e] + wg[2][e] * g0[e]; const float au = bu[e] + wu[0][e] * u2[e] + wu[1][e] * u1[e] + wu[2][e] * u0[e];
                    o[e] = ag * sigmoidf_(ag) * au; }
                u32x4 w; w.x = cvt_pk_bf16(o[0], o[1]); w.y = cvt_pk_bf16(o[2], o[3]); w.z = cvt_pk_bf16(o[4], o[5]); w.w = cvt_pk_bf16(o[6], o[7]);
                if ((u.pm == 0 || lo >= 2) && grow < SEQ) *(u32x4*)(act + (size_t)grow * DFF + j0) = w; }
        }
        asm volatile("s_waitcnt lgkmcnt(0)" ::: "memory"); __builtin_amdgcn_s_barrier(); asm volatile("" ::: "memory");
    }
};

template <class Epi, class Sched>
__device__ __forceinline__ void gemm_phase(LAS unsigned char* lds, const Gemm g, const Sched& S, const Epi& E) {
    int tid = threadIdx.x; asm volatile("" : "+v"(tid)); const int wid = __builtin_amdgcn_readfirstlane(tid >> 6), lane = tid & 63, wr = wid >> 2, wc = wid & 3, fr = lane & 15, fq = lane >> 4;
    const int K = g.K, nt = K / BK;
    unsigned voffA[2], voffB[2];
#pragma unroll
    for (int i = 0; i < 2; ++i) { int R, C; stage_rc(tid * 16 + i * 8192, R, C); const int Rb = (R & ~31) + perm32(R & 31);
        voffA[i] = (unsigned)(R * K + C) * 2u; voffB[i] = (unsigned)(Rb * K + C) * 2u; }
    const size_t kstep = (size_t)(BK * 2);
    const size_t hstep = (size_t)HALF * K * 2;
    const size_t tstep = 2 * hstep;
    const size_t tstepA = (size_t)g.a_step_rows * K * 2;
    const unsigned ldsw = (unsigned)wid * 1024u;
    const int aoff = lds_byte(wr * 64 + fr, fq * 8), boff = lds_byte(wc * 32 + fr, fq * 8);
#define PG8_SA(b, h) (((b) * 2 + (h)) * HTB)
#define PG8_SB(b, h) ((4 + (b) * 2 + (h)) * HTB)
#define PG8_STAGE(bufoff, gbase, voff) do { _Pragma("unroll") for (int _i = 0; _i < 2; ++_i) \
        __builtin_amdgcn_global_load_lds((const unsigned*)((const char*)(gbase) + (voff)[_i]), (LAS unsigned*)(lds + (bufoff) + ldsw + _i * 8192), 16, 0, 0); } while (0)
#define PG8_LDA(dst, b, h) do { _Pragma("unroll") for (int m = 0; m < 4; ++m) _Pragma("unroll") for (int k = 0; k < 2; ++k) dst[m][k] = *(const LAS bf16x8*)(lds + PG8_SA(b, h) + aoff + m * 2048 + k * 1024); } while (0)
#define PG8_LDB(dst, b, h) do { _Pragma("unroll") for (int n = 0; n < 2; ++n) _Pragma("unroll") for (int k = 0; k < 2; ++k) dst[n][k] = *(const LAS bf16x8*)(lds + PG8_SB(b, h) + boff + n * 2048 + k * 1024); } while (0)
#define PG8_MMA(ai, bj, At, Bt) do { __builtin_amdgcn_s_setprio(1); _Pragma("unroll") for (int m = 0; m < 4; ++m) _Pragma("unroll") for (int n = 0; n < 2; ++n) _Pragma("unroll") for (int k = 0; k < 2; ++k) \
        acc[ai][bj][m][n] = __builtin_amdgcn_mfma_f32_16x16x32_bf16(Bt[n][k], At[m][k], acc[ai][bj][m][n], 0, 0, 0); __builtin_amdgcn_s_setprio(0); } while (0)
#define PG8_WAIT_V(n) asm volatile("s_waitcnt vmcnt(" #n ")" ::: "memory")
#define PG8_WAIT_L(n) asm volatile("s_waitcnt lgkmcnt(" #n ")" ::: "memory")
#define PG8_BAR __builtin_amdgcn_s_barrier()
#define PG8_SCHED __builtin_amdgcn_sched_barrier(0)
    Unit cur, nxt; int ui = 0;
    if (!S.next(0, cur)) return;
    f32x4 acc[2][2][4][2];
#pragma unroll
    for (int a = 0; a < 2; ++a)
#pragma unroll
        for (int b = 0; b < 2; ++b)
#pragma unroll
            for (int m = 0; m < 4; ++m)
#pragma unroll
                for (int n = 0; n < 2; ++n) acc[a][b][m][n] = (f32x4){0.f, 0.f, 0.f, 0.f};
    bf16x8 At[4][2], B0[2][2], B1[2][2];
    const char* cA = (const char*)g.A + (size_t)cur.pm * tstepA; const char* cB = (const char*)g.Bt + (size_t)cur.pn * tstep;
    PG8_STAGE(PG8_SB(0, 0), cB, voffB); PG8_STAGE(PG8_SB(0, 1), cB + hstep, voffB); PG8_STAGE(PG8_SA(0, 0), cA, voffA); PG8_STAGE(PG8_SA(0, 1), cA + hstep, voffA);
    if (wr == 1) PG8_BAR;
    PG8_WAIT_V(2); PG8_BAR;
    PG8_STAGE(PG8_SB(1, 0), cB + kstep, voffB); PG8_STAGE(PG8_SA(1, 0), cA + kstep, voffA); PG8_STAGE(PG8_SB(1, 1), cB + hstep + kstep, voffB);
    PG8_WAIT_V(6); PG8_BAR;
    for (;;) {
        const bool has_next = S.next(ui + 1, nxt);
        const char* nA = has_next ? (const char*)g.A + (size_t)nxt.pm * tstepA : cA; const char* nB = has_next ? (const char*)g.Bt + (size_t)nxt.pn * tstep : cB;
        for (int t = 0; t < nt; t += 2) {
            const bool last = (t == nt - 2);
            const char* a1 = cA + (size_t)(t + 1) * kstep;
            const char* a2 = last ? nA : cA + (size_t)(t + 2) * kstep; const char* b2 = last ? nB : cB + (size_t)(t + 2) * kstep;
            const char* a3 = a2 + kstep; const char* b3 = b2 + kstep;
            PG8_LDB(B0, 0, 0); PG8_LDB(B1, 0, 1); PG8_SCHED; PG8_LDA(At, 0, 0); PG8_STAGE(PG8_SA(1, 1), a1 + hstep, voffA);
            PG8_WAIT_V(8); PG8_WAIT_L(0); PG8_BAR; PG8_MMA(0, 0, At, B0); PG8_MMA(0, 1, At, B1); PG8_BAR; PG8_SCHED;
            PG8_LDA(At, 0, 1); PG8_STAGE(PG8_SB(0, 0), b2, voffB); PG8_STAGE(PG8_SB(0, 1), b2 + hstep, voffB); PG8_STAGE(PG8_SA(0, 0), a2, voffA);
            PG8_WAIT_V(8); PG8_WAIT_L(0); PG8_BAR; PG8_MMA(1, 0, At, B0); PG8_MMA(1, 1, At, B1); PG8_BAR; PG8_SCHED;
            PG8_LDB(B0, 1, 0); PG8_LDB(B1, 1, 1); PG8_SCHED; PG8_LDA(At, 1, 0); PG8_STAGE(PG8_SA(0, 1), a2 + hstep, voffA);
            PG8_WAIT_V(8); PG8_WAIT_L(0); PG8_BAR; PG8_MMA(0, 0, At, B0); PG8_MMA(0, 1, At, B1); PG8_BAR; PG8_SCHED;
            PG8_LDA(At, 1, 1); PG8_STAGE(PG8_SB(1, 0), b3, voffB); PG8_STAGE(PG8_SB(1, 1), b3 + hstep, voffB); PG8_STAGE(PG8_SA(1, 0), a3, voffA);
            PG8_WAIT_V(8); PG8_WAIT_L(0); PG8_BAR; PG8_MMA(1, 0, At, B0); PG8_MMA(1, 1, At, B1); PG8_BAR; PG8_SCHED;
        }
        if (wr == 0) PG8_BAR;
        if constexpr (!Epi::AFTER_DRAIN) E(acc, cur, wr, wc, fr, fq);
        if (!has_next) break;
#pragma unroll
        for (int a = 0; a < 2; ++a)
#pragma unroll
            for (int b = 0; b < 2; ++b)
#pragma unroll
                for (int m = 0; m < 4; ++m)
#pragma unroll
                    for (int n = 0; n < 2; ++n) acc[a][b][m][n] = (f32x4){0.f, 0.f, 0.f, 0.f};
        cur = nxt; cA = nA; cB = nB; ++ui;
        if (wr == 1) PG8_BAR;
    }
    PG8_WAIT_V(0);
    PG8_BAR;
    if constexpr (Epi::AFTER_DRAIN) E.fused(acc, cur, wr, wc, fr, fq, lds);
#undef PG8_SA
#undef PG8_SB
#undef PG8_STAGE
#undef PG8_LDA
#undef PG8_LDB
#undef PG8_MMA
#undef PG8_WAIT_V
#undef PG8_WAIT_L
#undef PG8_BAR
#undef PG8_SCHED
}
}

struct Args { const float* in[28]; float* out; unsigned char* ws; };
enum { I_X = 0, I_MIXG, I_WIN, I_ALNG, I_ALNB, I_AWS, I_ABS, I_BMU, I_BW0, I_BW2, I_BA0, I_BA2, I_BG2, I_BKK, I_BKA, I_BRK, I_BLNG, I_BLNB, I_DGW2, I_DGB, I_DNG, I_WOUT, I_FFNG, I_WUP, I_CONVW, I_CONVB, I_WDOWN, I_FING };

__device__ __forceinline__ void p0_item(const float* W, int K, int N, bf16_t* WT, const float* gsc, LAS float* scr, int kb, int nb, int row_out0, int lane) {
    const int k0 = 64 * kb, n0 = 64 * nb;
    const int nn = n0 + 2 * (lane & 31); const bool ok = nn < N;
    f32x2 v[32];
#pragma unroll
    for (int i = 0; i < 32; ++i) { const int kk = 2 * i + (lane >> 5); v[i] = ok ? __builtin_nontemporal_load((const f32x2*)(W + (size_t)(k0 + kk) * N + nn)) : (f32x2){0.f, 0.f}; }
#pragma unroll
    for (int i = 0; i < 32; ++i) { const int kk = 2 * i + (lane >> 5); f32x2 x = v[i]; if (gsc) { const float g = gsc[k0 + kk]; x = x * g; }
        scr[kk * 65 + 2 * (lane & 31)] = x.x; scr[kk * 65 + 2 * (lane & 31) + 1] = x.y; }
    asm volatile("s_waitcnt lgkmcnt(0)" ::: "memory");
    const int c = lane & 7;
#pragma unroll
    for (int j = 0; j < 8; ++j) { const int n = (lane >> 3) + 8 * j; const LAS float* sp = scr + (8 * c) * 65 + n;
        u32x4 o; o.x = cvt_pk_bf16(sp[0 * 65], sp[1 * 65]); o.y = cvt_pk_bf16(sp[2 * 65], sp[3 * 65]); o.z = cvt_pk_bf16(sp[4 * 65], sp[5 * 65]); o.w = cvt_pk_bf16(sp[6 * 65], sp[7 * 65]);
        *(u32x4*)(WT + (size_t)(row_out0 + n) * K + k0 + 8 * c) = o; }
    asm volatile("s_waitcnt lgkmcnt(0)" ::: "memory");
}

__device__ __forceinline__ void convert_layer_weights(const Args& args, unsigned char* ws, int l, LAS float* scr, int w0, int nw, int lane, int it_lo, int it_hi) {
    constexpr int I_IN = 32 * 92, I_OUT = 32 * 32, I_UP = 32 * 176, I_DN = 88 * 32;
    unsigned char* wt = ws + WS_WT + (size_t)l * WT_LAYER;
    for (int it = it_lo + w0; it < it_hi; it += nw) {
        int r = it;
        if (r < I_IN) { const int kb = r / 92, nb = r % 92; p0_item(args.in[I_WIN] + (size_t)l * DM * NIN, DM, NIN, (bf16_t*)(wt + WT_IN), args.in[I_MIXG] + l * DM, scr, kb, nb, nb * 64, lane); continue; } r -= I_IN;
        if (r < I_OUT) { const int kb = r / 32, nb = r % 32; p0_item(args.in[I_WOUT] + (size_t)l * DM * DM, DM, DM, (bf16_t*)(wt + WT_OUT), nullptr, scr, kb, nb, nb * 64, lane); continue; } r -= I_OUT;
        if (r < I_UP) { const int kb = r / 176, nb = r % 176; const int n0 = nb * 64; const int j = n0 < DFF ? n0 : n0 - DFF; const int ro = (j >> 7) * 256 + (j & 127) + (n0 < DFF ? 0 : 128);
            p0_item(args.in[I_WUP] + (size_t)l * DM * NUP, DM, NUP, (bf16_t*)(wt + WT_UP), args.in[I_FFNG] + l * DM, scr, kb, nb, ro, lane); continue; } r -= I_UP;
        { const int kb = r / 32, nb = r % 32; p0_item(args.in[I_WDOWN] + (size_t)l * DFF * DM, DFF, DM, (bf16_t*)(wt + WT_DOWN), nullptr, scr, kb, nb, nb * 64, lane); }
    }
}

#define RWKV_LO(v) __builtin_shufflevector(v, v, 0, 1)
#define RWKV_HI(v) __builtin_shufflevector(v, v, 2, 3)
#define RWKV_LDB(set, g) do { _Pragma("unroll") for (int q = 0; q < 2; ++q) { lq_[set][q] = *(const LAS f32x4*)((st_) + 64 + (g) * 8 + q * 4); lq_[set][2 + q] = *(const LAS f32x4*)((st_) + 128 + (g) * 8 + q * 4); \
        lq_[set][4 + q] = *(const LAS f32x4*)((st_) + 192 + (g) * 8 + q * 4); if (WITH_Y_) lq_[set][6 + q] = *(const LAS f32x4*)((st_) + 256 + (g) * 8 + q * 4); } } while (0)
#define RWKV_STEP(st, vi, St, WITH_Y, WITH_V, yout) do { \
    const LAS float* st_ = (st); constexpr bool WITH_Y_ = (WITH_Y); \
    f32x2 a0_ = (f32x2){0.f, 0.f}, a1_ = (f32x2){0.f, 0.f}; \
    f32x4 na_[16]; f32x4 lq_[3][8]; \
    _Pragma("unroll") for (int q = 0; q < 16; ++q) na_[q] = *(const LAS f32x4*)(st_ + q * 4); \
    RWKV_LDB(0, 0); RWKV_LDB(1, 1); \
    __builtin_amdgcn_sched_barrier(0); \
    _Pragma("unroll") for (int q = 0; q < 16; ++q) { const f32x4 n = na_[q]; a0_ += St[2 * q] * RWKV_LO(n); a1_ += St[2 * q + 1] * RWKV_HI(n); } \
    const float sa_ = (a0_.x + a0_.y) + (a1_.x + a1_.y); const f32x2 sa2_ = (f32x2){sa_, sa_}; const f32x2 vi2_ = (f32x2){(vi), (vi)}; \
    f32x2 y0_ = (f32x2){0.f, 0.f}, y1_ = (f32x2){0.f, 0.f}; \
    __builtin_amdgcn_sched_barrier(0); \
    _Pragma("unroll") for (int gi = 0; gi < 8; ++gi) { \
        if (gi + 2 < 8) RWKV_LDB((gi + 2) % 3, gi + 2); \
        __builtin_amdgcn_sched_barrier(0); \
        _Pragma("unroll") for (int q = 0; q < 2; ++q) { const f32x4 dd = lq_[gi % 3][q], bb = lq_[gi % 3][2 + q], kk = lq_[gi % 3][4 + q]; const int k2 = gi * 4 + q * 2; \
            if (WITH_V) { St[k2] = St[k2] * RWKV_LO(dd) + sa2_ * RWKV_LO(bb) + vi2_ * RWKV_LO(kk); St[k2 + 1] = St[k2 + 1] * RWKV_HI(dd) + sa2_ * RWKV_HI(bb) + vi2_ * RWKV_HI(kk); } \
            else { St[k2] = St[k2] * RWKV_LO(dd) + sa2_ * RWKV_LO(bb); St[k2 + 1] = St[k2 + 1] * RWKV_HI(dd) + sa2_ * RWKV_HI(bb); } \
            if (WITH_Y_) { const f32x4 rr = lq_[gi % 3][6 + q]; y0_ += St[k2] * RWKV_LO(rr); y1_ += St[k2 + 1] * RWKV_HI(rr); } } \
        __builtin_amdgcn_sched_barrier(0); } \
    yout = (y0_.x + y0_.y) + (y1_.x + y1_.y); } while (0)

__global__ void __launch_bounds__(512, 2) mega_fwd(Args args) {
    extern __shared__ __attribute__((aligned(16))) unsigned char lds_raw[];
    LAS unsigned char* lds = (LAS unsigned char*)lds_raw;
    cg::grid_group grid = cg::this_grid();
    const int tid0 = threadIdx.x, wave = __builtin_amdgcn_readfirstlane(tid0 >> 6);
    const int bid = blockIdx.x, G = gridDim.x;
    const int gw = bid * 8 + wave, NGW = G * 8;
    unsigned char* ws = args.ws;
    float* XR = args.out;
    bf16_t* XB = (bf16_t*)(ws + WS_XB); bf16_t* Y = (bf16_t*)(ws + WS_Y); bf16_t* P = (bf16_t*)(ws + WS_P);
    float* IDZ = (float*)(ws + WS_IDZ); int* SEL = (int*)(ws + WS_SEL); float* PART = (float*)(ws + WS_PART);
    unsigned* BAR = (unsigned*)ws; unsigned bar_epoch = 0;
    float* SSQ = (float*)(ws + WS_SSQ); f32x2* ROPE = (f32x2*)(ws + WS_ROPE); float* KMEAN = (float*)(ws + WS_KMEAN);
    bf16_t* QB = (bf16_t*)(ws + WS_QB); bf16_t* KB = (bf16_t*)(ws + WS_KB); bf16_t* VT = (bf16_t*)(ws + WS_VT);
    float* VEC5 = (float*)(ws + WS_VEC5); float* VV = (float*)(ws + WS_VV); float* GG = (float*)(ws + WS_GG); float* BV = (float*)(ws + WS_BV);
    float* PCH = (float*)(ws + WS_PCH); float* LCH = (float*)(ws + WS_LCH); float* SIN = (float*)(ws + WS_SIN);
    float* OI = (float*)(ws + WS_OI); float* GU = (float*)(ws + WS_U); float* QT = (float*)(ws + WS_QT); float* LAM = (float*)(ws + WS_LAM);
    bf16_t* HB = (bf16_t*)(ws + WS_H); bf16_t* ACT = (bf16_t*)(ws + WS_ACT);

        { int tid = tid0; asm volatile("" : "+v"(tid)); const int lane = tid & 63; (void)lane;
    {
        LAS float* scr = (LAS float*)(lds + wave * 16896);
        const bool split_conv = (G >= 256);
        convert_layer_weights(args, ws, 0, scr, gw, NGW, lane, 0, split_conv ? 3968 : 12416);
        if (!split_conv) convert_layer_weights(args, ws, 1, scr, gw, NGW, lane, 0, 12416);
        for (int idx = bid * 512 + tid; idx < 8192; idx += G * 512) IDZ[idx] = (idx < 4096 && (idx >> 6) == (idx & 63)) ? 1.f : 0.f;
        for (int idx = bid * 512 + tid; idx < SEQ * 32; idx += G * 512) {
            const int t = idx >> 5, d = idx & 31;
            const float inv = exp2f(-(float)d * (13.287712379549449f / 32.0f));
            const float ang = (float)t * inv;
            const double rev = (double)ang * 0.15915494309189535; const float fr = (float)(rev - floor(rev));
            ROPE[idx] = (f32x2){__builtin_amdgcn_cosf(fr), __builtin_amdgcn_sinf(fr)};
        }
        const float* x = args.in[I_X];
        for (int row = gw; row < SEQ; row += NGW) {
            const f32x4* xr = (const f32x4*)(x + (size_t)row * DM) + lane; float s = 0.f;
            u32x2* ob = (u32x2*)(XB + (size_t)row * DM) + lane;
#pragma unroll
            for (int j = 0; j < 8; ++j) { const f32x4 v = xr[64 * j]; s += (v[0] * v[0] + v[1] * v[1]) + (v[2] * v[2] + v[3] * v[3]); u32x2 w; w.x = cvt_pk_bf16(v[0], v[1]); w.y = cvt_pk_bf16(v[2], v[3]); ob[64 * j] = w; }
            s = wave_sum(s);
            if (lane < 8) SSQ[(size_t)row * 8 + lane] = lane == 0 ? s : 0.f;
        }
    }
        }
    grid.sync();

    for (int l = 0; l < 2; ++l) {
        unsigned char* wt = ws + WS_WT + (size_t)l * WT_LAYER;
        { int tid = tid0; asm volatile("" : "+v"(tid)); const int lane = tid & 63; (void)lane;
        {
            pg8::Gemm g{XB, (const bf16_t*)(wt + WT_IN), SEQ, NINP, DM, 256}; pg8::StaticOrder S; S.init(SEQ, NINP, G, bid);
            pg8::EpiScaleBf16 E{P, NINP, SSQ};
            pg8::gemm_phase<pg8::EpiScaleBf16>(lds, g, S, E);
        }
        }
        fast_barrier(BAR, ++bar_epoch, (unsigned)G);
        { int tid = tid0; asm volatile("" : "+v"(tid)); const int lane = tid & 63; (void)lane;
        for (int unit = bid; unit < 256; unit += G) {
            const int n = unit >> 2, h = unit & 3, t0 = n * 128;
            LAS float* Vs = (LAS float*)lds; LAS float* Wt = (LAS float*)(lds + 65536); LAS float* st = (LAS float*)(lds + 65536 + 67584);
            const float* lng = args.in[I_ALNG] + l * 512; const float* lnb = args.in[I_ALNB] + l * 512;
            const float* wsrc = args.in[I_AWS] + ((size_t)l * 4 + h) * 16384; const float* bsrc = args.in[I_ABS] + (l * 4 + h) * 128;
            u32x4 raws[16];
#pragma unroll
            for (int i = 0; i < 16; ++i) raws[i] = *(const u32x4*)(P + (size_t)(t0 + wave * 16 + i) * NINP + PC_A + 512 + lane * 8);
#pragma unroll
            for (int i0 = 0; i0 < 16; i0 += 4) { float st8[8];
#pragma unroll
                for (int i = 0; i < 4; ++i) { float z[8]; unpack8(raws[i0 + i], z); float sm = 0.f, sq = 0.f;
#pragma unroll
                    for (int jj = 0; jj < 8; ++jj) { const float g = gelu_tanh(z[jj]); sm += g; sq += g * g; }
                    st8[i] = sm; st8[4 + i] = sq; }
                wave_sum_n<8>(st8);
                if (lane == 0) {
#pragma unroll
                    for (int i = 0; i < 4; ++i) { const int tt = wave * 16 + i0 + i; const float mu = st8[i] * (1.f / 512.f); const float var = fmaxf(st8[4 + i] * (1.f / 512.f) - mu * mu, 0.f);
                        st[tt * 2] = mu; st[tt * 2 + 1] = rsqrtf(var + EPS); } } }
            for (int i = 0; i < 32; ++i) { const int e = tid + 512 * i; const int t = e >> 7, s = e & 127; Wt[s * 132 + t] = (s <= t) ? wsrc[e] : 0.f; }
            __syncthreads();
            for (int i = 0; i < 4; ++i) { const int idx = tid + 512 * i; const int s = idx >> 4, c0 = (idx & 15) * 8;
                const u32x4 raw = *(const u32x4*)(P + (size_t)(t0 + s) * NINP + PC_A + 512 + h * 128 + c0); float z[8]; unpack8(raw, z);
                const float mu = st[s * 2], rs = st[s * 2 + 1];
#pragma unroll
                for (int j = 0; j < 8; ++j) Vs[s * 128 + c0 + j] = (gelu_tanh(z[j]) - mu) * rs * lng[h * 128 + c0 + j] + lnb[h * 128 + c0 + j]; }
            __syncthreads();
            const int tg = tid >> 4, cgp = tid & 15; const int s_end = wave * 16 + 16;
            float acc[4][8];
#pragma unroll
            for (int i = 0; i < 4; ++i)
#pragma unroll
                for (int j = 0; j < 8; ++j) acc[i][j] = 0.f;
            { f32x4 w4n[2], v0n[2], v1n[2];
#pragma unroll
              for (int q = 0; q < 2; ++q) { w4n[q] = *(const LAS f32x4*)(Wt + q * 132 + tg * 4); v0n[q] = *(const LAS f32x4*)(Vs + q * 128 + cgp * 8); v1n[q] = *(const LAS f32x4*)(Vs + q * 128 + cgp * 8 + 4); }
              for (int s = 0; s < s_end; s += 2) {
                f32x4 w4c[2], v0c[2], v1c[2];
#pragma unroll
                for (int q = 0; q < 2; ++q) { w4c[q] = w4n[q]; v0c[q] = v0n[q]; v1c[q] = v1n[q]; }
                const int sn = (s + 2 < 128) ? s + 2 : 126;
#pragma unroll
                for (int q = 0; q < 2; ++q) { w4n[q] = *(const LAS f32x4*)(Wt + (sn + q) * 132 + tg * 4); v0n[q] = *(const LAS f32x4*)(Vs + (sn + q) * 128 + cgp * 8); v1n[q] = *(const LAS f32x4*)(Vs + (sn + q) * 128 + cgp * 8 + 4); }
                __builtin_amdgcn_sched_barrier(0);
#pragma unroll
                for (int q = 0; q < 2; ++q)
#pragma unroll
                    for (int i = 0; i < 4; ++i) {
#pragma unroll
                        for (int j = 0; j < 4; ++j) { acc[i][j] += w4c[q][i] * v0c[q][j]; acc[i][4 + j] += w4c[q][i] * v1c[q][j]; } }
                __builtin_amdgcn_sched_barrier(0);
              } }
#pragma unroll
            for (int i = 0; i < 4; ++i) { const int t = tg * 4 + i; const float bias = bsrc[t];
                const u32x4 raw = *(const u32x4*)(P + (size_t)(t0 + t) * NINP + PC_A + h * 128 + cgp * 8); float z[8]; unpack8(raw, z); float o[8];
#pragma unroll
                for (int j = 0; j < 8; ++j) o[j] = gelu_tanh(z[j]) * (acc[i][j] + bias);
                u32x4 w; w.x = cvt_pk_bf16(o[0], o[1]); w.y = cvt_pk_bf16(o[2], o[3]); w.z = cvt_pk_bf16(o[4], o[5]); w.w = cvt_pk_bf16(o[6], o[7]);
                *(u32x4*)(Y + (size_t)(t0 + t) * DM + h * 128 + cgp * 8) = w; }
            __syncthreads();
        }
        }
        { int tid = tid0; asm volatile("" : "+v"(tid)); const int lane = tid & 63; (void)lane;
        for (int unit = bid; unit < 256; unit += G) {
            const int n = unit >> 3, h = unit & 7; const int tt = tid >> 1, half = tid & 1, t = n * 256 + tt, d0 = half * 16;
            LAS float* red = (LAS float*)lds;
            LAS bf16_t* vsT = (LAS bf16_t*)(lds + 4096);
            const bf16_t* prow = P + (size_t)t * NINP + PC_C + h * 64;
            float ql[16], qh[16], kl[16], kh[16];
            { u32x4 a0 = *(const u32x4*)(prow + d0), a1 = *(const u32x4*)(prow + d0 + 8), b0 = *(const u32x4*)(prow + 32 + d0), b1 = *(const u32x4*)(prow + 32 + d0 + 8);
              float z[8]; unpack8(a0, z);
#pragma unroll
              for (int j = 0; j < 8; ++j) ql[j] = z[j];
              unpack8(a1, z);
#pragma unroll
              for (int j = 0; j < 8; ++j) ql[8 + j] = z[j];
              unpack8(b0, z);
#pragma unroll
              for (int j = 0; j < 8; ++j) qh[j] = z[j];
              unpack8(b1, z);
#pragma unroll
              for (int j = 0; j < 8; ++j) qh[8 + j] = z[j]; }
            { u32x4 a0 = *(const u32x4*)(prow + 512 + d0), a1 = *(const u32x4*)(prow + 512 + d0 + 8), b0 = *(const u32x4*)(prow + 512 + 32 + d0), b1 = *(const u32x4*)(prow + 512 + 32 + d0 + 8);
              float z[8]; unpack8(a0, z);
#pragma unroll
              for (int j = 0; j < 8; ++j) kl[j] = z[j];
              unpack8(a1, z);
#pragma unroll
              for (int j = 0; j < 8; ++j) kl[8 + j] = z[j];
              unpack8(b0, z);
#pragma unroll
              for (int j = 0; j < 8; ++j) kh[j] = z[j];
              unpack8(b1, z);
#pragma unroll
              for (int j = 0; j < 8; ++j) kh[8 + j] = z[j]; }
            const f32x2* cs = ROPE + (size_t)t * 32 + d0;
#pragma unroll
            for (int j = 0; j < 16; ++j) { const f32x2 c = cs[j];
                const float q1 = ql[j], q2 = qh[j]; ql[j] = (q1 * c.x - q2 * c.y) * QSCALE; qh[j] = (q1 * c.y + q2 * c.x) * QSCALE;
                const float k1 = kl[j], k2 = kh[j]; kl[j] = k1 * c.x - k2 * c.y; kh[j] = k1 * c.y + k2 * c.x; }
            { bf16_t* qo = QB + (size_t)t * 512 + h * 64 + d0; bf16_t* ko = KB + (size_t)t * 512 + h * 64 + d0;
              u32x4 w;
              w.x = cvt_pk_bf16(ql[0], ql[1]); w.y = cvt_pk_bf16(ql[2], ql[3]); w.z = cvt_pk_bf16(ql[4], ql[5]); w.w = cvt_pk_bf16(ql[6], ql[7]); *(u32x4*)(qo) = w;
              w.x = cvt_pk_bf16(ql[8], ql[9]); w.y = cvt_pk_bf16(ql[10], ql[11]); w.z = cvt_pk_bf16(ql[12], ql[13]); w.w = cvt_pk_bf16(ql[14], ql[15]); *(u32x4*)(qo + 8) = w;
              w.x = cvt_pk_bf16(qh[0], qh[1]); w.y = cvt_pk_bf16(qh[2], qh[3]); w.z = cvt_pk_bf16(qh[4], qh[5]); w.w = cvt_pk_bf16(qh[6], qh[7]); *(u32x4*)(qo + 32) = w;
              w.x = cvt_pk_bf16(qh[8], qh[9]); w.y = cvt_pk_bf16(qh[10], qh[11]); w.z = cvt_pk_bf16(qh[12], qh[13]); w.w = cvt_pk_bf16(qh[14], qh[15]); *(u32x4*)(qo + 40) = w;
              w.x = cvt_pk_bf16(kl[0], kl[1]); w.y = cvt_pk_bf16(kl[2], kl[3]); w.z = cvt_pk_bf16(kl[4], kl[5]); w.w = cvt_pk_bf16(kl[6], kl[7]); *(u32x4*)(ko) = w;
              w.x = cvt_pk_bf16(kl[8], kl[9]); w.y = cvt_pk_bf16(kl[10], kl[11]); w.z = cvt_pk_bf16(kl[12], kl[13]); w.w = cvt_pk_bf16(kl[14], kl[15]); *(u32x4*)(ko + 8) = w;
              w.x = cvt_pk_bf16(kh[0], kh[1]); w.y = cvt_pk_bf16(kh[2], kh[3]); w.z = cvt_pk_bf16(kh[4], kh[5]); w.w = cvt_pk_bf16(kh[6], kh[7]); *(u32x4*)(ko + 32) = w;
              w.x = cvt_pk_bf16(kh[8], kh[9]); w.y = cvt_pk_bf16(kh[10], kh[11]); w.z = cvt_pk_bf16(kh[12], kh[13]); w.w = cvt_pk_bf16(kh[14], kh[15]); *(u32x4*)(ko + 40) = w; }
#pragma unroll
            for (int j = 0; j < 16; ++j) {
#pragma unroll
                for (int o = 2; o < 64; o <<= 1) { kl[j] += __shfl_xor(kl[j], o); kh[j] += __shfl_xor(kh[j], o); } }
            if (lane < 2) {
#pragma unroll
                for (int j = 0; j < 16; ++j) { red[(wave * 2 + lane) * 32 + j] = kl[j]; red[(wave * 2 + lane) * 32 + 16 + j] = kh[j]; } }
            { const bf16_t* vrow = prow + 1024 + half * 32;
#pragma unroll
              for (int q = 0; q < 4; ++q) { const u32x4 r = *(const u32x4*)(vrow + q * 8); const unsigned rr[4] = {r.x, r.y, r.z, r.w};
#pragma unroll
                  for (int j = 0; j < 4; ++j) { const int d = half * 32 + q * 8 + 2 * j; vsT[d * 264 + tt] = (bf16_t)(rr[j] & 0xffffu); vsT[(d + 1) * 264 + tt] = (bf16_t)(rr[j] >> 16); } } }
            __syncthreads();
            if (tid < 64) { const int hf = (tid & 31) >> 4, slot = (tid & 15) + (tid >= 32 ? 16 : 0); float s = 0.f;
#pragma unroll
                for (int w = 0; w < 8; ++w) s += red[(w * 2 + hf) * 32 + slot];
                KMEAN[(h * 32 + n) * 64 + tid] = s * (1.f / 256.f); }
            { const int d = tid >> 3, seg = tid & 7; const LAS u32x4* src = (const LAS u32x4*)(vsT + d * 264 + seg * 32); u32x4* dst = (u32x4*)(VT + (size_t)(h * 64 + d) * SEQ + n * 256 + seg * 32);
#pragma unroll
              for (int q = 0; q < 4; ++q) dst[q] = src[q]; }
            __syncthreads();
        }
        }
        { int tid = tid0; asm volatile("" : "+v"(tid)); const int lane = tid & 63; (void)lane;
        for (int unit = bid; unit < 256; unit += G) {
            const int t0 = unit * 32;
            LAS float* xs = (LAS float*)lds;
            const float* mu = args.in[I_BMU] + l * 1696;
            for (int i = 0; i < 10; ++i) { const int idx = tid + 512 * i; const int tt = idx / 160, j = idx - tt * 160; const int t = t0 + tt;
                const float cur = bf2f(P[(size_t)t * NINP + PC_B + 1536 + j]); const float prev = t > 0 ? bf2f(P[(size_t)(t - 1) * NINP + PC_B + 1536 + j]) : 0.f;
                const float x = cur + (prev - cur) * mu[1536 + j];
                xs[tt * 160 + j] = j < 32 ? tanhf(x) : (j < 64 ? x : sigmoidf_(x)); }
            const int c = tid, head = wave;
            const float w0c = args.in[I_BW0][l * 512 + c], a0c = args.in[I_BA0][l * 512 + c], kkc = args.in[I_BKK][l * 512 + c], kac = args.in[I_BKA][l * 512 + c], rkc = args.in[I_BRK][l * 512 + c];
            const float mur = mu[c], muk = mu[512 + c], muv = mu[1024 + c];
            const float* w2 = args.in[I_BW2] + (size_t)l * 32 * 512; const float* a2 = args.in[I_BA2] + (size_t)l * 32 * 512; const float* g2 = args.in[I_BG2] + (size_t)l * 96 * 512;
            __syncthreads();
            {
                float wr_[32], ar_[32];
                unsigned cu = (unsigned)c; asm volatile("" : "+v"(cu));
#pragma unroll
                for (int j = 0; j < 32; ++j) { const float* wj = w2 + j * 512; const float* aj = a2 + j * 512; wr_[j] = wj[cu]; ar_[j] = aj[cu]; }
                float rp = 0.f, kp = 0.f, vp = 0.f;
                { const bf16_t* pr = P + (size_t)t0 * NINP + PC_B + c; if (t0 > 0) { rp = bf2f(pr[-NINP]); kp = bf2f(pr[512 - NINP]); vp = bf2f(pr[1024 - NINP]); } }
                unsigned rnr, knr, vnr;
                { const bf16_t* pr = P + (size_t)t0 * NINP + PC_B + c; rnr = pr[0]; knr = pr[512]; vnr = pr[1024]; }
                {
                    float zf = 0.f; asm volatile("" : "+v"(zf));
                    float* v5 = VEC5 + ((size_t)head * SEQ + t0) * 320 + lane; v5[0] = zf; v5[64] = zf; v5[128] = zf; v5[192] = zf; v5[256] = zf;
                    VV[((size_t)head * SEQ + t0) * 64 + lane] = zf; BV[(size_t)t0 * 512 + c] = zf; }
#pragma unroll 1
                for (int i = 0; i < 32; ++i) { const int t = t0 + i;
                    asm volatile("" : "+v"(rnr), "+v"(knr), "+v"(vnr));
                    const float rc = __uint_as_float(rnr << 16), kc = __uint_as_float(knr << 16), vc = __uint_as_float(vnr << 16);
                    { const int tn = i + 1 < 32 ? t + 1 : t; const bf16_t* pr = P + (size_t)tn * NINP + PC_B + c; rnr = pr[0]; knr = pr[512]; vnr = pr[1024]; }
                    float aw = w0c, aa = a0c, aw1 = 0.f, aa1 = 0.f;
                    const LAS float* xr = xs + i * 160;
#pragma unroll
                    for (int j = 0; j < 32; j += 4) { const f32x4 x = *(const LAS f32x4*)(xr + j), y = *(const LAS f32x4*)(xr + 32 + j);
                        aw += x[0] * wr_[j]; aw1 += x[1] * wr_[j + 1]; aw += x[2] * wr_[j + 2]; aw1 += x[3] * wr_[j + 3];
                        aa += y[0] * ar_[j]; aa1 += y[1] * ar_[j + 1]; aa += y[2] * ar_[j + 2]; aa1 += y[3] * ar_[j + 3]; }
                    aw += aw1; aa += aa1;
                    const float rr = rc + (rp - rc) * mur, kx = kc + (kp - kc) * muk, vx = vc + (vp - vc) * muv;
                    const float mz = -aw; const float sp = mz > 20.f ? mz : __logf(1.f + __expf(mz));
                    const float wl = -sp - 0.5f; const float dec = __expf(-__expf(wl));
                    const float a = sigmoidf_(aa);
                    float kk = kx * kkc; const float k2 = kx * (1.f + (a - 1.f) * kac);
                    float red2[2] = {kk * kk, rr * k2 * rkc}; wave_sum_n<2>(red2);
                    kk = kk * __builtin_amdgcn_rsqf(fmaxf(red2[0], 1e-24f)); const float bb = kk * a;
                    const float bon = red2[1];
                    float* v5 = VEC5 + ((size_t)head * SEQ + t) * 320 + lane;
                    v5[0] = -kk; v5[64] = dec; v5[128] = bb; v5[192] = k2; v5[256] = rr;
                    VV[((size_t)head * SEQ + t) * 64 + lane] = vx; BV[(size_t)t * 512 + c] = bon * vx;
                    rp = rc; kp = kc; vp = vc; }
            }
            {
                float gr_[96];
                unsigned cu = (unsigned)c; asm volatile("" : "+v"(cu));
#pragma unroll
                for (int j = 0; j < 96; ++j) { const float* gj = g2 + j * 512; gr_[j] = gj[cu]; }
#pragma unroll 1
                for (int i = 0; i < 32; ++i) { const int t = t0 + i;
                    float ag = 0.f, ag1 = 0.f;
                    const LAS float* xr = xs + i * 160;
#pragma unroll
                    for (int j = 0; j < 96; j += 4) { const f32x4 x = *(const LAS f32x4*)(xr + 64 + j); ag += x[0] * gr_[j]; ag1 += x[1] * gr_[j + 1]; ag += x[2] * gr_[j + 2]; ag1 += x[3] * gr_[j + 3]; }
                    GG[(size_t)t * 512 + c] = ag + ag1; }
            }
            __syncthreads();
        }
        }
        fast_barrier(BAR, ++bar_epoch, (unsigned)G);
        { int tid = tid0; asm volatile("" : "+v"(tid)); const int lane = tid & 63; (void)lane;
        for (int pi = bid; pi < 256; pi += G) {
            const int h = pi & 7, r = pi >> 3, half = r & 1;
            for (int which = 0; which < 2; ++which) {
                const int qb = which ? 31 - (r >> 1) : (r >> 1);
                const int t0 = qb * 256 + half * 128;
                LAS bf16_t* Ks = (LAS bf16_t*)lds;
                LAS bf16_t* Vs = (LAS bf16_t*)(lds + 18432);
                LAS float* kmS = (LAS float*)(lds + 36864);
                LAS int* selS = (LAS int*)(lds + 36864 + 8192);
                for (int i = tid; i < qb * 64; i += 512) kmS[i] = KMEAN[h * 2048 + i];
                __syncthreads();
                if (tid < 128) {
                    const bf16_t* qr = QB + (size_t)(t0 + tid) * 512 + h * 64;
                    float q[64];
#pragma unroll
                    for (int j = 0; j < 8; ++j) { float z[8]; unpack8(*(const u32x4*)(qr + j * 8), z);
#pragma unroll
                        for (int e = 0; e < 8; ++e) q[j * 8 + e] = z[e]; }
                    float b0 = -INFINITY, b1 = -INFINITY, b2 = -INFINITY; int i0 = 255, i1 = 255, i2 = 255;
                    for (int n = 0; n < qb; ++n) { float s = 0.f, s1 = 0.f, s2 = 0.f, s3 = 0.f; f32x4 kv[16];
#pragma unroll
                        for (int j = 0; j < 16; ++j) kv[j] = *(const LAS f32x4*)(kmS + n * 64 + j * 4);
                        __builtin_amdgcn_sched_barrier(0);
#pragma unroll
                        for (int j = 0; j < 16; ++j) { s += q[4 * j] * kv[j][0]; s1 += q[4 * j + 1] * kv[j][1]; s2 += q[4 * j + 2] * kv[j][2]; s3 += q[4 * j + 3] * kv[j][3]; }
                        s = (s + s1) + (s2 + s3);
                        if (s > b0) { b2 = b1; i2 = i1; b1 = b0; i1 = i0; b0 = s; i0 = n; } else if (s > b1) { b2 = b1; i2 = i1; b1 = s; i1 = n; } else if (s > b2) { b2 = s; i2 = n; } }
                    selS[tid] = i0 | (i1 << 8) | (i2 << 16); SEL[h * SEQ + t0 + tid] = i0 | (i1 << 8) | (i2 << 16);
                }
                __syncthreads();
                const int ql = lane & 15, kg = lane >> 4;
                const int tq = t0 + wave * 16 + ql;
                const int sel = selS[wave * 16 + ql]; const int s0 = sel & 255, s1 = (sel >> 8) & 255, s2 = (sel >> 16) & 255;
                bf16x8 qf[2];
                qf[0] = *(const bf16x8*)(QB + (size_t)tq * 512 + h * 64 + kg * 8); qf[1] = *(const bf16x8*)(QB + (size_t)tq * 512 + h * 64 + 32 + kg * 8);
                const int nown = half ? 4 : 2, ntile = nown;
                float mrun = -1e30f, lrun = 0.f; f32x4 O[4];
#pragma unroll
                for (int d = 0; d < 4; ++d) O[d] = (f32x4){0.f, 0.f, 0.f, 0.f};
                const int lrow = tid >> 3, lseg = (tid & 7) ^ (lrow & 7);
                const bf16_t* kgp = KB + (size_t)lrow * 512 + h * 64 + lseg * 8; const bf16_t* vgp = VT + (size_t)(h * 64 + lrow) * SEQ + lseg * 8;
                LAS unsigned char* ring = lds + 49152;
#define ATT_KS(i_) ((i_) < nown ? qb * 256 + (i_) * 64 : ((i_) - nown) * 64)
#define ATT_ISSUE_S(i_, slot_) do { const int ks_ = ATT_KS(i_); LAS unsigned char* tb_ = ring + (slot_) * 16384 + wave * 1024; \
                    __builtin_amdgcn_global_load_lds((const unsigned*)(kgp + (size_t)ks_ * 512), (LAS unsigned*)tb_, 16, 0, 0); \
                    __builtin_amdgcn_global_load_lds((const unsigned*)(vgp + ks_), (LAS unsigned*)(tb_ + 8192), 16, 0, 0); } while (0)
                ATT_ISSUE_S(0, 0); if (ntile > 1) ATT_ISSUE_S(1, 1); if (ntile > 2) ATT_ISSUE_S(2, 2);
                const int sw = ql & 7;
                for (int i0 = 0; i0 < ntile; i0 += 4) {
#pragma unroll
                for (int ij = 0; ij < 4; ++ij) { const int i = i0 + ij; if (i < ntile) {
                    if (i + 2 < ntile) asm volatile("s_waitcnt vmcnt(4)" ::: "memory"); else if (i + 1 < ntile) asm volatile("s_waitcnt vmcnt(2)" ::: "memory"); else asm volatile("s_waitcnt vmcnt(0)" ::: "memory");
                    __builtin_amdgcn_s_barrier(); asm volatile("" ::: "memory");
                    if (i + 3 < ntile) ATT_ISSUE_S(i + 3, (ij + 3) & 3);
                    const int ks = ATT_KS(i);
                    const LAS unsigned char* Kc = ring + ij * 16384; const LAS unsigned char* Vc = Kc + 8192;
                    bf16x8 kfr[4][2];
#pragma unroll
                    for (int kt = 0; kt < 4; ++kt)
#pragma unroll
                        for (int c = 0; c < 2; ++c) kfr[kt][c] = *(const LAS bf16x8*)(Kc + (kt * 16 + ql) * 128 + (((c * 4 + kg) ^ sw) << 4));
                    u32x2 vfr[2][4][2];
#pragma unroll
                    for (int kc = 0; kc < 2; ++kc)
#pragma unroll
                        for (int d = 0; d < 4; ++d) { const LAS unsigned char* vr = Vc + (d * 16 + ql) * 128 + (kg & 1) * 8; const int sg = kc * 4 + (kg >> 1);
                            vfr[kc][d][0] = *(const LAS u32x2*)(vr + ((sg ^ sw) << 4)); vfr[kc][d][1] = *(const LAS u32x2*)(vr + (((sg + 2) ^ sw) << 4)); }
                    __builtin_amdgcn_sched_barrier(0);
                    f32x4 Sx[4];
#pragma unroll
                    for (int kt = 0; kt < 4; ++kt) Sx[kt] = __builtin_amdgcn_mfma_f32_16x16x32_bf16(kfr[kt][0], qf[0], (f32x4){0.f, 0.f, 0.f, 0.f}, 0, 0, 0);
#pragma unroll
                    for (int kt = 0; kt < 4; ++kt) Sx[kt] = __builtin_amdgcn_mfma_f32_16x16x32_bf16(kfr[kt][1], qf[1], Sx[kt], 0, 0, 0);
                    const int nblk = ks >> 8; const bool own = i < nown;
                    const bool keepl = true; (void)own; (void)nblk; (void)s0; (void)s1; (void)s2;
                    if (own && ks + 63 > t0) {
#pragma unroll
                        for (int kt = 0; kt < 4; ++kt)
#pragma unroll
                            for (int jj = 0; jj < 4; ++jj) { const int key = ks + kt * 16 + 4 * kg + jj; Sx[kt][jj] = (key <= tq) ? Sx[kt][jj] : -1e30f; }
                    }
                    float mx = fmaxf(fmaxf(fmaxf(Sx[0][0], Sx[0][1]), fmaxf(Sx[0][2], Sx[0][3])), fmaxf(fmaxf(Sx[1][0], Sx[1][1]), fmaxf(Sx[1][2], Sx[1][3])));
                    mx = fmaxf(mx, fmaxf(fmaxf(fmaxf(Sx[2][0], Sx[2][1]), fmaxf(Sx[2][2], Sx[2][3])), fmaxf(fmaxf(Sx[3][0], Sx[3][1]), fmaxf(Sx[3][2], Sx[3][3]))));
                    mx = keepl ? mx : -1e30f;
                    mx = fmaxf(mx, __shfl_xor(mx, 16)); mx = fmaxf(mx, __shfl_xor(mx, 32));
                    const float mnew = fmaxf(mrun, mx); const float alpha = __builtin_amdgcn_exp2f(mrun - mnew); mrun = mnew;
                    const float moff = keepl ? mnew : 1e30f;
                    float rs = 0.f;
#pragma unroll
                    for (int kt = 0; kt < 4; ++kt)
#pragma unroll
                        for (int jj = 0; jj < 4; ++jj) { const float p = __builtin_amdgcn_exp2f(Sx[kt][jj] - moff); Sx[kt][jj] = p; rs += p; }
                    lrun = lrun * alpha + rs;
#pragma unroll
                    for (int d = 0; d < 4; ++d) O[d] *= alpha;
#pragma unroll
                    for (int kc = 0; kc < 2; ++kc) {
                        u32x4 pw; pw.x = cvt_pk_bf16(Sx[2 * kc][0], Sx[2 * kc][1]); pw.y = cvt_pk_bf16(Sx[2 * kc][2], Sx[2 * kc][3]); pw.z = cvt_pk_bf16(Sx[2 * kc + 1][0], Sx[2 * kc + 1][1]); pw.w = cvt_pk_bf16(Sx[2 * kc + 1][2], Sx[2 * kc + 1][3]);
                        const bf16x8 pb = __builtin_bit_cast(bf16x8, pw);
#pragma unroll
                        for (int d = 0; d < 4; ++d) { u32x4 vw; vw.x = vfr[kc][d][0].x; vw.y = vfr[kc][d][0].y; vw.z = vfr[kc][d][1].x; vw.w = vfr[kc][d][1].y;
                            O[d] = __builtin_amdgcn_mfma_f32_16x16x32_bf16(__builtin_bit_cast(bf16x8, vw), pb, O[d], 0, 0, 0); }
                    }
                } } }
                lrun += __shfl_xor(lrun, 16); lrun += __shfl_xor(lrun, 32);
#undef ATT_KS
#undef ATT_ISSUE_S
                { float* pp = PART + ((size_t)(tq * 8 + h) * 4 + 3) * 36;
#pragma unroll
                  for (int d = 0; d < 4; ++d) { u32x2 w; w.x = cvt_pk_bf16(O[d][0], O[d][1]); w.y = cvt_pk_bf16(O[d][2], O[d][3]); *(u32x2*)(pp + d * 8 + 2 * kg) = w; }
                  if (kg == 0) { pp[32] = mrun; pp[33] = lrun; } }
                __syncthreads();
            }
        }
        }
        { int tid = tid0; asm volatile("" : "+v"(tid)); const int lane = tid & 63; (void)lane;
        for (int unit = bid; unit < 512; unit += G) {
            const int c = unit >> 2, h = unit & 3, t0 = c * 64;
            LAS float* qtT = (LAS float*)lds;
            LAS float* ktT = (LAS float*)(lds + 16384);
            LAS float* khS = (LAS float*)(lds + 32768);
            LAS float* vS = (LAS float*)(lds + 49152);
            LAS float* AT = (LAS float*)(lds + 81920);
            LAS float* xgs = (LAS float*)(lds + 98304);
            const bf16_t* pd = P + (size_t)t0 * NINP + PC_D;
            for (int i = tid; i < 1024; i += 512) { const int t = i >> 4, j = i & 15; xgs[i] = bf2f(pd[(size_t)t * NINP + 1024 + j]); }
            for (int i = 0; i < 2; ++i) { const int idx = tid + 512 * i; const int s = idx >> 4, e0 = (idx & 15) * 8; float z[8]; unpack8(*(const u32x4*)(pd + (size_t)s * NINP + 512 + h * 128 + e0), z);
#pragma unroll
                for (int j = 0; j < 8; ++j) vS[s * 128 + e0 + j] = z[j]; }
            __syncthreads();
            { const int t = tid >> 3, dg = (tid & 7) * 8; const float* gw2 = args.in[I_DGW2] + (size_t)l * 16 * 256 + h * 64 + dg; const float* gb = args.in[I_DGB] + l * 256 + h * 64 + dg;
              float a[8];
#pragma unroll
              for (int j = 0; j < 8; ++j) a[j] = gb[j];
              for (int r = 0; r < 16; ++r) { const float xv = xgs[t * 16 + r];
#pragma unroll
                  for (int j = 0; j < 8; ++j) a[j] += xv * gw2[r * 256 + j]; }
#pragma unroll
              for (int j = 0; j < 8; ++j) { const float x = a[j]; const float ls = fminf(x, 0.f) - __logf(1.f + __expf(-fabsf(x))); AT[t * 64 + dg + j] = ls * (1.f / 16.f); } }
            __syncthreads();
            if (tid < 64) { float run = 0.f; for (int t = 0; t < 64; ++t) { run += AT[t * 64 + tid]; AT[t * 64 + tid] = run; } }
            __syncthreads();
            { const int t = tid >> 3, dg = (tid & 7) * 8; float qz[8], kz[8];
              unpack8(*(const u32x4*)(pd + (size_t)t * NINP + h * 64 + dg), qz); unpack8(*(const u32x4*)(pd + (size_t)t * NINP + 256 + h * 64 + dg), kz);
#pragma unroll
              for (int j = 0; j < 8; ++j) { const int d = dg + j; const float cm = AT[t * 64 + d], last = AT[63 * 64 + d];
                  const float qv = qz[j] * 0.125f * __expf(cm); qtT[d * 64 + t] = qv; ktT[d * 64 + t] = kz[j] * __expf(-cm); khS[t * 64 + d] = kz[j] * __expf(last - cm);
                  QT[(size_t)(t0 + t) * 256 + h * 64 + d] = qv;
                  if (t == 63) LAM[(c * 4 + h) * 64 + d] = __expf(last); } }
            __syncthreads();
            if (tid < 256) { const int tq0 = (tid & 15) * 4, sq0 = (tid >> 4) * 4; float a[4][4];
#pragma unroll
                for (int i = 0; i < 4; ++i)
#pragma unroll
                    for (int j = 0; j < 4; ++j) a[i][j] = 0.f;
                for (int d0 = 0; d0 < 64; d0 += 8) { f32x4 qv[8], kv[8];
#pragma unroll
                    for (int q = 0; q < 8; ++q) { qv[q] = *(const LAS f32x4*)(qtT + (d0 + q) * 64 + tq0); kv[q] = *(const LAS f32x4*)(ktT + (d0 + q) * 64 + sq0); }
                    __builtin_amdgcn_sched_barrier(0);
#pragma unroll
                    for (int q = 0; q < 8; ++q)
#pragma unroll
                        for (int i = 0; i < 4; ++i)
#pragma unroll
                            for (int j = 0; j < 4; ++j) a[i][j] += qv[q][i] * kv[q][j];
                    __builtin_amdgcn_sched_barrier(0); }
                asm volatile("" ::: "memory");
#pragma unroll
                for (int j = 0; j < 4; ++j) { f32x4 o;
#pragma unroll
                    for (int i = 0; i < 4; ++i) o[i] = (sq0 + j <= tq0 + i) ? a[i][j] : 0.f;
                    *(LAS f32x4*)(AT + (sq0 + j) * 64 + tq0) = o; } }
            __syncthreads();
            { const int x0 = (tid & 15) * 4, e0 = (tid >> 4) * 4; float o[4][4], u[4][4];
#pragma unroll
              for (int i = 0; i < 4; ++i)
#pragma unroll
                  for (int j = 0; j < 4; ++j) { o[i][j] = 0.f; u[i][j] = 0.f; }
              for (int s0 = 0; s0 < 64; s0 += 4) { f32x4 av[4], kv[4], vv[4];
#pragma unroll
                  for (int q = 0; q < 4; ++q) { av[q] = *(const LAS f32x4*)(AT + (s0 + q) * 64 + x0); kv[q] = *(const LAS f32x4*)(khS + (s0 + q) * 64 + x0); vv[q] = *(const LAS f32x4*)(vS + (s0 + q) * 128 + e0); }
                  __builtin_amdgcn_sched_barrier(0);
#pragma unroll
                  for (int q = 0; q < 4; ++q)
#pragma unroll
                      for (int i = 0; i < 4; ++i)
#pragma unroll
                          for (int j = 0; j < 4; ++j) { o[i][j] += av[q][i] * vv[q][j]; u[i][j] += kv[q][i] * vv[q][j]; }
                  __builtin_amdgcn_sched_barrier(0); }
#pragma unroll
              for (int i = 0; i < 4; ++i) { *(f32x4*)(OI + (size_t)(t0 + x0 + i) * 512 + h * 128 + e0) = (f32x4){o[i][0], o[i][1], o[i][2], o[i][3]};
                  *(f32x4*)(GU + ((size_t)(c * 4 + h) * 64 + x0 + i) * 128 + e0) = (f32x4){u[i][0], u[i][1], u[i][2], u[i][3]}; } }
            __syncthreads();
        }
        }
        { int tid = tid0; asm volatile("" : "+v"(tid)); const int lane = tid & 63; (void)lane;
        { const int wu = bid * 8 + wave; if (wu < 2048) {
            const int h = wu >> 8, c = (wu >> 1) & 127, kind = wu & 1; const size_t tb = (size_t)h * SEQ + c * 64;
            LAS float* buf = (LAS float*)(lds + wave * 10240);
            const f32x4* src = (const f32x4*)(VEC5 + tb * 320);
            const float* vsrc = VV + tb * 64 + lane;
            f32x2 St[32];
            { const f32x4* si = (const f32x4*)(IDZ + kind * 4096 + lane * 64);
#pragma unroll
              for (int k4 = 0; k4 < 16; ++k4) { const f32x4 v = si[k4]; St[2 * k4] = RWKV_LO(v); St[2 * k4 + 1] = RWKV_HI(v); } }
            float vn[4];
#pragma unroll
            for (int j = 0; j < 5; ++j) __builtin_amdgcn_global_load_lds((const unsigned*)(src + j * 64 + lane), (LAS unsigned*)(buf + j * 256), 16, 0, 0);
            const float vsc = kind ? 1.f : 0.f;
#pragma unroll
            for (int j = 0; j < 4; ++j) vn[j] = vsrc[j * 64];
            asm volatile("s_waitcnt vmcnt(0)" ::: "memory");
            for (int b = 0; b < 16; ++b) {
                const float vc0 = vn[0], vc1 = vn[1], vc2 = vn[2], vc3 = vn[3];
                if (b + 1 < 16) { LAS float* nb = buf + ((b + 1) & 1) * 1280;
#pragma unroll
                    for (int j = 0; j < 5; ++j) __builtin_amdgcn_global_load_lds((const unsigned*)(src + (b + 1) * 320 + j * 64 + lane), (LAS unsigned*)(nb + j * 256), 16, 0, 0);
#pragma unroll
                    for (int j = 0; j < 4; ++j) vn[j] = vsrc[((b + 1) * 4 + j) * 64];
                }
                const LAS float* cb = buf + (b & 1) * 1280;
#pragma unroll 1
                for (int s = 0; s < 4; ++s) {
                    const LAS float* st = cb + s * 320;
                    const float vi = (s == 0 ? vc0 : (s == 1 ? vc1 : (s == 2 ? vc2 : vc3))) * vsc;
                    float yy; RWKV_STEP(st, vi, St, false, true, yy); (void)yy;
                }
                asm volatile("s_waitcnt vmcnt(0)" ::: "memory");
            }
            f32x4* po = (f32x4*)((kind ? LCH : PCH) + ((size_t)(h * 128 + c) * 64 + lane) * 64);
#pragma unroll
            for (int k4 = 0; k4 < 16; ++k4) po[k4] = (f32x4){St[2 * k4].x, St[2 * k4].y, St[2 * k4 + 1].x, St[2 * k4 + 1].y};
        }
        }
        }
        fast_barrier(BAR, ++bar_epoch, (unsigned)G);
        { int tid = tid0; asm volatile("" : "+v"(tid)); const int lane = tid & 63; (void)lane;
        if (bid < 64) {
            const int h = bid >> 3, rg = bid & 7;
            LAS float* Pb = (LAS float*)lds;
            LAS float* Sb = (LAS float*)(lds + 32768);
            if (wave < 4) {
                const int rl = wave * 2 + (lane >> 5), cl = 2 * (lane & 31); const int row = rg * 8 + rl;
                float zz = 0.f; asm volatile("" : "+v"(zz)); const f32x2 z2 = (f32x2){zz, zz};
                const float* Pg = PCH + (size_t)(h * 128) * 4096; const float* Lg = LCH + (size_t)(h * 128) * 4096 + row * 64 + cl;
                f32x4 pq[4][4]; f32x2 lnq[4];
                { const f32x4* ps = (const f32x4*)Pg + tid * 4;
#pragma unroll
                  for (int q = 0; q < 4; ++q) *(LAS f32x4*)(Pb + tid * 16 + q * 4) = ps[q]; }
#pragma unroll
                for (int p = 1; p <= 4; ++p) { const f32x4* ps = (const f32x4*)(Pg + (size_t)p * 4096) + tid * 4;
#pragma unroll
                    for (int q = 0; q < 4; ++q) pq[p & 3][q] = ps[q]; }
#pragma unroll
                for (int q = 0; q < 4; ++q) lnq[q] = *(const f32x2*)(Lg + (size_t)q * 4096);
                *(LAS f32x2*)(Sb + rl * 64 + cl) = z2;
                f32x2 sv = z2;
                asm volatile("s_waitcnt lgkmcnt(0)" ::: "memory"); __builtin_amdgcn_s_barrier(); asm volatile("" ::: "memory");
                for (int c0 = 0; c0 < 128; c0 += 4) {
#pragma unroll
                    for (int ci = 0; ci < 4; ++ci) {
                        const int c = c0 + ci;
                        const LAS float* Pc = Pb + (c & 1) * 4096; const LAS float* Sc = Sb + (c & 1) * 512 + rl * 64;
                        *(f32x2*)(SIN + (size_t)(h * 128 + c) * 4096 + row * 64 + cl) = sv;
                        f32x2 a0 = lnq[ci], a1 = z2;
                        { const int cn = c + 4 < 128 ? c + 4 : 127; lnq[ci] = *(const f32x2*)(Lg + (size_t)cn * 4096); }
                        f32x4 sr_[16]; f32x2 pr_[2][16];
#pragma unroll
                        for (int q = 0; q < 16; ++q) sr_[q] = *(const LAS f32x4*)(Sc + q * 4);
#pragma unroll
                        for (int q = 0; q < 16; ++q) pr_[0][q] = *(const LAS f32x2*)(Pc + q * 64 + cl);
#pragma unroll
                        for (int g = 0; g < 4; ++g) {
                            if (g + 1 < 4) {
#pragma unroll
                                for (int q = 0; q < 16; ++q) pr_[(g + 1) & 1][q] = *(const LAS f32x2*)(Pc + ((g + 1) * 16 + q) * 64 + cl); }
                            __builtin_amdgcn_sched_barrier(0);
#pragma unroll
                            for (int q = 0; q < 16; q += 2) { const int k = g * 16 + q; a0 += sr_[k >> 2][k & 3] * pr_[g & 1][q]; a1 += sr_[(k + 1) >> 2][(k + 1) & 3] * pr_[g & 1][q + 1]; }
                            __builtin_amdgcn_sched_barrier(0);
                        }
                        sv = a0 + a1;
                        *(LAS f32x2*)(Sb + ((c + 1) & 1) * 512 + rl * 64 + cl) = sv;
                        { LAS float* Pn = Pb + ((c + 1) & 1) * 4096 + tid * 16;
#pragma unroll
                          for (int q = 0; q < 4; ++q) *(LAS f32x4*)(Pn + q * 4) = pq[(ci + 1) & 3][q]; }
                        { const int cn = c + 5 < 128 ? c + 5 : 127; const f32x4* ps = (const f32x4*)(Pg + (size_t)cn * 4096) + tid * 4;
#pragma unroll
                          for (int q = 0; q < 4; ++q) pq[(ci + 1) & 3][q] = ps[q]; }
                        asm volatile("s_waitcnt lgkmcnt(0)" ::: "memory"); __builtin_amdgcn_s_barrier(); asm volatile("" ::: "memory");
                    }
                }
            } else {
                for (int c = 0; c < 129; ++c) { __builtin_amdgcn_s_barrier(); asm volatile("" ::: "memory"); }
            }
        } else if (bid < 128) {
            const int idx = (bid - 64) * 512 + tid; float S = 0.f;
            for (int c0 = 0; c0 < 128; c0 += 16) { float u[16], lam[16];
#pragma unroll
                for (int i = 0; i < 16; ++i) { u[i] = GU[(size_t)(c0 + i) * 32768 + idx]; lam[i] = LAM[(c0 + i) * 256 + (idx >> 7)]; }
#pragma unroll
                for (int i = 0; i < 16; ++i) { GU[(size_t)(c0 + i) * 32768 + idx] = S; S = lam[i] * S + u[i]; } }
        } else if (G >= 256) {
            convert_layer_weights(args, ws, l, (LAS float*)(lds + wave * 16896), (bid - 128) * 8 + wave, (G - 128) * 8, lane, 3968, 9600);
        }
        }
        { int tid = tid0; asm volatile("" : "+v"(tid)); const int lane = tid & 63; (void)lane;
        for (;;) {
            __syncthreads();
            if (tid == 0) *(LAS int*)(lds + 36864 + 4096 + 64) = (int)__hip_atomic_fetch_add(BAR + 1024 + 64 * l, 1u, __ATOMIC_RELAXED, __HIP_MEMORY_SCOPE_AGENT);
            __syncthreads();
            const int u = *(LAS int*)(lds + 36864 + 4096 + 64);
            if (u >= 1088) break;
            const int h = u & 7; int n = 0, r = 0;
            { int rem = u >> 3; for (n = 0; n < 31; ++n) { const int cn = 8 - ((n + 1) >> 2); if (rem < cn) { r = ((n + 1) >> 2) + rem; break; } rem -= cn; } }
            LAS int* listS = (LAS int*)(lds + 36864);
            LAS int* wcnt = (LAS int*)(lds + 36864 + 4096);
            LAS unsigned char* ring = lds + 49152;
            const int lrow = tid >> 3, lseg = (tid & 7) ^ (lrow & 7);
            const bf16_t* kgp = KB + (size_t)(n * 256 + lrow) * 512 + h * 64 + lseg * 8; const bf16_t* vgp = VT + (size_t)(h * 64 + lrow) * SEQ + n * 256 + lseg * 8;
#pragma unroll
            for (int j = 0; j < 4; ++j) { LAS unsigned char* tb_ = ring + j * 16384 + wave * 1024;
                __builtin_amdgcn_global_load_lds((const unsigned*)(kgp + (size_t)j * 64 * 512), (LAS unsigned*)tb_, 16, 0, 0);
                __builtin_amdgcn_global_load_lds((const unsigned*)(vgp + j * 64), (LAS unsigned*)(tb_ + 8192), 16, 0, 0); }
            int myslot[2], mypre[2];
#pragma unroll
            for (int p = 0; p < 2; ++p) { const int t = r * 1024 + p * 512 + tid; const int sv = SEL[h * SEQ + t];
                const int sl = ((sv & 255) == n) ? 0 : ((((sv >> 8) & 255) == n) ? 1 : ((((sv >> 16) & 255) == n) ? 2 : -1));
                const unsigned long long bal = __ballot(sl >= 0);
                myslot[p] = sl; mypre[p] = __popcll(bal & ((1ull << lane) - 1ull));
                if (lane == 0) wcnt[p * 8 + wave] = __popcll(bal); }
            __syncthreads();
            int cnt = 0, base0 = 0, base1 = 0;
#pragma unroll
            for (int q = 0; q < 16; ++q) { const int c = wcnt[q]; if (q == wave) base0 = cnt; if (q == 8 + wave) base1 = cnt; cnt += c; }
            if (myslot[0] >= 0) listS[base0 + mypre[0]] = ((r * 1024 + tid) << 2) | myslot[0];
            if (myslot[1] >= 0) listS[base1 + mypre[1]] = ((r * 1024 + 512 + tid) << 2) | myslot[1];
            asm volatile("s_waitcnt vmcnt(0)" ::: "memory");
            __syncthreads();
            const int ql = lane & 15, kg = lane >> 4, sw = ql & 7;
            for (int ch = 0; ch * 128 < cnt; ++ch) {
                const int e = ch * 128 + wave * 16 + ql; const bool has = e < cnt; const int ent = listS[has ? e : 0]; const int tq = ent >> 2, slot = ent & 3;
                bf16x8 qf[2];
                qf[0] = *(const bf16x8*)(QB + (size_t)tq * 512 + h * 64 + kg * 8); qf[1] = *(const bf16x8*)(QB + (size_t)tq * 512 + h * 64 + 32 + kg * 8);
                float mrun = -1e30f, lrun = 0.f; f32x4 O[4];
#pragma unroll
                for (int d = 0; d < 4; ++d) O[d] = (f32x4){0.f, 0.f, 0.f, 0.f};
#pragma unroll
                for (int ij = 0; ij < 4; ++ij) {
                    const LAS unsigned char* Kc = ring + ij * 16384; const LAS unsigned char* Vc = Kc + 8192;
                    bf16x8 kfr[4][2];
#pragma unroll
                    for (int kt = 0; kt < 4; ++kt)
#pragma unroll
                        for (int c = 0; c < 2; ++c) kfr[kt][c] = *(const LAS bf16x8*)(Kc + (kt * 16 + ql) * 128 + (((c * 4 + kg) ^ sw) << 4));
                    u32x2 vfr[2][4][2];
#pragma unroll
                    for (int kc = 0; kc < 2; ++kc)
#pragma unroll
                        for (int d = 0; d < 4; ++d) { const LAS unsigned char* vr = Vc + (d * 16 + ql) * 128 + (kg & 1) * 8; const int sg = kc * 4 + (kg >> 1);
                            vfr[kc][d][0] = *(const LAS u32x2*)(vr + ((sg ^ sw) << 4)); vfr[kc][d][1] = *(const LAS u32x2*)(vr + (((sg + 2) ^ sw) << 4)); }
                    __builtin_amdgcn_sched_barrier(0);
                    f32x4 Sx[4];
#pragma unroll
                    for (int kt = 0; kt < 4; ++kt) Sx[kt] = __builtin_amdgcn_mfma_f32_16x16x32_bf16(kfr[kt][0], qf[0], (f32x4){0.f, 0.f, 0.f, 0.f}, 0, 0, 0);
#pragma unroll
                    for (int kt = 0; kt < 4; ++kt) Sx[kt] = __builtin_amdgcn_mfma_f32_16x16x32_bf16(kfr[kt][1], qf[1], Sx[kt], 0, 0, 0);
                    float mx = fmaxf(fmaxf(fmaxf(Sx[0][0], Sx[0][1]), fmaxf(Sx[0][2], Sx[0][3])), fmaxf(fmaxf(Sx[1][0], Sx[1][1]), fmaxf(Sx[1][2], Sx[1][3])));
                    mx = fmaxf(mx, fmaxf(fmaxf(fmaxf(Sx[2][0], Sx[2][1]), fmaxf(Sx[2][2], Sx[2][3])), fmaxf(fmaxf(Sx[3][0], Sx[3][1]), fmaxf(Sx[3][2], Sx[3][3]))));
                    mx = fmaxf(mx, __shfl_xor(mx, 16)); mx = fmaxf(mx, __shfl_xor(mx, 32));
                    const float mnew = fmaxf(mrun, mx); const float alpha = __builtin_amdgcn_exp2f(mrun - mnew); mrun = mnew;
                    float rs = 0.f;
#pragma unroll
                    for (int kt = 0; kt < 4; ++kt)
#pragma unroll
                        for (int jj = 0; jj < 4; ++jj) { const float p = __builtin_amdgcn_exp2f(Sx[kt][jj] - mnew); Sx[kt][jj] = p; rs += p; }
                    lrun = lrun * alpha + rs;
#pragma unroll
                    for (int d = 0; d < 4; ++d) O[d] *= alpha;
#pragma unroll
                    for (int kc = 0; kc < 2; ++kc) {
                        u32x4 pw; pw.x = cvt_pk_bf16(Sx[2 * kc][0], Sx[2 * kc][1]); pw.y = cvt_pk_bf16(Sx[2 * kc][2], Sx[2 * kc][3]); pw.z = cvt_pk_bf16(Sx[2 * kc + 1][0], Sx[2 * kc + 1][1]); pw.w = cvt_pk_bf16(Sx[2 * kc + 1][2], Sx[2 * kc + 1][3]);
                        const bf16x8 pb = __builtin_bit_cast(bf16x8, pw);
#pragma unroll
                        for (int d = 0; d < 4; ++d) { u32x4 vw; vw.x = vfr[kc][d][0].x; vw.y = vfr[kc][d][0].y; vw.z = vfr[kc][d][1].x; vw.w = vfr[kc][d][1].y;
                            O[d] = __builtin_amdgcn_mfma_f32_16x16x32_bf16(__builtin_bit_cast(bf16x8, vw), pb, O[d], 0, 0, 0); }
                    }
                }
                lrun += __shfl_xor(lrun, 16); lrun += __shfl_xor(lrun, 32);
                if (has) { float* pp = PART + ((size_t)(tq * 8 + h) * 4 + slot) * 36;
#pragma unroll
                    for (int d = 0; d < 4; ++d) { u32x2 w; w.x = cvt_pk_bf16(O[d][0], O[d][1]); w.y = cvt_pk_bf16(O[d][2], O[d][3]); *(u32x2*)(pp + d * 8 + 2 * kg) = w; }
                    if (kg == 0) { pp[32] = mrun; pp[33] = lrun; } }
            }
            __syncthreads();
        }
        }
        fast_barrier(BAR, ++bar_epoch, (unsigned)G);
        { int tid = tid0; asm volatile("" : "+v"(tid)); const int lane = tid & 63; (void)lane;
        for (int unit = bid; unit < 512; unit += G) {
            const int c = unit >> 2, h = unit & 3, t0 = c * 64;
            LAS float* qtT = (LAS float*)lds;
            LAS float* Sd = (LAS float*)(lds + 16384);
            LAS float* red = (LAS float*)(lds + 49152);
            for (int i = 0; i < 8; ++i) { const int idx = tid + 512 * i; const int t = idx >> 6, d = idx & 63; qtT[d * 64 + t] = QT[(size_t)(t0 + t) * 256 + h * 64 + d]; }
            { const f32x4* ss = (const f32x4*)(GU + (size_t)(c * 4 + h) * 8192);
#pragma unroll
              for (int i = 0; i < 4; ++i) *(LAS f32x4*)(Sd + (tid + 512 * i) * 4) = ss[tid + 512 * i]; }
            __syncthreads();
            const int x0 = (tid & 15) * 4, e0 = (tid >> 4) * 4; float o[4][4];
#pragma unroll
            for (int i = 0; i < 4; ++i) { const f32x4 v = *(const f32x4*)(OI + (size_t)(t0 + x0 + i) * 512 + h * 128 + e0); o[i][0] = v[0]; o[i][1] = v[1]; o[i][2] = v[2]; o[i][3] = v[3]; }
            for (int d0 = 0; d0 < 64; d0 += 8) { f32x4 qv[8], sv[8];
#pragma unroll
                for (int q = 0; q < 8; ++q) { qv[q] = *(const LAS f32x4*)(qtT + (d0 + q) * 64 + x0); sv[q] = *(const LAS f32x4*)(Sd + (d0 + q) * 128 + e0); }
                __builtin_amdgcn_sched_barrier(0);
#pragma unroll
                for (int q = 0; q < 8; ++q)
#pragma unroll
                    for (int i = 0; i < 4; ++i)
#pragma unroll
                        for (int j = 0; j < 4; ++j) o[i][j] += qv[q][i] * sv[q][j];
                __builtin_amdgcn_sched_barrier(0); }
#pragma unroll
            for (int i = 0; i < 4; ++i) red[(x0 + i) * 32 + (tid >> 4)] = (o[i][0] * o[i][0] + o[i][1] * o[i][1]) + (o[i][2] * o[i][2] + o[i][3] * o[i][3]);
            __syncthreads();
            const float* ng = args.in[I_DNG] + l * 128 + e0;
#pragma unroll
            for (int i = 0; i < 4; ++i) { const int t = t0 + x0 + i; float s = 0.f;
#pragma unroll
                for (int j = 0; j < 8; ++j) { const f32x4 v = *(const LAS f32x4*)(red + (x0 + i) * 32 + j * 4); s += (v[0] + v[1]) + (v[2] + v[3]); }
                const float rs = rsqrtf(s * (1.f / 128.f) + EPS);
                const bf16_t* og = P + (size_t)t * NINP + PC_D + 1040 + h * 128 + e0; const u32x2 raw = *(const u32x2*)og;
                const float g0 = bflo(raw.x), g1 = bfhi(raw.x), g2 = bflo(raw.y), g3 = bfhi(raw.y);
                const float y0 = o[i][0] * rs * ng[0] * (g0 * sigmoidf_(g0)), y1 = o[i][1] * rs * ng[1] * (g1 * sigmoidf_(g1)), y2 = o[i][2] * rs * ng[2] * (g2 * sigmoidf_(g2)), y3 = o[i][3] * rs * ng[3] * (g3 * sigmoidf_(g3));
                u32x2 w; w.x = cvt_pk_bf16(y0, y1); w.y = cvt_pk_bf16(y2, y3);
                *(u32x2*)(Y + (size_t)t * DM + 1536 + h * 128 + e0) = w; }
            __syncthreads();
        }
        if (wave < 4) {
            const int u = bid * 4 + wave;
            if (u < 1024) {
                const int h = u >> 7, c = u & 127; const size_t tb = (size_t)h * SEQ + c * 64; const int tbase = c * 64;
                LAS float* buf = (LAS float*)(lds + wave * 10240);
                const f32x4* src = (const f32x4*)(VEC5 + tb * 320);
                const float* vsrc = VV + tb * 64 + lane;
                const int ch = h * 64 + lane;
                const float lg = args.in[I_BLNG][l * 512 + ch], lbias = args.in[I_BLNB][l * 512 + ch];
                const float* bvp = BV + (size_t)tbase * 512 + ch; const float* ggp = GG + (size_t)tbase * 512 + ch;
                f32x2 St[32];
                { const f32x4* si = (const f32x4*)(SIN + ((size_t)u * 64 + lane) * 64);
#pragma unroll
                  for (int k4 = 0; k4 < 16; ++k4) { const f32x4 v = si[k4]; St[2 * k4] = RWKV_LO(v); St[2 * k4 + 1] = RWKV_HI(v); } }
                float vn[4];
#pragma unroll
                for (int j = 0; j < 5; ++j) __builtin_amdgcn_global_load_lds((const unsigned*)(src + j * 64 + lane), (LAS unsigned*)(buf + j * 256), 16, 0, 0);
#pragma unroll
                for (int j = 0; j < 4; ++j) vn[j] = vsrc[j * 64];
                asm volatile("s_waitcnt vmcnt(0)" ::: "memory");
                for (int b = 0; b < 16; ++b) {
                    const float vc0 = vn[0], vc1 = vn[1], vc2 = vn[2], vc3 = vn[3];
                    float bvc[4], ggc[4];
#pragma unroll
                    for (int j = 0; j < 4; ++j) { bvc[j] = bvp[(b * 4 + j) * 512]; ggc[j] = ggp[(b * 4 + j) * 512]; }
                    float yv0 = 0.f, yv1 = 0.f, yv2 = 0.f, yv3 = 0.f;
                    if (b + 1 < 16) { LAS float* nb = buf + ((b + 1) & 1) * 1280;
#pragma unroll
                        for (int j = 0; j < 5; ++j) __builtin_amdgcn_global_load_lds((const unsigned*)(src + (b + 1) * 320 + j * 64 + lane), (LAS unsigned*)(nb + j * 256), 16, 0, 0);
#pragma unroll
                        for (int j = 0; j < 4; ++j) vn[j] = vsrc[((b + 1) * 4 + j) * 64];
                    }
                    const LAS float* cb = buf + (b & 1) * 1280;
#pragma unroll 1
                    for (int s = 0; s < 4; ++s) {
                        const LAS float* st = cb + s * 320;
                        const float vi = s == 0 ? vc0 : (s == 1 ? vc1 : (s == 2 ? vc2 : vc3));
                        float yy; RWKV_STEP(st, vi, St, true, true, yy);
                        yv0 = s == 0 ? yy : yv0; yv1 = s == 1 ? yy : yv1; yv2 = s == 2 ? yy : yv2; yv3 = s == 3 ? yy : yv3;
                    }
                    asm volatile("s_waitcnt vmcnt(0)" ::: "memory");
                    const float yv[4] = {yv0, yv1, yv2, yv3};
                    float st8[8] = {yv[0], yv[1], yv[2], yv[3], yv[0] * yv[0], yv[1] * yv[1], yv[2] * yv[2], yv[3] * yv[3]};
                    wave_sum_n<8>(st8);
#pragma unroll
                    for (int s = 0; s < 4; ++s) { const int t = tbase + b * 4 + s;
                        const float m = st8[s] * (1.f / 64.f); const float var = fmaxf(st8[4 + s] * (1.f / 64.f) - m * m, 0.f);
                        const float yn = (yv[s] - m) * rsqrtf(var + 64e-5f) * lg + lbias;
                        Y[(size_t)t * DM + 512 + ch] = f2bf((yn + bvc[s]) * ggc[s]); }
                }
            }
        } else {
            for (int t = bid * 4 + (wave - 4); t < SEQ; t += G * 4) {
            const int h = lane >> 3, dg = (lane & 7) * 8; const int qb = t >> 8; const int nv = qb < 3 ? qb : 3;
            const float* pp = PART + ((size_t)(t * 8 + h) * 4) * 36;
            const float m3 = pp[3 * 36 + 32], l3 = pp[3 * 36 + 33];
            float mk[3], lk[3]; float M = m3;
#pragma unroll
            for (int q = 0; q < 3; ++q) { mk[q] = q < nv ? pp[q * 36 + 32] : -1e30f; lk[q] = q < nv ? pp[q * 36 + 33] : 0.f; M = fmaxf(M, mk[q]); }
            const float w3 = __builtin_amdgcn_exp2f(m3 - M); float L = w3 * l3;
            float acc8[8];
            { float z[8]; unpack8(*(const u32x4*)(pp + 3 * 36 + (dg >> 1)), z);
#pragma unroll
              for (int e = 0; e < 8; ++e) acc8[e] = z[e] * w3; }
#pragma unroll
            for (int q = 0; q < 3; ++q) if (q < nv) { const float wq = __builtin_amdgcn_exp2f(mk[q] - M); L += wq * lk[q];
                float z[8]; unpack8(*(const u32x4*)(pp + q * 36 + (dg >> 1)), z);
#pragma unroll
                for (int e = 0; e < 8; ++e) acc8[e] += z[e] * wq; }
            const f32x4 a0 = (f32x4){acc8[0], acc8[1], acc8[2], acc8[3]}, a1 = (f32x4){acc8[4], acc8[5], acc8[6], acc8[7]};
            const float il = 1.f / L;
            u32x4 w; w.x = cvt_pk_bf16(a0[0] * il, a0[1] * il); w.y = cvt_pk_bf16(a0[2] * il, a0[3] * il); w.z = cvt_pk_bf16(a1[0] * il, a1[1] * il); w.w = cvt_pk_bf16(a1[2] * il, a1[3] * il);
            *(u32x4*)(Y + (size_t)t * DM + 1024 + h * 64 + dg) = w;
        }
            if (G >= 256) {
            LAS float* scr = (LAS float*)(lds + 49152 + (wave - 4) * 16896);
            convert_layer_weights(args, ws, l, scr, bid * 4 + (wave - 4), G * 4, lane, 9600, 12416);
            if (l == 0) convert_layer_weights(args, ws, 1, scr, bid * 4 + (wave - 4), G * 4, lane, 0, 3968);
            }
        }
        }
        fast_barrier(BAR, ++bar_epoch, (unsigned)G);
        { int tid = tid0; asm volatile("" : "+v"(tid)); const int lane = tid & 63; (void)lane;
        {
            pg8::Gemm g{Y, (const bf16_t*)(wt + WT_OUT), SEQ, DM, DM, 256}; pg8::StaticOrder S; S.init(SEQ, DM, G, bid);
            pg8::EpiResid E{l == 0 ? args.in[I_X] : (const float*)XR, XR, XB, SSQ, lds};
            pg8::gemm_phase<pg8::EpiResid>(lds, g, S, E);
        }
        }
        fast_barrier(BAR, ++bar_epoch, (unsigned)G);
        { int tid = tid0; asm volatile("" : "+v"(tid)); const int lane = tid & 63; (void)lane;
        {
            pg8::Gemm g{XB, (const bf16_t*)(wt + WT_UP), 33 * 256, NUP, DM, 254}; pg8::StaticOrder S; S.init(33 * 256, NUP, G, bid);
            pg8::EpiConvSwiGLU E{ACT, SSQ, args.in[I_CONVW] + (size_t)l * 3 * NUP, args.in[I_CONVB] + (size_t)l * NUP};
            pg8::Unit uu;
            for (int i = 0; S.next(i, uu); ++i) { pg8::OneUnit one{uu}; pg8::gemm_phase<pg8::EpiConvSwiGLU, pg8::OneUnit>(lds, g, one, E); }
        }
        }
        fast_barrier(BAR, ++bar_epoch, (unsigned)G);
        { int tid = tid0; asm volatile("" : "+v"(tid)); const int lane = tid & 63; (void)lane;
        {
            pg8::Gemm g{ACT, (const bf16_t*)(wt + WT_DOWN), SEQ, DM, DFF, 256}; pg8::StaticOrder S; S.init(SEQ, DM, G, bid);
            pg8::EpiResid E{(const float*)XR, XR, XB, SSQ, lds};
            pg8::gemm_phase<pg8::EpiResid>(lds, g, S, E);
        }
        }
        fast_barrier(BAR, ++bar_epoch, (unsigned)G);
    }
        { int tid = tid0; asm volatile("" : "+v"(tid)); const int lane = tid & 63; (void)lane;
    {
        const float* fg = args.in[I_FING];
        for (int row = gw; row < SEQ; row += NGW) {
            float s = SSQ[(size_t)row * 8 + (lane & 7)]; s = wave_sum(s) * 0.125f;
            const float rs = rsqrtf(s * (1.f / 2048.f) + EPS);
            f32x4* xr = (f32x4*)(XR + (size_t)row * DM) + lane; const f32x4* gp = (const f32x4*)fg + lane;
#pragma unroll
            for (int j = 0; j < 8; ++j) { f32x4 v = xr[64 * j]; const f32x4 gv = gp[64 * j]; v = v * rs * gv; xr[64 * j] = v; }
        }
    }
        }
}

extern "C" void kernel_launch(void* const* d_in, const int* in_sizes, int n_in, void* d_out, int out_size, void* d_ws, size_t ws_size, hipStream_t stream) {
    static int grid = 0;
    if (grid == 0) {
        if (n_in != 28 || ws_size < WS_END) { fprintf(stderr, "kernel_launch: unexpected n_in %d / ws_size %zu\n", n_in, ws_size); grid = -1; return; }
        int dev = 0, cus = 0, per_cu = 0;
        hipGetDevice(&dev); hipDeviceGetAttribute(&cus, hipDeviceAttributeMultiprocessorCount, dev);
        hipFuncSetAttribute((const void*)mega_fwd, hipFuncAttributeMaxDynamicSharedMemorySize, LDS_BYTES);
        hipOccupancyMaxActiveBlocksPerMultiprocessor(&per_cu, (const void*)mega_fwd, 512, LDS_BYTES);
        if (per_cu < 1) { fprintf(stderr, "kernel_launch: occupancy query says %d blocks/CU\n", per_cu); per_cu = 1; }
        grid = cus * (per_cu > 1 ? 1 : per_cu);
    }
    if (grid < 0) return;
    (void)hipMemsetAsync(d_ws, 0, 8192, stream);
    Args a{};
    for (int i = 0; i < 28; ++i) a.in[i] = (const float*)d_in[i];
    a.out = (float*)d_out; a.ws = (unsigned char*)d_ws;
    void* kargs[] = {&a};
    hipError_t e = hipLaunchCooperativeKernel((const void*)mega_fwd, dim3(grid), dim3(512), kargs, LDS_BYTES, stream);
    if (e != hipSuccess) fprintf(stderr, "cooperative launch failed: %s (grid %d)\n", hipGetErrorString(e), grid);
}
```

```cpp
#include <hip/hip_runtime.h>
#include <hip/hip_cooperative_groups.h>
#include <cstdio>
#include <cstdint>
namespace cg = cooperative_groups;

#define LAS __attribute__((address_space(3)))
typedef unsigned short bf16_t;
typedef short bf16x8 __attribute__((ext_vector_type(8)));
typedef float f32x4 __attribute__((ext_vector_type(4)));
typedef float f32x2 __attribute__((ext_vector_type(2)));
typedef unsigned u32x4 __attribute__((ext_vector_type(4)));
typedef unsigned u32x2 __attribute__((ext_vector_type(2)));

constexpr int SEQ = 8192, DM = 2048, NIN = 5808, NINP = 5888, DFF = 5632, NUP = 11264;
constexpr int PC_A = 0, PC_B = 1024, PC_C = 2720, PC_D = 4256;
constexpr float EPS = 1e-6f;
constexpr float QSCALE = 0.125f * 1.4426950408889634f;

constexpr size_t MiB = 1u << 20;
constexpr size_t WS_ROPE = 1 * MiB, WS_SSQ = 3 * MiB, WS_KMEAN = 4 * MiB, WS_IDZ = 5 * MiB, WS_SEL = 6 * MiB, WS_WT = 8 * MiB;
constexpr size_t WT_IN = 0, WT_OUT = 23 * MiB, WT_UP = 31 * MiB, WT_DOWN = 75 * MiB, WT_LAYER = 97 * MiB;
constexpr size_t WS_XB = 202 * MiB, WS_Y = 234 * MiB, WS_P = 266 * MiB;
constexpr size_t WS_QB = 358 * MiB, WS_KB = 366 * MiB, WS_VT = 374 * MiB, WS_VEC5 = 382 * MiB, WS_VV = 462 * MiB, WS_GG = 478 * MiB, WS_BV = 494 * MiB;
constexpr size_t WS_PCH = 510 * MiB, WS_LCH = 526 * MiB, WS_SIN = 542 * MiB, WS_OI = 558 * MiB, WS_U = 574 * MiB, WS_QT = 590 * MiB, WS_LAM = 598 * MiB;
constexpr size_t WS_PART = 600 * MiB, WS_H = 266 * MiB, WS_ACT = 442 * MiB, WS_END = 640 * MiB;
constexpr int LDS_BYTES = 147456;

__device__ __forceinline__ float bf2f(bf16_t v) { return __uint_as_float((unsigned)v << 16); }
__device__ __forceinline__ float bflo(unsigned u) { return __uint_as_float(u << 16); }
__device__ __forceinline__ float bfhi(unsigned u) { return __uint_as_float(u & 0xffff0000u); }
__device__ __forceinline__ unsigned cvt_pk_bf16(float lo, float hi) { unsigned r; asm volatile("v_cvt_pk_bf16_f32 %0, %1, %2" : "=v"(r) : "v"(lo), "v"(hi)); return r; }
__device__ __forceinline__ bf16_t f2bf(float f) { return (bf16_t)(cvt_pk_bf16(f, 0.f) & 0xffffu); }
__device__ __forceinline__ float wave_sum(float v) {
#pragma unroll
    for (int o = 32; o > 0; o >>= 1) v += __shfl_xor(v, o);
    return v;
}

template <int N> __device__ __forceinline__ void wave_sum_n(float (&v)[N]) {
#pragma unroll
    for (int o = 32; o > 0; o >>= 1) { float t[N];
#pragma unroll
        for (int i = 0; i < N; ++i) t[i] = __shfl_xor(v[i], o);
#pragma unroll
        for (int i = 0; i < N; ++i) v[i] += t[i]; }
}
__device__ __forceinline__ float sigmoidf_(float x) { return __builtin_amdgcn_rcpf(1.f + __expf(-x)); }
__device__ __forceinline__ float gelu_tanh(float x) { const float u = 0.7978845608f * (x + 0.044715f * x * x * x); const float e = __expf(2.f * u); const float th = 1.f - 2.f * __builtin_amdgcn_rcpf(e + 1.f); return 0.5f * x * (1.f + th); }
__device__ __forceinline__ void unpack8(const u32x4 r, float (&z)[8]) { z[0] = bflo(r.x); z[1] = bfhi(r.x); z[2] = bflo(r.y); z[3] = bfhi(r.y); z[4] = bflo(r.z); z[5] = bfhi(r.z); z[6] = bflo(r.w); z[7] = bfhi(r.w); }

__device__ __forceinline__ void fast_barrier(unsigned* bar, unsigned epoch  , unsigned G) {
    asm volatile("s_waitcnt vmcnt(0) lgkmcnt(0)" ::: "memory");
    __syncthreads();
    if (threadIdx.x == 0) {
        __builtin_amdgcn_fence(__ATOMIC_RELEASE, "agent");
        asm volatile("s_waitcnt vmcnt(0)" ::: "memory");
        const unsigned grp = blockIdx.x & 7u; const unsigned gsz = (G - grp + 7u) >> 3; const unsigned ngrp = G < 8u ? G : 8u;
        const unsigned old = __hip_atomic_fetch_add(bar + 64u * (1u + grp), 1u, __ATOMIC_RELAXED, __HIP_MEMORY_SCOPE_AGENT);
        if (old + 1u == epoch * gsz) __hip_atomic_fetch_add(bar, 1u, __ATOMIC_RELAXED, __HIP_MEMORY_SCOPE_AGENT);
        unsigned spins = 0;
        while (__hip_atomic_load(bar, __ATOMIC_RELAXED, __HIP_MEMORY_SCOPE_AGENT) < epoch * ngrp) { __builtin_amdgcn_s_sleep(1); if (++spins > (1u << 26)) break; }
        __builtin_amdgcn_fence(__ATOMIC_ACQUIRE, "agent");
        asm volatile("s_waitcnt vmcnt(0)" ::: "memory");
    }
    __syncthreads();
}

namespace pg8 {
constexpr int BM = 256, BK = 64, HALF = 128, HTB = HALF * BK * 2, STAGE_BYTES = 8 * HTB, NXCD = 8, WGM = 8;
__host__ __device__ __forceinline__ int lds_byte(int r, int c) { const int st = (r >> 4) * 2 + (c >> 5), rr = r & 15, cc = c & 31, ob = rr * 64 + cc * 2; return st * 1024 + (ob ^ (((ob >> 9) & 1) << 5)); }
__host__ __device__ __forceinline__ void stage_rc(int b, int& R, int& C) { const int st = b / 1024, sb = b % 1024, swz = sb ^ (((sb >> 9) & 1) << 5); R = (st >> 1) * 16 + swz / 64; C = (st & 1) * 32 + (swz % 64) / 2; }
__host__ __device__ __forceinline__ int perm32(int rho) { const int n = rho >> 4, i = rho & 15; return 8 * (i >> 2) + 4 * n + (i & 3); }
struct Unit { int pm, pn; };
struct Gemm { const bf16_t* A; const bf16_t* Bt; int M, N, K; int a_step_rows; };
struct OneUnit { Unit u; __device__ __forceinline__ bool next(int i, Unit& o) const { if (i) return false; o = u; return true; } };
struct StaticOrder {
    int nM, nN, nwg, G, c;
    __device__ __forceinline__ void init(int M, int N, int G_, int c_) { nM = M / BM; nN = N / BM; nwg = nM * nN; G = G_; c = c_; }
    __device__ __forceinline__ bool next(int i, Unit& u) const {
        const long L = (long)i * G + c; if (L >= nwg) return false;
        int wgid = (int)L; { const int q = nwg / NXCD, r = nwg % NXCD, xcd = wgid % NXCD, off = wgid / NXCD; wgid = (xcd < r ? xcd * (q + 1) : r * (q + 1) + (xcd - r) * q) + off; }
        const int nig = WGM * nN, gid = wgid / nig, fm = gid * WGM, gsz = (nM - fm) < WGM ? (nM - fm) : WGM;
        u.pm = fm + ((wgid % nig) % gsz); u.pn = (wgid % nig) / gsz; return true;
    }
};
struct EpiScaleBf16 {
    static constexpr bool AFTER_DRAIN = false;
    bf16_t* O; int ldc; const float* ssq;
    __device__ __forceinline__ void operator()(const f32x4 (&acc)[2][2][4][2], const Unit& u, int wr, int wc, int fr, int fq) const {
        const int row0 = u.pm * BM + wr * 64 + fr; const int col0 = u.pn * BM + wc * 32 + 8 * fq;
#pragma unroll
        for (int ai = 0; ai < 2; ++ai)
#pragma unroll
            for (int m = 0; m < 4; ++m) {
                const int row = row0 + ai * HALF + m * 16;
                const f32x4* sp = (const f32x4*)(ssq + (size_t)row * 8);
                f32x4 s4 = sp[0] + sp[1];
                const float rs = rsqrtf(((s4[0] + s4[1]) + (s4[2] + s4[3])) * (1.0f / 2048.0f) + EPS);
                bf16_t* rowp = O + (size_t)row * ldc + col0;
#pragma unroll
                for (int bj = 0; bj < 2; ++bj) { const f32x4 v0 = acc[ai][bj][m][0] * rs, v1 = acc[ai][bj][m][1] * rs;
                    u32x4 w; w.x = cvt_pk_bf16(v0[0], v0[1]); w.y = cvt_pk_bf16(v0[2], v0[3]); w.z = cvt_pk_bf16(v1[0], v1[1]); w.w = cvt_pk_bf16(v1[2], v1[3]);
                    *(u32x4*)(rowp + bj * HALF) = w; }
            }
    }
};
struct EpiResid {
    static constexpr bool AFTER_DRAIN = false;
    const float* base; float* xr; bf16_t* xb; float* ssq; LAS unsigned char* lds;
    __device__ __forceinline__ void operator()(const f32x4 (&acc)[2][2][4][2], const Unit& u, int wr, int wc, int fr, int fq) const {
        const int row0 = u.pm * BM + wr * 64 + fr; const int col0 = u.pn * BM + wc * 32 + 8 * fq;
        LAS float* xq = (LAS float*)(lds + 131072);
#pragma unroll
        for (int ai = 0; ai < 2; ++ai)
#pragma unroll
            for (int m = 0; m < 4; ++m) {
                const int row = row0 + ai * HALF + m * 16; float q = 0.f;
#pragma unroll
                for (int bj = 0; bj < 2; ++bj) { const size_t off = (size_t)row * DM + col0 + bj * HALF;
                    const f32x4 b0 = *(const f32x4*)(base + off), b1 = *(const f32x4*)(base + off + 4);
                    const f32x4 v0 = acc[ai][bj][m][0] + b0, v1 = acc[ai][bj][m][1] + b1;
                    *(f32x4*)(xr + off) = v0; *(f32x4*)(xr + off + 4) = v1;
                    u32x4 w; w.x = cvt_pk_bf16(v0[0], v0[1]); w.y = cvt_pk_bf16(v0[2], v0[3]); w.z = cvt_pk_bf16(v1[0], v1[1]); w.w = cvt_pk_bf16(v1[2], v1[3]);
                    *(u32x4*)(xb + off) = w;
                    q += (v0[0] * v0[0] + v0[1] * v0[1]) + (v0[2] * v0[2] + v0[3] * v0[3]) + (v1[0] * v1[0] + v1[1] * v1[1]) + (v1[2] * v1[2] + v1[3] * v1[3]); }
                q += __shfl_xor(q, 16); q += __shfl_xor(q, 32);
                if (fq == 0) xq[(ai * HALF + wr * 64 + m * 16 + fr) * 4 + wc] = q;
            }
        asm volatile("s_waitcnt lgkmcnt(0)" ::: "memory"); __builtin_amdgcn_s_barrier(); asm volatile("" ::: "memory");
        { const int tid_ = (wr * 4 + wc) * 64 + fq * 16 + fr;
          if (tid_ < 256) { const f32x4 v = *(const LAS f32x4*)(xq + tid_ * 4); ssq[(size_t)(u.pm * BM + tid_) * 8 + u.pn] = (v[0] + v[1]) + (v[2] + v[3]); } }
    }
};

struct EpiConvSwiGLU {
    static constexpr bool AFTER_DRAIN = true;
    bf16_t* act; const float* ssq; const float* cw; const float* cb;
    __device__ __forceinline__ void fused(const f32x4 (&acc)[2][2][4][2], const Unit& u, int wr, int wc, int fr, int fq, LAS unsigned char* lds) const {
        const int rs = u.pm * 254;
#pragma unroll
        for (int ai = 0; ai < 2; ++ai)
#pragma unroll
            for (int m = 0; m < 4; ++m) {
                const int lr = ai * HALF + wr * 64 + m * 16 + fr; int row = rs + lr; row = row < SEQ ? row : SEQ - 1;
                const f32x4* sp = (const f32x4*)(ssq + (size_t)row * 8);
                const f32x4 s4 = sp[0] + sp[1];
                const float rsd = rsqrtf(((s4[0] + s4[1]) + (s4[2] + s4[3])) * (1.0f / 2048.0f) + EPS);
#pragma unroll
                for (int bj = 0; bj < 2; ++bj) { const f32x4 v0 = acc[ai][bj][m][0] * rsd, v1 = acc[ai][bj][m][1] * rsd;
                    u32x4 w; w.x = cvt_pk_bf16(v0[0], v0[1]); w.y = cvt_pk_bf16(v0[2], v0[3]); w.z = cvt_pk_bf16(v1[0], v1[1]); w.w = cvt_pk_bf16(v1[2], v1[3]);
                    const int c = 16 * bj + 4 * wc + fq;
                    *(LAS u32x4*)(lds + lr * 512 + ((c ^ ((lr & 7) << 2)) << 4)) = w; }
            }
        asm volatile("s_waitcnt lgkmcnt(0)" ::: "memory"); __builtin_amdgcn_s_barrier(); asm volatile("" ::: "memory");
        const int tid_ = (wr * 4 + wc) * 64 + fq * 16 + fr; const int cgp = tid_ & 15, rr = tid_ >> 4;
        const int j0 = u.pn * 128 + cgp * 8;
        float wg[3][8], wu[3][8], bg[8], bu[8];
#pragma unroll
        for (int k = 0; k < 3; ++k) { const f32x4 a0 = *(const f32x4*)(cw + (size_t)k * NUP + j0), a1 = *(const f32x4*)(cw + (size_t)k * NUP + j0 + 4), b0 = *(const f32x4*)(cw + (size_t)k * NUP + DFF + j0), b1 = *(const f32x4*)(cw + (size_t)k * NUP + DFF + j0 + 4);
#pragma unroll
            for (int e = 0; e < 4; ++e) { wg[k][e] = a0[e]; wg[k][4 + e] = a1[e]; wu[k][e] = b0[e]; wu[k][4 + e] = b1[e]; } }
        { const f32x4 a0 = *(const f32x4*)(cb + j0), a1 = *(const f32x4*)(cb + j0 + 4), b0 = *(const f32x4*)(cb + DFF + j0), b1 = *(const f32x4*)(cb + DFF + j0 + 4);
#pragma unroll
          for (int e = 0; e < 4; ++e) { bg[e] = a0[e]; bg[4 + e] = a1[e]; bu[e] = b0[e]; bu[4 + e] = b1[e]; } }
#pragma unroll 1
        for (int hh = 0; hh < 2; ++hh) {
            u32x4 hg[6], hu[6];
#pragma unroll
            for (int i = 0; i < 6; ++i) { const int lr = 8 * rr + 4 * hh - 2 + i;
                if (lr >= 0) { const int sw = (lr & 7) << 2; hg[i] = *(const LAS u32x4*)(lds + lr * 512 + ((cgp ^ sw) << 4)); hu[i] = *(const LAS u32x4*)(lds + lr * 512 + (((16 + cgp) ^ sw) << 4)); }
                else { hg[i] = (u32x4){0u, 0u, 0u, 0u}; hu[i] = (u32x4){0u, 0u, 0u, 0u}; } }
#pragma unroll
            for (int i = 0; i < 4; ++i) { const int lo = 8 * rr + 4 * hh + i; const int grow = rs + lo;
                float g2[8], g1[8], g0[8], u2[8], u1[8], u0[8];
                unpack8(hg[i], g2); unpack8(hg[i + 1], g1); unpack8(hg[i + 2], g0); unpack8(hu[i], u2); unpack8(hu[i + 1], u1); unpack8(hu[i + 2], u0);
                float o[8];
#pragma unroll
                for (int e = 0; e < 8; ++e) { const float ag = bg[e] + wg[0][e] * g2[e] + wg[1][e] * g1[e] + wg[2][e] * g0[e]; const float au = bu[e] + wu[0][e] * u2[e] + wu[1][e] * u1[e] + wu[2][e] * u0[e];
                    o[e] = ag * sigmoidf_(ag) * au; }
                u32x4 w; w.x = cvt_pk_bf16(o[0], o[1]); w.y = cvt_pk_bf16(o[2], o[3]); w.z = cvt_pk_bf16(o[4], o[5]); w.w = cvt_pk_bf16(o[6], o[7]);
                if ((u.pm == 0 || lo >= 2) && grow < SEQ) *(u32x4*)(act + (size_t)grow * DFF + j0) = w; }
        }
        asm volatile("s_waitcnt lgkmcnt(0)" ::: "memory"); __builtin_amdgcn_s_barrier(); asm volatile("" ::: "memory");
    }
};

template <class Epi, class Sched>
__device__ __forceinline__ void gemm_phase(LAS unsigned char* lds, const Gemm g, const Sched& S, const Epi& E) {
    int tid = threadIdx.x; asm volatile("" : "+v"(tid)); const int wid = __builtin_amdgcn_readfirstlane(tid >> 6), lane = tid & 63, wr = wid >> 2, wc = wid & 3, fr = lane & 15, fq = lane >> 4;
    const int K = g.K, nt = K / BK;
    unsigned voffA[2], voffB[2];
#pragma unroll
    for (int i = 0; i < 2; ++i) { int R, C; stage_rc(tid * 16 + i * 8192, R, C); const int Rb = (R & ~31) + perm32(R & 31);
        voffA[i] = (unsigned)(R * K + C) * 2u; voffB[i] = (unsigned)(Rb * K + C) * 2u; }
    const size_t kstep = (size_t)(BK * 2);
    const size_t hstep = (size_t)HALF * K * 2;
    const size_t tstep = 2 * hstep;
    const size_t tstepA = (size_t)g.a_step_rows * K * 2;
    const unsigned ldsw = (unsigned)wid * 1024u;
    const int aoff = lds_byte(wr * 64 + fr, fq * 8), boff = lds_byte(wc * 32 + fr, fq * 8);
#define PG8_SA(b, h) (((b) * 2 + (h)) * HTB)
#define PG8_SB(b, h) ((4 + (b) * 2 + (h)) * HTB)
#define PG8_STAGE(bufoff, gbase, voff) do { _Pragma("unroll") for (int _i = 0; _i < 2; ++_i) \
        __builtin_amdgcn_global_load_lds((const unsigned*)((const char*)(gbase) + (voff)[_i]), (LAS unsigned*)(lds + (bufoff) + ldsw + _i * 8192), 16, 0, 0); } while (0)
#define PG8_LDA(dst, b, h) do { _Pragma("unroll") for (int m = 0; m < 4; ++m) _Pragma("unroll") for (int k = 0; k < 2; ++k) dst[m][k] = *(const LAS bf16x8*)(lds + PG8_SA(b, h) + aoff + m * 2048 + k * 1024); } while (0)
#define PG8_LDB(dst, b, h) do { _Pragma("unroll") for (int n = 0; n < 2; ++n) _Pragma("unroll") for (int k = 0; k < 2; ++k) dst[n][k] = *(const LAS bf16x8*)(lds + PG8_SB(b, h) + boff + n * 2048 + k * 1024); } while (0)
#define PG8_MMA(ai, bj, At, Bt) do { __builtin_amdgcn_s_setprio(1); _Pragma("unroll") for (int m = 0; m < 4; ++m) _Pragma("unroll") for (int n = 0; n < 2; ++n) _Pragma("unroll") for (int k = 0; k < 2; ++k) \
        acc[ai][bj][m][n] = __builtin_amdgcn_mfma_f32_16x16x32_bf16(Bt[n][k], At[m][k], acc[ai][bj][m][n], 0, 0, 0); __builtin_amdgcn_s_setprio(0); } while (0)
#define PG8_WAIT_V(n) asm volatile("s_waitcnt vmcnt(" #n ")" ::: "memory")
#define PG8_WAIT_L(n) asm volatile("s_waitcnt lgkmcnt(" #n ")" ::: "memory")
#define PG8_BAR __builtin_amdgcn_s_barrier()
#define PG8_SCHED __builtin_amdgcn_sched_barrier(0)
    Unit cur, nxt; int ui = 0;
    if (!S.next(0, cur)) return;
    f32x4 acc[2][2][4][2];
#pragma unroll
    for (int a = 0; a < 2; ++a)
#pragma unroll
        for (int b = 0; b < 2; ++b)
#pragma unroll
            for (int m = 0; m < 4; ++m)
#pragma unroll
                for (int n = 0; n < 2; ++n) acc[a][b][m][n] = (f32x4){0.f, 0.f, 0.f, 0.f};
    bf16x8 At[4][2], B0[2][2], B1[2][2];
    const char* cA = (const char*)g.A + (size_t)cur.pm * tstepA; const char* cB = (const char*)g.Bt + (size_t)cur.pn * tstep;
    PG8_STAGE(PG8_SB(0, 0), cB, voffB); PG8_STAGE(PG8_SB(0, 1), cB + hstep, voffB); PG8_STAGE(PG8_SA(0, 0), cA, voffA); PG8_STAGE(PG8_SA(0, 1), cA + hstep, voffA);
    if (wr == 1) PG8_BAR;
    PG8_WAIT_V(2); PG8_BAR;
    PG8_STAGE(PG8_SB(1, 0), cB + kstep, voffB); PG8_STAGE(PG8_SA(1, 0), cA + kstep, voffA); PG8_STAGE(PG8_SB(1, 1), cB + hstep + kstep, voffB);
    PG8_WAIT_V(6); PG8_BAR;
    for (;;) {
        const bool has_next = S.next(ui + 1, nxt);
        const char* nA = has_next ? (const char*)g.A + (size_t)nxt.pm * tstepA : cA; const char* nB = has_next ? (const char*)g.Bt + (size_t)nxt.pn * tstep : cB;
        for (int t = 0; t < nt; t += 2) {
            const bool last = (t == nt - 2);
            const char* a1 = cA + (size_t)(t + 1) * kstep;
            const char* a2 = last ? nA : cA + (size_t)(t + 2) * kstep; const char* b2 = last ? nB : cB + (size_t)(t + 2) * kstep;
            const char* a3 = a2 + kstep; const char* b3 = b2 + kstep;
            PG8_LDB(B0, 0, 0); PG8_LDB(B1, 0, 1); PG8_SCHED; PG8_LDA(At, 0, 0); PG8_STAGE(PG8_SA(1, 1), a1 + hstep, voffA);
            PG8_WAIT_V(8); PG8_WAIT_L(0); PG8_BAR; PG8_MMA(0, 0, At, B0); PG8_MMA(0, 1, At, B1); PG8_BAR; PG8_SCHED;
            PG8_LDA(At, 0, 1); PG8_STAGE(PG8_SB(0, 0), b2, voffB); PG8_STAGE(PG8_SB(0, 1), b2 + hstep, voffB); PG8_STAGE(PG8_SA(0, 0), a2, voffA);
            PG8_WAIT_V(8); PG8_WAIT_L(0); PG8_BAR; PG8_MMA(1, 0, At, B0); PG8_MMA(1, 1, At, B1); PG8_BAR; PG8_SCHED;
            PG8_LDB(B0, 1, 0); PG8_LDB(B1, 1, 1); PG8_SCHED; PG8_LDA(At, 1, 0); PG8_STAGE(PG8_SA(0, 1), a2 + hstep, voffA);
            PG8_WAIT_V(8); PG8_WAIT_L(0); PG8_BAR; PG8_MMA(0, 0, At, B0); PG8_MMA(0, 1, At, B1); PG8_BAR; PG8_SCHED;
            PG8_LDA(At, 1, 1); PG8_STAGE(PG8_SB(1, 0), b3, voffB); PG8_STAGE(PG8_SB(1, 1), b3 + hstep, voffB); PG8_STAGE(PG8_SA(1, 0), a3, voffA);
            PG8_WAIT_V(8); PG8_WAIT_L(0); PG8_BAR; PG8_MMA(1, 0, At, B0); PG8_MMA(1, 1, At, B1); PG8_BAR; PG8_SCHED;
        }
        if (wr == 0) PG8_BAR;
        if constexpr (!Epi::AFTER_DRAIN) E(acc, cur, wr, wc, fr, fq);
        if (!has_next) break;
#pragma unroll
        for (int a = 0; a < 2; ++a)
#pragma unroll
            for (int b = 0; b < 2; ++b)
#pragma unroll
                for (int m = 0; m < 4; ++m)
#pragma unroll
                    for (int n = 0; n < 2; ++n) acc[a][b][m][n] = (f32x4){0.f, 0.f, 0.f, 0.f};
        cur = nxt; cA = nA; cB = nB; ++ui;
        if (wr == 1) PG8_BAR;
    }
    PG8_WAIT_V(0);
    PG8_BAR;
    if constexpr (Epi::AFTER_DRAIN) E.fused(acc, cur, wr, wc, fr, fq, lds);
#undef PG8_SA
#undef PG8_SB
#undef PG8_STAGE
#undef PG8_LDA
#undef PG8_LDB
#undef PG8_MMA
#undef PG8_WAIT_V
#undef PG8_WAIT_L
#undef PG8_BAR
#undef PG8_SCHED
}
}

struct Args { const float* in[28]; float* out; unsigned char* ws; };
enum { I_X = 0, I_MIXG, I_WIN, I_ALNG, I_ALNB, I_AWS, I_ABS, I_BMU, I_BW0, I_BW2, I_BA0, I_BA2, I_BG2, I_BKK, I_BKA, I_BRK, I_BLNG, I_BLNB, I_DGW2, I_DGB, I_DNG, I_WOUT, I_FFNG, I_WUP, I_CONVW, I_CONVB, I_WDOWN, I_FING };

__device__ __forceinline__ void p0_item(const float* W, int K, int N, bf16_t* WT, const float* gsc, LAS float* scr, int kb, int nb, int row_out0, int lane) {
    const int k0 = 64 * kb, n0 = 64 * nb;
    const int nn = n0 + 2 * (lane & 31); const bool ok = nn < N;
    f32x2 v[32];
#pragma unroll
    for (int i = 0; i < 32; ++i) { const int kk = 2 * i + (lane >> 5); v[i] = ok ? __builtin_nontemporal_load((const f32x2*)(W + (size_t)(k0 + kk) * N + nn)) : (f32x2){0.f, 0.f}; }
#pragma unroll
    for (int i = 0; i < 32; ++i) { const int kk = 2 * i + (lane >> 5); f32x2 x = v[i]; if (gsc) { const float g = gsc[k0 + kk]; x = x * g; }
        scr[kk * 65 + 2 * (lane & 31)] = x.x; scr[kk * 65 + 2 * (lane & 31) + 1] = x.y; }
    asm volatile("s_waitcnt lgkmcnt(0)" ::: "memory");
    const int c = lane & 7;
#pragma unroll
    for (int j = 0; j < 8; ++j) { const int n = (lane >> 3) + 8 * j; const LAS float* sp = scr + (8 * c) * 65 + n;
        u32x4 o; o.x = cvt_pk_bf16(sp[0 * 65], sp[1 * 65]); o.y = cvt_pk_bf16(sp[2 * 65], sp[3 * 65]); o.z = cvt_pk_bf16(sp[4 * 65], sp[5 * 65]); o.w = cvt_pk_bf16(sp[6 * 65], sp[7 * 65]);
        *(u32x4*)(WT + (size_t)(row_out0 + n) * K + k0 + 8 * c) = o; }
    asm volatile("s_waitcnt lgkmcnt(0)" ::: "memory");
}

__device__ __forceinline__ void convert_layer_weights(const Args& args, unsigned char* ws, int l, LAS float* scr, int w0, int nw, int lane, int it_lo, int it_hi) {
    constexpr int I_IN = 32 * 92, I_OUT = 32 * 32, I_UP = 32 * 176, I_DN = 88 * 32;
    unsigned char* wt = ws + WS_WT + (size_t)l * WT_LAYER;
    for (int it = it_lo + w0; it < it_hi; it += nw) {
        int r = it;
        if (r < I_IN) { const int kb = r / 92, nb = r % 92; p0_item(args.in[I_WIN] + (size_t)l * DM * NIN, DM, NIN, (bf16_t*)(wt + WT_IN), args.in[I_MIXG] + l * DM, scr, kb, nb, nb * 64, lane); continue; } r -= I_IN;
        if (r < I_OUT) { const int kb = r / 32, nb = r % 32; p0_item(args.in[I_WOUT] + (size_t)l * DM * DM, DM, DM, (bf16_t*)(wt + WT_OUT), nullptr, scr, kb, nb, nb * 64, lane); continue; } r -= I_OUT;
        if (r < I_UP) { const int kb = r / 176, nb = r % 176; const int n0 = nb * 64; const int j = n0 < DFF ? n0 : n0 - DFF; const int ro = (j >> 7) * 256 + (j & 127) + (n0 < DFF ? 0 : 128);
            p0_item(args.in[I_WUP] + (size_t)l * DM * NUP, DM, NUP, (bf16_t*)(wt + WT_UP), args.in[I_FFNG] + l * DM, scr, kb, nb, ro, lane); continue; } r -= I_UP;
        { const int kb = r / 32, nb = r % 32; p0_item(args.in[I_WDOWN] + (size_t)l * DFF * DM, DFF, DM, (bf16_t*)(wt + WT_DOWN), nullptr, scr, kb, nb, nb * 64, lane); }
    }
}

#define RWKV_LO(v) __builtin_shufflevector(v, v, 0, 1)
#define RWKV_HI(v) __builtin_shufflevector(v, v, 2, 3)
#define RWKV_LDB(set, g) do { _Pragma("unroll") for (int q = 0; q < 2; ++q) { lq_[set][q] = *(const LAS f32x4*)((st_) + 64 + (g) * 8 + q * 4); lq_[set][2 + q] = *(const LAS f32x4*)((st_) + 128 + (g) * 8 + q * 4); \
        lq_[set][4 + q] = *(const LAS f32x4*)((st_) + 192 + (g) * 8 + q * 4); if (WITH_Y_) lq_[set][6 + q] = *(const LAS f32x4*)((st_) + 256 + (g) * 8 + q * 4); } } while (0)
#define RWKV_STEP(st, vi, St, WITH_Y, WITH_V, yout) do { \
    const LAS float* st_ = (st); constexpr bool WITH_Y_ = (WITH_Y); \
    f32x2 a0_ = (f32x2){0.f, 0.f}, a1_ = (f32x2){0.f, 0.f}; \
    f32x4 na_[16]; f32x4 lq_[3][8]; \
    _Pragma("unroll") for (int q = 0; q < 16; ++q) na_[q] = *(const LAS f32x4*)(st_ + q * 4); \
    RWKV_LDB(0, 0); RWKV_LDB(1, 1); \
    __builtin_amdgcn_sched_barrier(0); \
    _Pragma("unroll") for (int q = 0; q < 16; ++q) { const f32x4 n = na_[q]; a0_ += St[2 * q] * RWKV_LO(n); a1_ += St[2 * q + 1] * RWKV_HI(n); } \
    const float sa_ = (a0_.x + a0_.y) + (a1_.x + a1_.y); const f32x2 sa2_ = (f32x2){sa_, sa_}; const f32x2 vi2_ = (f32x2){(vi), (vi)}; \
    f32x2 y0_ = (f32x2){0.f, 0.f}, y1_ = (f32x2){0.f, 0.f}; \
    __builtin_amdgcn_sched_barrier(0); \
    _Pragma("unroll") for (int gi = 0; gi < 8; ++gi) { \
        if (gi + 2 < 8) RWKV_LDB((gi + 2) % 3, gi + 2); \
        __builtin_amdgcn_sched_barrier(0); \
        _Pragma("unroll") for (int q = 0; q < 2; ++q) { const f32x4 dd = lq_[gi % 3][q], bb = lq_[gi % 3][2 + q], kk = lq_[gi % 3][4 + q]; const int k2 = gi * 4 + q * 2; \
            if (WITH_V) { St[k2] = St[k2] * RWKV_LO(dd) + sa2_ * RWKV_LO(bb) + vi2_ * RWKV_LO(kk); St[k2 + 1] = St[k2 + 1] * RWKV_HI(dd) + sa2_ * RWKV_HI(bb) + vi2_ * RWKV_HI(kk); } \
            else { St[k2] = St[k2] * RWKV_LO(dd) + sa2_ * RWKV_LO(bb); St[k2 + 1] = St[k2 + 1] * RWKV_HI(dd) + sa2_ * RWKV_HI(bb); } \
            if (WITH_Y_) { const f32x4 rr = lq_[gi % 3][6 + q]; y0_ += St[k2] * RWKV_LO(rr); y1_ += St[k2 + 1] * RWKV_HI(rr); } } \
        __builtin_amdgcn_sched_barrier(0); } \
    yout = (y0_.x + y0_.y) + (y1_.x + y1_.y); } while (0)

__global__ void __launch_bounds__(512, 2) mega_fwd(Args args) {
    extern __shared__ __attribute__((aligned(16))) unsigned char lds_raw[];
    LAS unsigned char* lds = (LAS unsigned char*)lds_raw;
    cg::grid_group grid = cg::this_grid();
    const int tid0 = threadIdx.x, wave = __builtin_amdgcn_readfirstlane(tid0 >> 6);
    const int bid = blockIdx.x, G = gridDim.x;
    const int gw = bid * 8 + wave, NGW = G * 8;
    unsigned char* ws = args.ws;
    float* XR = args.out;
    bf16_t* XB = (bf16_t*)(ws + WS_XB); bf16_t* Y = (bf16_t*)(ws + WS_Y); bf16_t* P = (bf16_t*)(ws + WS_P);
    float* IDZ = (float*)(ws + WS_IDZ); int* SEL = (int*)(ws + WS_SEL); float* PART = (float*)(ws + WS_PART);
    unsigned* BAR = (unsigned*)ws; unsigned bar_epoch = 0;
    float* SSQ = (float*)(ws + WS_SSQ); f32x2* ROPE = (f32x2*)(ws + WS_ROPE); float* KMEAN = (float*)(ws + WS_KMEAN);
    bf16_t* QB = (bf16_t*)(ws + WS_QB); bf16_t* KB = (bf16_t*)(ws + WS_KB); bf16_t* VT = (bf16_t*)(ws + WS_VT);
    float* VEC5 = (float*)(ws + WS_VEC5); float* VV = (float*)(ws + WS_VV); float* GG = (float*)(ws + WS_GG); float* BV = (float*)(ws + WS_BV);
    float* PCH = (float*)(ws + WS_PCH); float* LCH = (float*)(ws + WS_LCH); float* SIN = (float*)(ws + WS_SIN);
    float* OI = (float*)(ws + WS_OI); float* GU = (float*)(ws + WS_U); float* QT = (float*)(ws + WS_QT); float* LAM = (float*)(ws + WS_LAM);
    bf16_t* HB = (bf16_t*)(ws + WS_H); bf16_t* ACT = (bf16_t*)(ws + WS_ACT);

        { int tid = tid0; asm volatile("" : "+v"(tid)); const int lane = tid & 63; (void)lane;
    {
        LAS float* scr = (LAS float*)(lds + wave * 16896);
        const bool split_conv = (G >= 256);
        convert_layer_weights(args, ws, 0, scr, gw, NGW, lane, 0, split_conv ? 3968 : 12416);
        if (!split_conv) convert_layer_weights(args, ws, 1, scr, gw, NGW, lane, 0, 12416);
        for (int idx = bid * 512 + tid; idx < 8192; idx += G * 512) IDZ[idx] = (idx < 4096 && (idx >> 6) == (idx & 63)) ? 1.f : 0.f;
        for (int idx = bid * 512 + tid; idx < SEQ * 32; idx += G * 512) {
            const int t = idx >> 5, d = idx & 31;
            const float inv = exp2f(-(float)d * (13.287712379549449f / 32.0f));
            const float ang = (float)t * inv;
            const double rev = (double)ang * 0.15915494309189535; const float fr = (float)(rev - floor(rev));
            ROPE[idx] = (f32x2){__builtin_amdgcn_cosf(fr), __builtin_amdgcn_sinf(fr)};
        }
        const float* x = args.in[I_X];
        for (int row = gw; row < SEQ; row += NGW) {
            const f32x4* xr = (const f32x4*)(x + (size_t)row * DM) + lane; float s = 0.f;
            u32x2* ob = (u32x2*)(XB + (size_t)row * DM) + lane;
#pragma unroll
            for (int j = 0; j < 8; ++j) { const f32x4 v = xr[64 * j]; s += (v[0] * v[0] + v[1] * v[1]) + (v[2] * v[2] + v[3] * v[3]); u32x2 w; w.x = cvt_pk_bf16(v[0], v[1]); w.y = cvt_pk_bf16(v[2], v[3]); ob[64 * j] = w; }
            s = wave_sum(s);
            if (lane < 8) SSQ[(size_t)row * 8 + lane] = lane == 0 ? s : 0.f;
        }
    }
        }
    grid.sync();

    for (int l = 0; l < 2; ++l) {
        unsigned char* wt = ws + WS_WT + (size_t)l * WT_LAYER;
        { int tid = tid0; asm volatile("" : "+v"(tid)); const int lane = tid & 63; (void)lane;
        {
            pg8::Gemm g{XB, (const bf16_t*)(wt + WT_IN), SEQ, NINP, DM, 256}; pg8::StaticOrder S; S.init(SEQ, NINP, G, bid);
            pg8::EpiScaleBf16 E{P, NINP, SSQ};
            pg8::gemm_phase<pg8::EpiScaleBf16>(lds, g, S, E);
        }
        }
        fast_barrier(BAR, ++bar_epoch, (unsigned)G);
        { int tid = tid0; asm volatile("" : "+v"(tid)); const int lane = tid & 63; (void)lane;
        for (int unit = bid; unit < 256; unit += G) {
            const int n = unit >> 2, h = unit & 3, t0 = n * 128;
            LAS float* Vs = (LAS float*)lds; LAS float* Wt = (LAS float*)(lds + 65536); LAS float* st = (LAS float*)(lds + 65536 + 67584);
            const float* lng = args.in[I_ALNG] + l * 512; const float* lnb = args.in[I_ALNB] + l * 512;
            const float* wsrc = args.in[I_AWS] + ((size_t)l * 4 + h) * 16384; const float* bsrc = args.in[I_ABS] + (l * 4 + h) * 128;
            u32x4 raws[16];
#pragma unroll
            for (int i = 0; i < 16; ++i) raws[i] = *(const u32x4*)(P + (size_t)(t0 + wave * 16 + i) * NINP + PC_A + 512 + lane * 8);
#pragma unroll
            for (int i0 = 0; i0 < 16; i0 += 4) { float st8[8];
#pragma unroll
                for (int i = 0; i < 4; ++i) { float z[8]; unpack8(raws[i0 + i], z); float sm = 0.f, sq = 0.f;
#pragma unroll
                    for (int jj = 0; jj < 8; ++jj) { const float g = gelu_tanh(z[jj]); sm += g; sq += g * g; }
                    st8[i] = sm; st8[4 + i] = sq; }
                wave_sum_n<8>(st8);
                if (lane == 0) {
#pragma unroll
                    for (int i = 0; i < 4; ++i) { const int tt = wave * 16 + i0 + i; const float mu = st8[i] * (1.f / 512.f); const float var = fmaxf(st8[4 + i] * (1.f / 512.f) - mu * mu, 0.f);
                        st[tt * 2] = mu; st[tt * 2 + 1] = rsqrtf(var + EPS); } } }
            for (int i = 0; i < 32; ++i) { const int e = tid + 512 * i; const int t = e >> 7, s = e & 127; Wt[s * 132 + t] = (s <= t) ? wsrc[e] : 0.f; }
            __syncthreads();
            for (int i = 0; i < 4; ++i) { const int idx = tid + 512 * i; const int s = idx >> 4, c0 = (idx & 15) * 8;
                const u32x4 raw = *(const u32x4*)(P + (size_t)(t0 + s) * NINP + PC_A + 512 + h * 128 + c0); float z[8]; unpack8(raw, z);
                const float mu = st[s * 2], rs = st[s * 2 + 1];
#pragma unroll
                for (int j = 0; j < 8; ++j) Vs[s * 128 + c0 + j] = (gelu_tanh(z[j]) - mu) * rs * lng[h * 128 + c0 + j] + lnb[h * 128 + c0 + j]; }
            __syncthreads();
            const int tg = tid >> 4, cgp = tid & 15; const int s_end = wave * 16 + 16;
            float acc[4][8];
#pragma unroll
            for (int i = 0; i < 4; ++i)
#pragma unroll
                for (int j = 0; j < 8; ++j) acc[i][j] = 0.f;
            { f32x4 w4n[2], v0n[2], v1n[2];
#pragma unroll
              for (int q = 0; q < 2; ++q) { w4n[q] = *(const LAS f32x4*)(Wt + q * 132 + tg * 4); v0n[q] = *(const LAS f32x4*)(Vs + q * 128 + cgp * 8); v1n[q] = *(const LAS f32x4*)(Vs + q * 128 + cgp * 8 + 4); }
              for (int s = 0; s < s_end; s += 2) {
                f32x4 w4c[2], v0c[2], v1c[2];
#pragma unroll
                for (int q = 0; q < 2; ++q) { w4c[q] = w4n[q]; v0c[q] = v0n[q]; v1c[q] = v1n[q]; }
                const int sn = (s + 2 < 128) ? s + 2 : 126;
#pragma unroll
                for (int q = 0; q < 2; ++q) { w4n[q] = *(const LAS f32x4*)(Wt + (sn + q) * 132 + tg * 4); v0n[q] = *(const LAS f32x4*)(Vs + (sn + q) * 128 + cgp * 8); v1n[q] = *(const LAS f32x4*)(Vs + (sn + q) * 128 + cgp * 8 + 4); }
                __builtin_amdgcn_sched_barrier(0);
#pragma unroll
                for (int q = 0; q < 2; ++q)
#pragma unroll
                    for (int i = 0; i < 4; ++i) {
#pragma unroll
                        for (int j = 0; j < 4; ++j) { acc[i][j] += w4c[q][i] * v0c[q][j]; acc[i][4 + j] += w4c[q][i] * v1c[q][j]; } }
                __builtin_amdgcn_sched_barrier(0);
              } }
#pragma unroll
            for (int i = 0; i < 4; ++i) { const int t = tg * 4 + i; const float bias = bsrc[t];
                const u32x4 raw = *(const u32x4*)(P + (size_t)(t0 + t) * NINP + PC_A + h * 128 + cgp * 8); float z[8]; unpack8(raw, z); float o[8];
#pragma unroll
                for (int j = 0; j < 8; ++j) o[j] = gelu_tanh(z[j]) * (acc[i][j] + bias);
                u32x4 w; w.x = cvt_pk_bf16(o[0], o[1]); w.y = cvt_pk_bf16(o[2], o[3]); w.z = cvt_pk_bf16(o[4], o[5]); w.w = cvt_pk_bf16(o[6], o[7]);
                *(u32x4*)(Y + (size_t)(t0 + t) * DM + h * 128 + cgp * 8) = w; }
            __syncthreads();
        }
        }
        { int tid = tid0; asm volatile("" : "+v"(tid)); const int lane = tid & 63; (void)lane;
        for (int unit = bid; unit < 256; unit += G) {
            const int n = unit >> 3, h = unit & 7; const int tt = tid >> 1, half = tid & 1, t = n * 256 + tt, d0 = half * 16;
            LAS float* red = (LAS float*)lds;
            LAS bf16_t* vsT = (LAS bf16_t*)(lds + 4096);
            const bf16_t* prow = P + (size_t)t * NINP + PC_C + h * 64;
            float ql[16], qh[16], kl[16], kh[16];
            { u32x4 a0 = *(const u32x4*)(prow + d0), a1 = *(const u32x4*)(prow + d0 + 8), b0 = *(const u32x4*)(prow + 32 + d0), b1 = *(const u32x4*)(prow + 32 + d0 + 8);
              float z[8]; unpack8(a0, z);
#pragma unroll
              for (int j = 0; j < 8; ++j) ql[j] = z[j];
              unpack8(a1, z);
#pragma unroll
              for (int j = 0; j < 8; ++j) ql[8 + j] = z[j];
              unpack8(b0, z);
#pragma unroll
              for (int j = 0; j < 8; ++j) qh[j] = z[j];
              unpack8(b1, z);
#pragma unroll
              for (int j = 0; j < 8; ++j) qh[8 + j] = z[j]; }
            { u32x4 a0 = *(const u32x4*)(prow + 512 + d0), a1 = *(const u32x4*)(prow + 512 + d0 + 8), b0 = *(const u32x4*)(prow + 512 + 32 + d0), b1 = *(const u32x4*)(prow + 512 + 32 + d0 + 8);
              float z[8]; unpack8(a0, z);
#pragma unroll
              for (int j = 0; j < 8; ++j) kl[j] = z[j];
              unpack8(a1, z);
#pragma unroll
              for (int j = 0; j < 8; ++j) kl[8 + j] = z[j];
              unpack8(b0, z);
#pragma unroll
              for (int j = 0; j < 8; ++j) kh[j] = z[j];
              unpack8(b1, z);
#pragma unroll
              for (int j = 0; j < 8; ++j) kh[8 + j] = z[j]; }
            const f32x2* cs = ROPE + (size_t)t * 32 + d0;
#pragma unroll
            for (int j = 0; j < 16; ++j) { const f32x2 c = cs[j];
                const float q1 = ql[j], q2 = qh[j]; ql[j] = (q1 * c.x - q2 * c.y) * QSCALE; qh[j] = (q1 * c.y + q2 * c.x) * QSCALE;
                const float k1 = kl[j], k2 = kh[j]; kl[j] = k1 * c.x - k2 * c.y; kh[j] = k1 * c.y + k2 * c.x; }
            { bf16_t* qo = QB + (size_t)t * 512 + h * 64 + d0; bf16_t* ko = KB + (size_t)t * 512 + h * 64 + d0;
              u32x4 w;
              w.x = cvt_pk_bf16(ql[0], ql[1]); w.y = cvt_pk_bf16(ql[2], ql[3]); w.z = cvt_pk_bf16(ql[4], ql[5]); w.w = cvt_pk_bf16(ql[6], ql[7]); *(u32x4*)(qo) = w;
              w.x = cvt_pk_bf16(ql[8], ql[9]); w.y = cvt_pk_bf16(ql[10], ql[11]); w.z = cvt_pk_bf16(ql[12], ql[13]); w.w = cvt_pk_bf16(ql[14], ql[15]); *(u32x4*)(qo + 8) = w;
              w.x = cvt_pk_bf16(qh[0], qh[1]); w.y = cvt_pk_bf16(qh[2], qh[3]); w.z = cvt_pk_bf16(qh[4], qh[5]); w.w = cvt_pk_bf16(qh[6], qh[7]); *(u32x4*)(qo + 32) = w;
              w.x = cvt_pk_bf16(qh[8], qh[9]); w.y = cvt_pk_bf16(qh[10], qh[11]); w.z = cvt_pk_bf16(qh[12], qh[13]); w.w = cvt_pk_bf16(qh[14], qh[15]); *(u32x4*)(qo + 40) = w;
              w.x = cvt_pk_bf16(kl[0], kl[1]); w.y = cvt_pk_bf16(kl[2], kl[3]); w.z = cvt_pk_bf16(kl[4], kl[5]); w.w = cvt_pk_bf16(kl[6], kl[7]); *(u32x4*)(ko) = w;
              w.x = cvt_pk_bf16(kl[8], kl[9]); w.y = cvt_pk_bf16(kl[10], kl[11]); w.z = cvt_pk_bf16(kl[12], kl[13]); w.w = cvt_pk_bf16(kl[14], kl[15]); *(u32x4*)(ko + 8) = w;
              w.x = cvt_pk_bf16(kh[0], kh[1]); w.y = cvt_pk_bf16(kh[2], kh[3]); w.z = cvt_pk_bf16(kh[4], kh[5]); w.w = cvt_pk_bf16(kh[6], kh[7]); *(u32x4*)(ko + 32) = w;
              w.x = cvt_pk_bf16(kh[8], kh[9]); w.y = cvt_pk_bf16(kh[10], kh[11]); w.z = cvt_pk_bf16(kh[12], kh[13]); w.w = cvt_pk_bf16(kh[14], kh[15]); *(u32x4*)(ko + 40) = w; }
#pragma unroll
            for (int j = 0; j < 16; ++j) {
#pragma unroll
                for (int o = 2; o < 64; o <<= 1) { kl[j] += __shfl_xor(kl[j], o); kh[j] += __shfl_xor(kh[j], o); } }
            if (lane < 2) {
#pragma unroll
                for (int j = 0; j < 16; ++j) { red[(wave * 2 + lane) * 32 + j] = kl[j]; red[(wave * 2 + lane) * 32 + 16 + j] = kh[j]; } }
            { const bf16_t* vrow = prow + 1024 + half * 32;
#pragma unroll
              for (int q = 0; q < 4; ++q) { const u32x4 r = *(const u32x4*)(vrow + q * 8); const unsigned rr[4] = {r.x, r.y, r.z, r.w};
#pragma unroll
                  for (int j = 0; j < 4; ++j) { const int d = half * 32 + q * 8 + 2 * j; vsT[d * 264 + tt] = (bf16_t)(rr[j] & 0xffffu); vsT[(d + 1) * 264 + tt] = (bf16_t)(rr[j] >> 16); } } }
            __syncthreads();
            if (tid < 64) { const int hf = (tid & 31) >> 4, slot = (tid & 15) + (tid >= 32 ? 16 : 0); float s = 0.f;
#pragma unroll
                for (int w = 0; w < 8; ++w) s += red[(w * 2 + hf) * 32 + slot];
                KMEAN[(h * 32 + n) * 64 + tid] = s * (1.f / 256.f); }
            { const int d = tid >> 3, seg = tid & 7; const LAS u32x4* src = (const LAS u32x4*)(vsT + d * 264 + seg * 32); u32x4* dst = (u32x4*)(VT + (size_t)(h * 64 + d) * SEQ + n * 256 + seg * 32);
#pragma unroll
              for (int q = 0; q < 4; ++q) dst[q] = src[q]; }
            __syncthreads();
        }
        }
        { int tid = tid0; asm volatile("" : "+v"(tid)); const int lane = tid & 63; (void)lane;
        for (int unit = bid; unit < 256; unit += G) {
            const int t0 = unit * 32;
            LAS float* xs = (LAS float*)lds;
            const float* mu = args.in[I_BMU] + l * 1696;
            for (int i = 0; i < 10; ++i) { const int idx = tid + 512 * i; const int tt = idx / 160, j = idx - tt * 160; const int t = t0 + tt;
                const float cur = bf2f(P[(size_t)t * NINP + PC_B + 1536 + j]); const float prev = t > 0 ? bf2f(P[(size_t)(t - 1) * NINP + PC_B + 1536 + j]) : 0.f;
                const float x = cur + (prev - cur) * mu[1536 + j];
                xs[tt * 160 + j] = j < 32 ? tanhf(x) : (j < 64 ? x : sigmoidf_(x)); }
            const int c = tid, head = wave;
            const float w0c = args.in[I_BW0][l * 512 + c], a0c = args.in[I_BA0][l * 512 + c], kkc = args.in[I_BKK][l * 512 + c], kac = args.in[I_BKA][l * 512 + c], rkc = args.in[I_BRK][l * 512 + c];
            const float mur = mu[c], muk = mu[512 + c], muv = mu[1024 + c];
            const float* w2 = args.in[I_BW2] + (size_t)l * 32 * 512; const float* a2 = args.in[I_BA2] + (size_t)l * 32 * 512; const float* g2 = args.in[I_BG2] + (size_t)l * 96 * 512;
            __syncthreads();
            {
                float wr_[32], ar_[32];
                unsigned cu = (unsigned)c; asm volatile("" : "+v"(cu));
#pragma unroll
                for (int j = 0; j < 32; ++j) { const float* wj = w2 + j * 512; const float* aj = a2 + j * 512; wr_[j] = wj[cu]; ar_[j] = aj[cu]; }
                float rp = 0.f, kp = 0.f, vp = 0.f;
                { const bf16_t* pr = P + (size_t)t0 * NINP + PC_B + c; if (t0 > 0) { rp = bf2f(pr[-NINP]); kp = bf2f(pr[512 - NINP]); vp = bf2f(pr[1024 - NINP]); } }
                unsigned rnr, knr, vnr;
                { const bf16_t* pr = P + (size_t)t0 * NINP + PC_B + c; rnr = pr[0]; knr = pr[512]; vnr = pr[1024]; }
                {
                    float zf = 0.f; asm volatile("" : "+v"(zf));
                    float* v5 = VEC5 + ((size_t)head * SEQ + t0) * 320 + lane; v5[0] = zf; v5[64] = zf; v5[128] = zf; v5[192] = zf; v5[256] = zf;
                    VV[((size_t)head * SEQ + t0) * 64 + lane] = zf; BV[(size_t)t0 * 512 + c] = zf; }
#pragma unroll 1
                for (int i = 0; i < 32; ++i) { const int t = t0 + i;
                    asm volatile("" : "+v"(rnr), "+v"(knr), "+v"(vnr));
                    const float rc = __uint_as_float(rnr << 16), kc = __uint_as_float(knr << 16), vc = __uint_as_float(vnr << 16);
                    { const int tn = i + 1 < 32 ? t + 1 : t; const bf16_t* pr = P + (size_t)tn * NINP + PC_B + c; rnr = pr[0]; knr = pr[512]; vnr = pr[1024]; }
                    float aw = w0c, aa = a0c, aw1 = 0.f, aa1 = 0.f;
                    const LAS float* xr = xs + i * 160;
#pragma unroll
                    for (int j = 0; j < 32; j += 4) { const f32x4 x = *(const LAS f32x4*)(xr + j), y = *(const LAS f32x4*)(xr + 32 + j);
                        aw += x[0] * wr_[j]; aw1 += x[1] * wr_[j + 1]; aw += x[2] * wr_[j + 2]; aw1 += x[3] * wr_[j + 3];
                        aa += y[0] * ar_[j]; aa1 += y[1] * ar_[j + 1]; aa += y[2] * ar_[j + 2]; aa1 += y[3] * ar_[j + 3]; }
                    aw += aw1; aa += aa1;
                    const float rr = rc + (rp - rc) * mur, kx = kc + (kp - kc) * muk, vx = vc + (vp - vc) * muv;
                    const float mz = -aw; const float sp = mz > 20.f ? mz : __logf(1.f + __expf(mz));
                    const float wl = -sp - 0.5f; const float dec = __expf(-__expf(wl));
                    const float a = sigmoidf_(aa);
                    float kk = kx * kkc; const float k2 = kx * (1.f + (a - 1.f) * kac);
                    float red2[2] = {kk * kk, rr * k2 * rkc}; wave_sum_n<2>(red2);
                    kk = kk * __builtin_amdgcn_rsqf(fmaxf(red2[0], 1e-24f)); const float bb = kk * a;
                    const float bon = red2[1];
                    float* v5 = VEC5 + ((size_t)head * SEQ + t) * 320 + lane;
                    v5[0] = -kk; v5[64] = dec; v5[128] = bb; v5[192] = k2; v5[256] = rr;
                    VV[((size_t)head * SEQ + t) * 64 + lane] = vx; BV[(size_t)t * 512 + c] = bon * vx;
                    rp = rc; kp = kc; vp = vc; }
            }
            {
                float gr_[96];
                unsigned cu = (unsigned)c; asm volatile("" : "+v"(cu));
#pragma unroll
                for (int j = 0; j < 96; ++j) { const float* gj = g2 + j * 512; gr_[j] = gj[cu]; }
#pragma unroll 1
                for (int i = 0; i < 32; ++i) { const int t = t0 + i;
                    float ag = 0.f, ag1 = 0.f;
                    const LAS float* xr = xs + i * 160;
#pragma unroll
                    for (int j = 0; j < 96; j += 4) { const f32x4 x = *(const LAS f32x4*)(xr + 64 + j); ag += x[0] * gr_[j]; ag1 += x[1] * gr_[j + 1]; ag += x[2] * gr_[j + 2]; ag1 += x[3] * gr_[j + 3]; }
                    GG[(size_t)t * 512 + c] = ag + ag1; }
            }
            __syncthreads();
        }
        }
        fast_barrier(BAR, ++bar_epoch, (unsigned)G);
        { int tid = tid0; asm volatile("" : "+v"(tid)); const int lane = tid & 63; (void)lane;
        for (int pi = bid; pi < 256; pi += G) {
            const int h = pi & 7, r = pi >> 3, half = r & 1;
            for (int which = 0; which < 2; ++which) {
                const int qb = which ? 31 - (r >> 1) : (r >> 1);
                const int t0 = qb * 256 + half * 128;
                LAS bf16_t* Ks = (LAS bf16_t*)lds;
                LAS bf16_t* Vs = (LAS bf16_t*)(lds + 18432);
                LAS float* kmS = (LAS float*)(lds + 36864);
                LAS int* selS = (LAS int*)(lds + 36864 + 8192);
                for (int i = tid; i < qb * 64; i += 512) kmS[i] = KMEAN[h * 2048 + i];
                __syncthreads();
                if (tid < 128) {
                    const bf16_t* qr = QB + (size_t)(t0 + tid) * 512 + h * 64;
                    float q[64];
#pragma unroll
                    for (int j = 0; j < 8; ++j) { float z[8]; unpack8(*(const u32x4*)(qr + j * 8), z);
#pragma unroll
                        for (int e = 0; e < 8; ++e) q[j * 8 + e] = z[e]; }
                    float b0 = -INFINITY, b1 = -INFINITY, b2 = -INFINITY; int i0 = 255, i1 = 255, i2 = 255;
                    for (int n = 0; n < qb; ++n) { float s = 0.f, s1 = 0.f, s2 = 0.f, s3 = 0.f; f32x4 kv[16];
#pragma unroll
                        for (int j = 0; j < 16; ++j) kv[j] = *(const LAS f32x4*)(kmS + n * 64 + j * 4);
                        __builtin_amdgcn_sched_barrier(0);
#pragma unroll
                        for (int j = 0; j < 16; ++j) { s += q[4 * j] * kv[j][0]; s1 += q[4 * j + 1] * kv[j][1]; s2 += q[4 * j + 2] * kv[j][2]; s3 += q[4 * j + 3] * kv[j][3]; }
                        s = (s + s1) + (s2 + s3);
                        if (s > b0) { b2 = b1; i2 = i1; b1 = b0; i1 = i0; b0 = s; i0 = n; } else if (s > b1) { b2 = b1; i2 = i1; b1 = s; i1 = n; } else if (s > b2) { b2 = s; i2 = n; } }
                    selS[tid] = i0 | (i1 << 8) | (i2 << 16); SEL[h * SEQ + t0 + tid] = i0 | (i1 << 8) | (i2 << 16);
                }
                __syncthreads();
                const int ql = lane & 15, kg = lane >> 4;
                const int tq = t0 + wave * 16 + ql;
                const int sel = selS[wave * 16 + ql]; const int s0 = sel & 255, s1 = (sel >> 8) & 255, s2 = (sel >> 16) & 255;
                bf16x8 qf[2];
                qf[0] = *(const bf16x8*)(QB + (size_t)tq * 512 + h * 64 + kg * 8); qf[1] = *(const bf16x8*)(QB + (size_t)tq * 512 + h * 64 + 32 + kg * 8);
                const int nown = half ? 4 : 2, ntile = nown;
                float mrun = -1e30f, lrun = 0.f; f32x4 O[4];
#pragma unroll
                for (int d = 0; d < 4; ++d) O[d] = (f32x4){0.f, 0.f, 0.f, 0.f};
                const int lrow = tid >> 3, lseg = (tid & 7) ^ (lrow & 7);
                const bf16_t* kgp = KB + (size_t)lrow * 512 + h * 64 + lseg * 8; const bf16_t* vgp = VT + (size_t)(h * 64 + lrow) * SEQ + lseg * 8;
                LAS unsigned char* ring = lds + 49152;
#define ATT_KS(i_) ((i_) < nown ? qb * 256 + (i_) * 64 : ((i_) - nown) * 64)
#define ATT_ISSUE_S(i_, slot_) do { const int ks_ = ATT_KS(i_); LAS unsigned char* tb_ = ring + (slot_) * 16384 + wave * 1024; \
                    __builtin_amdgcn_global_load_lds((const unsigned*)(kgp + (size_t)ks_ * 512), (LAS unsigned*)tb_, 16, 0, 0); \
                    __builtin_amdgcn_global_load_lds((const unsigned*)(vgp + ks_), (LAS unsigned*)(tb_ + 8192), 16, 0, 0); } while (0)
                ATT_ISSUE_S(0, 0); if (ntile > 1) ATT_ISSUE_S(1, 1); if (ntile > 2) ATT_ISSUE_S(2, 2);
                const int sw = ql & 7;
                for (int i0 = 0; i0 < ntile; i0 += 4) {
#pragma unroll
                for (int ij = 0; ij < 4; ++ij) { const int i = i0 + ij; if (i < ntile) {
                    if (i + 2 < ntile) asm volatile("s_waitcnt vmcnt(4)" ::: "memory"); else if (i + 1 < ntile) asm volatile("s_waitcnt vmcnt(2)" ::: "memory"); else asm volatile("s_waitcnt vmcnt(0)" ::: "memory");
                    __builtin_amdgcn_s_barrier(); asm volatile("" ::: "memory");
                    if (i + 3 < ntile) ATT_ISSUE_S(i + 3, (ij + 3) & 3);
                    const int ks = ATT_KS(i);
                    const LAS unsigned char* Kc = ring + ij * 16384; const LAS unsigned char* Vc = Kc + 8192;
                    bf16x8 kfr[4][2];
#pragma unroll
                    for (int kt = 0; kt < 4; ++kt)
#pragma unroll
                        for (int c = 0; c < 2; ++c) kfr[kt][c] = *(const LAS bf16x8*)(Kc + (kt * 16 + ql) * 128 + (((c * 4 + kg) ^ sw) << 4));
                    u32x2 vfr[2][4][2];
#pragma unroll
                    for (int kc = 0; kc < 2; ++kc)
#pragma unroll
                        for (int d = 0; d < 4; ++d) { const LAS unsigned char* vr = Vc + (d * 16 + ql) * 128 + (kg & 1) * 8; const int sg = kc * 4 + (kg >> 1);
                            vfr[kc][d][0] = *(const LAS u32x2*)(vr + ((sg ^ sw) << 4)); vfr[kc][d][1] = *(const LAS u32x2*)(vr + (((sg + 2) ^ sw) << 4)); }
                    __builtin_amdgcn_sched_barrier(0);
                    f32x4 Sx[4];
#pragma unroll
                    for (int kt = 0; kt < 4; ++kt) Sx[kt] = __builtin_amdgcn_mfma_f32_16x16x32_bf16(kfr[kt][0], qf[0], (f32x4){0.f, 0.f, 0.f, 0.f}, 0, 0, 0);
#pragma unroll
                    for (int kt = 0; kt < 4; ++kt) Sx[kt] = __builtin_amdgcn_mfma_f32_16x16x32_bf16(kfr[kt][1], qf[1], Sx[kt], 0, 0, 0);
                    const int nblk = ks >> 8; const bool own = i < nown;
                    const bool keepl = true; (void)own; (void)nblk; (void)s0; (void)s1; (void)s2;
                    if (own && ks + 63 > t0) {
#pragma unroll
                        for (int kt = 0; kt < 4; ++kt)
#pragma unroll
                            for (int jj = 0; jj < 4; ++jj) { const int key = ks + kt * 16 + 4 * kg + jj; Sx[kt][jj] = (key <= tq) ? Sx[kt][jj] : -1e30f; }
                    }
                    float mx = fmaxf(fmaxf(fmaxf(Sx[0][0], Sx[0][1]), fmaxf(Sx[0][2], Sx[0][3])), fmaxf(fmaxf(Sx[1][0], Sx[1][1]), fmaxf(Sx[1][2], Sx[1][3])));
                    mx = fmaxf(mx, fmaxf(fmaxf(fmaxf(Sx[2][0], Sx[2][1]), fmaxf(Sx[2][2], Sx[2][3])), fmaxf(fmaxf(Sx[3][0], Sx[3][1]), fmaxf(Sx[3][2], Sx[3][3]))));
                    mx = keepl ? mx : -1e30f;
                    mx = fmaxf(mx, __shfl_xor(mx, 16)); mx = fmaxf(mx, __shfl_xor(mx, 32));
                    const float mnew = fmaxf(mrun, mx); const float alpha = __builtin_amdgcn_exp2f(mrun - mnew); mrun = mnew;
                    const float moff = keepl ? mnew : 1e30f;
                    float rs = 0.f;
#pragma unroll
                    for (int kt = 0; kt < 4; ++kt)
#pragma unroll
                        for (int jj = 0; jj < 4; ++jj) { const float p = __builtin_amdgcn_exp2f(Sx[kt][jj] - moff); Sx[kt][jj] = p; rs += p; }
                    lrun = lrun * alpha + rs;
#pragma unroll
                    for (int d = 0; d < 4; ++d) O[d] *= alpha;
#pragma unroll
                    for (int kc = 0; kc < 2; ++kc) {
                        u32x4 pw; pw.x = cvt_pk_bf16(Sx[2 * kc][0], Sx[2 * kc][1]); pw.y = cvt_pk_bf16(Sx[2 * kc][2], Sx[2 * kc][3]); pw.z = cvt_pk_bf16(Sx[2 * kc + 1][0], Sx[2 * kc + 1][1]); pw.w = cvt_pk_bf16(Sx[2 * kc + 1][2], Sx[2 * kc + 1][3]);
                        const bf16x8 pb = __builtin_bit_cast(bf16x8, pw);
#pragma unroll
                        for (int d = 0; d < 4; ++d) { u32x4 vw; vw.x = vfr[kc][d][0].x; vw.y = vfr[kc][d][0].y; vw.z = vfr[kc][d][1].x; vw.w = vfr[kc][d][1].y;
                            O[d] = __builtin_amdgcn_mfma_f32_16x16x32_bf16(__builtin_bit_cast(bf16x8, vw), pb, O[d], 0, 0, 0); }
                    }
                } } }
                lrun += __shfl_xor(lrun, 16); lrun += __shfl_xor(lrun, 32);
#undef ATT_KS
#undef ATT_ISSUE_S
                { float* pp = PART + ((size_t)(tq * 8 + h) * 4 + 3) * 36;
#pragma unroll
                  for (int d = 0; d < 4; ++d) { u32x2 w; w.x = cvt_pk_bf16(O[d][0], O[d][1]); w.y = cvt_pk_bf16(O[d][2], O[d][3]); *(u32x2*)(pp + d * 8 + 2 * kg) = w; }
                  if (kg == 0) { pp[32] = mrun; pp[33] = lrun; } }
                __syncthreads();
            }
        }
        }
        { int tid = tid0; asm volatile("" : "+v"(tid)); const int lane = tid & 63; (void)lane;
        for (int unit = bid; unit < 512; unit += G) {
            const int c = unit >> 2, h = unit & 3, t0 = c * 64;
            LAS float* qtT = (LAS float*)lds;
            LAS float* ktT = (LAS float*)(lds + 16384);
            LAS float* khS = (LAS float*)(lds + 32768);
            LAS float* vS = (LAS float*)(lds + 49152);
            LAS float* AT = (LAS float*)(lds + 81920);
            LAS float* xgs = (LAS float*)(lds + 98304);
            const bf16_t* pd = P + (size_t)t0 * NINP + PC_D;
            for (int i = tid; i < 1024; i += 512) { const int t = i >> 4, j = i & 15; xgs[i] = bf2f(pd[(size_t)t * NINP + 1024 + j]); }
            for (int i = 0; i < 2; ++i) { const int idx = tid + 512 * i; const int s = idx >> 4, e0 = (idx & 15) * 8; float z[8]; unpack8(*(const u32x4*)(pd + (size_t)s * NINP + 512 + h * 128 + e0), z);
#pragma unroll
                for (int j = 0; j < 8; ++j) vS[s * 128 + e0 + j] = z[j]; }
            __syncthreads();
            { const int t = tid >> 3, dg = (tid & 7) * 8; const float* gw2 = args.in[I_DGW2] + (size_t)l * 16 * 256 + h * 64 + dg; const float* gb = args.in[I_DGB] + l * 256 + h * 64 + dg;
              float a[8];
#pragma unroll
              for (int j = 0; j < 8; ++j) a[j] = gb[j];
              for (int r = 0; r < 16; ++r) { const float xv = xgs[t * 16 + r];
#pragma unroll
                  for (int j = 0; j < 8; ++j) a[j] += xv * gw2[r * 256 + j]; }
#pragma unroll
              for (int j = 0; j < 8; ++j) { const float x = a[j]; const float ls = fminf(x, 0.f) - __logf(1.f + __expf(-fabsf(x))); AT[t * 64 + dg + j] = ls * (1.f / 16.f); } }
            __syncthreads();
            if (tid < 64) { float run = 0.f; for (int t = 0; t < 64; ++t) { run += AT[t * 64 + tid]; AT[t * 64 + tid] = run; } }
            __syncthreads();
            { const int t = tid >> 3, dg = (tid & 7) * 8; float qz[8], kz[8];
              unpack8(*(const u32x4*)(pd + (size_t)t * NINP + h * 64 + dg), qz); unpack8(*(const u32x4*)(pd + (size_t)t * NINP + 256 + h * 64 + dg), kz);
#pragma unroll
              for (int j = 0; j < 8; ++j) { const int d = dg + j; const float cm = AT[t * 64 + d], last = AT[63 * 64 + d];
                  const float qv = qz[j] * 0.125f * __expf(cm); qtT[d * 64 + t] = qv; ktT[d * 64 + t] = kz[j] * __expf(-cm); khS[t * 64 + d] = kz[j] * __expf(last - cm);
                  QT[(size_t)(t0 + t) * 256 + h * 64 + d] = qv;
                  if (t == 63) LAM[(c * 4 + h) * 64 + d] = __expf(last); } }
            __syncthreads();
            if (tid < 256) { const int tq0 = (tid & 15) * 4, sq0 = (tid >> 4) * 4; float a[4][4];
#pragma unroll
                for (int i = 0; i < 4; ++i)
#pragma unroll
                    for (int j = 0; j < 4; ++j) a[i][j] = 0.f;
                for (int d0 = 0; d0 < 64; d0 += 8) { f32x4 qv[8], kv[8];
#pragma unroll
                    for (int q = 0; q < 8; ++q) { qv[q] = *(const LAS f32x4*)(qtT + (d0 + q) * 64 + tq0); kv[q] = *(const LAS f32x4*)(ktT + (d0 + q) * 64 + sq0); }
                    __builtin_amdgcn_sched_barrier(0);
#pragma unroll
                    for (int q = 0; q < 8; ++q)
#pragma unroll
                        for (int i = 0; i < 4; ++i)
#pragma unroll
                            for (int j = 0; j < 4; ++j) a[i][j] += qv[q][i] * kv[q][j];
                    __builtin_amdgcn_sched_barrier(0); }
                asm volatile("" ::: "memory");
#pragma unroll
                for (int j = 0; j < 4; ++j) { f32x4 o;
#pragma unroll
                    for (int i = 0; i < 4; ++i) o[i] = (sq0 + j <= tq0 + i) ? a[i][j] : 0.f;
                    *(LAS f32x4*)(AT + (sq0 + j) * 64 + tq0) = o; } }
            __syncthreads();
            { const int x0 = (tid & 15) * 4, e0 = (tid >> 4) * 4; float o[4][4], u[4][4];
#pragma unroll
              for (int i = 0; i < 4; ++i)
#pragma unroll
                  for (int j = 0; j < 4; ++j) { o[i][j] = 0.f; u[i][j] = 0.f; }
              for (int s0 = 0; s0 < 64; s0 += 4) { f32x4 av[4], kv[4], vv[4];
#pragma unroll
                  for (int q = 0; q < 4; ++q) { av[q] = *(const LAS f32x4*)(AT + (s0 + q) * 64 + x0); kv[q] = *(const LAS f32x4*)(khS + (s0 + q) * 64 + x0); vv[q] = *(const LAS f32x4*)(vS + (s0 + q) * 128 + e0); }
                  __builtin_amdgcn_sched_barrier(0);
#pragma unroll
                  for (int q = 0; q < 4; ++q)
#pragma unroll
                      for (int i = 0; i < 4; ++i)
#pragma unroll
                          for (int j = 0; j < 4; ++j) { o[i][j] += av[q][i] * vv[q][j]; u[i][j] += kv[q][i] * vv[q][j]; }
                  __builtin_amdgcn_sched_barrier(0); }
#pragma unroll
              for (int i = 0; i < 4; ++i) { *(f32x4*)(OI + (size_t)(t0 + x0 + i) * 512 + h * 128 + e0) = (f32x4){o[i][0], o[i][1], o[i][2], o[i][3]};
                  *(f32x4*)(GU + ((size_t)(c * 4 + h) * 64 + x0 + i) * 128 + e0) = (f32x4){u[i][0], u[i][1], u[i][2], u[i][3]}; } }
            __syncthreads();
        }
        }
        { int tid = tid0; asm volatile("" : "+v"(tid)); const int lane = tid & 63; (void)lane;
        { const int wu = bid * 8 + wave; if (wu < 2048) {
            const int h = wu >> 8, c = (wu >> 1) & 127, kind = wu & 1; const size_t tb = (size_t)h * SEQ + c * 64;
            LAS float* buf = (LAS float*)(lds + wave * 10240);
            const f32x4* src = (const f32x4*)(VEC5 + tb * 320);
            const float* vsrc = VV + tb * 64 + lane;
            f32x2 St[32];
            { const f32x4* si = (const f32x4*)(IDZ + kind * 4096 + lane * 64);
#pragma unroll
              for (int k4 = 0; k4 < 16; ++k4) { const f32x4 v = si[k4]; St[2 * k4] = RWKV_LO(v); St[2 * k4 + 1] = RWKV_HI(v); } }
            float vn[4];
#pragma unroll
            for (int j = 0; j < 5; ++j) __builtin_amdgcn_global_load_lds((const unsigned*)(src + j * 64 + lane), (LAS unsigned*)(buf + j * 256), 16, 0, 0);
            const float vsc = kind ? 1.f : 0.f;
#pragma unroll
            for (int j = 0; j < 4; ++j) vn[j] = vsrc[j * 64];
            asm volatile("s_waitcnt vmcnt(0)" ::: "memory");
            for (int b = 0; b < 16; ++b) {
                const float vc0 = vn[0], vc1 = vn[1], vc2 = vn[2], vc3 = vn[3];
                if (b + 1 < 16) { LAS float* nb = buf + ((b + 1) & 1) * 1280;
#pragma unroll
                    for (int j = 0; j < 5; ++j) __builtin_amdgcn_global_load_lds((const unsigned*)(src + (b + 1) * 320 + j * 64 + lane), (LAS unsigned*)(nb + j * 256), 16, 0, 0);
#pragma unroll
                    for (int j = 0; j < 4; ++j) vn[j] = vsrc[((b + 1) * 4 + j) * 64];
                }
                const LAS float* cb = buf + (b & 1) * 1280;
#pragma unroll 1
                for (int s = 0; s < 4; ++s) {
                    const LAS float* st = cb + s * 320;
                    const float vi = (s == 0 ? vc0 : (s == 1 ? vc1 : (s == 2 ? vc2 : vc3))) * vsc;
                    float yy; RWKV_STEP(st, vi, St, false, true, yy); (void)yy;
                }
                asm volatile("s_waitcnt vmcnt(0)" ::: "memory");
            }
            f32x4* po = (f32x4*)((kind ? LCH : PCH) + ((size_t)(h * 128 + c) * 64 + lane) * 64);
#pragma unroll
            for (int k4 = 0; k4 < 16; ++k4) po[k4] = (f32x4){St[2 * k4].x, St[2 * k4].y, St[2 * k4 + 1].x, St[2 * k4 + 1].y};
        }
        }
        }
        fast_barrier(BAR, ++bar_epoch, (unsigned)G);
        { int tid = tid0; asm volatile("" : "+v"(tid)); const int lane = tid & 63; (void)lane;
        if (bid < 64) {
            const int h = bid >> 3, rg = bid & 7;
            LAS float* Pb = (LAS float*)lds;
            LAS float* Sb = (LAS float*)(lds + 32768);
            if (wave < 4) {
                const int rl = wave * 2 + (lane >> 5), cl = 2 * (lane & 31); const int row = rg * 8 + rl;
                float zz = 0.f; asm volatile("" : "+v"(zz)); const f32x2 z2 = (f32x2){zz, zz};
                const float* Pg = PCH + (size_t)(h * 128) * 4096; const float* Lg = LCH + (size_t)(h * 128) * 4096 + row * 64 + cl;
                f32x4 pq[4][4]; f32x2 lnq[4];
                { const f32x4* ps = (const f32x4*)Pg + tid * 4;
#pragma unroll
                  for (int q = 0; q < 4; ++q) *(LAS f32x4*)(Pb + tid * 16 + q * 4) = ps[q]; }
#pragma unroll
                for (int p = 1; p <= 4; ++p) { const f32x4* ps = (const f32x4*)(Pg + (size_t)p * 4096) + tid * 4;
#pragma unroll
                    for (int q = 0; q < 4; ++q) pq[p & 3][q] = ps[q]; }
#pragma unroll
                for (int q = 0; q < 4; ++q) lnq[q] = *(const f32x2*)(Lg + (size_t)q * 4096);
                *(LAS f32x2*)(Sb + rl * 64 + cl) = z2;
                f32x2 sv = z2;
                asm volatile("s_waitcnt lgkmcnt(0)" ::: "memory"); __builtin_amdgcn_s_barrier(); asm volatile("" ::: "memory");
                for (int c0 = 0; c0 < 128; c0 += 4) {
#pragma unroll
                    for (int ci = 0; ci < 4; ++ci) {
                        const int c = c0 + ci;
                        const LAS float* Pc = Pb + (c & 1) * 4096; const LAS float* Sc = Sb + (c & 1) * 512 + rl * 64;
                        *(f32x2*)(SIN + (size_t)(h * 128 + c) * 4096 + row * 64 + cl) = sv;
                        f32x2 a0 = lnq[ci], a1 = z2;
                        { const int cn = c + 4 < 128 ? c + 4 : 127; lnq[ci] = *(const f32x2*)(Lg + (size_t)cn * 4096); }
                        f32x4 sr_[16]; f32x2 pr_[2][16];
#pragma unroll
                        for (int q = 0; q < 16; ++q) sr_[q] = *(const LAS f32x4*)(Sc + q * 4);
#pragma unroll
                        for (int q = 0; q < 16; ++q) pr_[0][q] = *(const LAS f32x2*)(Pc + q * 64 + cl);
#pragma unroll
                        for (int g = 0; g < 4; ++g) {
                            if (g + 1 < 4) {
#pragma unroll
                                for (int q = 0; q < 16; ++q) pr_[(g + 1) & 1][q] = *(const LAS f32x2*)(Pc + ((g + 1) * 16 + q) * 64 + cl); }
                            __builtin_amdgcn_sched_barrier(0);
#pragma unroll
                            for (int q = 0; q < 16; q += 2) { const int k = g * 16 + q; a0 += sr_[k >> 2][k & 3] * pr_[g & 1][q]; a1 += sr_[(k + 1) >> 2][(k + 1) & 3] * pr_[g & 1][q + 1]; }
                            __builtin_amdgcn_sched_barrier(0);
                        }
                        sv = a0 + a1;
                        *(LAS f32x2*)(Sb + ((c + 1) & 1) * 512 + rl * 64 + cl) = sv;
                        { LAS float* Pn = Pb + ((c + 1) & 1) * 4096 + tid * 16;
#pragma unroll
                          for (int q = 0; q < 4; ++q) *(LAS f32x4*)(Pn + q * 4) = pq[(ci + 1) & 3][q]; }
                        { const int cn = c + 5 < 128 ? c + 5 : 127; const f32x4* ps = (const f32x4*)(Pg + (size_t)cn * 4096) + tid * 4;
#pragma unroll
                          for (int q = 0; q < 4; ++q) pq[(ci + 1) & 3][q] = ps[q]; }
                        asm volatile("s_waitcnt lgkmcnt(0)" ::: "memory"); __builtin_amdgcn_s_barrier(); asm volatile("" ::: "memory");
                    }
                }
            } else {
                for (int c = 0; c < 129; ++c) { __builtin_amdgcn_s_barrier(); asm volatile("" ::: "memory"); }
            }
        } else if (bid < 128) {
            const int idx = (bid - 64) * 512 + tid; float S = 0.f;
            for (int c0 = 0; c0 < 128; c0 += 16) { float u[16], lam[16];
#pragma unroll
                for (int i = 0; i < 16; ++i) { u[i] = GU[(size_t)(c0 + i) * 32768 + idx]; lam[i] = LAM[(c0 + i) * 256 + (idx >> 7)]; }
#pragma unroll
                for (int i = 0; i < 16; ++i) { GU[(size_t)(c0 + i) * 32768 + idx] = S; S = lam[i] * S + u[i]; } }
        } else if (G >= 256) {
            convert_layer_weights(args, ws, l, (LAS float*)(lds + wave * 16896), (bid - 128) * 8 + wave, (G - 128) * 8, lane, 3968, 9600);
        }
        }
        { int tid = tid0; asm volatile("" : "+v"(tid)); const int lane = tid & 63; (void)lane;
        for (;;) {
            __syncthreads();
            if (tid == 0) *(LAS int*)(lds + 36864 + 4096 + 64) = (int)__hip_atomic_fetch_add(BAR + 1024 + 64 * l, 1u, __ATOMIC_RELAXED, __HIP_MEMORY_SCOPE_AGENT);
            __syncthreads();
            const int u = *(LAS int*)(lds + 36864 + 4096 + 64);
            if (u >= 1088) break;
            const int h = u & 7; int n = 0, r = 0;
            { int rem = u >> 3; for (n = 0; n < 31; ++n) { const int cn = 8 - ((n + 1) >> 2); if (rem < cn) { r = ((n + 1) >> 2) + rem; break; } rem -= cn; } }
            LAS int* listS = (LAS int*)(lds + 36864);
            LAS int* wcnt = (LAS int*)(lds + 36864 + 4096);
            LAS unsigned char* ring = lds + 49152;
            const int lrow = tid >> 3, lseg = (tid & 7) ^ (lrow & 7);
            const bf16_t* kgp = KB + (size_t)(n * 256 + lrow) * 512 + h * 64 + lseg * 8; const bf16_t* vgp = VT + (size_t)(h * 64 + lrow) * SEQ + n * 256 + lseg * 8;
#pragma unroll
            for (int j = 0; j < 4; ++j) { LAS unsigned char* tb_ = ring + j * 16384 + wave * 1024;
                __builtin_amdgcn_global_load_lds((const unsigned*)(kgp + (size_t)j * 64 * 512), (LAS unsigned*)tb_, 16, 0, 0);
                __builtin_amdgcn_global_load_lds((const unsigned*)(vgp + j * 64), (LAS unsigned*)(tb_ + 8192), 16, 0, 0); }
            int myslot[2], mypre[2];
#pragma unroll
            for (int p = 0; p < 2; ++p) { const int t = r * 1024 + p * 512 + tid; const int sv = SEL[h * SEQ + t];
                const int sl = ((sv & 255) == n) ? 0 : ((((sv >> 8) & 255) == n) ? 1 : ((((sv >> 16) & 255) == n) ? 2 : -1));
                const unsigned long long bal = __ballot(sl >= 0);
                myslot[p] = sl; mypre[p] = __popcll(bal & ((1ull << lane) - 1ull));
                if (lane == 0) wcnt[p * 8 + wave] = __popcll(bal); }
            __syncthreads();
            int cnt = 0, base0 = 0, base1 = 0;
#pragma unroll
            for (int q = 0; q < 16; ++q) { const int c = wcnt[q]; if (q == wave) base0 = cnt; if (q == 8 + wave) base1 = cnt; cnt += c; }
            if (myslot[0] >= 0) listS[base0 + mypre[0]] = ((r * 1024 + tid) << 2) | myslot[0];
            if (myslot[1] >= 0) listS[base1 + mypre[1]] = ((r * 1024 + 512 + tid) << 2) | myslot[1];
            asm volatile("s_waitcnt vmcnt(0)" ::: "memory");
            __syncthreads();
            const int ql = lane & 15, kg = lane >> 4, sw = ql & 7;
            for (int ch = 0; ch * 128 < cnt; ++ch) {
                const int e = ch * 128 + wave * 16 + ql; const bool has = e < cnt; const int ent = listS[has ? e : 0]; const int tq = ent >> 2, slot = ent & 3;
                bf16x8 qf[2];
                qf[0] = *(const bf16x8*)(QB + (size_t)tq * 512 + h * 64 + kg * 8); qf[1] = *(const bf16x8*)(QB + (size_t)tq * 512 + h * 64 + 32 + kg * 8);
                float mrun = -1e30f, lrun = 0.f; f32x4 O[4];
#pragma unroll
                for (int d = 0; d < 4; ++d) O[d] = (f32x4){0.f, 0.f, 0.f, 0.f};
#pragma unroll
                for (int ij = 0; ij < 4; ++ij) {
                    const LAS unsigned char* Kc = ring + ij * 16384; const LAS unsigned char* Vc = Kc + 8192;
                    bf16x8 kfr[4][2];
#pragma unroll
                    for (int kt = 0; kt < 4; ++kt)
#pragma unroll
                        for (int c = 0; c < 2; ++c) kfr[kt][c] = *(const LAS bf16x8*)(Kc + (kt * 16 + ql) * 128 + (((c * 4 + kg) ^ sw) << 4));
                    u32x2 vfr[2][4][2];
#pragma unroll
                    for (int kc = 0; kc < 2; ++kc)
#pragma unroll
                        for (int d = 0; d < 4; ++d) { const LAS unsigned char* vr = Vc + (d * 16 + ql) * 128 + (kg & 1) * 8; const int sg = kc * 4 + (kg >> 1);
                            vfr[kc][d][0] = *(const LAS u32x2*)(vr + ((sg ^ sw) << 4)); vfr[kc][d][1] = *(const LAS u32x2*)(vr + (((sg + 2) ^ sw) << 4)); }
                    __builtin_amdgcn_sched_barrier(0);
                    f32x4 Sx[4];
#pragma unroll
                    for (int kt = 0; kt < 4; ++kt) Sx[kt] = __builtin_amdgcn_mfma_f32_16x16x32_bf16(kfr[kt][0], qf[0], (f32x4){0.f, 0.f, 0.f, 0.f}, 0, 0, 0);
#pragma unroll
                    for (int kt = 0; kt < 4; ++kt) Sx[kt] = __builtin_amdgcn_mfma_f32_16x16x32_bf16(kfr[kt][1], qf[1], Sx[kt], 0, 0, 0);
                    float mx = fmaxf(fmaxf(fmaxf(Sx[0][0], Sx[0][1]), fmaxf(Sx[0][2], Sx[0][3])), fmaxf(fmaxf(Sx[1][0], Sx[1][1]), fmaxf(Sx[1][2], Sx[1][3])));
                    mx = fmaxf(mx, fmaxf(fmaxf(fmaxf(Sx[2][0], Sx[2][1]), fmaxf(Sx[2][2], Sx[2][3])), fmaxf(fmaxf(Sx[3][0], Sx[3][1]), fmaxf(Sx[3][2], Sx[3][3]))));
                    mx = fmaxf(mx, __shfl_xor(mx, 16)); mx = fmaxf(mx, __shfl_xor(mx, 32));
                    const float mnew = fmaxf(mrun, mx); const float alpha = __builtin_amdgcn_exp2f(mrun - mnew); mrun = mnew;
                    float rs = 0.f;
#pragma unroll
                    for (int kt = 0; kt < 4; ++kt)
#pragma unroll
                        for (int jj = 0; jj < 4; ++jj) { const float p = __builtin_amdgcn_exp2f(Sx[kt][jj] - mnew); Sx[kt][jj] = p; rs += p; }
                    lrun = lrun * alpha + rs;
#pragma unroll
                    for (int d = 0; d < 4; ++d) O[d] *= alpha;
#pragma unroll
                    for (int kc = 0; kc < 2; ++kc) {
                        u32x4 pw; pw.x = cvt_pk_bf16(Sx[2 * kc][0], Sx[2 * kc][1]); pw.y = cvt_pk_bf16(Sx[2 * kc][2], Sx[2 * kc][3]); pw.z = cvt_pk_bf16(Sx[2 * kc + 1][0], Sx[2 * kc + 1][1]); pw.w = cvt_pk_bf16(Sx[2 * kc + 1][2], Sx[2 * kc + 1][3]);
                        const bf16x8 pb = __builtin_bit_cast(bf16x8, pw);
#pragma unroll
                        for (int d = 0; d < 4; ++d) { u32x4 vw; vw.x = vfr[kc][d][0].x; vw.y = vfr[kc][d][0].y; vw.z = vfr[kc][d][1].x; vw.w = vfr[kc][d][1].y;
                            O[d] = __builtin_amdgcn_mfma_f32_16x16x32_bf16(__builtin_bit_cast(bf16x8, vw), pb, O[d], 0, 0, 0); }
                    }
                }
                lrun += __shfl_xor(lrun, 16); lrun += __shfl_xor(lrun, 32);
                if (has) { float* pp = PART + ((size_t)(tq * 8 + h) * 4 + slot) * 36;
#pragma unroll
                    for (int d = 0; d < 4; ++d) { u32x2 w; w.x = cvt_pk_bf16(O[d][0], O[d][1]); w.y = cvt_pk_bf16(O[d][2], O[d][3]); *(u32x2*)(pp + d * 8 + 2 * kg) = w; }
                    if (kg == 0) { pp[32] = mrun; pp[33] = lrun; } }
            }
            __syncthreads();
        }
        }
        fast_barrier(BAR, ++bar_epoch, (unsigned)G);
        { int tid = tid0; asm volatile("" : "+v"(tid)); const int lane = tid & 63; (void)lane;
        for (int unit = bid; unit < 512; unit += G) {
            const int c = unit >> 2, h = unit & 3, t0 = c * 64;
            LAS float* qtT = (LAS float*)lds;
            LAS float* Sd = (LAS float*)(lds + 16384);
            LAS float* red = (LAS float*)(lds + 49152);
            for (int i = 0; i < 8; ++i) { const int idx = tid + 512 * i; const int t = idx >> 6, d = idx & 63; qtT[d * 64 + t] = QT[(size_t)(t0 + t) * 256 + h * 64 + d]; }
            { const f32x4* ss = (const f32x4*)(GU + (size_t)(c * 4 + h) * 8192);
#pragma unroll
              for (int i = 0; i < 4; ++i) *(LAS f32x4*)(Sd + (tid + 512 * i) * 4) = ss[tid + 512 * i]; }
            __syncthreads();
            const int x0 = (tid & 15) * 4, e0 = (tid >> 4) * 4; float o[4][4];
#pragma unroll
            for (int i = 0; i < 4; ++i) { const f32x4 v = *(const f32x4*)(OI + (size_t)(t0 + x0 + i) * 512 + h * 128 + e0); o[i][0] = v[0]; o[i][1] = v[1]; o[i][2] = v[2]; o[i][3] = v[3]; }
            for (int d0 = 0; d0 < 64; d0 += 8) { f32x4 qv[8], sv[8];
#pragma unroll
                for (int q = 0; q < 8; ++q) { qv[q] = *(const LAS f32x4*)(qtT + (d0 + q) * 64 + x0); sv[q] = *(const LAS f32x4*)(Sd + (d0 + q) * 128 + e0); }
                __builtin_amdgcn_sched_barrier(0);
#pragma unroll
                for (int q = 0; q < 8; ++q)
#pragma unroll
                    for (int i = 0; i < 4; ++i)
#pragma unroll
                        for (int j = 0; j < 4; ++j) o[i][j] += qv[q][i] * sv[q][j];
                __builtin_amdgcn_sched_barrier(0); }
#pragma unroll
            for (int i = 0; i < 4; ++i) red[(x0 + i) * 32 + (tid >> 4)] = (o[i][0] * o[i][0] + o[i][1] * o[i][1]) + (o[i][2] * o[i][2] + o[i][3] * o[i][3]);
            __syncthreads();
            const float* ng = args.in[I_DNG] + l * 128 + e0;
#pragma unroll
            for (int i = 0; i < 4; ++i) { const int t = t0 + x0 + i; float s = 0.f;
#pragma unroll
                for (int j = 0; j < 8; ++j) { const f32x4 v = *(const LAS f32x4*)(red + (x0 + i) * 32 + j * 4); s += (v[0] + v[1]) + (v[2] + v[3]); }
                const float rs = rsqrtf(s * (1.f / 128.f) + EPS);
                const bf16_t* og = P + (size_t)t * NINP + PC_D + 1040 + h * 128 + e0; const u32x2 raw = *(const u32x2*)og;
                const float g0 = bflo(raw.x), g1 = bfhi(raw.x), g2 = bflo(raw.y), g3 = bfhi(raw.y);
                const float y0 = o[i][0] * rs * ng[0] * (g0 * sigmoidf_(g0)), y1 = o[i][1] * rs * ng[1] * (g1 * sigmoidf_(g1)), y2 = o[i][2] * rs * ng[2] * (g2 * sigmoidf_(g2)), y3 = o[i][3] * rs * ng[3] * (g3 * sigmoidf_(g3));
                u32x2 w; w.x = cvt_pk_bf16(y0, y1); w.y = cvt_pk_bf16(y2, y3);
                *(u32x2*)(Y + (size_t)t * DM + 1536 + h * 128 + e0) = w; }
            __syncthreads();
        }
        if (wave < 4) {
            __builtin_amdgcn_s_setprio(3);
            const int u = bid * 4 + wave;
            if (u < 1024) {
                const int h = u >> 7, c = u & 127; const size_t tb = (size_t)h * SEQ + c * 64; const int tbase = c * 64;
                LAS float* buf = (LAS float*)(lds + wave * 10240);
                const f32x4* src = (const f32x4*)(VEC5 + tb * 320);
                const float* vsrc = VV + tb * 64 + lane;
                const int ch = h * 64 + lane;
                const float lg = args.in[I_BLNG][l * 512 + ch], lbias = args.in[I_BLNB][l * 512 + ch];
                const float* bvp = BV + (size_t)tbase * 512 + ch; const float* ggp = GG + (size_t)tbase * 512 + ch;
                f32x2 St[32];
                { const f32x4* si = (const f32x4*)(SIN + ((size_t)u * 64 + lane) * 64);
#pragma unroll
                  for (int k4 = 0; k4 < 16; ++k4) { const f32x4 v = si[k4]; St[2 * k4] = RWKV_LO(v); St[2 * k4 + 1] = RWKV_HI(v); } }
                float vn[4];
#pragma unroll
                for (int j = 0; j < 5; ++j) __builtin_amdgcn_global_load_lds((const unsigned*)(src + j * 64 + lane), (LAS unsigned*)(buf + j * 256), 16, 0, 0);
#pragma unroll
                for (int j = 0; j < 4; ++j) vn[j] = vsrc[j * 64];
                asm volatile("s_waitcnt vmcnt(0)" ::: "memory");
                for (int b = 0; b < 16; ++b) {
                    const float vc0 = vn[0], vc1 = vn[1], vc2 = vn[2], vc3 = vn[3];
                    float bvc[4], ggc[4];
#pragma unroll
                    for (int j = 0; j < 4; ++j) { bvc[j] = bvp[(b * 4 + j) * 512]; ggc[j] = ggp[(b * 4 + j) * 512]; }
                    float yv0 = 0.f, yv1 = 0.f, yv2 = 0.f, yv3 = 0.f;
                    if (b + 1 < 16) { LAS float* nb = buf + ((b + 1) & 1) * 1280;
#pragma unroll
                        for (int j = 0; j < 5; ++j) __builtin_amdgcn_global_load_lds((const unsigned*)(src + (b + 1) * 320 + j * 64 + lane), (LAS unsigned*)(nb + j * 256), 16, 0, 0);
#pragma unroll
                        for (int j = 0; j < 4; ++j) vn[j] = vsrc[((b + 1) * 4 + j) * 64];
                    }
                    const LAS float* cb = buf + (b & 1) * 1280;
#pragma unroll 1
                    for (int s = 0; s < 4; ++s) {
                        const LAS float* st = cb + s * 320;
                        const float vi = s == 0 ? vc0 : (s == 1 ? vc1 : (s == 2 ? vc2 : vc3));
                        float yy; RWKV_STEP(st, vi, St, true, true, yy);
                        yv0 = s == 0 ? yy : yv0; yv1 = s == 1 ? yy : yv1; yv2 = s == 2 ? yy : yv2; yv3 = s == 3 ? yy : yv3;
                    }
                    asm volatile("s_waitcnt vmcnt(0)" ::: "memory");
                    const float yv[4] = {yv0, yv1, yv2, yv3};
                    float st8[8] = {yv[0], yv[1], yv[2], yv[3], yv[0] * yv[0], yv[1] * yv[1], yv[2] * yv[2], yv[3] * yv[3]};
                    wave_sum_n<8>(st8);
#pragma unroll
                    for (int s = 0; s < 4; ++s) { const int t = tbase + b * 4 + s;
                        const float m = st8[s] * (1.f / 64.f); const float var = fmaxf(st8[4 + s] * (1.f / 64.f) - m * m, 0.f);
                        const float yn = (yv[s] - m) * rsqrtf(var + 64e-5f) * lg + lbias;
                        Y[(size_t)t * DM + 512 + ch] = f2bf((yn + bvc[s]) * ggc[s]); }
                }
            }
            __builtin_amdgcn_s_setprio(0);
        } else {
            for (int t = bid * 4 + (wave - 4); t < SEQ; t += G * 4) {
            const int h = lane >> 3, dg = (lane & 7) * 8; const int qb = t >> 8; const int nv = qb < 3 ? qb : 3;
            const float* pp = PART + ((size_t)(t * 8 + h) * 4) * 36;
            const float m3 = pp[3 * 36 + 32], l3 = pp[3 * 36 + 33];
            float mk[3], lk[3]; float M = m3;
#pragma unroll
            for (int q = 0; q < 3; ++q) { mk[q] = q < nv ? pp[q * 36 + 32] : -1e30f; lk[q] = q < nv ? pp[q * 36 + 33] : 0.f; M = fmaxf(M, mk[q]); }
            const float w3 = __builtin_amdgcn_exp2f(m3 - M); float L = w3 * l3;
            float acc8[8];
            { float z[8]; unpack8(*(const u32x4*)(pp + 3 * 36 + (dg >> 1)), z);
#pragma unroll
              for (int e = 0; e < 8; ++e) acc8[e] = z[e] * w3; }
#pragma unroll
            for (int q = 0; q < 3; ++q) if (q < nv) { const float wq = __builtin_amdgcn_exp2f(mk[q] - M); L += wq * lk[q];
                float z[8]; unpack8(*(const u32x4*)(pp + q * 36 + (dg >> 1)), z);
#pragma unroll
                for (int e = 0; e < 8; ++e) acc8[e] += z[e] * wq; }
            const f32x4 a0 = (f32x4){acc8[0], acc8[1], acc8[2], acc8[3]}, a1 = (f32x4){acc8[4], acc8[5], acc8[6], acc8[7]};
            const float il = 1.f / L;
            u32x4 w; w.x = cvt_pk_bf16(a0[0] * il, a0[1] * il); w.y = cvt_pk_bf16(a0[2] * il, a0[3] * il); w.z = cvt_pk_bf16(a1[0] * il, a1[1] * il); w.w = cvt_pk_bf16(a1[2] * il, a1[3] * il);
            *(u32x4*)(Y + (size_t)t * DM + 1024 + h * 64 + dg) = w;
        }
            if (G >= 256) {
            LAS float* scr = (LAS float*)(lds + 49152 + (wave - 4) * 16896);
            convert_layer_weights(args, ws, l, scr, bid * 4 + (wave - 4), G * 4, lane, 9600, 12416);
            if (l == 0) convert_layer_weights(args, ws, 1, scr, bid * 4 + (wave - 4), G * 4, lane, 0, 3968);
            }
        }
        }
        fast_barrier(BAR, ++bar_epoch, (unsigned)G);
        { int tid = tid0; asm volatile("" : "+v"(tid)); const int lane = tid & 63; (void)lane;
        {
            pg8::Gemm g{Y, (const bf16_t*)(wt + WT_OUT), SEQ, DM, DM, 256}; pg8::StaticOrder S; S.init(SEQ, DM, G, bid);
            pg8::EpiResid E{l == 0 ? args.in[I_X] : (const float*)XR, XR, XB, SSQ, lds};
            pg8::gemm_phase<pg8::EpiResid>(lds, g, S, E);
        }
        }
        fast_barrier(BAR, ++bar_epoch, (unsigned)G);
        { int tid = tid0; asm volatile("" : "+v"(tid)); const int lane = tid & 63; (void)lane;
        {
            pg8::Gemm g{XB, (const bf16_t*)(wt + WT_UP), 33 * 256, NUP, DM, 254}; pg8::StaticOrder S; S.init(33 * 256, NUP, G, bid);
            pg8::EpiConvSwiGLU E{ACT, SSQ, args.in[I_CONVW] + (size_t)l * 3 * NUP, args.in[I_CONVB] + (size_t)l * NUP};
            pg8::Unit uu;
            for (int i = 0; S.next(i, uu); ++i) { pg8::OneUnit one{uu}; pg8::gemm_phase<pg8::EpiConvSwiGLU, pg8::OneUnit>(lds, g, one, E); }
        }
        }
        fast_barrier(BAR, ++bar_epoch, (unsigned)G);
        { int tid = tid0; asm volatile("" : "+v"(tid)); const int lane = tid & 63; (void)lane;
        {
            pg8::Gemm g{ACT, (const bf16_t*)(wt + WT_DOWN), SEQ, DM, DFF, 256}; pg8::StaticOrder S; S.init(SEQ, DM, G, bid);
            pg8::EpiResid E{(const float*)XR, XR, XB, SSQ, lds};
            pg8::gemm_phase<pg8::EpiResid>(lds, g, S, E);
        }
        }
        fast_barrier(BAR, ++bar_epoch, (unsigned)G);
    }
        { int tid = tid0; asm volatile("" : "+v"(tid)); const int lane = tid & 63; (void)lane;
    {
        const float* fg = args.in[I_FING];
        for (int row = gw; row < SEQ; row += NGW) {
            float s = SSQ[(size_t)row * 8 + (lane & 7)]; s = wave_sum(s) * 0.125f;
            const float rs = rsqrtf(s * (1.f / 2048.f) + EPS);
            f32x4* xr = (f32x4*)(XR + (size_t)row * DM) + lane; const f32x4* gp = (const f32x4*)fg + lane;
#pragma unroll
            for (int j = 0; j < 8; ++j) { f32x4 v = xr[64 * j]; const f32x4 gv = gp[64 * j]; v = v * rs * gv; xr[64 * j] = v; }
        }
    }
        }
}

extern "C" void kernel_launch(void* const* d_in, const int* in_sizes, int n_in, void* d_out, int out_size, void* d_ws, size_t ws_size, hipStream_t stream) {
    static int grid = 0;
    if (grid == 0) {
        if (n_in != 28 || ws_size < WS_END) { fprintf(stderr, "kernel_launch: unexpected n_in %d / ws_size %zu\n", n_in, ws_size); grid = -1; return; }
        int dev = 0, cus = 0, per_cu = 0;
        hipGetDevice(&dev); hipDeviceGetAttribute(&cus, hipDeviceAttributeMultiprocessorCount, dev);
        hipFuncSetAttribute((const void*)mega_fwd, hipFuncAttributeMaxDynamicSharedMemorySize, LDS_BYTES);
        hipOccupancyMaxActiveBlocksPerMultiprocessor(&per_cu, (const void*)mega_fwd, 512, LDS_BYTES);
        if (per_cu < 1) { fprintf(stderr, "kernel_launch: occupancy query says %d blocks/CU\n", per_cu); per_cu = 1; }
        grid = cus * (per_cu > 1 ? 1 : per_cu);
    }
    if (grid < 0) return;
    (void)hipMemsetAsync(d_ws, 0, 8192, stream);
    Args a{};
    for (int i = 0; i < 28; ++i) a.in[i] = (const float*)d_in[i];
    a.out = (float*)d_out; a.ws = (unsigned char*)d_ws;
    void* kargs[] = {&a};
    hipError_t e = hipLaunchCooperativeKernel((const void*)mega_fwd, dim3(grid), dim3(512), kargs, LDS_BYTES, stream);
    if (e != hipSuccess) fprintf(stderr, "cooperative launch failed: %s (grid %d)\n", hipGetErrorString(e), grid);
}
```
